# Optimizing an MI355X kernel written in HIP

```python
import math
import jax, jax.numpy as jnp
from jax import lax
import numpy as np

D_MODEL = 2048
BATCH = 1
SEQ = 16384
DEPTH = 2

N_MIXERS = 2
N_GLA_LAYERS = (DEPTH + 1) // 2
N_CONV_LAYERS = DEPTH // 2
EPS = 1e-6

GLA_HEADS = 4
GLA_KD = D_MODEL // 2
GLA_VD = D_MODEL
GLA_DK = GLA_KD // GLA_HEADS
GLA_DV = GLA_VD // GLA_HEADS
GATE_RANK = 16
GATE_NORMALIZER = 16.0
GLA_CHUNK = 64
GLA_IN = 2 * GLA_KD + 2 * GLA_VD + GATE_RANK

CONV_WIDTH = 3

N_GROUPS = 4
EXPERTS_PER_GROUP = 8
N_EXPERTS = N_GROUPS * EXPERTS_PER_GROUP
TOP_K = 2
D_FF_EXPERT = D_MODEL // 4
ROW_BLOCK = 128

kernel_name = "hybrid_gla_shortconv_hmoe"


def rmsnorm(x, w):
    xf = x.astype(jnp.float32)
    xf = xf * lax.rsqrt(jnp.mean(xf * xf, axis=-1, keepdims=True) + EPS)
    return (xf * w.astype(jnp.float32)).astype(x.dtype)


def gla_mixer(xn, w_in, w_gk2, b_gk, head_norm, w_out):
    B, T, _ = xn.shape
    nc = T // GLA_CHUNK
    proj = xn @ w_in
    q, k, v, g, gl = jnp.split(
        proj, [GLA_KD, 2 * GLA_KD, 2 * GLA_KD + GLA_VD, 2 * GLA_KD + 2 * GLA_VD], axis=-1)
    log_a = jax.nn.log_sigmoid((gl @ w_gk2 + b_gk).astype(jnp.float32)) / GATE_NORMALIZER

    def to_chunks(t, d):
        return t.astype(jnp.float32).reshape(B, nc, GLA_CHUNK, GLA_HEADS, d).transpose(1, 0, 3, 2, 4)

    qc = to_chunks(q, GLA_DK) * (GLA_DK ** -0.5)
    kc = to_chunks(k, GLA_DK)
    vc = to_chunks(v, GLA_DV)
    gc = to_chunks(log_a, GLA_DK)
    causal = jnp.tril(jnp.ones((GLA_CHUNK, GLA_CHUNK), dtype=bool))

    def step(S, inp):
        qb, kb, vb, gb = inp
        b = jnp.cumsum(gb, axis=-2)
        o_inter = jnp.einsum('bhcd,bhdv->bhcv', qb * jnp.exp(b), S)
        diff = b[:, :, :, None, :] - b[:, :, None, :, :]
        decay = jnp.exp(jnp.where(causal[None, None, :, :, None], diff, -jnp.inf))
        A = jnp.einsum('bhid,bhjd,bhijd->bhij', qb, kb, decay)
        o = o_inter + jnp.einsum('bhij,bhjv->bhiv', A, vb)
        b_last = b[:, :, -1:, :]
        S = jnp.exp(b_last[:, :, 0, :])[..., None] * S + jnp.einsum(
            'bhjd,bhjv->bhdv', kb * jnp.exp(b_last - b), vb)
        return S, o

    S0 = jnp.zeros((B, GLA_HEADS, GLA_DK, GLA_DV), jnp.float32)
    _, o = lax.scan(step, S0, (qc, kc, vc, gc))
    o = o.transpose(1, 0, 3, 2, 4).reshape(B, T, GLA_HEADS, GLA_DV)
    o = o * lax.rsqrt(jnp.mean(o * o, axis=-1, keepdims=True) + EPS) * head_norm.astype(jnp.float32)
    o = o.reshape(B, T, GLA_VD).astype(xn.dtype) * jax.nn.silu(g)
    return o @ w_out


def conv_mixer(xn, w_in, conv_w, w_out):
    bg, cg, h = jnp.split(xn @ w_in, 3, axis=-1)
    u = cg * h
    up = jnp.pad(u, ((0, 0), (CONV_WIDTH - 1, 0), (0, 0)))
    T = u.shape[1]
    conv = conv_w[0] * up[:, 0:T] + conv_w[1] * up[:, 1:T + 1] + conv_w[2] * up[:, 2:T + 2]
    return (bg * conv) @ w_out


def hier_moe(xn, w_group, b_group, w_router, b_router, w_gate_up, w_down):
    N, D = xn.shape
    group_probs = jax.nn.softmax((xn @ w_group + b_group).astype(jnp.float32), axis=-1)
    top_gp, top_g = lax.top_k(group_probs, 1)
    exp_logits = (xn @ w_router + b_router).astype(jnp.float32).reshape(N, N_GROUPS, EXPERTS_PER_GROUP)
    sel = jnp.take_along_axis(exp_logits, top_g[:, :, None], axis=1)[:, 0]
    top_ep, top_e = lax.top_k(jax.nn.softmax(sel, axis=-1), TOP_K)
    top_ep = top_ep / jnp.sum(top_ep, axis=-1, keepdims=True)
    gates = (top_gp * top_ep).reshape(-1)
    ids = (top_g * EXPERTS_PER_GROUP + top_e).reshape(-1).astype(jnp.int32)
    tok = jnp.repeat(jnp.arange(N, dtype=jnp.int32), TOP_K)

    NK = N * TOP_K
    n_blocks = -(-(NK + N_EXPERTS * (ROW_BLOCK - 1)) // ROW_BLOCK)
    P = n_blocks * ROW_BLOCK
    order = jnp.argsort(ids)
    sorted_ids = ids[order]
    counts = jnp.bincount(ids, length=N_EXPERTS)
    padded = ((counts + ROW_BLOCK - 1) // ROW_BLOCK) * ROW_BLOCK
    starts = jnp.cumsum(counts) - counts
    pends = jnp.cumsum(padded)
    pstarts = pends - padded
    dest = pstarts[sorted_ids] + (jnp.arange(NK, dtype=jnp.int32) - starts[sorted_ids])
    row_tok = jnp.zeros((P,), jnp.int32).at[dest].set(tok[order])
    row_w = jnp.zeros((P,), jnp.float32).at[dest].set(gates[order])
    block_exp = jnp.minimum(
        jnp.searchsorted(pends, jnp.arange(n_blocks, dtype=jnp.int32) * ROW_BLOCK, side='right'),
        N_EXPERTS - 1)
    xs = xn[row_tok].reshape(n_blocks, ROW_BLOCK, D)

    def expert_block(args):
        xb, e = args
        gt, up = jnp.split(xb @ w_gate_up[e], 2, axis=-1)
        return (jax.nn.silu(gt) * up) @ w_down[e]

    yb = lax.map(expert_block, (xs, block_exp)).reshape(P, D)
    return jax.ops.segment_sum(yb * row_w[:, None].astype(yb.dtype), row_tok, num_segments=N)


def setup_inputs(seed: int = 0) -> dict:
    key = jax.random.key(seed)
    ks = jax.random.split(key, 20)
    n = jax.random.normal
    D, F = D_MODEL, D_FF_EXPERT
    return {
        "x": n(ks[0], (BATCH, SEQ, D), jnp.float32),
        "mix_norm": 1.0 + 0.02 * n(ks[1], (DEPTH, D), jnp.float32),
        "gla_w_in": n(ks[2], (N_GLA_LAYERS, D, GLA_IN), jnp.float32) * D ** -0.5,
        "gla_w_gk2": n(ks[3], (N_GLA_LAYERS, GATE_RANK, GLA_KD), jnp.float32) * GATE_RANK ** -0.5,
        "gla_b_gk": 0.1 * n(ks[4], (N_GLA_LAYERS, GLA_KD), jnp.float32),
        "gla_head_norm": 1.0 + 0.02 * n(ks[5], (N_GLA_LAYERS, GLA_DV), jnp.float32),
        "gla_w_out": n(ks[6], (N_GLA_LAYERS, GLA_VD, D), jnp.float32) * GLA_VD ** -0.5,
        "conv_w_in": n(ks[7], (N_CONV_LAYERS, D, 3 * D), jnp.float32) * D ** -0.5,
        "conv_w": n(ks[8], (N_CONV_LAYERS, CONV_WIDTH, D), jnp.float32) * CONV_WIDTH ** -0.5,
        "conv_w_out": n(ks[9], (N_CONV_LAYERS, D, D), jnp.float32) * D ** -0.5,
        "ffn_norm": 1.0 + 0.02 * n(ks[10], (DEPTH, D), jnp.float32),
        "w_group": n(ks[11], (DEPTH, D, N_GROUPS), jnp.float32) * D ** -0.5,
        "b_group": 0.01 * n(ks[12], (DEPTH, N_GROUPS), jnp.float32),
        "w_router": n(ks[13], (DEPTH, D, N_EXPERTS), jnp.float32) * D ** -0.5,
        "b_router": 0.01 * n(ks[14], (DEPTH, N_EXPERTS), jnp.float32),
        "w_gate_up": n(ks[15], (DEPTH, N_EXPERTS, D, 2 * F), jnp.float32) * D ** -0.5,
        "w_down": n(ks[16], (DEPTH, N_EXPERTS, F, D), jnp.float32) * F ** -0.5,
        "final_norm": 1.0 + 0.02 * n(ks[17], (D,), jnp.float32),
    }


def reference(x, mix_norm, gla_w_in, gla_w_gk2, gla_b_gk, gla_head_norm, gla_w_out,
              conv_w_in, conv_w, conv_w_out, ffn_norm, w_group, b_group, w_router, b_router,
              w_gate_up, w_down, final_norm):
    B, T, D = x.shape
    h = x
    for i in range(DEPTH):
        j = i // N_MIXERS
        hn = rmsnorm(h, mix_norm[i])
        if i % N_MIXERS == 0:
            m = gla_mixer(hn, gla_w_in[j], gla_w_gk2[j], gla_b_gk[j], gla_head_norm[j], gla_w_out[j])
        else:
            m = conv_mixer(hn, conv_w_in[j], conv_w[j], conv_w_out[j])
        h = h + m
        hn = rmsnorm(h, ffn_norm[i]).reshape(B * T, D)
        h = h + hier_moe(hn, w_group[i], b_group[i], w_router[i], b_router[i],
                         w_gate_up[i], w_down[i]).reshape(B, T, D)
    return rmsnorm(h, final_norm)
```

```cpp
#include <hip/hip_runtime.h>
#include <cstdio>
#include <cstdint>

#ifndef MK_N_LAUNCHES
#define MK_N_LAUNCHES 1
#endif

namespace pg8 {
#define PG8_LAS __attribute__((address_space(3)))
typedef unsigned short bf16_t;
typedef short bf16x8 __attribute__((ext_vector_type(8)));
typedef float f32x4 __attribute__((ext_vector_type(4)));
typedef unsigned u32x4 __attribute__((ext_vector_type(4)));
constexpr int BM = 256, BK = 64, HALF = 128, HTB = HALF * BK * 2, STAGE_BYTES = 8 * HTB, NXCD = 8, WGM = 8;

__host__ __device__ __forceinline__ int lds_byte(int r, int c) { const int st = (r >> 4) * 2 + (c >> 5), rr = r & 15, cc = c & 31, ob = rr * 64 + cc * 2; return st * 1024 + (ob ^ (((ob >> 9) & 1) << 5)); }
__host__ __device__ __forceinline__ void stage_rc(int b, int& R, int& C) { const int st = b / 1024, sb = b % 1024, swz = sb ^ (((sb >> 9) & 1) << 5); R = (st >> 1) * 16 + swz / 64; C = (st & 1) * 32 + (swz % 64) / 2; }
__host__ __device__ __forceinline__ int perm32(int rho) { const int n = rho >> 4, i = rho & 15; return 8 * (i >> 2) + 4 * n + (i & 3); }

struct Unit { int pm, pn; size_t boff; };
struct Gemm { const bf16_t* A; const bf16_t* Bt; int M, N, K; };

struct StaticOrder {
    int nM, nN, nwg, G, c;
    __host__ __device__ void init(int M, int N, int G_, int c_) { nM = M / BM; nN = N / BM; nwg = nM * nN; G = G_; c = c_; }
    __host__ __device__ bool next(int i, Unit& u) const {
        const long L = (long)i * G + c; if (L >= nwg) return false;
        int wgid = (int)L; { const int q = nwg / NXCD, r = nwg % NXCD, xcd = wgid % NXCD, off = wgid / NXCD; wgid = (xcd < r ? xcd * (q + 1) : r * (q + 1) + (xcd - r) * q) + off; }
        const int nig = WGM * nN, gid = wgid / nig, fm = gid * WGM, gsz = (nM - fm) < WGM ? (nM - fm) : WGM;
        u.pm = fm + ((wgid % nig) % gsz); u.pn = (wgid % nig) / gsz; u.boff = 0; return true;
    }
    __device__ __forceinline__ void a_ready(const Unit&) const {}
    __device__ __forceinline__ void done(const Unit&) const {}
};
struct MoeOrder {
    int nrt, NT, nwg, G, c; size_t estride; const volatile PG8_LAS int* tile_exp;
    __device__ __forceinline__ bool next(int i, Unit& u) const {
        const long L = (long)i * G + c; if (L >= nwg) return false;
        int wgid = (int)L; { const int q = nwg / NXCD, r = nwg % NXCD, xcd = wgid % NXCD, off = wgid / NXCD; wgid = (xcd < r ? xcd * (q + 1) : r * (q + 1) + (xcd - r) * q) + off; }
        u.pm = wgid / NT; u.pn = wgid % NT;
        const int e = __builtin_amdgcn_readfirstlane(tile_exp[u.pm]);
        u.boff = (size_t)e * estride; return true;
    }
    __device__ __forceinline__ void a_ready(const Unit&) const {}
    __device__ __forceinline__ void done(const Unit&) const {}
};

__device__ __forceinline__ unsigned cvt_pk_bf16(float lo, float hi) { unsigned r; asm volatile("v_cvt_pk_bf16_f32 %0, %1, %2" : "=v"(r) : "v"(lo), "v"(hi)); return r; }
__device__ __forceinline__ u32x4 pack8(const f32x4& v0, const f32x4& v1) { u32x4 w; w.x = cvt_pk_bf16(v0[0], v0[1]); w.y = cvt_pk_bf16(v0[2], v0[3]); w.z = cvt_pk_bf16(v1[0], v1[1]); w.w = cvt_pk_bf16(v1[2], v1[3]); return w; }
__device__ __forceinline__ float fexp(float x) { return __builtin_amdgcn_exp2f(x * 1.44269504089f); }
__device__ __forceinline__ float silu_f(float x) { return x * __builtin_amdgcn_rcpf(1.0f + fexp(-x)); }

struct EpiRes {
    static constexpr bool PERM = false, AFTER_DRAIN = false;
    const float* base; float* out; int ldc;
    __device__ __forceinline__ void operator()(const f32x4 (&acc)[2][2][4][2], const Unit& u, int wr, int wc, int fr, int fq) const {
        const int row0 = u.pm * BM + wr * 64 + fr, col0 = u.pn * BM + wc * 32 + 4 * fq;
#pragma unroll
        for (int ai = 0; ai < 2; ++ai)
#pragma unroll
            for (int m = 0; m < 4; ++m) { const size_t off = (size_t)(row0 + ai * HALF + m * 16) * ldc + col0;
#pragma unroll
                for (int bj = 0; bj < 2; ++bj)
#pragma unroll
                    for (int n = 0; n < 2; ++n) { const f32x4 bs = *(const f32x4*)(base + off + bj * HALF + n * 16); *(f32x4*)(out + off + bj * HALF + n * 16) = bs + acc[ai][bj][m][n]; } }
    }
};
struct EpiGlaIn {
    static constexpr bool PERM = true, AFTER_DRAIN = false;
    bf16_t *Qp, *Kp, *Vb, *Gb; const float* Bc;
    __device__ __forceinline__ void operator()(const f32x4 (&acc)[2][2][4][2], const Unit& u, int wr, int wc, int fr, int fq) const {
        const int row0 = u.pm * BM + wr * 64 + fr, cl = wc * 32 + 8 * fq, ct = u.pn;
        if (ct < 8) {
            const bool isq = ct < 4; const int cb = (ct & 3) * 256 + cl; bf16_t* dst = isq ? Qp : Kp; const float sgn = isq ? 1.0f : -1.0f, mul = isq ? 0.0625f : 1.0f;
#pragma unroll
            for (int ai = 0; ai < 2; ++ai)
#pragma unroll
                for (int m = 0; m < 4; ++m) { const size_t ro = (size_t)(row0 + ai * HALF + m * 16) * 1024;
#pragma unroll
                    for (int bj = 0; bj < 2; ++bj) { const int c = cb + bj * HALF; const f32x4 b0 = *(const f32x4*)(Bc + ro + c), b1 = *(const f32x4*)(Bc + ro + c + 4);
                        f32x4 v0 = acc[ai][bj][m][0], v1 = acc[ai][bj][m][1];
#pragma unroll
                        for (int j = 0; j < 4; ++j) { v0[j] *= fexp(sgn * b0[j]) * mul; v1[j] *= fexp(sgn * b1[j]) * mul; }
                        *(u32x4*)(dst + ro + c) = pack8(v0, v1); } }
        } else if (ct < 16) {
            const int cb = (ct - 8) * 256 + cl;
#pragma unroll
            for (int ai = 0; ai < 2; ++ai)
#pragma unroll
                for (int m = 0; m < 4; ++m) { const size_t ro = (size_t)(row0 + ai * HALF + m * 16) * 2048;
#pragma unroll
                    for (int bj = 0; bj < 2; ++bj) *(u32x4*)(Vb + ro + cb + bj * HALF) = pack8(acc[ai][bj][m][0], acc[ai][bj][m][1]); }
        } else {
            const int cb = (ct - 16) * 256 + cl;
#pragma unroll
            for (int ai = 0; ai < 2; ++ai)
#pragma unroll
                for (int m = 0; m < 4; ++m) { const size_t ro = (size_t)(row0 + ai * HALF + m * 16) * 2048;
#pragma unroll
                    for (int bj = 0; bj < 2; ++bj) { f32x4 v0 = acc[ai][bj][m][0], v1 = acc[ai][bj][m][1];
#pragma unroll
                        for (int j = 0; j < 4; ++j) { v0[j] = silu_f(v0[j]); v1[j] = silu_f(v1[j]); }
                        *(u32x4*)(Gb + ro + cb + bj * HALF) = pack8(v0, v1); } }
        }
    }
};
struct EpiConvIn {
    static constexpr bool PERM = true, AFTER_DRAIN = false;
    bf16_t *BG, *U;
    __device__ __forceinline__ void operator()(const f32x4 (&acc)[2][2][4][2], const Unit& u, int wr, int wc, int fr, int fq) const {
        const int row0 = u.pm * BM + wr * 64 + fr, cl = wc * 32 + 8 * fq, ct = u.pn;
        if (ct < 8) {
            const int cb = ct * 256 + cl;
#pragma unroll
            for (int ai = 0; ai < 2; ++ai)
#pragma unroll
                for (int m = 0; m < 4; ++m) { const size_t ro = (size_t)(row0 + ai * HALF + m * 16) * 2048;
#pragma unroll
                    for (int bj = 0; bj < 2; ++bj) *(u32x4*)(BG + ro + cb + bj * HALF) = pack8(acc[ai][bj][m][0], acc[ai][bj][m][1]); }
        } else {
            const int cb = (ct - 8) * 128 + cl;
#pragma unroll
            for (int ai = 0; ai < 2; ++ai)
#pragma unroll
                for (int m = 0; m < 4; ++m) { const size_t ro = (size_t)(row0 + ai * HALF + m * 16) * 2048;
                    *(u32x4*)(U + ro + cb) = pack8(acc[ai][0][m][0] * acc[ai][1][m][0], acc[ai][0][m][1] * acc[ai][1][m][1]); }
        }
    }
};
struct EpiGateUp {
    static constexpr bool PERM = true, AFTER_DRAIN = false;
    bf16_t* ACT;
    __device__ __forceinline__ void operator()(const f32x4 (&acc)[2][2][4][2], const Unit& u, int wr, int wc, int fr, int fq) const {
        const int row0 = u.pm * BM + wr * 64 + fr, cb = u.pn * 128 + wc * 32 + 8 * fq;
#pragma unroll
        for (int ai = 0; ai < 2; ++ai)
#pragma unroll
            for (int m = 0; m < 4; ++m) { const size_t ro = (size_t)(row0 + ai * HALF + m * 16) * 512;
                f32x4 v0 = acc[ai][0][m][0], v1 = acc[ai][0][m][1];
#pragma unroll
                for (int j = 0; j < 4; ++j) { v0[j] = silu_f(v0[j]) * acc[ai][1][m][0][j]; v1[j] = silu_f(v1[j]) * acc[ai][1][m][1][j]; }
                *(u32x4*)(ACT + ro + cb) = pack8(v0, v1); }
    }
};
struct EpiDown {
    static constexpr bool PERM = true, AFTER_DRAIN = false;
    bf16_t* Y; const float* rgate;
    __device__ __forceinline__ void operator()(const f32x4 (&acc)[2][2][4][2], const Unit& u, int wr, int wc, int fr, int fq) const {
        const int row0 = u.pm * BM + wr * 64 + fr, cb = u.pn * 256 + wc * 32 + 8 * fq;
#pragma unroll
        for (int ai = 0; ai < 2; ++ai)
#pragma unroll
            for (int m = 0; m < 4; ++m) { const int row = row0 + ai * HALF + m * 16; const float g = rgate[row]; const size_t ro = (size_t)row * 2048;
#pragma unroll
                for (int bj = 0; bj < 2; ++bj) *(u32x4*)(Y + ro + cb + bj * HALF) = pack8(acc[ai][bj][m][0] * g, acc[ai][bj][m][1] * g); }
    }
};

template <class Epi, class Sched, bool ALIGN_EPI = false, bool SP2 = false>
__device__ __forceinline__ void gemm_phase(PG8_LAS unsigned char* lds, const Gemm g, const Sched& S, const Epi& E) {
    const int tid = threadIdx.x, wid = __builtin_amdgcn_readfirstlane(tid >> 6), lane = tid & 63, wr = wid >> 2, wc = wid & 3, fr = lane & 15, fq = lane >> 4;
    const int K = g.K, nt = K / BK;
    unsigned voffA[2], voffB[2];
#pragma unroll
    for (int i = 0; i < 2; ++i) { int R, C; stage_rc(tid * 16 + i * 8192, R, C); const int Rb = Epi::PERM ? ((R & ~31) + perm32(R & 31)) : R;
        voffA[i] = (unsigned)(R * K + C) * 2u; voffB[i] = (unsigned)(Rb * K + C) * 2u; }
    const size_t kstep = (size_t)(BK * 2);
    const size_t hstep = (size_t)HALF * K * 2;
    const size_t tstep = 2 * hstep;
    const unsigned ldsw = (unsigned)wid * 1024u;
    const int aoff = lds_byte(wr * 64 + fr, fq * 8), boff = lds_byte(wc * 32 + fr, fq * 8);
#define PG8_SA(b, h) (((b) * 2 + (h)) * HTB)
#define PG8_SB(b, h) ((4 + (b) * 2 + (h)) * HTB)
#define PG8_STAGE(bufoff, gbase, voff) do { _Pragma("unroll") for (int _i = 0; _i < 2; ++_i) \
        __builtin_amdgcn_global_load_lds((const unsigned*)((const char*)(gbase) + (voff)[_i]), (PG8_LAS unsigned*)(lds + (bufoff) + ldsw + _i * 8192), 16, 0, 0); } while (0)
#define PG8_LDA(dst, b, h) do { _Pragma("unroll") for (int m = 0; m < 4; ++m) _Pragma("unroll") for (int k = 0; k < 2; ++k) dst[m][k] = *(const PG8_LAS bf16x8*)(lds + PG8_SA(b, h) + aoff + m * 2048 + k * 1024); } while (0)
#define PG8_LDB(dst, b, h) do { _Pragma("unroll") for (int n = 0; n < 2; ++n) _Pragma("unroll") for (int k = 0; k < 2; ++k) dst[n][k] = *(const PG8_LAS bf16x8*)(lds + PG8_SB(b, h) + boff + n * 2048 + k * 1024); } while (0)
#define PG8_MMA(ai, bj, At, Bt) do { __builtin_amdgcn_s_setprio(1); _Pragma("unroll") for (int m = 0; m < 4; ++m) _Pragma("unroll") for (int n = 0; n < 2; ++n) _Pragma("unroll") for (int k = 0; k < 2; ++k) \
        acc[ai][bj][m][n] = __builtin_amdgcn_mfma_f32_16x16x32_bf16(Bt[n][k], At[m][k], acc[ai][bj][m][n], 0, 0, 0); __builtin_amdgcn_s_setprio(0); } while (0)
#define PG8_WAIT_V(n) asm volatile("s_waitcnt vmcnt(" #n ")" ::: "memory")
#define PG8_WAIT_L(n) asm volatile("s_waitcnt lgkmcnt(" #n ")" ::: "memory")
#define PG8_BAR __builtin_amdgcn_s_barrier()
#define PG8_SCHED __builtin_amdgcn_sched_barrier(0)
    Unit cur, nxt; int ui = 0;
    if (!S.next(0, cur)) return;
    f32x4 acc[2][2][4][2];
#pragma unroll
    for (int a = 0; a < 2; ++a)
#pragma unroll
        for (int b = 0; b < 2; ++b)
#pragma unroll
            for (int m = 0; m < 4; ++m)
#pragma unroll
                for (int n = 0; n < 2; ++n) acc[a][b][m][n] = (f32x4){0.f, 0.f, 0.f, 0.f};
    bf16x8 At[4][2], B0[2][2], B1[2][2];
    const char* cA = (const char*)g.A + (size_t)cur.pm * tstep; const char* cB = (const char*)g.Bt + cur.boff + (size_t)cur.pn * tstep;
    S.a_ready(cur);
    if constexpr (SP2) {
        PG8_STAGE(PG8_SB(0, 0), cB, voffB); PG8_STAGE(PG8_SB(0, 1), cB + hstep, voffB); PG8_STAGE(PG8_SA(0, 0), cA, voffA); PG8_STAGE(PG8_SA(0, 1), cA + hstep, voffA);
        if (wr == 1) PG8_BAR;
        PG8_WAIT_V(2); PG8_BAR;
        PG8_STAGE(PG8_SB(1, 0), cB + kstep, voffB); PG8_STAGE(PG8_SA(1, 0), cA + kstep, voffA); PG8_STAGE(PG8_SB(1, 1), cB + hstep + kstep, voffB);
        PG8_WAIT_V(6); PG8_BAR;
    } else {
        PG8_STAGE(PG8_SB(0, 0), cB, voffB); PG8_STAGE(PG8_SA(0, 0), cA, voffA); PG8_STAGE(PG8_SB(0, 1), cB + hstep, voffB); PG8_STAGE(PG8_SA(0, 1), cA + hstep, voffA);
        if (wr == 1) PG8_BAR;
        PG8_WAIT_V(4); PG8_BAR;
        PG8_STAGE(PG8_SB(1, 0), cB + kstep, voffB); PG8_STAGE(PG8_SA(1, 0), cA + kstep, voffA); PG8_STAGE(PG8_SB(1, 1), cB + hstep + kstep, voffB);
        PG8_WAIT_V(6); PG8_BAR;
    }
    for (;;) {
        const bool has_next = S.next(ui + 1, nxt);
        const char* nA = has_next ? (const char*)g.A + (size_t)nxt.pm * tstep : cA; const char* nB = has_next ? (const char*)g.Bt + nxt.boff + (size_t)nxt.pn * tstep : cB;
        for (int t = 0; t < nt; t += 2) {
            const bool last = (t == nt - 2);
            const char* a1 = cA + (size_t)(t + 1) * kstep;
            const char* a2 = last ? nA : cA + (size_t)(t + 2) * kstep; const char* b2 = last ? nB : cB + (size_t)(t + 2) * kstep;
            const char* a3 = a2 + kstep; const char* b3 = b2 + kstep;
            if (last && has_next) S.a_ready(nxt);
            if constexpr (SP2) {
            PG8_LDB(B0, 0, 0); PG8_LDB(B1, 0, 1); PG8_SCHED; PG8_LDA(At, 0, 0); PG8_STAGE(PG8_SA(1, 1), a1 + hstep, voffA);
            PG8_WAIT_V(8); PG8_WAIT_L(0); PG8_BAR; PG8_MMA(0, 0, At, B0); PG8_MMA(0, 1, At, B1); PG8_BAR; PG8_SCHED;
            PG8_LDA(At, 0, 1); PG8_STAGE(PG8_SB(0, 0), b2, voffB); PG8_STAGE(PG8_SB(0, 1), b2 + hstep, voffB); PG8_STAGE(PG8_SA(0, 0), a2, voffA);
            PG8_WAIT_V(8); PG8_WAIT_L(0); PG8_BAR; PG8_MMA(1, 0, At, B0); PG8_MMA(1, 1, At, B1); PG8_BAR; PG8_SCHED;
            PG8_LDB(B0, 1, 0); PG8_LDB(B1, 1, 1); PG8_SCHED; PG8_LDA(At, 1, 0); PG8_STAGE(PG8_SA(0, 1), a2 + hstep, voffA);
            PG8_WAIT_V(8); PG8_WAIT_L(0); PG8_BAR; PG8_MMA(0, 0, At, B0); PG8_MMA(0, 1, At, B1); PG8_BAR; PG8_SCHED;
            PG8_LDA(At, 1, 1); PG8_STAGE(PG8_SB(1, 0), b3, voffB); PG8_STAGE(PG8_SB(1, 1), b3 + hstep, voffB); PG8_STAGE(PG8_SA(1, 0), a3, voffA);
            PG8_WAIT_V(8); PG8_WAIT_L(0); PG8_BAR; PG8_MMA(1, 0, At, B0); PG8_MMA(1, 1, At, B1); PG8_BAR; PG8_SCHED;
            } else {
            PG8_LDB(B0, 0, 0); PG8_SCHED; PG8_LDA(At, 0, 0); PG8_STAGE(PG8_SA(1, 1), a1 + hstep, voffA);
            PG8_WAIT_L(8); PG8_BAR; PG8_WAIT_L(0); PG8_MMA(0, 0, At, B0); PG8_BAR; PG8_SCHED;
            PG8_LDB(B1, 0, 1); PG8_STAGE(PG8_SB(0, 0), b2, voffB);
            PG8_BAR; PG8_WAIT_L(0); PG8_MMA(0, 1, At, B1); PG8_BAR;
            PG8_LDA(At, 0, 1); PG8_STAGE(PG8_SA(0, 0), a2, voffA);
            PG8_BAR; PG8_WAIT_L(0); PG8_MMA(1, 0, At, B0); PG8_BAR; PG8_SCHED;
            PG8_STAGE(PG8_SB(0, 1), b2 + hstep, voffB);
            PG8_WAIT_V(6); PG8_BAR; PG8_MMA(1, 1, At, B1); PG8_BAR;
            PG8_LDB(B0, 1, 0); PG8_SCHED; PG8_LDA(At, 1, 0); PG8_STAGE(PG8_SA(0, 1), a2 + hstep, voffA);
            PG8_WAIT_L(8); PG8_BAR; PG8_WAIT_L(0); PG8_MMA(0, 0, At, B0); PG8_BAR; PG8_SCHED;
            PG8_LDB(B1, 1, 1); PG8_STAGE(PG8_SB(1, 0), b3, voffB);
            PG8_BAR; PG8_WAIT_L(0); PG8_MMA(0, 1, At, B1); PG8_BAR;
            PG8_LDA(At, 1, 1); PG8_STAGE(PG8_SA(1, 0), a3, voffA);
            PG8_BAR; PG8_WAIT_L(0); PG8_MMA(1, 0, At, B0); PG8_BAR; PG8_SCHED;
            PG8_STAGE(PG8_SB(1, 1), b3 + hstep, voffB);
            PG8_WAIT_V(6); PG8_BAR; PG8_MMA(1, 1, At, B1); PG8_BAR;
            }
        }
        if constexpr (ALIGN_EPI) { if (wr == 0) PG8_BAR; }
        if constexpr (!Epi::AFTER_DRAIN) { E(acc, cur, wr, wc, fr, fq); S.done(cur); }
        if (!has_next) break;
#pragma unroll
        for (int a = 0; a < 2; ++a)
#pragma unroll
            for (int b = 0; b < 2; ++b)
#pragma unroll
                for (int m = 0; m < 4; ++m)
#pragma unroll
                    for (int n = 0; n < 2; ++n) acc[a][b][m][n] = (f32x4){0.f, 0.f, 0.f, 0.f};
        cur = nxt; cA = nA; cB = nB; ++ui;
        if constexpr (ALIGN_EPI) { if (wr == 1) PG8_BAR; }
    }
    PG8_WAIT_V(0);
    if constexpr (!ALIGN_EPI) { if (wr == 0) PG8_BAR; }
    PG8_BAR;
#undef PG8_SA
#undef PG8_SB
#undef PG8_STAGE
#undef PG8_LDA
#undef PG8_LDB
#undef PG8_MMA
#undef PG8_WAIT_V
#undef PG8_WAIT_L
#undef PG8_BAR
#undef PG8_SCHED
}
}

constexpr int NWAVES = 8;
constexpr int NPH = 18;
constexpr int N_LAUNCHES = (MK_N_LAUNCHES == 1) ? 1 : NPH;

constexpr int T = 16384, D = 2048;
constexpr int KD = 1024, VD = 2048, GIN = 6160, GINM = 6144, DKH = 256, DVH = 512, NHEAD = 4, CHK = 64, NCHUNK = T / CHK, RANK = 16;
constexpr int NE = 32, FF = 512, NGRP = 4, EPG = 8, NLOG = 48;
constexpr int MAX_RT = 160;
constexpr float EPS = 1e-6f;

constexpr size_t MiB = 1u << 20;
constexpr size_t WS_CTL = 0, CTL_ZERO_BYTES = 65536;
constexpr size_t WS_GL = 1 * MiB;
constexpr size_t WS_TKE = 2 * MiB;
constexpr size_t WS_TKS = WS_TKE + 131072;
constexpr size_t WS_TKG = WS_TKS + 131072;
constexpr size_t WS_RGATE = WS_TKG + 131072;
constexpr size_t WS_LIST = 3 * MiB;
constexpr size_t WS_WRT = 5 * MiB;
constexpr size_t WS_WGI = 8 * MiB;
constexpr size_t WS_WGO = 32 * MiB;
constexpr size_t WS_WCI = 40 * MiB;
constexpr size_t WS_WCO = 64 * MiB;
constexpr size_t WS_WGU = 72 * MiB;
constexpr size_t WS_WDN = 328 * MiB;
constexpr size_t WS_HN = 456 * MiB;
constexpr size_t WS_BC = 520 * MiB;
constexpr size_t WS_QP = 584 * MiB;
constexpr size_t WS_KP = 616 * MiB;
constexpr size_t WS_VB = 648 * MiB;
constexpr size_t WS_GB = 712 * MiB;
constexpr size_t WS_O = 776 * MiB;
constexpr size_t WS_OG = 904 * MiB;
constexpr size_t WS_H1 = 968 * MiB;
constexpr size_t WS_H2 = 1096 * MiB;
constexpr size_t WS_XS = 1224 * MiB;
constexpr size_t WS_ACT = 1384 * MiB;
constexpr size_t WS_Y = 1424 * MiB;
constexpr size_t WS_END = 1584 * MiB;
constexpr int CW_TMO = 0, CW_CODE = 1;
constexpr int CW_BAR = 4096;
constexpr int CW_CNT = 8192;

constexpr int RING_OFF = 0, RING_BYTES = 131072;
constexpr int SCR_OFF = 131072, SCR_BYTES = 8192;
constexpr int MISC_OFF = SCR_OFF + SCR_BYTES;
constexpr int MISC_BYTES = 2048;
constexpr int LDS_BYTES = 147456;
static_assert(MISC_OFF + MISC_BYTES <= LDS_BYTES, "LDS map");
constexpr int MI_PSTART = 16, MI_NRT = 49, MI_TEXP = 64, MI_CNTL = 256, MI_BASEL = 288;

#define GAS __attribute__((address_space(1)))
#define LAS __attribute__((address_space(3)))
typedef unsigned short bf16;
typedef unsigned v4u __attribute__((ext_vector_type(4)));
typedef unsigned v2u __attribute__((ext_vector_type(2)));
typedef float f32x4 __attribute__((ext_vector_type(4)));
typedef GAS unsigned gu32;
#define RLX_AGENT __ATOMIC_RELAXED, __HIP_MEMORY_SCOPE_AGENT
#define LDS_WAIT() asm volatile("s_waitcnt lgkmcnt(0)" ::: "memory")
#define VM_WAIT() asm volatile("s_waitcnt vmcnt(0)" ::: "memory")
__device__ __forceinline__ unsigned f2bf(float f) { unsigned u = __builtin_bit_cast(unsigned, f); return (u + 0x7fffu + ((u >> 16) & 1u)) >> 16; }
__device__ __forceinline__ unsigned pk2(float lo, float hi) { return f2bf(lo) | (f2bf(hi) << 16); }
__device__ __forceinline__ float bflo(unsigned w) { return __uint_as_float(w << 16); }
__device__ __forceinline__ float bfhi(unsigned w) { return __uint_as_float(w & 0xffff0000u); }

#define XB_TMO      128
#define XB_XCNT(j)  (256  + 64 * (j))
#define XB_XSUB(j)  (1280 + 64 * (j))
#define XB_XGEN(j)  (2304 + 64 * (j))
#define XB_TOP      3328
#define XB_TOPGEN   3392
#define XCD_BAR_WORDS 3456
#define XB_SPIN_CAP (1u << 22)
__device__ __forceinline__ unsigned xb_ld(unsigned* p)              { return __hip_atomic_load(p, __ATOMIC_RELAXED, __HIP_MEMORY_SCOPE_AGENT); }
__device__ __forceinline__ unsigned xb_add(unsigned* p, unsigned v) { return __hip_atomic_fetch_add(p, v, __ATOMIC_RELAXED, __HIP_MEMORY_SCOPE_AGENT); }
__device__ __forceinline__ unsigned xb_xcc_id() { return (unsigned)__builtin_amdgcn_s_getreg((3 << 11) | 20) & 0xFu; }
#define XB_SPIN(cond, bar) do { unsigned _sp = 0; while (cond) { __builtin_amdgcn_s_sleep(1); \
    if ((++_sp & 255u) == 0u) { if (xb_ld(&(bar)[XB_TMO])) break; if (_sp > XB_SPIN_CAP) { atomicAdd(&(bar)[XB_TMO], 1u); break; } } } } while (0)
struct XcdBarrier { unsigned* bar; unsigned x; volatile LAS unsigned* st; };
__device__ __forceinline__ XcdBarrier xcd_barrier_post(unsigned* bar, volatile LAS unsigned* st) {
    XcdBarrier b; b.bar = bar; b.x = xb_xcc_id(); b.st = st;
    if (threadIdx.x == 0) (void)xb_add(&bar[XB_XCNT(b.x)], 1u);
    return b;
}
__device__ __forceinline__ void xcd_barrier_complete(unsigned* bar, unsigned x, unsigned& nloc, unsigned& nx) {
    const unsigned G = gridDim.x * gridDim.y * gridDim.z;
    unsigned sum, cnt, mine, sp = 0u;
    for (;;) {
        sum = 0u; cnt = 0u; mine = 0u;
#pragma unroll
        for (unsigned j = 0; j < 16; ++j) { const unsigned c = xb_ld(&bar[XB_XCNT(j)]); sum += c; cnt += (c > 0u) ? 1u : 0u; mine = (j == x) ? c : mine; }
        if (sum == G) break;
        __builtin_amdgcn_s_sleep(1);
        if ((++sp & 255u) == 0u) { if (xb_ld(&bar[XB_TMO])) break; if (sp > XB_SPIN_CAP) { atomicAdd(&bar[XB_TMO], 1u); break; } }
    }
    nloc = mine > 0u ? mine : 1u; nx = cnt > 0u ? cnt : 1u;
}
__device__ __forceinline__ void xcd_barrier(const XcdBarrier& b) {
    asm volatile("s_waitcnt vmcnt(0)" ::: "memory");
    __syncthreads();
    if (threadIdx.x == 0) {
        unsigned* bar = b.bar;
        __builtin_amdgcn_s_waitcnt(0);
        unsigned nloc = b.st[0], nx = b.st[1];
        if (nloc == 0u) { xcd_barrier_complete(bar, b.x, nloc, nx); b.st[0] = nloc; b.st[1] = nx; }
        const unsigned old = xb_add(&bar[XB_XSUB(b.x)], 1u);
        const unsigned gen = old / nloc;
        if (old + 1u == (gen + 1u) * nloc) {
            __builtin_amdgcn_fence(__ATOMIC_RELEASE, "agent");
            asm volatile("s_waitcnt vmcnt(0)" ::: "memory");
            const unsigned og = xb_add(&bar[XB_TOP], 1u);
            const unsigned tg = og / nx;
            if (og + 1u == (tg + 1u) * nx) xb_add(&bar[XB_TOPGEN], 1u);
            else XB_SPIN(xb_ld(&bar[XB_TOPGEN]) == tg, bar);
            __builtin_amdgcn_fence(__ATOMIC_ACQUIRE, "agent");
            xb_add(&bar[XB_XGEN(b.x)], 1u);
            asm volatile("s_waitcnt vmcnt(0)" ::: "memory");
        } else {
            XB_SPIN(xb_ld(&bar[XB_XGEN(b.x)]) == gen, bar);
            __builtin_amdgcn_fence(__ATOMIC_ACQUIRE, "agent");
            asm volatile("s_waitcnt vmcnt(0)" ::: "memory");
        }
    }
    __syncthreads();
}

struct Frame {
    LAS unsigned char* lds;
    volatile LAS int* MISC;
    unsigned* ctl;
    int tid, lane, wave, G;
    __attribute__((address_space(4))) const unsigned char* ka;
};
#define KIN(i) (*(const float* const __attribute__((address_space(4)))*)(F.ka + 8 * (i)))
#define KOUT   (*(float* const __attribute__((address_space(4)))*)(F.ka + 8 * 18))
#define KWS    (*(unsigned char* const __attribute__((address_space(4)))*)(F.ka + 8 * 19))
__device__ __forceinline__ float wave_sum(float v) {
#pragma unroll
    for (int o = 1; o < 64; o <<= 1) v += __shfl_xor(v, o);
    return v;
}

__device__ __forceinline__ void transpose_item(const float* W, int K, int ldw, int ncols, bf16* WT, int destrow0, LAS float* scr, int kb, int nb, int lane) {
    const int k0 = 64 * kb, n0 = 32 * nb; (void)ncols;
#pragma unroll 8
    for (int i = 0; i < 32; ++i) { const int kk = 2 * i + (lane >> 5); scr[kk * 33 + (lane & 31)] = W[(size_t)(k0 + kk) * ldw + n0 + (lane & 31)]; }
    LDS_WAIT(); asm volatile("" ::: "memory");
    const int c = lane & 7;
#pragma unroll
    for (int j = 0; j < 4; ++j) { const int n = (lane >> 3) + 8 * j; const LAS float* s = scr + (8 * c) * 33 + n;
        v4u o; o.x = pk2(s[0 * 33], s[1 * 33]); o.y = pk2(s[2 * 33], s[3 * 33]); o.z = pk2(s[4 * 33], s[5 * 33]); o.w = pk2(s[6 * 33], s[7 * 33]);
        *(v4u*)(WT + (size_t)(destrow0 + n) * K + k0 + 8 * c) = o; }
    LDS_WAIT(); asm volatile("" ::: "memory");
}
__device__ __forceinline__ int conv_in_row(int n) { if (n < 2048) return n; const int s = (n - 2048) >> 11, f = (n - 2048) & 2047; return 2048 + 256 * (f >> 7) + 128 * s + (f & 127); }
__device__ __forceinline__ int gate_up_row(int n) { const int s = n >> 9, f = n & 511; return 256 * (f >> 7) + 128 * s + (f & 127); }

__device__ __forceinline__ void p0_convert(Frame& F) {
    LAS float* scr = (LAS float*)(F.lds + RING_OFF + F.wave * 16384);
    const int gw = blockIdx.x * NWAVES + F.wave, NGW = F.G * NWAVES;
    constexpr int I_GI = 32 * 192, I_GO = 32 * 64, I_CI = 32 * 192, I_CO = 32 * 64, I_GU1 = 32 * 32, I_DN1 = 8 * 64;
    constexpr int I_GU = I_GU1 * 64, I_DN = I_DN1 * 64;
    constexpr int NITEMS = I_GI + I_GO + I_CI + I_CO + I_GU + I_DN;
    bf16* WGI = (bf16*)(KWS + WS_WGI); bf16* WGO = (bf16*)(KWS + WS_WGO); bf16* WCI = (bf16*)(KWS + WS_WCI); bf16* WCO = (bf16*)(KWS + WS_WCO);
    bf16* WGU = (bf16*)(KWS + WS_WGU); bf16* WDN = (bf16*)(KWS + WS_WDN);
    for (int it = gw; it < NITEMS; it += NGW) {
        int r = it;
        if (r < I_GI) { const int kb = r / 192, nb = r % 192; transpose_item(KIN(2), 2048, GIN, GINM, WGI, 32 * nb, scr, kb, nb, F.lane); continue; } r -= I_GI;
        if (r < I_GO) { const int kb = r / 64, nb = r % 64; transpose_item(KIN(6), 2048, 2048, 2048, WGO, 32 * nb, scr, kb, nb, F.lane); continue; } r -= I_GO;
        if (r < I_CI) { const int kb = r / 192, nb = r % 192; transpose_item(KIN(7), 2048, 6144, 6144, WCI, conv_in_row(32 * nb), scr, kb, nb, F.lane); continue; } r -= I_CI;
        if (r < I_CO) { const int kb = r / 64, nb = r % 64; transpose_item(KIN(9), 2048, 2048, 2048, WCO, 32 * nb, scr, kb, nb, F.lane); continue; } r -= I_CO;
        if (r < I_GU) { const int le = r / I_GU1, q = r % I_GU1, kb = q / 32, nb = q % 32;
            transpose_item(KIN(15) + (size_t)le * 2048 * 1024, 2048, 1024, 1024, WGU + (size_t)le * 1024 * 2048, gate_up_row(32 * nb), scr, kb, nb, F.lane); continue; } r -= I_GU;
        { const int le = r / I_DN1, q = r % I_DN1, kb = q / 64, nb = q % 64;
            transpose_item(KIN(16) + (size_t)le * 512 * 2048, 512, 2048, 2048, WDN + (size_t)le * 2048 * 512, 32 * nb, scr, kb, nb, F.lane); }
    }
    float* WRT = (float*)(KWS + WS_WRT);
    for (int i = blockIdx.x * 512 + F.tid; i < 2 * NLOG * 2048; i += F.G * 512) {
        const int l = i / (NLOG * 2048), c = (i / 2048) % NLOG, k = i % 2048;
        float w = 0.f;
        if (c < 4) w = KIN(11)[((size_t)l * 2048 + k) * 4 + c]; else if (c < 36) w = KIN(13)[((size_t)l * 2048 + k) * 32 + (c - 4)];
        WRT[i] = w * KIN(10)[l * 2048 + k];
    }
}

constexpr int WGT_LD = 2052;
__device__ __forceinline__ void p0_norm_gl(Frame& F) {
    LAS float* wgt = (LAS float*)(F.lds);
    LAS float* glc = (LAS float*)(F.lds + 16 * WGT_LD * 4);
    static_assert(16 * WGT_LD * 4 + 64 * 16 * 4 <= MISC_OFF, "p0 LDS");
    const float* w_in = KIN(2);
    for (int idx = F.tid; idx < 2048 * 16; idx += 512) { const int k = idx >> 4, r = idx & 15; wgt[r * WGT_LD + k] = w_in[(size_t)k * GIN + GINM + r]; }
    __syncthreads();
    const float* x = KIN(0); const float* wn = KIN(1); bf16* HN = (bf16*)(KWS + WS_HN); float* BC = (float*)(KWS + WS_BC);
    const float* w2 = KIN(3); const float* bgk = KIN(4);
    for (int ch = blockIdx.x; ch < NCHUNK; ch += F.G) {
        for (int rr = 0; rr < 8; ++rr) {
            const int rl = F.wave * 8 + rr, row = ch * CHK + rl;
            const f32x4* xr = (const f32x4*)(x + (size_t)row * D) + F.lane;
            float s = 0.f;
#pragma unroll
            for (int j = 0; j < 8; ++j) { const f32x4 v = xr[64 * j]; s += (v.x * v.x + v.y * v.y) + (v.z * v.z + v.w * v.w); }
            const float rstd = 1.0f / sqrtf(wave_sum(s) * (1.0f / D) + EPS);
            float ga[16];
#pragma unroll
            for (int r = 0; r < 16; ++r) ga[r] = 0.f;
            v2u* o8 = (v2u*)(HN + (size_t)row * D) + F.lane;
#pragma unroll 1
            for (int j = 0; j < 8; ++j) { const f32x4 w = ((const f32x4*)wn)[F.lane + 64 * j]; const f32x4 v = xr[64 * j] * rstd * w;
                v2u o; o.x = pk2(v.x, v.y); o.y = pk2(v.z, v.w); o8[64 * j] = o;
#pragma unroll
                for (int r = 0; r < 16; ++r) { const f32x4 g = *(const LAS f32x4*)(wgt + r * WGT_LD + 4 * F.lane + 256 * j); ga[r] += (v.x * g.x + v.y * g.y) + (v.z * g.z + v.w * g.w); } }
#pragma unroll
            for (int r = 0; r < 16; ++r) ga[r] = wave_sum(ga[r]);
            if (F.lane == 0) {
#pragma unroll
                for (int r = 0; r < 16; ++r) glc[rl * 16 + r] = ga[r]; }
        }
        __syncthreads();
#pragma unroll
        for (int hh = 0; hh < 2; ++hh) {
            const int c = F.tid + 512 * hh; float w2r[16];
#pragma unroll
            for (int r = 0; r < 16; ++r) w2r[r] = w2[r * KD + c];
            const float bias = bgk[c]; float cum = 0.f;
            for (int t = 0; t < CHK; ++t) {
                float z = bias;
#pragma unroll
                for (int r = 0; r < 16; ++r) z += glc[t * 16 + r] * w2r[r];
                const float ls = fminf(z, 0.f) - log1pf(expf(-fabsf(z)));
                cum += ls * (1.0f / 16.0f);
                BC[(size_t)(ch * CHK + t) * KD + c] = cum;
            }
        }
        __syncthreads();
    }
}

__device__ __forceinline__ void ph_gla_naive(Frame& F) {
    const bf16* QP = (const bf16*)(KWS + WS_QP); const bf16* KP = (const bf16*)(KWS + WS_KP); const bf16* VB = (const bf16*)(KWS + WS_VB);
    const float* BC = (const float*)(KWS + WS_BC); float* O = (float*)(KWS + WS_O);
    for (int u = blockIdx.x; u < 128; u += F.G) {
        const int h = u >> 5, col0 = (u & 31) * 16, ds = F.tid & 31, col = F.tid >> 5;
        float R[8];
#pragma unroll
        for (int i = 0; i < 8; ++i) R[i] = 0.f;
        const bf16* qp = QP + h * DKH + ds * 8; const bf16* kp = KP + h * DKH + ds * 8; const bf16* vp = VB + h * DVH + col0 + col;
        const float* bp = BC + h * DKH + ds * 8; float* op = O + h * DVH + col0 + col;
        for (int t0 = 0; t0 < T; t0 += 8) {
            v4u kk[8], qq[8]; unsigned short vv[8];
#pragma unroll
            for (int j = 0; j < 8; ++j) { kk[j] = *(const v4u*)(kp + (size_t)(t0 + j) * KD); qq[j] = *(const v4u*)(qp + (size_t)(t0 + j) * KD); vv[j] = vp[(size_t)(t0 + j) * VD]; }
#pragma unroll
            for (int j = 0; j < 8; ++j) {
                const float v = __uint_as_float(((unsigned)vv[j]) << 16);
                float po = 0.f;
#pragma unroll
                for (int i = 0; i < 4; ++i) { const unsigned kw = kk[j][i], qw = qq[j][i];
                    R[2 * i] += bflo(kw) * v; R[2 * i + 1] += bfhi(kw) * v; po += bflo(qw) * R[2 * i] + bfhi(qw) * R[2 * i + 1]; }
                po += __shfl_xor(po, 1); po += __shfl_xor(po, 2); po += __shfl_xor(po, 4); po += __shfl_xor(po, 8); po += __shfl_xor(po, 16);
                if (ds == 0) op[(size_t)(t0 + j) * VD] = po;
            }
            if (((t0 + 8) & 63) == 0) { const f32x4 b0 = *(const f32x4*)(bp + (size_t)(t0 + 7) * KD), b1 = *(const f32x4*)(bp + (size_t)(t0 + 7) * KD + 4);
#pragma unroll
                for (int i = 0; i < 4; ++i) { R[i] *= expf(b0[i]); R[4 + i] *= expf(b1[i]); } }
        }
    }
}

__device__ __forceinline__ void ph_headnorm(Frame& F) {
    const float* O = (const float*)(KWS + WS_O); const bf16* GB = (const bf16*)(KWS + WS_GB); bf16* OG = (bf16*)(KWS + WS_OG); const float* hnw = KIN(5);
    const int gw = blockIdx.x * NWAVES + F.wave, NGW = F.G * NWAVES;
    const f32x4 w0 = ((const f32x4*)hnw)[2 * F.lane], w1 = ((const f32x4*)hnw)[2 * F.lane + 1];
    for (int it = gw; it < T * NHEAD; it += NGW) {
        const size_t off = (size_t)(it >> 2) * VD + (it & 3) * DVH + 8 * F.lane;
        const f32x4 a = *(const f32x4*)(O + off), b = *(const f32x4*)(O + off + 4);
        const float ss = wave_sum((a.x * a.x + a.y * a.y) + (a.z * a.z + a.w * a.w) + (b.x * b.x + b.y * b.y) + (b.z * b.z + b.w * b.w));
        const float rstd = 1.0f / sqrtf(ss * (1.0f / DVH) + EPS);
        const v4u g = *(const v4u*)(GB + off);
        v4u o;
        o.x = pk2(a.x * rstd * w0.x * bflo(g.x), a.y * rstd * w0.y * bfhi(g.x)); o.y = pk2(a.z * rstd * w0.z * bflo(g.y), a.w * rstd * w0.w * bfhi(g.y));
        o.z = pk2(b.x * rstd * w1.x * bflo(g.z), b.y * rstd * w1.y * bfhi(g.z)); o.w = pk2(b.z * rstd * w1.z * bflo(g.w), b.w * rstd * w1.w * bfhi(g.w));
        *(v4u*)(OG + off) = o;
    }
}

__device__ __forceinline__ void ph_router(Frame& F, int layer, const float* H) {
    typedef float f32x4v __attribute__((ext_vector_type(4)));
    const float* WRT = (const float*)(KWS + WS_WRT) + (size_t)layer * NLOG * 2048;
    const float* wn = KIN(10) + layer * D; const float* bg = KIN(12) + layer * NGRP; const float* br = KIN(14) + layer * NE;
    bf16* HN = (bf16*)(KWS + WS_HN);
    int* TKE = (int*)(KWS + WS_TKE); int* TKS = (int*)(KWS + WS_TKS); float* TKG = (float*)(KWS + WS_TKG); int* LIST = (int*)(KWS + WS_LIST);
    unsigned* gcnt = F.ctl + CW_CNT + 64 * layer;
    LAS float* lg = (LAS float*)(F.lds + RING_OFF);
    LAS float* rs = (LAS float*)(F.lds + RING_OFF + 64 * 48 * 4);
    LAS int* sel = (LAS int*)(F.lds + RING_OFF + 64 * 48 * 4 + 256);
    LAS float* selg = (LAS float*)(F.lds + RING_OFF + 64 * 48 * 4 + 256 + 1024);
    volatile LAS int* cntl = F.MISC + MI_CNTL; volatile LAS int* basel = F.MISC + MI_BASEL;
    for (int blk = blockIdx.x; blk < T / 64; blk += F.G) {
        if (F.tid < 32) cntl[F.tid] = 0;
        if (F.wave < 4) {
            const int r = F.lane & 15, q = F.lane >> 4, row = blk * 64 + F.wave * 16 + r;
            const float* hp = H + (size_t)row * D + 4 * q;
            const float* wp0 = WRT + (size_t)r * 2048 + 4 * q; const float* wp1 = wp0 + 16 * 2048; const float* wp2 = wp0 + 32 * 2048;
            f32x4v a0 = {0.f, 0.f, 0.f, 0.f}, a1 = a0, a2 = a0; float ss = 0.f;
#pragma unroll 4
            for (int k0 = 0; k0 < D; k0 += 16) {
                const f32x4 a = *(const f32x4*)(hp + k0), b0 = *(const f32x4*)(wp0 + k0), b1 = *(const f32x4*)(wp1 + k0), b2 = *(const f32x4*)(wp2 + k0);
                ss += (a.x * a.x + a.y * a.y) + (a.z * a.z + a.w * a.w);
#pragma unroll
                for (int s = 0; s < 4; ++s) { a0 = __builtin_amdgcn_mfma_f32_16x16x4f32(a[s], b0[s], a0, 0, 0, 0); a1 = __builtin_amdgcn_mfma_f32_16x16x4f32(a[s], b1[s], a1, 0, 0, 0); a2 = __builtin_amdgcn_mfma_f32_16x16x4f32(a[s], b2[s], a2, 0, 0, 0); }
            }
            ss += __shfl_xor(ss, 16); ss += __shfl_xor(ss, 32);
            const float rstd = 1.0f / sqrtf(ss * (1.0f / D) + EPS);
            if (q == 0) rs[F.wave * 16 + r] = rstd;
#pragma unroll
            for (int j = 0; j < 4; ++j) { const int rl = F.wave * 16 + 4 * q + j; lg[rl * 48 + r] = a0[j]; lg[rl * 48 + 16 + r] = a1[j]; lg[rl * 48 + 32 + r] = a2[j]; }
        }
        __syncthreads();
        if (F.tid < 64) {
            const int rl = F.tid; const float rstd = rs[rl]; const LAS float* L = lg + rl * 48;
            float gl0 = L[0] * rstd + bg[0]; int g = 0; float gv[4]; gv[0] = gl0;
#pragma unroll
            for (int j = 1; j < 4; ++j) { gv[j] = L[j] * rstd + bg[j]; if (gv[j] > gl0) { gl0 = gv[j]; g = j; } }
            float den = 0.f;
#pragma unroll
            for (int j = 0; j < 4; ++j) den += expf(gv[j] - gl0);
            const float gp = 1.0f / den;
            float l1 = -3.0e38f, l2 = -3.0e38f; int e1 = 0, e2 = 0;
            for (int j = 0; j < 8; ++j) { const float v = L[4 + 8 * g + j] * rstd + br[8 * g + j];
                if (v > l1) { l2 = l1; e2 = e1; l1 = v; e1 = j; } else if (v > l2) { l2 = v; e2 = j; } }
            const float ex = expf(l2 - l1), p1 = 1.0f / (1.0f + ex), p2 = ex * p1;
            const int E0 = 8 * g + e1, E1 = 8 * g + e2;
            sel[rl * 4 + 0] = E0; sel[rl * 4 + 1] = E1;
            sel[rl * 4 + 2] = __hip_atomic_fetch_add((LAS int*)&cntl[E0], 1, __ATOMIC_RELAXED, __HIP_MEMORY_SCOPE_WORKGROUP); sel[rl * 4 + 3] = __hip_atomic_fetch_add((LAS int*)&cntl[E1], 1, __ATOMIC_RELAXED, __HIP_MEMORY_SCOPE_WORKGROUP);
            selg[rl * 2 + 0] = gp * p1; selg[rl * 2 + 1] = gp * p2;
        }
        __syncthreads();
        if (F.tid < 32) basel[F.tid] = (int)__hip_atomic_fetch_add(gcnt + F.tid, (unsigned)cntl[F.tid], RLX_AGENT);
        __syncthreads();
        if (F.tid < 128) {
            const int rl = F.tid >> 1, k = F.tid & 1, tk = (blk * 64 + rl) * 2 + k, e = sel[rl * 4 + k], slot = basel[e] + sel[rl * 4 + 2 + k];
            TKE[tk] = e; TKS[tk] = slot; TKG[tk] = selg[rl * 2 + k]; LIST[e * T + slot] = tk;
        }
        for (int rr = 0; rr < 8; ++rr) {
            const int rl = F.wave * 8 + rr, row = blk * 64 + rl; const float rstd = rs[rl];
            const f32x4* xr = (const f32x4*)(H + (size_t)row * D) + F.lane; v2u* o8 = (v2u*)(HN + (size_t)row * D) + F.lane;
#pragma unroll
            for (int j = 0; j < 8; ++j) { const f32x4 v = xr[64 * j] * rstd * ((const f32x4*)wn)[F.lane + 64 * j]; v2u o; o.x = pk2(v.x, v.y); o.y = pk2(v.z, v.w); o8[64 * j] = o; }
        }
        __syncthreads();
    }
}

__device__ __forceinline__ void moe_meta(Frame& F, int layer) {
    __syncthreads();
    if (F.tid == 0) {
        const unsigned* gcnt = F.ctl + CW_CNT + 64 * layer; int p = 0, nt = 0;
        for (int e = 0; e < NE; ++e) { const int c = (int)__hip_atomic_load(gcnt + e, RLX_AGENT); F.MISC[MI_PSTART + e] = p; const int tl = (c + 255) >> 8;
            for (int j = 0; j < tl; ++j) F.MISC[MI_TEXP + nt + j] = e; nt += tl; p += tl * 256; }
        F.MISC[MI_PSTART + NE] = p; F.MISC[MI_NRT] = nt;
    }
    __syncthreads();
}

__device__ __forceinline__ void ph_gather(Frame& F, int layer) {
    const bf16* HN = (const bf16*)(KWS + WS_HN); bf16* XS = (bf16*)(KWS + WS_XS); const int* LIST = (const int*)(KWS + WS_LIST);
    const float* TKG = (const float*)(KWS + WS_TKG); float* RG = (float*)(KWS + WS_RGATE); const unsigned* gcnt = F.ctl + CW_CNT + 64 * layer;
    const int nrows = F.MISC[MI_NRT] * 256, gw = blockIdx.x * NWAVES + F.wave, NGW = F.G * NWAVES;
    for (int r = gw; r < nrows; r += NGW) {
        const int e = F.MISC[MI_TEXP + (r >> 8)], slot = r - F.MISC[MI_PSTART + e], cnt = (int)__hip_atomic_load(gcnt + e, RLX_AGENT);
        const bool valid = slot < cnt; const int tk = valid ? LIST[e * T + slot] : 0;
        const v4u* src = (const v4u*)(HN + (size_t)(tk >> 1) * D) + F.lane; v4u* dst = (v4u*)(XS + (size_t)r * D) + F.lane;
#pragma unroll
        for (int j = 0; j < 4; ++j) dst[64 * j] = src[64 * j];
        if (F.lane == 0) RG[r] = valid ? TKG[tk] : 0.f;
    }
}

template <bool FINAL>
__device__ __forceinline__ void ph_combine(Frame& F, const float* H, float* Hout, const float* wn) {
    const bf16* Y = (const bf16*)(KWS + WS_Y); const int* TKE = (const int*)(KWS + WS_TKE); const int* TKS = (const int*)(KWS + WS_TKS); bf16* HN = (bf16*)(KWS + WS_HN);
    const int gw = blockIdx.x * NWAVES + F.wave, NGW = F.G * NWAVES;
    for (int t = gw; t < T; t += NGW) {
        const int r0 = F.MISC[MI_PSTART + TKE[2 * t]] + TKS[2 * t], r1 = F.MISC[MI_PSTART + TKE[2 * t + 1]] + TKS[2 * t + 1];
        const f32x4* hr = (const f32x4*)(H + (size_t)t * D) + F.lane;
        const v2u* y0 = (const v2u*)(Y + (size_t)r0 * D) + F.lane; const v2u* y1 = (const v2u*)(Y + (size_t)r1 * D) + F.lane;
        f32x4 v[8]; float s = 0.f;
#pragma unroll
        for (int j = 0; j < 8; ++j) { const v2u a = y0[64 * j], b = y1[64 * j]; f32x4 h = hr[64 * j];
            h.x += bflo(a.x) + bflo(b.x); h.y += bfhi(a.x) + bfhi(b.x); h.z += bflo(a.y) + bflo(b.y); h.w += bfhi(a.y) + bfhi(b.y);
            v[j] = h; s += (h.x * h.x + h.y * h.y) + (h.z * h.z + h.w * h.w); }
        const float rstd = 1.0f / sqrtf(wave_sum(s) * (1.0f / D) + EPS);
        if (FINAL) {
            f32x4* o = (f32x4*)(KOUT + (size_t)t * D) + F.lane;
#pragma unroll
            for (int j = 0; j < 8; ++j) o[64 * j] = v[j] * rstd * ((const f32x4*)wn)[F.lane + 64 * j];
        } else {
            f32x4* ho = (f32x4*)(Hout + (size_t)t * D) + F.lane; v2u* o8 = (v2u*)(HN + (size_t)t * D) + F.lane;
#pragma unroll
            for (int j = 0; j < 8; ++j) { ho[64 * j] = v[j]; const f32x4 w = v[j] * rstd * ((const f32x4*)wn)[F.lane + 64 * j]; v2u o; o.x = pk2(w.x, w.y); o.y = pk2(w.z, w.w); o8[64 * j] = o; }
        }
    }
}

__device__ __forceinline__ void ph_conv(Frame& F) {
    const bf16* BG = (const bf16*)(KWS + WS_VB); const bf16* U = (const bf16*)(KWS + WS_GB); bf16* OG = (bf16*)(KWS + WS_OG); const float* cw = KIN(8);
    const size_t n8 = (size_t)T * D / 8;
    for (size_t i = (size_t)blockIdx.x * 512 + F.tid; i < n8; i += (size_t)F.G * 512) {
        const int t = (int)(i >> 8), c = (int)(i & 255) * 8; const size_t off = (size_t)t * D + c;
        const v4u u0 = *(const v4u*)(U + off); const v4u zero = {0u, 0u, 0u, 0u};
        const v4u u1 = t >= 1 ? *(const v4u*)(U + off - D) : zero; const v4u u2 = t >= 2 ? *(const v4u*)(U + off - 2 * D) : zero;
        const v4u b = *(const v4u*)(BG + off);
        const f32x4 wa0 = *(const f32x4*)(cw + c), wa1 = *(const f32x4*)(cw + c + 4), wb0 = *(const f32x4*)(cw + D + c), wb1 = *(const f32x4*)(cw + D + c + 4), wc0 = *(const f32x4*)(cw + 2 * D + c), wc1 = *(const f32x4*)(cw + 2 * D + c + 4);
        v4u o;
        o.x = pk2(bflo(b.x) * (wa0.x * bflo(u2.x) + wb0.x * bflo(u1.x) + wc0.x * bflo(u0.x)), bfhi(b.x) * (wa0.y * bfhi(u2.x) + wb0.y * bfhi(u1.x) + wc0.y * bfhi(u0.x)));
        o.y = pk2(bflo(b.y) * (wa0.z * bflo(u2.y) + wb0.z * bflo(u1.y) + wc0.z * bflo(u0.y)), bfhi(b.y) * (wa0.w * bfhi(u2.y) + wb0.w * bfhi(u1.y) + wc0.w * bfhi(u0.y)));
        o.z = pk2(bflo(b.z) * (wa1.x * bflo(u2.z) + wb1.x * bflo(u1.z) + wc1.x * bflo(u0.z)), bfhi(b.z) * (wa1.y * bfhi(u2.z) + wb1.y * bfhi(u1.z) + wc1.y * bfhi(u0.z)));
        o.w = pk2(bflo(b.w) * (wa1.z * bflo(u2.w) + wb1.z * bflo(u1.w) + wc1.z * bflo(u0.w)), bfhi(b.w) * (wa1.w * bfhi(u2.w) + wb1.w * bfhi(u1.w) + wc1.w * bfhi(u0.w)));
        *(v4u*)(OG + off) = o;
    }
}

#ifndef PH_MASK
#define PH_MASK 0xFFFFFFFFu
#endif
#define IN(k) (((PH_MASK >> (k)) & 1u) && lo <= (k) && (k) < hi)
#define BOTH(k) (IN(k) && IN((k) + 1))
#define GRID_BAR() do { if (N_LAUNCHES == 1) xcd_barrier(bar); } while (0)
template <int LAYER>
__device__ __forceinline__ void moe_block(Frame& F, const int lo, const int hi, const XcdBarrier& bar) {
    constexpr int pb = LAYER ? 13 : 5;
    float* H1 = (float*)(KWS + WS_H1); float* H2 = (float*)(KWS + WS_H2);
    if (IN(pb + 0)) { ph_router(F, LAYER, H1); if (BOTH(pb + 0)) GRID_BAR(); }
    if (IN(pb + 1)) { moe_meta(F, LAYER); ph_gather(F, LAYER); if (BOTH(pb + 1)) GRID_BAR(); }
    if (IN(pb + 2)) {
        moe_meta(F, LAYER);
        const int nrt = F.MISC[MI_NRT];
        pg8::Gemm g{(const bf16*)(KWS + WS_XS), (const bf16*)(KWS + WS_WGU) + (size_t)LAYER * NE * 1024 * 2048, nrt * 256, 1024, D};
        pg8::MoeOrder S{nrt, 4, nrt * 4, F.G, (int)blockIdx.x, (size_t)1024 * 2048 * 2, (const volatile LAS int*)(F.MISC + MI_TEXP)};
        pg8::EpiGateUp E{(bf16*)(KWS + WS_ACT)};
        pg8::gemm_phase<pg8::EpiGateUp, pg8::MoeOrder, true, true>(F.lds + RING_OFF, g, S, E);
        if (BOTH(pb + 2)) GRID_BAR();
    }
    if (IN(pb + 3)) {
        moe_meta(F, LAYER);
        const int nrt = F.MISC[MI_NRT];
        pg8::Gemm g{(const bf16*)(KWS + WS_ACT), (const bf16*)(KWS + WS_WDN) + (size_t)LAYER * NE * 2048 * 512, nrt * 256, 2048, FF};
        pg8::MoeOrder S{nrt, 8, nrt * 8, F.G, (int)blockIdx.x, (size_t)2048 * 512 * 2, (const volatile LAS int*)(F.MISC + MI_TEXP)};
        pg8::EpiDown E{(bf16*)(KWS + WS_Y), (const float*)(KWS + WS_RGATE)};
        pg8::gemm_phase<pg8::EpiDown, pg8::MoeOrder, true, true>(F.lds + RING_OFF, g, S, E);
        if (BOTH(pb + 3)) GRID_BAR();
    }
    if (IN(pb + 4)) {
        moe_meta(F, LAYER);
        if (LAYER == 0) { ph_combine<false>(F, H1, H2, KIN(1) + D); if (BOTH(pb + 4)) GRID_BAR(); }
        else ph_combine<true>(F, H1, nullptr, KIN(17));
    }
}

struct Args { const float* in[18]; float* out; unsigned char* ws; int ph_lo, ph_hi, li, pad; };
__global__ void __launch_bounds__(NWAVES * 64, 2) mega_fwd(Args args) {
    extern __shared__ __attribute__((aligned(16))) unsigned char lds[];
    Frame F;
    F.lds = (LAS unsigned char*)lds;
    F.MISC = (volatile LAS int*)(F.lds + MISC_OFF);
    F.tid = threadIdx.x; F.lane = F.tid & 63; F.wave = __builtin_amdgcn_readfirstlane(F.tid >> 6);
    F.G = gridDim.x;
    F.ka = (__attribute__((address_space(4))) const unsigned char*)__builtin_amdgcn_kernarg_segment_ptr();
    F.ctl = (unsigned*)(args.ws + WS_CTL);
    for (int u = F.tid; u < MISC_BYTES / 4; u += NWAVES * 64) F.MISC[u] = 0;
    __syncthreads();
    XcdBarrier bar; bar.bar = F.ctl + CW_BAR; bar.x = 0; bar.st = nullptr;
    if (N_LAUNCHES == 1) bar = xcd_barrier_post(F.ctl + CW_BAR, (volatile LAS unsigned*)(F.MISC + 8));
    const int lo = args.ph_lo, hi = args.ph_hi;
    bf16* HN = (bf16*)(KWS + WS_HN); float* H1 = (float*)(KWS + WS_H1); float* H2 = (float*)(KWS + WS_H2);

    if (IN(0)) { p0_convert(F); __syncthreads(); p0_norm_gl(F); if (BOTH(0)) GRID_BAR(); }
    if (IN(1)) {
        pg8::Gemm g{HN, (const bf16*)(KWS + WS_WGI), T, GINM, D}; pg8::StaticOrder S; S.init(T, GINM, F.G, (int)blockIdx.x);
        pg8::EpiGlaIn E{(bf16*)(KWS + WS_QP), (bf16*)(KWS + WS_KP), (bf16*)(KWS + WS_VB), (bf16*)(KWS + WS_GB), (const float*)(KWS + WS_BC)};
        pg8::gemm_phase<pg8::EpiGlaIn, pg8::StaticOrder, true, true>(F.lds + RING_OFF, g, S, E);
        if (BOTH(1)) GRID_BAR();
    }
    if (IN(2)) { ph_gla_naive(F); if (BOTH(2)) GRID_BAR(); }
    if (IN(3)) { ph_headnorm(F); if (BOTH(3)) GRID_BAR(); }
    if (IN(4)) {
        pg8::Gemm g{(const bf16*)(KWS + WS_OG), (const bf16*)(KWS + WS_WGO), T, D, D}; pg8::StaticOrder S; S.init(T, D, F.G, (int)blockIdx.x);
        pg8::EpiRes E{KIN(0), H1, D};
        pg8::gemm_phase<pg8::EpiRes, pg8::StaticOrder, true, true>(F.lds + RING_OFF, g, S, E);
        if (BOTH(4)) GRID_BAR();
    }
    moe_block<0>(F, lo, hi, bar);
    if (IN(10)) {
        pg8::Gemm g{HN, (const bf16*)(KWS + WS_WCI), T, 6144, D}; pg8::StaticOrder S; S.init(T, 6144, F.G, (int)blockIdx.x);
        pg8::EpiConvIn E{(bf16*)(KWS + WS_VB), (bf16*)(KWS + WS_GB)};
        pg8::gemm_phase<pg8::EpiConvIn, pg8::StaticOrder, true, true>(F.lds + RING_OFF, g, S, E);
        if (BOTH(10)) GRID_BAR();
    }
    if (IN(11)) { ph_conv(F); if (BOTH(11)) GRID_BAR(); }
    if (IN(12)) {
        pg8::Gemm g{(const bf16*)(KWS + WS_OG), (const bf16*)(KWS + WS_WCO), T, D, D}; pg8::StaticOrder S; S.init(T, D, F.G, (int)blockIdx.x);
        pg8::EpiRes E{H2, H1, D};
        pg8::gemm_phase<pg8::EpiRes, pg8::StaticOrder, true, true>(F.lds + RING_OFF, g, S, E);
        if (BOTH(12)) GRID_BAR();
    }
    moe_block<1>(F, lo, hi, bar);
#undef IN
#undef BOTH
#undef GRID_BAR
}

extern "C" void kernel_launch(void* const* d_in, const int* in_sizes, int n_in, void* d_out, int out_size, void* d_ws, size_t ws_size, hipStream_t stream) {
    static int grid = 0;
    if (grid == 0) {
        if (n_in != 18 || in_sizes[0] != T * D || out_size != T * D || ws_size < WS_END) { fprintf(stderr, "kernel_launch: unexpected shapes (n_in %d, in0 %d, out %d, ws %zu)\n", n_in, n_in > 0 ? in_sizes[0] : -1, out_size, ws_size); grid = -1; return; }
        int dev = 0, cus = 0, per_cu = 0;
        if (hipGetDevice(&dev) != hipSuccess || hipDeviceGetAttribute(&cus, hipDeviceAttributeMultiprocessorCount, dev) != hipSuccess) { grid = -1; return; }
        if (hipFuncSetAttribute((const void*)mega_fwd, hipFuncAttributeMaxDynamicSharedMemorySize, LDS_BYTES) != hipSuccess) { fprintf(stderr, "kernel_launch: hipFuncSetAttribute failed\n"); grid = -1; return; }
        if (hipOccupancyMaxActiveBlocksPerMultiprocessor(&per_cu, (const void*)mega_fwd, NWAVES * 64, LDS_BYTES) != hipSuccess || per_cu < 1) { fprintf(stderr, "kernel_launch: occupancy query reports %d\n", per_cu); }
        (void)hipGetLastError();
        grid = cus;
    }
    if (grid < 0) return;
    if (hipMemsetAsync((char*)d_ws + WS_CTL, 0, CTL_ZERO_BYTES, stream) != hipSuccess) return;
    Args a{};
    for (int i = 0; i < 18; ++i) a.in[i] = (const float*)d_in[i];
    a.out = (float*)d_out; a.ws = (unsigned char*)d_ws;
    for (int li = 0; li < N_LAUNCHES; ++li) {
        a.ph_lo = (N_LAUNCHES == 1) ? 0 : li; a.ph_hi = (N_LAUNCHES == 1) ? NPH : li + 1; a.li = li; a.pad = 0;
        hipLaunchKernelGGL(mega_fwd, dim3(grid), dim3(NWAVES * 64), LDS_BYTES, stream, a);
        const hipError_t le = hipPeekAtLastError();
        if (le != hipSuccess) { fprintf(stderr, "kernel_launch: launch %d failed: %s\n", li, hipGetErrorName(le)); break; }
    }
}
```

```cpp
#include <hip/hip_runtime.h>
#include <cstdio>
#include <cstdint>

#ifndef MK_N_LAUNCHES
#define MK_N_LAUNCHES 1
#endif

namespace pg8 {
#define PG8_LAS __attribute__((address_space(3)))
typedef unsigned short bf16_t;
typedef short bf16x8 __attribute__((ext_vector_type(8)));
typedef float f32x4 __attribute__((ext_vector_type(4)));
typedef unsigned u32x4 __attribute__((ext_vector_type(4)));
constexpr int BM = 256, BK = 64, HALF = 128, HTB = HALF * BK * 2, STAGE_BYTES = 8 * HTB, NXCD = 8, WGM = 8;

__host__ __device__ __forceinline__ int lds_byte(int r, int c) { const int st = (r >> 4) * 2 + (c >> 5), rr = r & 15, cc = c & 31, ob = rr * 64 + cc * 2; return st * 1024 + (ob ^ (((ob >> 9) & 1) << 5)); }
__host__ __device__ __forceinline__ void stage_rc(int b, int& R, int& C) { const int st = b / 1024, sb = b % 1024, swz = sb ^ (((sb >> 9) & 1) << 5); R = (st >> 1) * 16 + swz / 64; C = (st & 1) * 32 + (swz % 64) / 2; }
__host__ __device__ __forceinline__ int perm32(int rho) { const int n = rho >> 4, i = rho & 15; return 8 * (i >> 2) + 4 * n + (i & 3); }

struct Unit { int pm, pn; size_t boff; };
struct Gemm { const bf16_t* A; const bf16_t* Bt; int M, N, K; };

struct StaticOrder {
    int nM, nN, nwg, G, c;
    __host__ __device__ void init(int M, int N, int G_, int c_) { nM = M / BM; nN = N / BM; nwg = nM * nN; G = G_; c = c_; }
    __host__ __device__ bool next(int i, Unit& u) const {
        const long L = (long)i * G + c; if (L >= nwg) return false;
        int wgid = (int)L; { const int q = nwg / NXCD, r = nwg % NXCD, xcd = wgid % NXCD, off = wgid / NXCD; wgid = (xcd < r ? xcd * (q + 1) : r * (q + 1) + (xcd - r) * q) + off; }
        const int nig = WGM * nN, gid = wgid / nig, fm = gid * WGM, gsz = (nM - fm) < WGM ? (nM - fm) : WGM;
        u.pm = fm + ((wgid % nig) % gsz); u.pn = (wgid % nig) / gsz; u.boff = 0; return true;
    }
    __device__ __forceinline__ void a_ready(const Unit&) const {}
    __device__ __forceinline__ void done(const Unit&) const {}
};
struct MoeOrder {
    int nrt, NT, nwg, G, c; size_t estride; const volatile PG8_LAS int* tile_exp;
    __device__ __forceinline__ bool next(int i, Unit& u) const {
        const long L = (long)i * G + c; if (L >= nwg) return false;
        int wgid = (int)L; { const int q = nwg / NXCD, r = nwg % NXCD, xcd = wgid % NXCD, off = wgid / NXCD; wgid = (xcd < r ? xcd * (q + 1) : r * (q + 1) + (xcd - r) * q) + off; }
        u.pm = wgid / NT; u.pn = wgid % NT;
        const int e = __builtin_amdgcn_readfirstlane(tile_exp[u.pm]);
        u.boff = (size_t)e * estride; return true;
    }
    __device__ __forceinline__ void a_ready(const Unit&) const {}
    __device__ __forceinline__ void done(const Unit&) const {}
};

__device__ __forceinline__ unsigned cvt_pk_bf16(float lo, float hi) { unsigned r; asm volatile("v_cvt_pk_bf16_f32 %0, %1, %2" : "=v"(r) : "v"(lo), "v"(hi)); return r; }
__device__ __forceinline__ u32x4 pack8(const f32x4& v0, const f32x4& v1) { u32x4 w; w.x = cvt_pk_bf16(v0[0], v0[1]); w.y = cvt_pk_bf16(v0[2], v0[3]); w.z = cvt_pk_bf16(v1[0], v1[1]); w.w = cvt_pk_bf16(v1[2], v1[3]); return w; }
__device__ __forceinline__ float fexp(float x) { return __builtin_amdgcn_exp2f(x * 1.44269504089f); }
__device__ __forceinline__ float silu_f(float x) { return x * __builtin_amdgcn_rcpf(1.0f + fexp(-x)); }

struct EpiRes {
    static constexpr bool PERM = false, AFTER_DRAIN = false;
    const float* base; float* out; int ldc;
    __device__ __forceinline__ void operator()(const f32x4 (&acc)[2][2][4][2], const Unit& u, int wr, int wc, int fr, int fq) const {
        const int row0 = u.pm * BM + wr * 64 + fr, col0 = u.pn * BM + wc * 32 + 4 * fq;
#pragma unroll
        for (int ai = 0; ai < 2; ++ai)
#pragma unroll
            for (int m = 0; m < 4; ++m) { const size_t off = (size_t)(row0 + ai * HALF + m * 16) * ldc + col0;
#pragma unroll
                for (int bj = 0; bj < 2; ++bj)
#pragma unroll
                    for (int n = 0; n < 2; ++n) { const f32x4 bs = *(const f32x4*)(base + off + bj * HALF + n * 16); *(f32x4*)(out + off + bj * HALF + n * 16) = bs + acc[ai][bj][m][n]; } }
    }
};
struct EpiGlaIn {
    static constexpr bool PERM = true, AFTER_DRAIN = false;
    bf16_t *Qp, *Kp, *Vb, *Gb; const float* Bc;
    __device__ __forceinline__ void operator()(const f32x4 (&acc)[2][2][4][2], const Unit& u, int wr, int wc, int fr, int fq) const {
        const int row0 = u.pm * BM + wr * 64 + fr, cl = wc * 32 + 8 * fq, ct = u.pn;
        if (ct < 8) {
            const bool isq = ct < 4; const int cb = (ct & 3) * 256 + cl; bf16_t* dst = isq ? Qp : Kp; const float sgn = isq ? 1.0f : -1.0f, mul = isq ? 0.0625f : 1.0f;
#pragma unroll
            for (int ai = 0; ai < 2; ++ai)
#pragma unroll
                for (int m = 0; m < 4; ++m) { const size_t ro = (size_t)(row0 + ai * HALF + m * 16) * 1024;
#pragma unroll
                    for (int bj = 0; bj < 2; ++bj) { const int c = cb + bj * HALF; const f32x4 b0 = *(const f32x4*)(Bc + ro + c), b1 = *(const f32x4*)(Bc + ro + c + 4);
                        f32x4 v0 = acc[ai][bj][m][0], v1 = acc[ai][bj][m][1];
#pragma unroll
                        for (int j = 0; j < 4; ++j) { v0[j] *= fexp(sgn * b0[j]) * mul; v1[j] *= fexp(sgn * b1[j]) * mul; }
                        *(u32x4*)(dst + ro + c) = pack8(v0, v1); } }
        } else if (ct < 16) {
            const int cb = (ct - 8) * 256 + cl;
#pragma unroll
            for (int ai = 0; ai < 2; ++ai)
#pragma unroll
                for (int m = 0; m < 4; ++m) { const size_t ro = (size_t)(row0 + ai * HALF + m * 16) * 2048;
#pragma unroll
                    for (int bj = 0; bj < 2; ++bj) *(u32x4*)(Vb + ro + cb + bj * HALF) = pack8(acc[ai][bj][m][0], acc[ai][bj][m][1]); }
        } else {
            const int cb = (ct - 16) * 256 + cl;
#pragma unroll
            for (int ai = 0; ai < 2; ++ai)
#pragma unroll
                for (int m = 0; m < 4; ++m) { const size_t ro = (size_t)(row0 + ai * HALF + m * 16) * 2048;
#pragma unroll
                    for (int bj = 0; bj < 2; ++bj) { f32x4 v0 = acc[ai][bj][m][0], v1 = acc[ai][bj][m][1];
#pragma unroll
                        for (int j = 0; j < 4; ++j) { v0[j] = silu_f(v0[j]); v1[j] = silu_f(v1[j]); }
                        *(u32x4*)(Gb + ro + cb + bj * HALF) = pack8(v0, v1); } }
        }
    }
};
struct EpiConvIn {
    static constexpr bool PERM = true, AFTER_DRAIN = false;
    bf16_t *BG, *U;
    __device__ __forceinline__ void operator()(const f32x4 (&acc)[2][2][4][2], const Unit& u, int wr, int wc, int fr, int fq) const {
        const int row0 = u.pm * BM + wr * 64 + fr, cl = wc * 32 + 8 * fq, ct = u.pn;
        if (ct < 8) {
            const int cb = ct * 256 + cl;
#pragma unroll
            for (int ai = 0; ai < 2; ++ai)
#pragma unroll
                for (int m = 0; m < 4; ++m) { const size_t ro = (size_t)(row0 + ai * HALF + m * 16) * 2048;
#pragma unroll
                    for (int bj = 0; bj < 2; ++bj) *(u32x4*)(BG + ro + cb + bj * HALF) = pack8(acc[ai][bj][m][0], acc[ai][bj][m][1]); }
        } else {
            const int cb = (ct - 8) * 128 + cl;
#pragma unroll
            for (int ai = 0; ai < 2; ++ai)
#pragma unroll
                for (int m = 0; m < 4; ++m) { const size_t ro = (size_t)(row0 + ai * HALF + m * 16) * 2048;
                    *(u32x4*)(U + ro + cb) = pack8(acc[ai][0][m][0] * acc[ai][1][m][0], acc[ai][0][m][1] * acc[ai][1][m][1]); }
        }
    }
};
struct EpiGateUp {
    static constexpr bool PERM = true, AFTER_DRAIN = false;
    bf16_t* ACT;
    __device__ __forceinline__ void operator()(const f32x4 (&acc)[2][2][4][2], const Unit& u, int wr, int wc, int fr, int fq) const {
        const int row0 = u.pm * BM + wr * 64 + fr, cb = u.pn * 128 + wc * 32 + 8 * fq;
#pragma unroll
        for (int ai = 0; ai < 2; ++ai)
#pragma unroll
            for (int m = 0; m < 4; ++m) { const size_t ro = (size_t)(row0 + ai * HALF + m * 16) * 512;
                f32x4 v0 = acc[ai][0][m][0], v1 = acc[ai][0][m][1];
#pragma unroll
                for (int j = 0; j < 4; ++j) { v0[j] = silu_f(v0[j]) * acc[ai][1][m][0][j]; v1[j] = silu_f(v1[j]) * acc[ai][1][m][1][j]; }
                *(u32x4*)(ACT + ro + cb) = pack8(v0, v1); }
    }
};
struct EpiDown {
    static constexpr bool PERM = true, AFTER_DRAIN = false;
    bf16_t* Y; const float* rgate;
    __device__ __forceinline__ void operator()(const f32x4 (&acc)[2][2][4][2], const Unit& u, int wr, int wc, int fr, int fq) const {
        const int row0 = u.pm * BM + wr * 64 + fr, cb = u.pn * 256 + wc * 32 + 8 * fq;
#pragma unroll
        for (int ai = 0; ai < 2; ++ai)
#pragma unroll
            for (int m = 0; m < 4; ++m) { const int row = row0 + ai * HALF + m * 16; const float g = rgate[row]; const size_t ro = (size_t)row * 2048;
#pragma unroll
                for (int bj = 0; bj < 2; ++bj) *(u32x4*)(Y + ro + cb + bj * HALF) = pack8(acc[ai][bj][m][0] * g, acc[ai][bj][m][1] * g); }
    }
};

template <class Epi, class Sched, bool ALIGN_EPI = false, bool SP2 = false>
__device__ __forceinline__ void gemm_phase(PG8_LAS unsigned char* lds, const Gemm g, const Sched& S, const Epi& E) {
    const int tid = threadIdx.x, wid = __builtin_amdgcn_readfirstlane(tid >> 6), lane = tid & 63, wr = wid >> 2, wc = wid & 3, fr = lane & 15, fq = lane >> 4;
    const int K = g.K, nt = K / BK;
    unsigned voffA[2], voffB[2];
#pragma unroll
    for (int i = 0; i < 2; ++i) { int R, C; stage_rc(tid * 16 + i * 8192, R, C); const int Rb = Epi::PERM ? ((R & ~31) + perm32(R & 31)) : R;
        voffA[i] = (unsigned)(R * K + C) * 2u; voffB[i] = (unsigned)(Rb * K + C) * 2u; }
    const size_t kstep = (size_t)(BK * 2);
    const size_t hstep = (size_t)HALF * K * 2;
    const size_t tstep = 2 * hstep;
    const unsigned ldsw = (unsigned)wid * 1024u;
    const int aoff = lds_byte(wr * 64 + fr, fq * 8), boff = lds_byte(wc * 32 + fr, fq * 8);
#define PG8_SA(b, h) (((b) * 2 + (h)) * HTB)
#define PG8_SB(b, h) ((4 + (b) * 2 + (h)) * HTB)
#define PG8_STAGE(bufoff, gbase, voff) do { _Pragma("unroll") for (int _i = 0; _i < 2; ++_i) \
        __builtin_amdgcn_global_load_lds((const unsigned*)((const char*)(gbase) + (voff)[_i]), (PG8_LAS unsigned*)(lds + (bufoff) + ldsw + _i * 8192), 16, 0, 0); } while (0)
#define PG8_LDA(dst, b, h) do { _Pragma("unroll") for (int m = 0; m < 4; ++m) _Pragma("unroll") for (int k = 0; k < 2; ++k) dst[m][k] = *(const PG8_LAS bf16x8*)(lds + PG8_SA(b, h) + aoff + m * 2048 + k * 1024); } while (0)
#define PG8_LDB(dst, b, h) do { _Pragma("unroll") for (int n = 0; n < 2; ++n) _Pragma("unroll") for (int k = 0; k < 2; ++k) dst[n][k] = *(const PG8_LAS bf16x8*)(lds + PG8_SB(b, h) + boff + n * 2048 + k * 1024); } while (0)
#define PG8_MMA(ai, bj, At, Bt) do { __builtin_amdgcn_s_setprio(1); _Pragma("unroll") for (int m = 0; m < 4; ++m) _Pragma("unroll") for (int n = 0; n < 2; ++n) _Pragma("unroll") for (int k = 0; k < 2; ++k) \
        acc[ai][bj][m][n] = __builtin_amdgcn_mfma_f32_16x16x32_bf16(Bt[n][k], At[m][k], acc[ai][bj][m][n], 0, 0, 0); __builtin_amdgcn_s_setprio(0); } while (0)
#define PG8_WAIT_V(n) asm volatile("s_waitcnt vmcnt(" #n ")" ::: "memory")
#define PG8_WAIT_L(n) asm volatile("s_waitcnt lgkmcnt(" #n ")" ::: "memory")
#define PG8_BAR __builtin_amdgcn_s_barrier()
#define PG8_SCHED __builtin_amdgcn_sched_barrier(0)
    Unit cur, nxt; int ui = 0;
    if (!S.next(0, cur)) return;
    f32x4 acc[2][2][4][2];
#pragma unroll
    for (int a = 0; a < 2; ++a)
#pragma unroll
        for (int b = 0; b < 2; ++b)
#pragma unroll
            for (int m = 0; m < 4; ++m)
#pragma unroll
                for (int n = 0; n < 2; ++n) acc[a][b][m][n] = (f32x4){0.f, 0.f, 0.f, 0.f};
    bf16x8 At[4][2], B0[2][2], B1[2][2];
    const char* cA = (const char*)g.A + (size_t)cur.pm * tstep; const char* cB = (const char*)g.Bt + cur.boff + (size_t)cur.pn * tstep;
    S.a_ready(cur);
    if constexpr (SP2) {
        PG8_STAGE(PG8_SB(0, 0), cB, voffB); PG8_STAGE(PG8_SB(0, 1), cB + hstep, voffB); PG8_STAGE(PG8_SA(0, 0), cA, voffA); PG8_STAGE(PG8_SA(0, 1), cA + hstep, voffA);
        if (wr == 1) PG8_BAR;
        PG8_WAIT_V(2); PG8_BAR;
        PG8_STAGE(PG8_SB(1, 0), cB + kstep, voffB); PG8_STAGE(PG8_SA(1, 0), cA + kstep, voffA); PG8_STAGE(PG8_SB(1, 1), cB + hstep + kstep, voffB);
        PG8_WAIT_V(6); PG8_BAR;
    } else {
        PG8_STAGE(PG8_SB(0, 0), cB, voffB); PG8_STAGE(PG8_SA(0, 0), cA, voffA); PG8_STAGE(PG8_SB(0, 1), cB + hstep, voffB); PG8_STAGE(PG8_SA(0, 1), cA + hstep, voffA);
        if (wr == 1) PG8_BAR;
        PG8_WAIT_V(4); PG8_BAR;
        PG8_STAGE(PG8_SB(1, 0), cB + kstep, voffB); PG8_STAGE(PG8_SA(1, 0), cA + kstep, voffA); PG8_STAGE(PG8_SB(1, 1), cB + hstep + kstep, voffB);
        PG8_WAIT_V(6); PG8_BAR;
    }
    for (;;) {
        const bool has_next = S.next(ui + 1, nxt);
        const char* nA = has_next ? (const char*)g.A + (size_t)nxt.pm * tstep : cA; const char* nB = has_next ? (const char*)g.Bt + nxt.boff + (size_t)nxt.pn * tstep : cB;
        for (int t = 0; t < nt; t += 2) {
            const bool last = (t == nt - 2);
            const char* a1 = cA + (size_t)(t + 1) * kstep;
            const char* a2 = last ? nA : cA + (size_t)(t + 2) * kstep; const char* b2 = last ? nB : cB + (size_t)(t + 2) * kstep;
            const char* a3 = a2 + kstep; const char* b3 = b2 + kstep;
            if (last && has_next) S.a_ready(nxt);
            if constexpr (SP2) {
            PG8_LDB(B0, 0, 0); PG8_LDB(B1, 0, 1); PG8_SCHED; PG8_LDA(At, 0, 0); PG8_STAGE(PG8_SA(1, 1), a1 + hstep, voffA);
            PG8_WAIT_V(8); PG8_WAIT_L(0); PG8_BAR; PG8_MMA(0, 0, At, B0); PG8_MMA(0, 1, At, B1); PG8_BAR; PG8_SCHED;
            PG8_LDA(At, 0, 1); PG8_STAGE(PG8_SB(0, 0), b2, voffB); PG8_STAGE(PG8_SB(0, 1), b2 + hstep, voffB); PG8_STAGE(PG8_SA(0, 0), a2, voffA);
            PG8_WAIT_V(8); PG8_WAIT_L(0); PG8_BAR; PG8_MMA(1, 0, At, B0); PG8_MMA(1, 1, At, B1); PG8_BAR; PG8_SCHED;
            PG8_LDB(B0, 1, 0); PG8_LDB(B1, 1, 1); PG8_SCHED; PG8_LDA(At, 1, 0); PG8_STAGE(PG8_SA(0, 1), a2 + hstep, voffA);
            PG8_WAIT_V(8); PG8_WAIT_L(0); PG8_BAR; PG8_MMA(0, 0, At, B0); PG8_MMA(0, 1, At, B1); PG8_BAR; PG8_SCHED;
            PG8_LDA(At, 1, 1); PG8_STAGE(PG8_SB(1, 0), b3, voffB); PG8_STAGE(PG8_SB(1, 1), b3 + hstep, voffB); PG8_STAGE(PG8_SA(1, 0), a3, voffA);
            PG8_WAIT_V(8); PG8_WAIT_L(0); PG8_BAR; PG8_MMA(1, 0, At, B0); PG8_MMA(1, 1, At, B1); PG8_BAR; PG8_SCHED;
            } else {
            PG8_LDB(B0, 0, 0); PG8_SCHED; PG8_LDA(At, 0, 0); PG8_STAGE(PG8_SA(1, 1), a1 + hstep, voffA);
            PG8_WAIT_L(8); PG8_BAR; PG8_WAIT_L(0); PG8_MMA(0, 0, At, B0); PG8_BAR; PG8_SCHED;
            PG8_LDB(B1, 0, 1); PG8_STAGE(PG8_SB(0, 0), b2, voffB);
            PG8_BAR; PG8_WAIT_L(0); PG8_MMA(0, 1, At, B1); PG8_BAR;
            PG8_LDA(At, 0, 1); PG8_STAGE(PG8_SA(0, 0), a2, voffA);
            PG8_BAR; PG8_WAIT_L(0); PG8_MMA(1, 0, At, B0); PG8_BAR; PG8_SCHED;
            PG8_STAGE(PG8_SB(0, 1), b2 + hstep, voffB);
            PG8_WAIT_V(6); PG8_BAR; PG8_MMA(1, 1, At, B1); PG8_BAR;
            PG8_LDB(B0, 1, 0); PG8_SCHED; PG8_LDA(At, 1, 0); PG8_STAGE(PG8_SA(0, 1), a2 + hstep, voffA);
            PG8_WAIT_L(8); PG8_BAR; PG8_WAIT_L(0); PG8_MMA(0, 0, At, B0); PG8_BAR; PG8_SCHED;
            PG8_LDB(B1, 1, 1); PG8_STAGE(PG8_SB(1, 0), b3, voffB);
            PG8_BAR; PG8_WAIT_L(0); PG8_MMA(0, 1, At, B1); PG8_BAR;
            PG8_LDA(At, 1, 1); PG8_STAGE(PG8_SA(1, 0), a3, voffA);
            PG8_BAR; PG8_WAIT_L(0); PG8_MMA(1, 0, At, B0); PG8_BAR; PG8_SCHED;
            PG8_STAGE(PG8_SB(1, 1), b3 + hstep, voffB);
            PG8_WAIT_V(6); PG8_BAR; PG8_MMA(1, 1, At, B1); PG8_BAR;
            }
        }
        if constexpr (ALIGN_EPI) { if (wr == 0) PG8_BAR; }
        if constexpr (!Epi::AFTER_DRAIN) { E(acc, cur, wr, wc, fr, fq); S.done(cur); }
        if (!has_next) break;
#pragma unroll
        for (int a = 0; a < 2; ++a)
#pragma unroll
            for (int b = 0; b < 2; ++b)
#pragma unroll
                for (int m = 0; m < 4; ++m)
#pragma unroll
                    for (int n = 0; n < 2; ++n) acc[a][b][m][n] = (f32x4){0.f, 0.f, 0.f, 0.f};
        cur = nxt; cA = nA; cB = nB; ++ui;
        if constexpr (ALIGN_EPI) { if (wr == 1) PG8_BAR; }
    }
    PG8_WAIT_V(0);
    if constexpr (!ALIGN_EPI) { if (wr == 0) PG8_BAR; }
    PG8_BAR;
#undef PG8_SA
#undef PG8_SB
#undef PG8_STAGE
#undef PG8_LDA
#undef PG8_LDB
#undef PG8_MMA
#undef PG8_WAIT_V
#undef PG8_WAIT_L
#undef PG8_BAR
#undef PG8_SCHED
}
}

constexpr int NWAVES = 8;
constexpr int NPH = 19;
constexpr int N_LAUNCHES = (MK_N_LAUNCHES == 1) ? 1 : NPH;

constexpr int T = 16384, D = 2048;
constexpr int KD = 1024, VD = 2048, GIN = 6160, GINM = 6144, DKH = 256, DVH = 512, NHEAD = 4, CHK = 64, NCHUNK = T / CHK, RANK = 16;
constexpr int NE = 32, FF = 512, NGRP = 4, EPG = 8, NLOG = 48;
constexpr int MAX_RT = 160;
constexpr float EPS = 1e-6f;

constexpr size_t MiB = 1u << 20;
constexpr size_t WS_CTL = 0, CTL_ZERO_BYTES = 65536;
constexpr size_t WS_GL = 1 * MiB;
constexpr size_t WS_TKE = 2 * MiB;
constexpr size_t WS_TKS = WS_TKE + 131072;
constexpr size_t WS_TKG = WS_TKS + 131072;
constexpr size_t WS_RGATE = WS_TKG + 131072;
constexpr size_t WS_LIST = 3 * MiB;
constexpr size_t WS_WRT = 5 * MiB;
constexpr size_t WS_WGI = 8 * MiB;
constexpr size_t WS_WGO = 32 * MiB;
constexpr size_t WS_WCI = 40 * MiB;
constexpr size_t WS_WCO = 64 * MiB;
constexpr size_t WS_WGU = 72 * MiB;
constexpr size_t WS_WDN = 328 * MiB;
constexpr size_t WS_HN = 456 * MiB;
constexpr size_t WS_BC = 520 * MiB;
constexpr size_t WS_QP = 584 * MiB;
constexpr size_t WS_KP = 616 * MiB;
constexpr size_t WS_VB = 648 * MiB;
constexpr size_t WS_GB = 712 * MiB;
constexpr size_t WS_O = 776 * MiB;
constexpr size_t WS_OG = 904 * MiB;
constexpr size_t WS_H1 = 968 * MiB;
constexpr size_t WS_H2 = 1096 * MiB;
constexpr size_t WS_XS = 1224 * MiB;
constexpr size_t WS_ACT = 1384 * MiB;
constexpr size_t WS_Y = 1424 * MiB;
constexpr size_t WS_SEND = 1584 * MiB;
constexpr size_t WS_GTOT = 1616 * MiB;
constexpr size_t WS_END = 1617 * MiB;
constexpr int CW_TMO = 0, CW_CODE = 1;
constexpr int CW_BAR = 4096;
constexpr int CW_CNT = 8192;

constexpr int RING_OFF = 0, RING_BYTES = 131072;
constexpr int SCR_OFF = 131072, SCR_BYTES = 8192;
constexpr int MISC_OFF = SCR_OFF + SCR_BYTES;
constexpr int MISC_BYTES = 2048;
constexpr int LDS_BYTES = 147456;
static_assert(MISC_OFF + MISC_BYTES <= LDS_BYTES, "LDS map");
constexpr int MI_PSTART = 16, MI_NRT = 49, MI_TEXP = 64, MI_CNTL = 256, MI_BASEL = 288;

#define GAS __attribute__((address_space(1)))
#define LAS __attribute__((address_space(3)))
typedef unsigned short bf16;
typedef unsigned v4u __attribute__((ext_vector_type(4)));
typedef unsigned v2u __attribute__((ext_vector_type(2)));
typedef float f32x4 __attribute__((ext_vector_type(4)));
typedef GAS unsigned gu32;
#define RLX_AGENT __ATOMIC_RELAXED, __HIP_MEMORY_SCOPE_AGENT
#define LDS_WAIT() asm volatile("s_waitcnt lgkmcnt(0)" ::: "memory")
#define VM_WAIT() asm volatile("s_waitcnt vmcnt(0)" ::: "memory")
__device__ __forceinline__ unsigned f2bf(float f) { unsigned u = __builtin_bit_cast(unsigned, f); return (u + 0x7fffu + ((u >> 16) & 1u)) >> 16; }
__device__ __forceinline__ unsigned pk2(float lo, float hi) { return f2bf(lo) | (f2bf(hi) << 16); }
__device__ __forceinline__ float bflo(unsigned w) { return __uint_as_float(w << 16); }
__device__ __forceinline__ float bfhi(unsigned w) { return __uint_as_float(w & 0xffff0000u); }

#define XB_TMO      128
#define XB_XCNT(j)  (256  + 64 * (j))
#define XB_XSUB(j)  (1280 + 64 * (j))
#define XB_XGEN(j)  (2304 + 64 * (j))
#define XB_TOP      3328
#define XB_TOPGEN   3392
#define XCD_BAR_WORDS 3456
#define XB_SPIN_CAP (1u << 22)
__device__ __forceinline__ unsigned xb_ld(unsigned* p)              { return __hip_atomic_load(p, __ATOMIC_RELAXED, __HIP_MEMORY_SCOPE_AGENT); }
__device__ __forceinline__ unsigned xb_add(unsigned* p, unsigned v) { return __hip_atomic_fetch_add(p, v, __ATOMIC_RELAXED, __HIP_MEMORY_SCOPE_AGENT); }
__device__ __forceinline__ unsigned xb_xcc_id() { return (unsigned)__builtin_amdgcn_s_getreg((3 << 11) | 20) & 0xFu; }
#define XB_SPIN(cond, bar) do { unsigned _sp = 0; while (cond) { __builtin_amdgcn_s_sleep(1); \
    if ((++_sp & 255u) == 0u) { if (xb_ld(&(bar)[XB_TMO])) break; if (_sp > XB_SPIN_CAP) { atomicAdd(&(bar)[XB_TMO], 1u); break; } } } } while (0)
struct XcdBarrier { unsigned* bar; unsigned x; volatile LAS unsigned* st; };
__device__ __forceinline__ XcdBarrier xcd_barrier_post(unsigned* bar, volatile LAS unsigned* st) {
    XcdBarrier b; b.bar = bar; b.x = xb_xcc_id(); b.st = st;
    if (threadIdx.x == 0) (void)xb_add(&bar[XB_XCNT(b.x)], 1u);
    return b;
}
__device__ __forceinline__ void xcd_barrier_complete(unsigned* bar, unsigned x, unsigned& nloc, unsigned& nx) {
    const unsigned G = gridDim.x * gridDim.y * gridDim.z;
    unsigned sum, cnt, mine, sp = 0u;
    for (;;) {
        sum = 0u; cnt = 0u; mine = 0u;
#pragma unroll
        for (unsigned j = 0; j < 16; ++j) { const unsigned c = xb_ld(&bar[XB_XCNT(j)]); sum += c; cnt += (c > 0u) ? 1u : 0u; mine = (j == x) ? c : mine; }
        if (sum == G) break;
        __builtin_amdgcn_s_sleep(1);
        if ((++sp & 255u) == 0u) { if (xb_ld(&bar[XB_TMO])) break; if (sp > XB_SPIN_CAP) { atomicAdd(&bar[XB_TMO], 1u); break; } }
    }
    nloc = mine > 0u ? mine : 1u; nx = cnt > 0u ? cnt : 1u;
}
__device__ __forceinline__ void xcd_barrier(const XcdBarrier& b) {
    asm volatile("s_waitcnt vmcnt(0)" ::: "memory");
    __syncthreads();
    if (threadIdx.x == 0) {
        unsigned* bar = b.bar;
        __builtin_amdgcn_s_waitcnt(0);
        unsigned nloc = b.st[0], nx = b.st[1];
        if (nloc == 0u) { xcd_barrier_complete(bar, b.x, nloc, nx); b.st[0] = nloc; b.st[1] = nx; }
        const unsigned old = xb_add(&bar[XB_XSUB(b.x)], 1u);
        const unsigned gen = old / nloc;
        if (old + 1u == (gen + 1u) * nloc) {
            __builtin_amdgcn_fence(__ATOMIC_RELEASE, "agent");
            asm volatile("s_waitcnt vmcnt(0)" ::: "memory");
            const unsigned og = xb_add(&bar[XB_TOP], 1u);
            const unsigned tg = og / nx;
            if (og + 1u == (tg + 1u) * nx) xb_add(&bar[XB_TOPGEN], 1u);
            else XB_SPIN(xb_ld(&bar[XB_TOPGEN]) == tg, bar);
            __builtin_amdgcn_fence(__ATOMIC_ACQUIRE, "agent");
            xb_add(&bar[XB_XGEN(b.x)], 1u);
            asm volatile("s_waitcnt vmcnt(0)" ::: "memory");
        } else {
            XB_SPIN(xb_ld(&bar[XB_XGEN(b.x)]) == gen, bar);
            __builtin_amdgcn_fence(__ATOMIC_ACQUIRE, "agent");
            asm volatile("s_waitcnt vmcnt(0)" ::: "memory");
        }
    }
    __syncthreads();
}

struct Frame {
    LAS unsigned char* lds;
    volatile LAS int* MISC;
    unsigned* ctl;
    int tid, lane, wave, G;
    __attribute__((address_space(4))) const unsigned char* ka;
};
#define KIN(i) (*(const float* const __attribute__((address_space(4)))*)(F.ka + 8 * (i)))
#define KOUT   (*(float* const __attribute__((address_space(4)))*)(F.ka + 8 * 18))
#define KWS    (*(unsigned char* const __attribute__((address_space(4)))*)(F.ka + 8 * 19))
__device__ __forceinline__ float wave_sum(float v) {
#pragma unroll
    for (int o = 1; o < 64; o <<= 1) v += __shfl_xor(v, o);
    return v;
}

__device__ __forceinline__ void transpose_item(const float* W, int K, int ldw, int ncols, bf16* WT, int destrow0, LAS float* scr, int kb, int nb, int lane) {
    const int k0 = 64 * kb, n0 = 32 * nb; (void)ncols;
#pragma unroll 8
    for (int i = 0; i < 32; ++i) { const int kk = 2 * i + (lane >> 5); scr[kk * 33 + (lane & 31)] = W[(size_t)(k0 + kk) * ldw + n0 + (lane & 31)]; }
    LDS_WAIT(); asm volatile("" ::: "memory");
    const int c = lane & 7;
#pragma unroll
    for (int j = 0; j < 4; ++j) { const int n = (lane >> 3) + 8 * j; const LAS float* s = scr + (8 * c) * 33 + n;
        v4u o; o.x = pk2(s[0 * 33], s[1 * 33]); o.y = pk2(s[2 * 33], s[3 * 33]); o.z = pk2(s[4 * 33], s[5 * 33]); o.w = pk2(s[6 * 33], s[7 * 33]);
        *(v4u*)(WT + (size_t)(destrow0 + n) * K + k0 + 8 * c) = o; }
    LDS_WAIT(); asm volatile("" ::: "memory");
}
__device__ __forceinline__ int conv_in_row(int n) { if (n < 2048) return n; const int s = (n - 2048) >> 11, f = (n - 2048) & 2047; return 2048 + 256 * (f >> 7) + 128 * s + (f & 127); }
__device__ __forceinline__ int gate_up_row(int n) { const int s = n >> 9, f = n & 511; return 256 * (f >> 7) + 128 * s + (f & 127); }

__device__ __forceinline__ void p0_convert(Frame& F) {
    LAS float* scr = (LAS float*)(F.lds + RING_OFF + F.wave * 16384);
    const int gw = blockIdx.x * NWAVES + F.wave, NGW = F.G * NWAVES;
    constexpr int I_GI = 32 * 192, I_GO = 32 * 64, I_CI = 32 * 192, I_CO = 32 * 64, I_GU1 = 32 * 32, I_DN1 = 8 * 64;
    constexpr int I_GU = I_GU1 * 64, I_DN = I_DN1 * 64;
    constexpr int NITEMS = I_GI + I_GO + I_CI + I_CO + I_GU + I_DN;
    bf16* WGI = (bf16*)(KWS + WS_WGI); bf16* WGO = (bf16*)(KWS + WS_WGO); bf16* WCI = (bf16*)(KWS + WS_WCI); bf16* WCO = (bf16*)(KWS + WS_WCO);
    bf16* WGU = (bf16*)(KWS + WS_WGU); bf16* WDN = (bf16*)(KWS + WS_WDN);
    for (int it = gw; it < NITEMS; it += NGW) {
        int r = it;
        if (r < I_GI) { const int kb = r / 192, nb = r % 192; transpose_item(KIN(2), 2048, GIN, GINM, WGI, 32 * nb, scr, kb, nb, F.lane); continue; } r -= I_GI;
        if (r < I_GO) { const int kb = r / 64, nb = r % 64; transpose_item(KIN(6), 2048, 2048, 2048, WGO, 32 * nb, scr, kb, nb, F.lane); continue; } r -= I_GO;
        if (r < I_CI) { const int kb = r / 192, nb = r % 192; transpose_item(KIN(7), 2048, 6144, 6144, WCI, conv_in_row(32 * nb), scr, kb, nb, F.lane); continue; } r -= I_CI;
        if (r < I_CO) { const int kb = r / 64, nb = r % 64; transpose_item(KIN(9), 2048, 2048, 2048, WCO, 32 * nb, scr, kb, nb, F.lane); continue; } r -= I_CO;
        if (r < I_GU) { const int le = r / I_GU1, q = r % I_GU1, kb = q / 32, nb = q % 32;
            transpose_item(KIN(15) + (size_t)le * 2048 * 1024, 2048, 1024, 1024, WGU + (size_t)le * 1024 * 2048, gate_up_row(32 * nb), scr, kb, nb, F.lane); continue; } r -= I_GU;
        { const int le = r / I_DN1, q = r % I_DN1, kb = q / 64, nb = q % 64;
            transpose_item(KIN(16) + (size_t)le * 512 * 2048, 512, 2048, 2048, WDN + (size_t)le * 2048 * 512, 32 * nb, scr, kb, nb, F.lane); }
    }
    float* WRT = (float*)(KWS + WS_WRT);
    for (int i = blockIdx.x * 512 + F.tid; i < 2 * NLOG * 2048; i += F.G * 512) {
        const int l = i / (NLOG * 2048), c = (i / 2048) % NLOG, k = i % 2048;
        float w = 0.f;
        if (c < 4) w = KIN(11)[((size_t)l * 2048 + k) * 4 + c]; else if (c < 36) w = KIN(13)[((size_t)l * 2048 + k) * 32 + (c - 4)];
        WRT[i] = w * KIN(10)[l * 2048 + k];
    }
}

constexpr int WGT_LD = 2052;
__device__ __forceinline__ void p0_norm_gl(Frame& F) {
    LAS float* wgt = (LAS float*)(F.lds);
    LAS float* glc = (LAS float*)(F.lds + 16 * WGT_LD * 4);
    static_assert(16 * WGT_LD * 4 + 64 * 16 * 4 <= MISC_OFF, "p0 LDS");
    const float* w_in = KIN(2);
    for (int idx = F.tid; idx < 2048 * 16; idx += 512) { const int k = idx >> 4, r = idx & 15; wgt[r * WGT_LD + k] = w_in[(size_t)k * GIN + GINM + r]; }
    __syncthreads();
    const float* x = KIN(0); const float* wn = KIN(1); bf16* HN = (bf16*)(KWS + WS_HN); float* BC = (float*)(KWS + WS_BC);
    const float* w2 = KIN(3); const float* bgk = KIN(4);
    for (int ch = blockIdx.x; ch < NCHUNK; ch += F.G) {
        for (int rr = 0; rr < 8; ++rr) {
            const int rl = F.wave * 8 + rr, row = ch * CHK + rl;
            const f32x4* xr = (const f32x4*)(x + (size_t)row * D) + F.lane;
            float s = 0.f;
#pragma unroll
            for (int j = 0; j < 8; ++j) { const f32x4 v = xr[64 * j]; s += (v.x * v.x + v.y * v.y) + (v.z * v.z + v.w * v.w); }
            const float rstd = 1.0f / sqrtf(wave_sum(s) * (1.0f / D) + EPS);
            float ga[16];
#pragma unroll
            for (int r = 0; r < 16; ++r) ga[r] = 0.f;
            v2u* o8 = (v2u*)(HN + (size_t)row * D) + F.lane;
#pragma unroll 1
            for (int j = 0; j < 8; ++j) { const f32x4 w = ((const f32x4*)wn)[F.lane + 64 * j]; const f32x4 v = xr[64 * j] * rstd * w;
                v2u o; o.x = pk2(v.x, v.y); o.y = pk2(v.z, v.w); o8[64 * j] = o;
#pragma unroll
                for (int r = 0; r < 16; ++r) { const f32x4 g = *(const LAS f32x4*)(wgt + r * WGT_LD + 4 * F.lane + 256 * j); ga[r] += (v.x * g.x + v.y * g.y) + (v.z * g.z + v.w * g.w); } }
#pragma unroll
            for (int r = 0; r < 16; ++r) ga[r] = wave_sum(ga[r]);
            if (F.lane == 0) {
#pragma unroll
                for (int r = 0; r < 16; ++r) glc[rl * 16 + r] = ga[r]; }
        }
        __syncthreads();
#pragma unroll
        for (int hh = 0; hh < 2; ++hh) {
            const int c = F.tid + 512 * hh; float w2r[16];
#pragma unroll
            for (int r = 0; r < 16; ++r) w2r[r] = w2[r * KD + c];
            const float bias = bgk[c]; float cum = 0.f;
            for (int t = 0; t < CHK; ++t) {
                float z = bias;
#pragma unroll
                for (int r = 0; r < 16; ++r) z += glc[t * 16 + r] * w2r[r];
                const float ls = fminf(z, 0.f) - log1pf(expf(-fabsf(z)));
                cum += ls * (1.0f / 16.0f);
                BC[(size_t)(ch * CHK + t) * KD + c] = cum;
            }
        }
        __syncthreads();
    }
}

__device__ __forceinline__ void ph_gla_naive(Frame& F) {
    const bf16* QP = (const bf16*)(KWS + WS_QP); const bf16* KP = (const bf16*)(KWS + WS_KP); const bf16* VB = (const bf16*)(KWS + WS_VB);
    const float* BC = (const float*)(KWS + WS_BC); float* O = (float*)(KWS + WS_O);
    for (int u = blockIdx.x; u < 128; u += F.G) {
        const int h = u >> 5, col0 = (u & 31) * 16, ds = F.tid & 31, col = F.tid >> 5;
        float R[8];
#pragma unroll
        for (int i = 0; i < 8; ++i) R[i] = 0.f;
        const bf16* qp = QP + h * DKH + ds * 8; const bf16* kp = KP + h * DKH + ds * 8; const bf16* vp = VB + h * DVH + col0 + col;
        const float* bp = BC + h * DKH + ds * 8; float* op = O + h * DVH + col0 + col;
        for (int t0 = 0; t0 < T; t0 += 8) {
            v4u kk[8], qq[8]; unsigned short vv[8];
#pragma unroll
            for (int j = 0; j < 8; ++j) { kk[j] = *(const v4u*)(kp + (size_t)(t0 + j) * KD); qq[j] = *(const v4u*)(qp + (size_t)(t0 + j) * KD); vv[j] = vp[(size_t)(t0 + j) * VD]; }
#pragma unroll
            for (int j = 0; j < 8; ++j) {
                const float v = __uint_as_float(((unsigned)vv[j]) << 16);
                float po = 0.f;
#pragma unroll
                for (int i = 0; i < 4; ++i) { const unsigned kw = kk[j][i], qw = qq[j][i];
                    R[2 * i] += bflo(kw) * v; R[2 * i + 1] += bfhi(kw) * v; po += bflo(qw) * R[2 * i] + bfhi(qw) * R[2 * i + 1]; }
                po += __shfl_xor(po, 1); po += __shfl_xor(po, 2); po += __shfl_xor(po, 4); po += __shfl_xor(po, 8); po += __shfl_xor(po, 16);
                if (ds == 0) op[(size_t)(t0 + j) * VD] = po;
            }
            if (((t0 + 8) & 63) == 0) { const f32x4 b0 = *(const f32x4*)(bp + (size_t)(t0 + 7) * KD), b1 = *(const f32x4*)(bp + (size_t)(t0 + 7) * KD + 4);
#pragma unroll
                for (int i = 0; i < 4; ++i) { R[i] *= expf(b0[i]); R[4 + i] *= expf(b1[i]); } }
        }
    }
}

namespace gla {
typedef short bf16x8 __attribute__((ext_vector_type(8)));
typedef short s16x4 __attribute__((ext_vector_type(4)));
typedef short v4i16_t __attribute__((ext_vector_type(4)));
typedef float f32x2_t __attribute__((ext_vector_type(2))); typedef __bf16 bf16x2_t __attribute__((ext_vector_type(2)));
__device__ __forceinline__ unsigned cvtpk(float lo, float hi) { f32x2_t v = {lo, hi}; bf16x2_t b = __builtin_convertvector(v, bf16x2_t); return __builtin_bit_cast(unsigned, b); }
__device__ __forceinline__ s16x4 trread(const LAS unsigned char* p) { return __builtin_bit_cast(s16x4, __builtin_amdgcn_ds_read_tr16_b64_v4i16((LAS v4i16_t*)p)); }
__device__ __forceinline__ bf16x8 cat4(s16x4 a, s16x4 b) { bf16x8 r; r[0] = a[0]; r[1] = a[1]; r[2] = a[2]; r[3] = a[3]; r[4] = b[0]; r[5] = b[1]; r[6] = b[2]; r[7] = b[3]; return r; }
constexpr int QS = 528, VS = 272, PS = 144;
constexpr int OFF_Q = 0, OFF_K = 64 * QS, OFF_V = 2 * 64 * QS, OFF_P = OFF_V + 64 * VS, OFF_G = OFF_P + 64 * PS, LDS_END = OFF_G + 1024;
static_assert(LDS_END <= RING_BYTES, "gla LDS");
constexpr int NPART = 16, CPP = NCHUNK / NPART;
struct Stage { v4u q[4], k[4], v[2]; float g; };
template <bool NEEDQ>
__device__ __forceinline__ void issue_loads(Stage& st, const bf16* QP, const bf16* KP, const bf16* VB, const float* BC, int tok0, int h, int s, int tid) {
#pragma unroll
    for (int i = 0; i < 4; ++i) { const int id = tid + 512 * i, row = id >> 5, cc = id & 31; const size_t o = (size_t)(tok0 + row) * KD + h * DKH + cc * 8;
        if (NEEDQ) st.q[i] = *(const v4u*)(QP + o); st.k[i] = *(const v4u*)(KP + o); }
#pragma unroll
    for (int i = 0; i < 2; ++i) { const int id = tid + 512 * i, row = id >> 4, cc = id & 15; st.v[i] = *(const v4u*)(VB + (size_t)(tok0 + row) * VD + h * DVH + s * 128 + cc * 8); }
    st.g = BC[(size_t)(tok0 + 63) * KD + h * DKH + (tid & 255)];
}
template <bool NEEDQ>
__device__ __forceinline__ void write_stage(LAS unsigned char* lds, const Stage& st, int tid) {
#pragma unroll
    for (int i = 0; i < 4; ++i) { const int id = tid + 512 * i, row = id >> 5, cc = id & 31;
        if (NEEDQ) *(LAS v4u*)(lds + OFF_Q + row * QS + cc * 16) = st.q[i]; *(LAS v4u*)(lds + OFF_K + row * QS + cc * 16) = st.k[i]; }
#pragma unroll
    for (int i = 0; i < 2; ++i) { const int id = tid + 512 * i, row = id >> 4, cc = id & 15; *(LAS v4u*)(lds + OFF_V + row * VS + cc * 16) = st.v[i]; }
    if (tid < 256) *(LAS float*)(lds + OFF_G + 4 * tid) = expf(st.g);
}
template <int PASS>
__device__ __forceinline__ void unit(LAS unsigned char* lds, int tid, int lane, int w, int p, int h, int s, const bf16* QP, const bf16* KP, const bf16* VB, const float* BC, float* O, f32x4* SEND, float* GTOT) {
    const int r = lane & 15, q = lane >> 4, qq = r >> 2, pp = r & 3;
    f32x4 S[16];
#pragma unroll
    for (int dt = 0; dt < 16; ++dt) S[dt] = (f32x4){0.f, 0.f, 0.f, 0.f};
    if (PASS == 2) {
        for (int pj = 0; pj < p; ++pj) {
            const f32x4* se = SEND + ((((size_t)pj * 4 + h) * 4 + s) * 8 + w) * 16 * 64 + lane; const float* gt = GTOT + ((size_t)pj * 4 + h) * DKH;
#pragma unroll
            for (int dt = 0; dt < 16; ++dt) { const f32x4 gg = *(const f32x4*)(gt + 16 * dt + 4 * q); S[dt] = S[dt] * gg + se[dt * 64]; }
        }
    }
    const int tokbase = p * CPP * CHK;
    Stage st;
    issue_loads<PASS == 2>(st, QP, KP, VB, BC, tokbase, h, s, tid);
    __syncthreads();
    write_stage<PASS == 2>(lds, st, tid);
    __syncthreads();
    const LAS unsigned char* qnat = lds + OFF_Q + r * QS + q * 16;
    const LAS unsigned char* knat = lds + OFF_K + r * QS + q * 16;
    const LAS unsigned char* qperm = lds + OFF_Q + r * QS + q * 8;
    const LAS unsigned char* ktr = lds + OFF_K + (8 * q + qq) * QS + pp * 8;
    const LAS unsigned char* vtr = lds + OFF_V + (8 * q + qq) * VS + w * 32 + pp * 8;
    const LAS unsigned char* pnat = lds + OFF_P + r * PS + q * 16;
    for (int c = 0; c < CPP; ++c) {
        const int tok0 = tokbase + c * CHK;
        if (c + 1 < CPP) issue_loads<PASS == 2>(st, QP, KP, VB, BC, tok0 + CHK, h, s, tid);
        bf16x8 vb[2];
#pragma unroll
        for (int kt = 0; kt < 2; ++kt) vb[kt] = cat4(trread(vtr + kt * 32 * VS), trread(vtr + kt * 32 * VS + 4 * VS));
        if (PASS == 2) {
            const int it = w >> 1;
#pragma unroll
            for (int j2 = 0; j2 < 2; ++j2) {
                const int jt = 2 * (w & 1) + j2; f32x4 pa = (f32x4){0.f, 0.f, 0.f, 0.f};
#pragma unroll
                for (int ks = 0; ks < 8; ++ks) { const bf16x8 a = *(const LAS bf16x8*)(knat + jt * 16 * QS + ks * 64), b = *(const LAS bf16x8*)(qnat + it * 16 * QS + ks * 64);
                    pa = __builtin_amdgcn_mfma_f32_16x16x32_bf16(a, b, pa, 0, 0, 0); }
                const int i = 16 * it + r, j0 = 16 * jt + 4 * q;
                v2u o; o.x = cvtpk(j0 + 0 <= i ? pa[0] : 0.f, j0 + 1 <= i ? pa[1] : 0.f); o.y = cvtpk(j0 + 2 <= i ? pa[2] : 0.f, j0 + 3 <= i ? pa[3] : 0.f);
                *(LAS v2u*)(lds + OFF_P + i * PS + j0 * 2) = o;
            }
            f32x4 Oa[4];
#pragma unroll
            for (int i4 = 0; i4 < 4; ++i4) Oa[i4] = (f32x4){0.f, 0.f, 0.f, 0.f};
#pragma unroll
            for (int ks = 0; ks < 8; ++ks) {
                v4u bw; bw.x = cvtpk(S[2 * ks][0], S[2 * ks][1]); bw.y = cvtpk(S[2 * ks][2], S[2 * ks][3]); bw.z = cvtpk(S[2 * ks + 1][0], S[2 * ks + 1][1]); bw.w = cvtpk(S[2 * ks + 1][2], S[2 * ks + 1][3]);
                const bf16x8 bfrag = __builtin_bit_cast(bf16x8, bw);
#pragma unroll
                for (int i4 = 0; i4 < 4; ++i4) { const bf16x8 a = cat4(*(const LAS s16x4*)(qperm + i4 * 16 * QS + ks * 64), *(const LAS s16x4*)(qperm + i4 * 16 * QS + ks * 64 + 32));
                    Oa[i4] = __builtin_amdgcn_mfma_f32_16x16x32_bf16(a, bfrag, Oa[i4], 0, 0, 0); }
            }
            __syncthreads();
#pragma unroll
            for (int i4 = 0; i4 < 4; ++i4)
#pragma unroll
                for (int kj = 0; kj < 2; ++kj) { if (kj == 1 && i4 < 2) continue;
                    const bf16x8 a = *(const LAS bf16x8*)(pnat + i4 * 16 * PS + kj * 64); Oa[i4] = __builtin_amdgcn_mfma_f32_16x16x32_bf16(a, vb[kj], Oa[i4], 0, 0, 0); }
            float* op = O + (size_t)(tok0 + 4 * q) * VD + h * DVH + s * 128 + 16 * w + r;
#pragma unroll
            for (int i4 = 0; i4 < 4; ++i4)
#pragma unroll
                for (int g = 0; g < 4; ++g) op[(size_t)(16 * i4 + g) * VD] = Oa[i4][g];
        }
#pragma unroll
        for (int dt = 0; dt < 16; ++dt) {
#pragma unroll
            for (int kt = 0; kt < 2; ++kt) { const bf16x8 a = cat4(trread(ktr + kt * 32 * QS + dt * 32), trread(ktr + kt * 32 * QS + dt * 32 + 4 * QS)); S[dt] = __builtin_amdgcn_mfma_f32_16x16x32_bf16(a, vb[kt], S[dt], 0, 0, 0); }
            S[dt] = S[dt] * *(const LAS f32x4*)(lds + OFF_G + (16 * dt + 4 * q) * 4);
        }
        __syncthreads();
        if (c + 1 < CPP) { write_stage<PASS == 2>(lds, st, tid); __syncthreads(); }
    }
    if (PASS == 1) {
        f32x4* se = SEND + ((((size_t)p * 4 + h) * 4 + s) * 8 + w) * 16 * 64 + lane;
#pragma unroll
        for (int dt = 0; dt < 16; ++dt) se[dt * 64] = S[dt];
        if (s == 0 && tid < 256) { float a = 0.f; for (int c = 0; c < CPP; ++c) a += BC[(size_t)(tokbase + c * CHK + 63) * KD + h * DKH + tid]; GTOT[((size_t)p * 4 + h) * DKH + tid] = expf(a); }
    }
}
}
template <int PASS>
__device__ __forceinline__ void ph_gla(Frame& F) {
    const bf16* QP = (const bf16*)(KWS + WS_QP); const bf16* KP = (const bf16*)(KWS + WS_KP); const bf16* VB = (const bf16*)(KWS + WS_VB);
    const float* BC = (const float*)(KWS + WS_BC); float* O = (float*)(KWS + WS_O); f32x4* SEND = (f32x4*)(KWS + WS_SEND); float* GTOT = (float*)(KWS + WS_GTOT);
    for (int u = blockIdx.x; u < 256; u += F.G) {
        const int idx = u >> 3, s = idx & 3, ph = (u & 7) * 8 + (idx >> 2), p = ph >> 2, h = ph & 3;
        if (PASS == 1 && p == gla::NPART - 1) continue;
        gla::unit<PASS>(F.lds, F.tid, F.lane, F.wave, p, h, s, QP, KP, VB, BC, O, SEND, GTOT);
    }
}

__device__ __forceinline__ void ph_headnorm(Frame& F) {
    const float* O = (const float*)(KWS + WS_O); const bf16* GB = (const bf16*)(KWS + WS_GB); bf16* OG = (bf16*)(KWS + WS_OG); const float* hnw = KIN(5);
    const int gw = blockIdx.x * NWAVES + F.wave, NGW = F.G * NWAVES;
    const f32x4 w0 = ((const f32x4*)hnw)[2 * F.lane], w1 = ((const f32x4*)hnw)[2 * F.lane + 1];
    for (int it = gw; it < T * NHEAD; it += NGW) {
        const size_t off = (size_t)(it >> 2) * VD + (it & 3) * DVH + 8 * F.lane;
        const f32x4 a = *(const f32x4*)(O + off), b = *(const f32x4*)(O + off + 4);
        const float ss = wave_sum((a.x * a.x + a.y * a.y) + (a.z * a.z + a.w * a.w) + (b.x * b.x + b.y * b.y) + (b.z * b.z + b.w * b.w));
        const float rstd = 1.0f / sqrtf(ss * (1.0f / DVH) + EPS);
        const v4u g = *(const v4u*)(GB + off);
        v4u o;
        o.x = pk2(a.x * rstd * w0.x * bflo(g.x), a.y * rstd * w0.y * bfhi(g.x)); o.y = pk2(a.z * rstd * w0.z * bflo(g.y), a.w * rstd * w0.w * bfhi(g.y));
        o.z = pk2(b.x * rstd * w1.x * bflo(g.z), b.y * rstd * w1.y * bfhi(g.z)); o.w = pk2(b.z * rstd * w1.z * bflo(g.w), b.w * rstd * w1.w * bfhi(g.w));
        *(v4u*)(OG + off) = o;
    }
}

__device__ __forceinline__ void ph_router(Frame& F, int layer, const float* H) {
    typedef float f32x4v __attribute__((ext_vector_type(4)));
    const float* WRT = (const float*)(KWS + WS_WRT) + (size_t)layer * NLOG * 2048;
    const float* wn = KIN(10) + layer * D; const float* bg = KIN(12) + layer * NGRP; const float* br = KIN(14) + layer * NE;
    bf16* HN = (bf16*)(KWS + WS_HN);
    int* TKE = (int*)(KWS + WS_TKE); int* TKS = (int*)(KWS + WS_TKS); float* TKG = (float*)(KWS + WS_TKG); int* LIST = (int*)(KWS + WS_LIST);
    unsigned* gcnt = F.ctl + CW_CNT + 64 * layer;
    LAS float* lg = (LAS float*)(F.lds + RING_OFF);
    LAS float* rs = (LAS float*)(F.lds + RING_OFF + 64 * 48 * 4);
    LAS int* sel = (LAS int*)(F.lds + RING_OFF + 64 * 48 * 4 + 256);
    LAS float* selg = (LAS float*)(F.lds + RING_OFF + 64 * 48 * 4 + 256 + 1024);
    volatile LAS int* cntl = F.MISC + MI_CNTL; volatile LAS int* basel = F.MISC + MI_BASEL;
    for (int blk = blockIdx.x; blk < T / 64; blk += F.G) {
        if (F.tid < 32) cntl[F.tid] = 0;
        if (F.wave < 4) {
            const int r = F.lane & 15, q = F.lane >> 4, row = blk * 64 + F.wave * 16 + r;
            const float* hp = H + (size_t)row * D + 4 * q;
            const float* wp0 = WRT + (size_t)r * 2048 + 4 * q; const float* wp1 = wp0 + 16 * 2048; const float* wp2 = wp0 + 32 * 2048;
            f32x4v a0 = {0.f, 0.f, 0.f, 0.f}, a1 = a0, a2 = a0; float ss = 0.f;
#pragma unroll 4
            for (int k0 = 0; k0 < D; k0 += 16) {
                const f32x4 a = *(const f32x4*)(hp + k0), b0 = *(const f32x4*)(wp0 + k0), b1 = *(const f32x4*)(wp1 + k0), b2 = *(const f32x4*)(wp2 + k0);
                ss += (a.x * a.x + a.y * a.y) + (a.z * a.z + a.w * a.w);
#pragma unroll
                for (int s = 0; s < 4; ++s) { a0 = __builtin_amdgcn_mfma_f32_16x16x4f32(a[s], b0[s], a0, 0, 0, 0); a1 = __builtin_amdgcn_mfma_f32_16x16x4f32(a[s], b1[s], a1, 0, 0, 0); a2 = __builtin_amdgcn_mfma_f32_16x16x4f32(a[s], b2[s], a2, 0, 0, 0); }
            }
            ss += __shfl_xor(ss, 16); ss += __shfl_xor(ss, 32);
            const float rstd = 1.0f / sqrtf(ss * (1.0f / D) + EPS);
            if (q == 0) rs[F.wave * 16 + r] = rstd;
#pragma unroll
            for (int j = 0; j < 4; ++j) { const int rl = F.wave * 16 + 4 * q + j; lg[rl * 48 + r] = a0[j]; lg[rl * 48 + 16 + r] = a1[j]; lg[rl * 48 + 32 + r] = a2[j]; }
        }
        __syncthreads();
        if (F.tid < 64) {
            const int rl = F.tid; const float rstd = rs[rl]; const LAS float* L = lg + rl * 48;
            float gl0 = L[0] * rstd + bg[0]; int g = 0; float gv[4]; gv[0] = gl0;
#pragma unroll
            for (int j = 1; j < 4; ++j) { gv[j] = L[j] * rstd + bg[j]; if (gv[j] > gl0) { gl0 = gv[j]; g = j; } }
            float den = 0.f;
#pragma unroll
            for (int j = 0; j < 4; ++j) den += expf(gv[j] - gl0);
            const float gp = 1.0f / den;
            float l1 = -3.0e38f, l2 = -3.0e38f; int e1 = 0, e2 = 0;
            for (int j = 0; j < 8; ++j) { const float v = L[4 + 8 * g + j] * rstd + br[8 * g + j];
                if (v > l1) { l2 = l1; e2 = e1; l1 = v; e1 = j; } else if (v > l2) { l2 = v; e2 = j; } }
            const float ex = expf(l2 - l1), p1 = 1.0f / (1.0f + ex), p2 = ex * p1;
            const int E0 = 8 * g + e1, E1 = 8 * g + e2;
            sel[rl * 4 + 0] = E0; sel[rl * 4 + 1] = E1;
            sel[rl * 4 + 2] = __hip_atomic_fetch_add((LAS int*)&cntl[E0], 1, __ATOMIC_RELAXED, __HIP_MEMORY_SCOPE_WORKGROUP); sel[rl * 4 + 3] = __hip_atomic_fetch_add((LAS int*)&cntl[E1], 1, __ATOMIC_RELAXED, __HIP_MEMORY_SCOPE_WORKGROUP);
            selg[rl * 2 + 0] = gp * p1; selg[rl * 2 + 1] = gp * p2;
        }
        __syncthreads();
        if (F.tid < 32) basel[F.tid] = (int)__hip_atomic_fetch_add(gcnt + F.tid, (unsigned)cntl[F.tid], RLX_AGENT);
        __syncthreads();
        if (F.tid < 128) {
            const int rl = F.tid >> 1, k = F.tid & 1, tk = (blk * 64 + rl) * 2 + k, e = sel[rl * 4 + k], slot = basel[e] + sel[rl * 4 + 2 + k];
            TKE[tk] = e; TKS[tk] = slot; TKG[tk] = selg[rl * 2 + k]; LIST[e * T + slot] = tk;
        }
        for (int rr = 0; rr < 8; ++rr) {
            const int rl = F.wave * 8 + rr, row = blk * 64 + rl; const float rstd = rs[rl];
            const f32x4* xr = (const f32x4*)(H + (size_t)row * D) + F.lane; v2u* o8 = (v2u*)(HN + (size_t)row * D) + F.lane;
#pragma unroll
            for (int j = 0; j < 8; ++j) { const f32x4 v = xr[64 * j] * rstd * ((const f32x4*)wn)[F.lane + 64 * j]; v2u o; o.x = pk2(v.x, v.y); o.y = pk2(v.z, v.w); o8[64 * j] = o; }
        }
        __syncthreads();
    }
}

__device__ __forceinline__ void moe_meta(Frame& F, int layer) {
    __syncthreads();
    if (F.tid == 0) {
        const unsigned* gcnt = F.ctl + CW_CNT + 64 * layer; int p = 0, nt = 0;
        for (int e = 0; e < NE; ++e) { const int c = (int)__hip_atomic_load(gcnt + e, RLX_AGENT); F.MISC[MI_PSTART + e] = p; const int tl = (c + 255) >> 8;
            for (int j = 0; j < tl; ++j) F.MISC[MI_TEXP + nt + j] = e; nt += tl; p += tl * 256; }
        F.MISC[MI_PSTART + NE] = p; F.MISC[MI_NRT] = nt;
    }
    __syncthreads();
}

__device__ __forceinline__ void ph_gather(Frame& F, int layer) {
    const bf16* HN = (const bf16*)(KWS + WS_HN); bf16* XS = (bf16*)(KWS + WS_XS); const int* LIST = (const int*)(KWS + WS_LIST);
    const float* TKG = (const float*)(KWS + WS_TKG); float* RG = (float*)(KWS + WS_RGATE); const unsigned* gcnt = F.ctl + CW_CNT + 64 * layer;
    const int nrows = F.MISC[MI_NRT] * 256, gw = blockIdx.x * NWAVES + F.wave, NGW = F.G * NWAVES;
    for (int r = gw; r < nrows; r += NGW) {
        const int e = F.MISC[MI_TEXP + (r >> 8)], slot = r - F.MISC[MI_PSTART + e], cnt = (int)__hip_atomic_load(gcnt + e, RLX_AGENT);
        const bool valid = slot < cnt; const int tk = valid ? LIST[e * T + slot] : 0;
        const v4u* src = (const v4u*)(HN + (size_t)(tk >> 1) * D) + F.lane; v4u* dst = (v4u*)(XS + (size_t)r * D) + F.lane;
#pragma unroll
        for (int j = 0; j < 4; ++j) dst[64 * j] = src[64 * j];
        if (F.lane == 0) RG[r] = valid ? TKG[tk] : 0.f;
    }
}

template <bool FINAL>
__device__ __forceinline__ void ph_combine(Frame& F, const float* H, float* Hout, const float* wn) {
    const bf16* Y = (const bf16*)(KWS + WS_Y); const int* TKE = (const int*)(KWS + WS_TKE); const int* TKS = (const int*)(KWS + WS_TKS); bf16* HN = (bf16*)(KWS + WS_HN);
    const int gw = blockIdx.x * NWAVES + F.wave, NGW = F.G * NWAVES;
    for (int t = gw; t < T; t += NGW) {
        const int r0 = F.MISC[MI_PSTART + TKE[2 * t]] + TKS[2 * t], r1 = F.MISC[MI_PSTART + TKE[2 * t + 1]] + TKS[2 * t + 1];
        const f32x4* hr = (const f32x4*)(H + (size_t)t * D) + F.lane;
        const v2u* y0 = (const v2u*)(Y + (size_t)r0 * D) + F.lane; const v2u* y1 = (const v2u*)(Y + (size_t)r1 * D) + F.lane;
        f32x4 v[8]; float s = 0.f;
#pragma unroll
        for (int j = 0; j < 8; ++j) { const v2u a = y0[64 * j], b = y1[64 * j]; f32x4 h = hr[64 * j];
            h.x += bflo(a.x) + bflo(b.x); h.y += bfhi(a.x) + bfhi(b.x); h.z += bflo(a.y) + bflo(b.y); h.w += bfhi(a.y) + bfhi(b.y);
            v[j] = h; s += (h.x * h.x + h.y * h.y) + (h.z * h.z + h.w * h.w); }
        const float rstd = 1.0f / sqrtf(wave_sum(s) * (1.0f / D) + EPS);
        if (FINAL) {
            f32x4* o = (f32x4*)(KOUT + (size_t)t * D) + F.lane;
#pragma unroll
            for (int j = 0; j < 8; ++j) o[64 * j] = v[j] * rstd * ((const f32x4*)wn)[F.lane + 64 * j];
        } else {
            f32x4* ho = (f32x4*)(Hout + (size_t)t * D) + F.lane; v2u* o8 = (v2u*)(HN + (size_t)t * D) + F.lane;
#pragma unroll
            for (int j = 0; j < 8; ++j) { ho[64 * j] = v[j]; const f32x4 w = v[j] * rstd * ((const f32x4*)wn)[F.lane + 64 * j]; v2u o; o.x = pk2(w.x, w.y); o.y = pk2(w.z, w.w); o8[64 * j] = o; }
        }
    }
}

__device__ __forceinline__ void ph_conv(Frame& F) {
    const bf16* BG = (const bf16*)(KWS + WS_VB); const bf16* U = (const bf16*)(KWS + WS_GB); bf16* OG = (bf16*)(KWS + WS_OG); const float* cw = KIN(8);
    const size_t n8 = (size_t)T * D / 8;
    for (size_t i = (size_t)blockIdx.x * 512 + F.tid; i < n8; i += (size_t)F.G * 512) {
        const int t = (int)(i >> 8), c = (int)(i & 255) * 8; const size_t off = (size_t)t * D + c;
        const v4u u0 = *(const v4u*)(U + off); const v4u zero = {0u, 0u, 0u, 0u};
        const v4u u1 = t >= 1 ? *(const v4u*)(U + off - D) : zero; const v4u u2 = t >= 2 ? *(const v4u*)(U + off - 2 * D) : zero;
        const v4u b = *(const v4u*)(BG + off);
        const f32x4 wa0 = *(const f32x4*)(cw + c), wa1 = *(const f32x4*)(cw + c + 4), wb0 = *(const f32x4*)(cw + D + c), wb1 = *(const f32x4*)(cw + D + c + 4), wc0 = *(const f32x4*)(cw + 2 * D + c), wc1 = *(const f32x4*)(cw + 2 * D + c + 4);
        v4u o;
        o.x = pk2(bflo(b.x) * (wa0.x * bflo(u2.x) + wb0.x * bflo(u1.x) + wc0.x * bflo(u0.x)), bfhi(b.x) * (wa0.y * bfhi(u2.x) + wb0.y * bfhi(u1.x) + wc0.y * bfhi(u0.x)));
        o.y = pk2(bflo(b.y) * (wa0.z * bflo(u2.y) + wb0.z * bflo(u1.y) + wc0.z * bflo(u0.y)), bfhi(b.y) * (wa0.w * bfhi(u2.y) + wb0.w * bfhi(u1.y) + wc0.w * bfhi(u0.y)));
        o.z = pk2(bflo(b.z) * (wa1.x * bflo(u2.z) + wb1.x * bflo(u1.z) + wc1.x * bflo(u0.z)), bfhi(b.z) * (wa1.y * bfhi(u2.z) + wb1.y * bfhi(u1.z) + wc1.y * bfhi(u0.z)));
        o.w = pk2(bflo(b.w) * (wa1.z * bflo(u2.w) + wb1.z * bflo(u1.w) + wc1.z * bflo(u0.w)), bfhi(b.w) * (wa1.w * bfhi(u2.w) + wb1.w * bfhi(u1.w) + wc1.w * bfhi(u0.w)));
        *(v4u*)(OG + off) = o;
    }
}

#ifndef PH_MASK
#define PH_MASK 0xFFFFFFFFu
#endif
#define IN(k) (((PH_MASK >> (k)) & 1u) && lo <= (k) && (k) < hi)
#define BOTH(k) (IN(k) && IN((k) + 1))
#define GRID_BAR() do { if (N_LAUNCHES == 1) xcd_barrier(bar); } while (0)
template <int LAYER>
__device__ __forceinline__ void moe_block(Frame& F, const int lo, const int hi, const XcdBarrier& bar) {
    constexpr int pb = LAYER ? 14 : 6;
    float* H1 = (float*)(KWS + WS_H1); float* H2 = (float*)(KWS + WS_H2);
    if (IN(pb + 0)) { ph_router(F, LAYER, H1); if (BOTH(pb + 0)) GRID_BAR(); }
    if (IN(pb + 1)) { moe_meta(F, LAYER); ph_gather(F, LAYER); if (BOTH(pb + 1)) GRID_BAR(); }
    if (IN(pb + 2)) {
        moe_meta(F, LAYER);
        const int nrt = F.MISC[MI_NRT];
        pg8::Gemm g{(const bf16*)(KWS + WS_XS), (const bf16*)(KWS + WS_WGU) + (size_t)LAYER * NE * 1024 * 2048, nrt * 256, 1024, D};
        pg8::MoeOrder S{nrt, 4, nrt * 4, F.G, (int)blockIdx.x, (size_t)1024 * 2048 * 2, (const volatile LAS int*)(F.MISC + MI_TEXP)};
        pg8::EpiGateUp E{(bf16*)(KWS + WS_ACT)};
        pg8::gemm_phase<pg8::EpiGateUp, pg8::MoeOrder, true, true>(F.lds + RING_OFF, g, S, E);
        if (BOTH(pb + 2)) GRID_BAR();
    }
    if (IN(pb + 3)) {
        moe_meta(F, LAYER);
        const int nrt = F.MISC[MI_NRT];
        pg8::Gemm g{(const bf16*)(KWS + WS_ACT), (const bf16*)(KWS + WS_WDN) + (size_t)LAYER * NE * 2048 * 512, nrt * 256, 2048, FF};
        pg8::MoeOrder S{nrt, 8, nrt * 8, F.G, (int)blockIdx.x, (size_t)2048 * 512 * 2, (const volatile LAS int*)(F.MISC + MI_TEXP)};
        pg8::EpiDown E{(bf16*)(KWS + WS_Y), (const float*)(KWS + WS_RGATE)};
        pg8::gemm_phase<pg8::EpiDown, pg8::MoeOrder, true, true>(F.lds + RING_OFF, g, S, E);
        if (BOTH(pb + 3)) GRID_BAR();
    }
    if (IN(pb + 4)) {
        moe_meta(F, LAYER);
        if (LAYER == 0) { ph_combine<false>(F, H1, H2, KIN(1) + D); if (BOTH(pb + 4)) GRID_BAR(); }
        else ph_combine<true>(F, H1, nullptr, KIN(17));
    }
}

struct Args { const float* in[18]; float* out; unsigned char* ws; int ph_lo, ph_hi, li, pad; };
__global__ void __launch_bounds__(NWAVES * 64, 2) mega_fwd(Args args) {
    extern __shared__ __attribute__((aligned(16))) unsigned char lds[];
    Frame F;
    F.lds = (LAS unsigned char*)lds;
    F.MISC = (volatile LAS int*)(F.lds + MISC_OFF);
    F.tid = threadIdx.x; F.lane = F.tid & 63; F.wave = __builtin_amdgcn_readfirstlane(F.tid >> 6);
    F.G = gridDim.x;
    F.ka = (__attribute__((address_space(4))) const unsigned char*)__builtin_amdgcn_kernarg_segment_ptr();
    F.ctl = (unsigned*)(args.ws + WS_CTL);
    for (int u = F.tid; u < MISC_BYTES / 4; u += NWAVES * 64) F.MISC[u] = 0;
    __syncthreads();
    XcdBarrier bar; bar.bar = F.ctl + CW_BAR; bar.x = 0; bar.st = nullptr;
    if (N_LAUNCHES == 1) bar = xcd_barrier_post(F.ctl + CW_BAR, (volatile LAS unsigned*)(F.MISC + 8));
    const int lo = args.ph_lo, hi = args.ph_hi;
    bf16* HN = (bf16*)(KWS + WS_HN); float* H1 = (float*)(KWS + WS_H1); float* H2 = (float*)(KWS + WS_H2);

    if (IN(0)) { p0_convert(F); __syncthreads(); p0_norm_gl(F); if (BOTH(0)) GRID_BAR(); }
    if (IN(1)) {
        pg8::Gemm g{HN, (const bf16*)(KWS + WS_WGI), T, GINM, D}; pg8::StaticOrder S; S.init(T, GINM, F.G, (int)blockIdx.x);
        pg8::EpiGlaIn E{(bf16*)(KWS + WS_QP), (bf16*)(KWS + WS_KP), (bf16*)(KWS + WS_VB), (bf16*)(KWS + WS_GB), (const float*)(KWS + WS_BC)};
        pg8::gemm_phase<pg8::EpiGlaIn, pg8::StaticOrder, true, true>(F.lds + RING_OFF, g, S, E);
        if (BOTH(1)) GRID_BAR();
    }
#ifdef GLA_NAIVE
    if (IN(2)) { if (BOTH(2)) GRID_BAR(); }
    if (IN(3)) { ph_gla_naive(F); if (BOTH(3)) GRID_BAR(); }
#else
    if (IN(2)) { ph_gla<1>(F); if (BOTH(2)) GRID_BAR(); }
    if (IN(3)) { ph_gla<2>(F); if (BOTH(3)) GRID_BAR(); }
#endif
    if (IN(4)) { ph_headnorm(F); if (BOTH(4)) GRID_BAR(); }
    if (IN(5)) {
        pg8::Gemm g{(const bf16*)(KWS + WS_OG), (const bf16*)(KWS + WS_WGO), T, D, D}; pg8::StaticOrder S; S.init(T, D, F.G, (int)blockIdx.x);
        pg8::EpiRes E{KIN(0), H1, D};
        pg8::gemm_phase<pg8::EpiRes, pg8::StaticOrder, true, true>(F.lds + RING_OFF, g, S, E);
        if (BOTH(5)) GRID_BAR();
    }
    moe_block<0>(F, lo, hi, bar);
    if (IN(11)) {
        pg8::Gemm g{HN, (const bf16*)(KWS + WS_WCI), T, 6144, D}; pg8::StaticOrder S; S.init(T, 6144, F.G, (int)blockIdx.x);
        pg8::EpiConvIn E{(bf16*)(KWS + WS_VB), (bf16*)(KWS + WS_GB)};
        pg8::gemm_phase<pg8::EpiConvIn, pg8::StaticOrder, true, true>(F.lds + RING_OFF, g, S, E);
        if (BOTH(11)) GRID_BAR();
    }
    if (IN(12)) { ph_conv(F); if (BOTH(12)) GRID_BAR(); }
    if (IN(13)) {
        pg8::Gemm g{(const bf16*)(KWS + WS_OG), (const bf16*)(KWS + WS_WCO), T, D, D}; pg8::StaticOrder S; S.init(T, D, F.G, (int)blockIdx.x);
        pg8::EpiRes E{H2, H1, D};
        pg8::gemm_phase<pg8::EpiRes, pg8::StaticOrder, true, true>(F.lds + RING_OFF, g, S, E);
        if (BOTH(13)) GRID_BAR();
    }
    moe_block<1>(F, lo, hi, bar);
#undef IN
#undef BOTH
#undef GRID_BAR
}

extern "C" void kernel_launch(void* const* d_in, const int* in_sizes, int n_in, void* d_out, int out_size, void* d_ws, size_t ws_size, hipStream_t stream) {
    static int grid = 0;
    if (grid == 0) {
        if (n_in != 18 || in_sizes[0] != T * D || out_size != T * D || ws_size < WS_END) { fprintf(stderr, "kernel_launch: unexpected shapes (n_in %d, in0 %d, out %d, ws %zu)\n", n_in, n_in > 0 ? in_sizes[0] : -1, out_size, ws_size); grid = -1; return; }
        int dev = 0, cus = 0, per_cu = 0;
        if (hipGetDevice(&dev) != hipSuccess || hipDeviceGetAttribute(&cus, hipDeviceAttributeMultiprocessorCount, dev) != hipSuccess) { grid = -1; return; }
        if (hipFuncSetAttribute((const void*)mega_fwd, hipFuncAttributeMaxDynamicSharedMemorySize, LDS_BYTES) != hipSuccess) { fprintf(stderr, "kernel_launch: hipFuncSetAttribute failed\n"); grid = -1; return; }
        if (hipOccupancyMaxActiveBlocksPerMultiprocessor(&per_cu, (const void*)mega_fwd, NWAVES * 64, LDS_BYTES) != hipSuccess || per_cu < 1) { fprintf(stderr, "kernel_launch: occupancy query reports %d\n", per_cu); }
        (void)hipGetLastError();
        grid = cus;
    }
    if (grid < 0) return;
    if (hipMemsetAsync((char*)d_ws + WS_CTL, 0, CTL_ZERO_BYTES, stream) != hipSuccess) return;
    Args a{};
    for (int i = 0; i < 18; ++i) a.in[i] = (const float*)d_in[i];
    a.out = (float*)d_out; a.ws = (unsigned char*)d_ws;
    for (int li = 0; li < N_LAUNCHES; ++li) {
        a.ph_lo = (N_LAUNCHES == 1) ? 0 : li; a.ph_hi = (N_LAUNCHES == 1) ? NPH : li + 1; a.li = li; a.pad = 0;
        hipLaunchKernelGGL(mega_fwd, dim3(grid), dim3(NWAVES * 64), LDS_BYTES, stream, a);
        const hipError_t le = hipPeekAtLastError();
        if (le != hipSuccess) { fprintf(stderr, "kernel_launch: launch %d failed: %s\n", li, hipGetErrorName(le)); break; }
    }
}
```

```cpp
#include <hip/hip_runtime.h>
#include <cstdio>
#include <cstdint>

#ifndef MK_N_LAUNCHES
#define MK_N_LAUNCHES 1
#endif

namespace pg8 {
#define PG8_LAS __attribute__((address_space(3)))
typedef unsigned short bf16_t;
typedef short bf16x8 __attribute__((ext_vector_type(8)));
typedef float f32x4 __attribute__((ext_vector_type(4)));
typedef unsigned u32x4 __attribute__((ext_vector_type(4)));
constexpr int BM = 256, BK = 64, HALF = 128, HTB = HALF * BK * 2, STAGE_BYTES = 8 * HTB, NXCD = 8, WGM = 8;

__host__ __device__ __forceinline__ int lds_byte(int r, int c) { const int st = (r >> 4) * 2 + (c >> 5), rr = r & 15, cc = c & 31, ob = rr * 64 + cc * 2; return st * 1024 + (ob ^ (((ob >> 9) & 1) << 5)); }
__host__ __device__ __forceinline__ void stage_rc(int b, int& R, int& C) { const int st = b / 1024, sb = b % 1024, swz = sb ^ (((sb >> 9) & 1) << 5); R = (st >> 1) * 16 + swz / 64; C = (st & 1) * 32 + (swz % 64) / 2; }
__host__ __device__ __forceinline__ int perm32(int rho) { const int n = rho >> 4, i = rho & 15; return 8 * (i >> 2) + 4 * n + (i & 3); }

struct Unit { int pm, pn; size_t boff; int e, s0, cnt; };
struct Gemm { const bf16_t* A; const bf16_t* Bt; int M, N, K; };

struct StaticOrder {
    static constexpr bool GATHER = false;
    int nM, nN, nwg, G, c;
    __host__ __device__ void init(int M, int N, int G_, int c_) { nM = M / BM; nN = N / BM; nwg = nM * nN; G = G_; c = c_; }
    __host__ __device__ bool next(int i, Unit& u) const {
        const long L = (long)i * G + c; if (L >= nwg) return false;
        int wgid = (int)L; { const int q = nwg / NXCD, r = nwg % NXCD, xcd = wgid % NXCD, off = wgid / NXCD; wgid = (xcd < r ? xcd * (q + 1) : r * (q + 1) + (xcd - r) * q) + off; }
        const int nig = WGM * nN, gid = wgid / nig, fm = gid * WGM, gsz = (nM - fm) < WGM ? (nM - fm) : WGM;
        u.pm = fm + ((wgid % nig) % gsz); u.pn = (wgid % nig) / gsz; u.boff = 0; u.e = 0; u.s0 = 0; u.cnt = 0; return true;
    }
    __device__ __forceinline__ int arow(const Unit& u, int r) const { return u.pm * BM + r; }
    __device__ __forceinline__ void a_ready(const Unit&) const {}
    __device__ __forceinline__ void done(const Unit&) const {}
};
template <bool GATHER_>
struct MoeOrder {
    static constexpr bool GATHER = GATHER_;
    int nrt, NT, nwg, G, c; size_t estride; const volatile PG8_LAS int* misc; const int* list;
    __device__ __forceinline__ bool next(int i, Unit& u) const {
        const long L = (long)i * G + c; if (L >= nwg) return false;
        int wgid = (int)L; { const int q = nwg / NXCD, r = nwg % NXCD, xcd = wgid % NXCD, off = wgid / NXCD; wgid = (xcd < r ? xcd * (q + 1) : r * (q + 1) + (xcd - r) * q) + off; }
        u.pm = wgid / NT; u.pn = wgid % NT;
        u.e = __builtin_amdgcn_readfirstlane(misc[64 + u.pm]); u.s0 = __builtin_amdgcn_readfirstlane(misc[320 + u.pm]); u.cnt = __builtin_amdgcn_readfirstlane(misc[480 + u.e]);
        u.boff = (size_t)u.e * estride; return true;
    }
    __device__ __forceinline__ int arow(const Unit& u, int r) const { if (!GATHER_) return u.pm * BM + r; const int slot = u.s0 + r; const int tk = slot < u.cnt ? list[u.e * 16384 + slot] : 0; return tk >> 1; }
    __device__ __forceinline__ void a_ready(const Unit&) const {}
    __device__ __forceinline__ void done(const Unit&) const {}
};

__device__ __forceinline__ unsigned cvt_pk_bf16(float lo, float hi) { unsigned r; asm volatile("v_cvt_pk_bf16_f32 %0, %1, %2" : "=v"(r) : "v"(lo), "v"(hi)); return r; }
__device__ __forceinline__ u32x4 pack8(const f32x4& v0, const f32x4& v1) { u32x4 w; w.x = cvt_pk_bf16(v0[0], v0[1]); w.y = cvt_pk_bf16(v0[2], v0[3]); w.z = cvt_pk_bf16(v1[0], v1[1]); w.w = cvt_pk_bf16(v1[2], v1[3]); return w; }
__device__ __forceinline__ float fexp(float x) { return __builtin_amdgcn_exp2f(x * 1.44269504089f); }
__device__ __forceinline__ float silu_f(float x) { return x * __builtin_amdgcn_rcpf(1.0f + fexp(-x)); }

struct EpiRes {
    static constexpr bool PERM = false, AFTER_DRAIN = false;
    const float* base; float* out; int ldc;
    __device__ __forceinline__ void operator()(const f32x4 (&acc)[2][2][4][2], const Unit& u, int wr, int wc, int fr, int fq) const {
        const int row0 = u.pm * BM + wr * 64 + fr, col0 = u.pn * BM + wc * 32 + 4 * fq;
#pragma unroll
        for (int ai = 0; ai < 2; ++ai)
#pragma unroll
            for (int m = 0; m < 4; ++m) { const size_t off = (size_t)(row0 + ai * HALF + m * 16) * ldc + col0;
#pragma unroll
                for (int bj = 0; bj < 2; ++bj)
#pragma unroll
                    for (int n = 0; n < 2; ++n) { const f32x4 bs = *(const f32x4*)(base + off + bj * HALF + n * 16); *(f32x4*)(out + off + bj * HALF + n * 16) = bs + acc[ai][bj][m][n]; } }
    }
};
struct EpiGlaIn {
    static constexpr bool PERM = true, AFTER_DRAIN = false;
    bf16_t *Qp, *Kp, *Vb, *Gb; const float* Bc;
    __device__ __forceinline__ void operator()(const f32x4 (&acc)[2][2][4][2], const Unit& u, int wr, int wc, int fr, int fq) const {
        const int row0 = u.pm * BM + wr * 64 + fr, cl = wc * 32 + 8 * fq, ct = u.pn;
        if (ct < 8) {
            const bool isq = ct < 4; const int cb = (ct & 3) * 256 + cl; bf16_t* dst = isq ? Qp : Kp; const float sgn = isq ? 1.0f : -1.0f, mul = isq ? 0.0625f : 1.0f;
#pragma unroll
            for (int ai = 0; ai < 2; ++ai)
#pragma unroll
                for (int m = 0; m < 4; ++m) { const size_t ro = (size_t)(row0 + ai * HALF + m * 16) * 1024;
#pragma unroll
                    for (int bj = 0; bj < 2; ++bj) { const int c = cb + bj * HALF; const f32x4 b0 = *(const f32x4*)(Bc + ro + c), b1 = *(const f32x4*)(Bc + ro + c + 4);
                        f32x4 v0 = acc[ai][bj][m][0], v1 = acc[ai][bj][m][1];
#pragma unroll
                        for (int j = 0; j < 4; ++j) { v0[j] *= fexp(sgn * b0[j]) * mul; v1[j] *= fexp(sgn * b1[j]) * mul; }
                        *(u32x4*)(dst + ro + c) = pack8(v0, v1); } }
        } else if (ct < 16) {
            const int cb = (ct - 8) * 256 + cl;
#pragma unroll
            for (int ai = 0; ai < 2; ++ai)
#pragma unroll
                for (int m = 0; m < 4; ++m) { const size_t ro = (size_t)(row0 + ai * HALF + m * 16) * 2048;
#pragma unroll
                    for (int bj = 0; bj < 2; ++bj) *(u32x4*)(Vb + ro + cb + bj * HALF) = pack8(acc[ai][bj][m][0], acc[ai][bj][m][1]); }
        } else {
            const int cb = (ct - 16) * 256 + cl;
#pragma unroll
            for (int ai = 0; ai < 2; ++ai)
#pragma unroll
                for (int m = 0; m < 4; ++m) { const size_t ro = (size_t)(row0 + ai * HALF + m * 16) * 2048;
#pragma unroll
                    for (int bj = 0; bj < 2; ++bj) { f32x4 v0 = acc[ai][bj][m][0], v1 = acc[ai][bj][m][1];
#pragma unroll
                        for (int j = 0; j < 4; ++j) { v0[j] = silu_f(v0[j]); v1[j] = silu_f(v1[j]); }
                        *(u32x4*)(Gb + ro + cb + bj * HALF) = pack8(v0, v1); } }
        }
    }
};
struct EpiConvIn {
    static constexpr bool PERM = true, AFTER_DRAIN = false;
    bf16_t *BG, *U;
    __device__ __forceinline__ void operator()(const f32x4 (&acc)[2][2][4][2], const Unit& u, int wr, int wc, int fr, int fq) const {
        const int row0 = u.pm * BM + wr * 64 + fr, cl = wc * 32 + 8 * fq, ct = u.pn;
        if (ct < 8) {
            const int cb = ct * 256 + cl;
#pragma unroll
            for (int ai = 0; ai < 2; ++ai)
#pragma unroll
                for (int m = 0; m < 4; ++m) { const size_t ro = (size_t)(row0 + ai * HALF + m * 16) * 2048;
#pragma unroll
                    for (int bj = 0; bj < 2; ++bj) *(u32x4*)(BG + ro + cb + bj * HALF) = pack8(acc[ai][bj][m][0], acc[ai][bj][m][1]); }
        } else {
            const int cb = (ct - 8) * 128 + cl;
#pragma unroll
            for (int ai = 0; ai < 2; ++ai)
#pragma unroll
                for (int m = 0; m < 4; ++m) { const size_t ro = (size_t)(row0 + ai * HALF + m * 16) * 2048;
                    *(u32x4*)(U + ro + cb) = pack8(acc[ai][0][m][0] * acc[ai][1][m][0], acc[ai][0][m][1] * acc[ai][1][m][1]); }
        }
    }
};
struct EpiGateUp {
    static constexpr bool PERM = true, AFTER_DRAIN = false;
    bf16_t* ACT;
    __device__ __forceinline__ void operator()(const f32x4 (&acc)[2][2][4][2], const Unit& u, int wr, int wc, int fr, int fq) const {
        const int row0 = u.pm * BM + wr * 64 + fr, cb = u.pn * 128 + wc * 32 + 8 * fq;
#pragma unroll
        for (int ai = 0; ai < 2; ++ai)
#pragma unroll
            for (int m = 0; m < 4; ++m) { const size_t ro = (size_t)(row0 + ai * HALF + m * 16) * 512;
                f32x4 v0 = acc[ai][0][m][0], v1 = acc[ai][0][m][1];
#pragma unroll
                for (int j = 0; j < 4; ++j) { v0[j] = silu_f(v0[j]) * acc[ai][1][m][0][j]; v1[j] = silu_f(v1[j]) * acc[ai][1][m][1][j]; }
                *(u32x4*)(ACT + ro + cb) = pack8(v0, v1); }
    }
};
struct EpiDown {
    static constexpr bool PERM = true, AFTER_DRAIN = false;
    bf16_t* Y;
    __device__ __forceinline__ void operator()(const f32x4 (&acc)[2][2][4][2], const Unit& u, int wr, int wc, int fr, int fq) const {
        const int row0 = u.pm * BM + wr * 64 + fr, cb = u.pn * 256 + wc * 32 + 8 * fq;
#pragma unroll
        for (int ai = 0; ai < 2; ++ai)
#pragma unroll
            for (int m = 0; m < 4; ++m) { const size_t ro = (size_t)(row0 + ai * HALF + m * 16) * 2048;
#pragma unroll
                for (int bj = 0; bj < 2; ++bj) *(u32x4*)(Y + ro + cb + bj * HALF) = pack8(acc[ai][bj][m][0], acc[ai][bj][m][1]); }
    }
};

template <class Epi, class Sched, bool ALIGN_EPI = false>
__device__ __forceinline__ void gemm_phase(PG8_LAS unsigned char* lds, const Gemm g, const Sched& S, const Epi& E) {
    const int tid = threadIdx.x, wid = __builtin_amdgcn_readfirstlane(tid >> 6), lane = tid & 63, wr = wid >> 2, wc = wid & 3, fr = lane & 15, fq = lane >> 4;
    const int K = g.K, nt = K / BK;
    unsigned voffA[2], voffB[2]; int RA[2], CA[2];
#pragma unroll
    for (int i = 0; i < 2; ++i) { int R, C; stage_rc(tid * 16 + i * 8192, R, C); const int Rb = Epi::PERM ? ((R & ~31) + perm32(R & 31)) : R; RA[i] = R; CA[i] = C;
        voffA[i] = (unsigned)(R * K + C) * 2u; voffB[i] = (unsigned)(Rb * K + C) * 2u; }
    const size_t kstep = (size_t)(BK * 2);
    const size_t hstep = (size_t)HALF * K * 2;
    const size_t tstep = 2 * hstep;
    const size_t hstepA = Sched::GATHER ? 0 : hstep;
    const unsigned ldsw = (unsigned)wid * 1024u;
    const int aoff = lds_byte(wr * 64 + fr, fq * 8), boff = lds_byte(wc * 32 + fr, fq * 8);
#define PG8_SA(b, h) (((b) * 2 + (h)) * HTB)
#define PG8_SB(b, h) ((4 + (b) * 2 + (h)) * HTB)
#define PG8_STAGE(bufoff, gbase, voff) do { _Pragma("unroll") for (int _i = 0; _i < 2; ++_i) \
        __builtin_amdgcn_global_load_lds((const unsigned*)((const char*)(gbase) + (voff)[_i]), (PG8_LAS unsigned*)(lds + (bufoff) + ldsw + _i * 8192), 16, 0, 0); } while (0)
#define PG8_LDA(dst, b, h) do { _Pragma("unroll") for (int m = 0; m < 4; ++m) _Pragma("unroll") for (int k = 0; k < 2; ++k) dst[m][k] = *(const PG8_LAS bf16x8*)(lds + PG8_SA(b, h) + aoff + m * 2048 + k * 1024); } while (0)
#define PG8_LDB(dst, b, h) do { _Pragma("unroll") for (int n = 0; n < 2; ++n) _Pragma("unroll") for (int k = 0; k < 2; ++k) dst[n][k] = *(const PG8_LAS bf16x8*)(lds + PG8_SB(b, h) + boff + n * 2048 + k * 1024); } while (0)
#define PG8_MMA(ai, bj, At, Bt) do { __builtin_amdgcn_s_setprio(1); _Pragma("unroll") for (int m = 0; m < 4; ++m) _Pragma("unroll") for (int n = 0; n < 2; ++n) _Pragma("unroll") for (int k = 0; k < 2; ++k) \
        acc[ai][bj][m][n] = __builtin_amdgcn_mfma_f32_16x16x32_bf16(Bt[n][k], At[m][k], acc[ai][bj][m][n], 0, 0, 0); __builtin_amdgcn_s_setprio(0); } while (0)
#define PG8_WAIT_V(n) asm volatile("s_waitcnt vmcnt(" #n ")" ::: "memory")
#define PG8_WAIT_L(n) asm volatile("s_waitcnt lgkmcnt(" #n ")" ::: "memory")
#define PG8_BAR __builtin_amdgcn_s_barrier()
#define PG8_SCHED __builtin_amdgcn_sched_barrier(0)
    Unit cur, nxt; int ui = 0;
    if (!S.next(0, cur)) return;
    f32x4 acc[2][2][4][2];
#pragma unroll
    for (int a = 0; a < 2; ++a)
#pragma unroll
        for (int b = 0; b < 2; ++b)
#pragma unroll
            for (int m = 0; m < 4; ++m)
#pragma unroll
                for (int n = 0; n < 2; ++n) acc[a][b][m][n] = (f32x4){0.f, 0.f, 0.f, 0.f};
    bf16x8 At[4][2], B0[2][2], B1[2][2];
    unsigned vc0[2], vc1[2], vn0[2], vn1[2];
    if constexpr (Sched::GATHER) {
#pragma unroll
        for (int i = 0; i < 2; ++i) { vc0[i] = (unsigned)(S.arow(cur, RA[i]) * K + CA[i]) * 2u; vc1[i] = (unsigned)(S.arow(cur, RA[i] + HALF) * K + CA[i]) * 2u; vn0[i] = vc0[i]; vn1[i] = vc1[i]; }
    } else {
#pragma unroll
        for (int i = 0; i < 2; ++i) { vc0[i] = voffA[i]; vc1[i] = voffA[i]; vn0[i] = voffA[i]; vn1[i] = voffA[i]; }
    }
    const char* cA = Sched::GATHER ? (const char*)g.A : (const char*)g.A + (size_t)cur.pm * tstep; const char* cB = (const char*)g.Bt + cur.boff + (size_t)cur.pn * tstep;
    S.a_ready(cur);
    PG8_STAGE(PG8_SB(0, 0), cB, voffB); PG8_STAGE(PG8_SB(0, 1), cB + hstep, voffB); PG8_STAGE(PG8_SA(0, 0), cA, vc0); PG8_STAGE(PG8_SA(0, 1), cA + hstepA, vc1);
    if (wr == 1) PG8_BAR;
    PG8_WAIT_V(2); PG8_BAR;
    PG8_STAGE(PG8_SB(1, 0), cB + kstep, voffB); PG8_STAGE(PG8_SA(1, 0), cA + kstep, vc0); PG8_STAGE(PG8_SB(1, 1), cB + hstep + kstep, voffB);
    PG8_WAIT_V(6); PG8_BAR;
    for (;;) {
        const bool has_next = S.next(ui + 1, nxt);
        if constexpr (Sched::GATHER) { if (has_next) {
#pragma unroll
            for (int i = 0; i < 2; ++i) { vn0[i] = (unsigned)(S.arow(nxt, RA[i]) * K + CA[i]) * 2u; vn1[i] = (unsigned)(S.arow(nxt, RA[i] + HALF) * K + CA[i]) * 2u; } } }
        const char* nA = Sched::GATHER ? (const char*)g.A : (has_next ? (const char*)g.A + (size_t)nxt.pm * tstep : cA); const char* nB = has_next ? (const char*)g.Bt + nxt.boff + (size_t)nxt.pn * tstep : cB;
        for (int t = 0; t < nt; t += 2) {
            const bool last = (t == nt - 2);
            const char* a1 = cA + (size_t)(t + 1) * kstep;
            const char* a2 = last ? nA : cA + (size_t)(t + 2) * kstep; const char* b2 = last ? nB : cB + (size_t)(t + 2) * kstep;
            const char* a3 = a2 + kstep; const char* b3 = b2 + kstep;
            unsigned w0[2], w1[2];
#pragma unroll
            for (int i = 0; i < 2; ++i) { w0[i] = (Sched::GATHER && last) ? vn0[i] : vc0[i]; w1[i] = (Sched::GATHER && last) ? vn1[i] : vc1[i]; }
            if (last && has_next) S.a_ready(nxt);
            PG8_LDB(B0, 0, 0); PG8_LDB(B1, 0, 1); PG8_SCHED; PG8_LDA(At, 0, 0); PG8_STAGE(PG8_SA(1, 1), a1 + hstepA, vc1);
            PG8_WAIT_V(8); PG8_WAIT_L(0); PG8_BAR; PG8_MMA(0, 0, At, B0); PG8_MMA(0, 1, At, B1); PG8_BAR; PG8_SCHED;
            PG8_LDA(At, 0, 1); PG8_STAGE(PG8_SB(0, 0), b2, voffB); PG8_STAGE(PG8_SB(0, 1), b2 + hstep, voffB); PG8_STAGE(PG8_SA(0, 0), a2, w0);
            PG8_WAIT_V(8); PG8_WAIT_L(0); PG8_BAR; PG8_MMA(1, 0, At, B0); PG8_MMA(1, 1, At, B1); PG8_BAR; PG8_SCHED;
            PG8_LDB(B0, 1, 0); PG8_LDB(B1, 1, 1); PG8_SCHED; PG8_LDA(At, 1, 0); PG8_STAGE(PG8_SA(0, 1), a2 + hstepA, w1);
            PG8_WAIT_V(8); PG8_WAIT_L(0); PG8_BAR; PG8_MMA(0, 0, At, B0); PG8_MMA(0, 1, At, B1); PG8_BAR; PG8_SCHED;
            PG8_LDA(At, 1, 1); PG8_STAGE(PG8_SB(1, 0), b3, voffB); PG8_STAGE(PG8_SB(1, 1), b3 + hstep, voffB); PG8_STAGE(PG8_SA(1, 0), a3, w0);
            PG8_WAIT_V(8); PG8_WAIT_L(0); PG8_BAR; PG8_MMA(1, 0, At, B0); PG8_MMA(1, 1, At, B1); PG8_BAR; PG8_SCHED;
        }
        if constexpr (ALIGN_EPI) { if (wr == 0) PG8_BAR; }
        if constexpr (!Epi::AFTER_DRAIN) { E(acc, cur, wr, wc, fr, fq); S.done(cur); }
        if (!has_next) break;
#pragma unroll
        for (int a = 0; a < 2; ++a)
#pragma unroll
            for (int b = 0; b < 2; ++b)
#pragma unroll
                for (int m = 0; m < 4; ++m)
#pragma unroll
                    for (int n = 0; n < 2; ++n) acc[a][b][m][n] = (f32x4){0.f, 0.f, 0.f, 0.f};
        cur = nxt; cA = nA; cB = nB; ++ui;
        if constexpr (Sched::GATHER) {
#pragma unroll
            for (int i = 0; i < 2; ++i) { vc0[i] = vn0[i]; vc1[i] = vn1[i]; } }
        if constexpr (ALIGN_EPI) { if (wr == 1) PG8_BAR; }
    }
    PG8_WAIT_V(0);
    if constexpr (!ALIGN_EPI) { if (wr == 0) PG8_BAR; }
    PG8_BAR;
#undef PG8_SA
#undef PG8_SB
#undef PG8_STAGE
#undef PG8_LDA
#undef PG8_LDB
#undef PG8_MMA
#undef PG8_WAIT_V
#undef PG8_WAIT_L
#undef PG8_BAR
#undef PG8_SCHED
}
}

constexpr int NWAVES = 8;
constexpr int NPH = 17;
constexpr int N_LAUNCHES = (MK_N_LAUNCHES == 1) ? 1 : NPH;

constexpr int T = 16384, D = 2048;
constexpr int KD = 1024, VD = 2048, GIN = 6160, GINM = 6144, DKH = 256, DVH = 512, NHEAD = 4, CHK = 64, NCHUNK = T / CHK, RANK = 16;
constexpr int NE = 32, FF = 512, NGRP = 4, EPG = 8, NLOG = 48;
constexpr int MAX_RT = 160;
constexpr float EPS = 1e-6f;

constexpr size_t MiB = 1u << 20;
constexpr size_t WS_CTL = 0, CTL_ZERO_BYTES = 65536;
constexpr size_t WS_GL = 1 * MiB;
constexpr size_t WS_TKE = 2 * MiB;
constexpr size_t WS_TKS = WS_TKE + 131072;
constexpr size_t WS_TKG = WS_TKS + 131072;
constexpr size_t WS_RGATE = WS_TKG + 131072;
constexpr size_t WS_LIST = 3 * MiB;
constexpr size_t WS_WRT = 5 * MiB;
constexpr size_t WS_WGI = 8 * MiB;
constexpr size_t WS_WGO = 32 * MiB;
constexpr size_t WS_WCI = 40 * MiB;
constexpr size_t WS_WCO = 64 * MiB;
constexpr size_t WS_WGU = 72 * MiB;
constexpr size_t WS_WDN = 328 * MiB;
constexpr size_t WS_HN = 456 * MiB;
constexpr size_t WS_BC = 520 * MiB;
constexpr size_t WS_QP = 584 * MiB;
constexpr size_t WS_KP = 616 * MiB;
constexpr size_t WS_VB = 648 * MiB;
constexpr size_t WS_GB = 712 * MiB;
constexpr size_t WS_O = 776 * MiB;
constexpr size_t WS_OG = 904 * MiB;
constexpr size_t WS_H1 = 968 * MiB;
constexpr size_t WS_H2 = 1096 * MiB;
constexpr size_t WS_XS = 1224 * MiB;
constexpr size_t WS_ACT = 1384 * MiB;
constexpr size_t WS_Y = 1424 * MiB;
constexpr size_t WS_SEND = 1584 * MiB;
constexpr size_t WS_GTOT = 1616 * MiB;
constexpr size_t WS_END = 1617 * MiB;
constexpr int CW_TMO = 0, CW_CODE = 1;
constexpr int CW_BAR = 4096;
constexpr int CW_CNT = 8192;

constexpr int RING_OFF = 0, RING_BYTES = 131072;
constexpr int SCR_OFF = 131072, SCR_BYTES = 8192;
constexpr int MISC_OFF = SCR_OFF + SCR_BYTES;
constexpr int MISC_BYTES = 2048;
constexpr int LDS_BYTES = 147456;
static_assert(MISC_OFF + MISC_BYTES <= LDS_BYTES, "LDS map");
constexpr int MI_PSTART = 16, MI_NRT = 49, MI_TEXP = 64, MI_CNTL = 256, MI_BASEL = 288, MI_TSLOT = 320, MI_ECNT = 480;
static_assert(MI_TEXP == 64 && MI_TSLOT == 320 && MI_ECNT == 480, "pg8::MoeOrder reads these words by number");

#define GAS __attribute__((address_space(1)))
#define LAS __attribute__((address_space(3)))
typedef unsigned short bf16;
typedef unsigned v4u __attribute__((ext_vector_type(4)));
typedef unsigned v2u __attribute__((ext_vector_type(2)));
typedef float f32x4 __attribute__((ext_vector_type(4)));
typedef GAS unsigned gu32;
#define RLX_AGENT __ATOMIC_RELAXED, __HIP_MEMORY_SCOPE_AGENT
#define LDS_WAIT() asm volatile("s_waitcnt lgkmcnt(0)" ::: "memory")
#define VM_WAIT() asm volatile("s_waitcnt vmcnt(0)" ::: "memory")
__device__ __forceinline__ unsigned f2bf(float f) { unsigned u = __builtin_bit_cast(unsigned, f); return (u + 0x7fffu + ((u >> 16) & 1u)) >> 16; }
__device__ __forceinline__ unsigned pk2(float lo, float hi) { return f2bf(lo) | (f2bf(hi) << 16); }
__device__ __forceinline__ float bflo(unsigned w) { return __uint_as_float(w << 16); }
__device__ __forceinline__ float bfhi(unsigned w) { return __uint_as_float(w & 0xffff0000u); }

#define XB_TMO      128
#define XB_XCNT(j)  (256  + 64 * (j))
#define XB_XSUB(j)  (1280 + 64 * (j))
#define XB_XGEN(j)  (2304 + 64 * (j))
#define XB_TOP      3328
#define XB_TOPGEN   3392
#define XCD_BAR_WORDS 3456
#define XB_SPIN_CAP (1u << 22)
__device__ __forceinline__ unsigned xb_ld(unsigned* p)              { return __hip_atomic_load(p, __ATOMIC_RELAXED, __HIP_MEMORY_SCOPE_AGENT); }
__device__ __forceinline__ unsigned xb_add(unsigned* p, unsigned v) { return __hip_atomic_fetch_add(p, v, __ATOMIC_RELAXED, __HIP_MEMORY_SCOPE_AGENT); }
__device__ __forceinline__ unsigned xb_xcc_id() { return (unsigned)__builtin_amdgcn_s_getreg((3 << 11) | 20) & 0xFu; }
#define XB_SPIN(cond, bar) do { unsigned _sp = 0; while (cond) { __builtin_amdgcn_s_sleep(1); \
    if ((++_sp & 255u) == 0u) { if (xb_ld(&(bar)[XB_TMO])) break; if (_sp > XB_SPIN_CAP) { atomicAdd(&(bar)[XB_TMO], 1u); break; } } } } while (0)
struct XcdBarrier { unsigned* bar; unsigned x; volatile LAS unsigned* st; };
__device__ __forceinline__ XcdBarrier xcd_barrier_post(unsigned* bar, volatile LAS unsigned* st) {
    XcdBarrier b; b.bar = bar; b.x = xb_xcc_id(); b.st = st;
    if (threadIdx.x == 0) (void)xb_add(&bar[XB_XCNT(b.x)], 1u);
    return b;
}
__device__ __forceinline__ void xcd_barrier_complete(unsigned* bar, unsigned x, unsigned& nloc, unsigned& nx) {
    const unsigned G = gridDim.x * gridDim.y * gridDim.z;
    unsigned sum, cnt, mine, sp = 0u;
    for (;;) {
        sum = 0u; cnt = 0u; mine = 0u;
#pragma unroll
        for (unsigned j = 0; j < 16; ++j) { const unsigned c = xb_ld(&bar[XB_XCNT(j)]); sum += c; cnt += (c > 0u) ? 1u : 0u; mine = (j == x) ? c : mine; }
        if (sum == G) break;
        __builtin_amdgcn_s_sleep(1);
        if ((++sp & 255u) == 0u) { if (xb_ld(&bar[XB_TMO])) break; if (sp > XB_SPIN_CAP) { atomicAdd(&bar[XB_TMO], 1u); break; } }
    }
    nloc = mine > 0u ? mine : 1u; nx = cnt > 0u ? cnt : 1u;
}
__device__ __forceinline__ void xcd_barrier(const XcdBarrier& b) {
    asm volatile("s_waitcnt vmcnt(0)" ::: "memory");
    __syncthreads();
    if (threadIdx.x == 0) {
        unsigned* bar = b.bar;
        __builtin_amdgcn_s_waitcnt(0);
        unsigned nloc = b.st[0], nx = b.st[1];
        if (nloc == 0u) { xcd_barrier_complete(bar, b.x, nloc, nx); b.st[0] = nloc; b.st[1] = nx; }
        const unsigned old = xb_add(&bar[XB_XSUB(b.x)], 1u);
        const unsigned gen = old / nloc;
        if (old + 1u == (gen + 1u) * nloc) {
            __builtin_amdgcn_fence(__ATOMIC_RELEASE, "agent");
            asm volatile("s_waitcnt vmcnt(0)" ::: "memory");
            const unsigned og = xb_add(&bar[XB_TOP], 1u);
            const unsigned tg = og / nx;
            if (og + 1u == (tg + 1u) * nx) xb_add(&bar[XB_TOPGEN], 1u);
            else XB_SPIN(xb_ld(&bar[XB_TOPGEN]) == tg, bar);
            __builtin_amdgcn_fence(__ATOMIC_ACQUIRE, "agent");
            xb_add(&bar[XB_XGEN(b.x)], 1u);
            asm volatile("s_waitcnt vmcnt(0)" ::: "memory");
        } else {
            XB_SPIN(xb_ld(&bar[XB_XGEN(b.x)]) == gen, bar);
            __builtin_amdgcn_fence(__ATOMIC_ACQUIRE, "agent");
            asm volatile("s_waitcnt vmcnt(0)" ::: "memory");
        }
    }
    __syncthreads();
}

struct Frame {
    LAS unsigned char* lds;
    volatile LAS int* MISC;
    unsigned* ctl;
    int tid, lane, wave, G;
    __attribute__((address_space(4))) const unsigned char* ka;
};
#define KIN(i) (*(const float* const __attribute__((address_space(4)))*)(F.ka + 8 * (i)))
#define KOUT   (*(float* const __attribute__((address_space(4)))*)(F.ka + 8 * 18))
#define KWS    (*(unsigned char* const __attribute__((address_space(4)))*)(F.ka + 8 * 19))
__device__ __forceinline__ float wave_sum(float v) {
#pragma unroll
    for (int o = 1; o < 64; o <<= 1) v += __shfl_xor(v, o);
    return v;
}

__device__ __forceinline__ void transpose_item(const float* W, int K, int ldw, int ncols, bf16* WT, int destrow0, LAS float* scr, int kb, int nb, int lane) {
    const int k0 = 64 * kb, n0 = 32 * nb; (void)ncols;
#pragma unroll 8
    for (int i = 0; i < 32; ++i) { const int kk = 2 * i + (lane >> 5); scr[kk * 33 + (lane & 31)] = W[(size_t)(k0 + kk) * ldw + n0 + (lane & 31)]; }
    LDS_WAIT(); asm volatile("" ::: "memory");
    const int c = lane & 7;
#pragma unroll
    for (int j = 0; j < 4; ++j) { const int n = (lane >> 3) + 8 * j; const LAS float* s = scr + (8 * c) * 33 + n;
        v4u o; o.x = pk2(s[0 * 33], s[1 * 33]); o.y = pk2(s[2 * 33], s[3 * 33]); o.z = pk2(s[4 * 33], s[5 * 33]); o.w = pk2(s[6 * 33], s[7 * 33]);
        *(v4u*)(WT + (size_t)(destrow0 + n) * K + k0 + 8 * c) = o; }
    LDS_WAIT(); asm volatile("" ::: "memory");
}
__device__ __forceinline__ int conv_in_row(int n) { if (n < 2048) return n; const int s = (n - 2048) >> 11, f = (n - 2048) & 2047; return 2048 + 256 * (f >> 7) + 128 * s + (f & 127); }
__device__ __forceinline__ int gate_up_row(int n) { const int s = n >> 9, f = n & 511; return 256 * (f >> 7) + 128 * s + (f & 127); }

__device__ __forceinline__ void p0_convert(Frame& F) {
    LAS float* scr = (LAS float*)(F.lds + RING_OFF + F.wave * 16384);
    const int gw = blockIdx.x * NWAVES + F.wave, NGW = F.G * NWAVES;
    constexpr int I_GI = 32 * 192, I_GO = 32 * 64, I_CI = 32 * 192, I_CO = 32 * 64, I_GU1 = 32 * 32, I_DN1 = 8 * 64;
    constexpr int I_GU = I_GU1 * 64, I_DN = I_DN1 * 64;
    constexpr int NITEMS = I_GI + I_GO + I_CI + I_CO + I_GU + I_DN;
    bf16* WGI = (bf16*)(KWS + WS_WGI); bf16* WGO = (bf16*)(KWS + WS_WGO); bf16* WCI = (bf16*)(KWS + WS_WCI); bf16* WCO = (bf16*)(KWS + WS_WCO);
    bf16* WGU = (bf16*)(KWS + WS_WGU); bf16* WDN = (bf16*)(KWS + WS_WDN);
    for (int it = gw; it < NITEMS; it += NGW) {
        int r = it;
        if (r < I_GI) { const int kb = r / 192, nb = r % 192; transpose_item(KIN(2), 2048, GIN, GINM, WGI, 32 * nb, scr, kb, nb, F.lane); continue; } r -= I_GI;
        if (r < I_GO) { const int kb = r / 64, nb = r % 64; transpose_item(KIN(6), 2048, 2048, 2048, WGO, 32 * nb, scr, kb, nb, F.lane); continue; } r -= I_GO;
        if (r < I_CI) { const int kb = r / 192, nb = r % 192; transpose_item(KIN(7), 2048, 6144, 6144, WCI, conv_in_row(32 * nb), scr, kb, nb, F.lane); continue; } r -= I_CI;
        if (r < I_CO) { const int kb = r / 64, nb = r % 64; transpose_item(KIN(9), 2048, 2048, 2048, WCO, 32 * nb, scr, kb, nb, F.lane); continue; } r -= I_CO;
        if (r < I_GU) { const int le = r / I_GU1, q = r % I_GU1, kb = q / 32, nb = q % 32;
            transpose_item(KIN(15) + (size_t)le * 2048 * 1024, 2048, 1024, 1024, WGU + (size_t)le * 1024 * 2048, gate_up_row(32 * nb), scr, kb, nb, F.lane); continue; } r -= I_GU;
        { const int le = r / I_DN1, q = r % I_DN1, kb = q / 64, nb = q % 64;
            transpose_item(KIN(16) + (size_t)le * 512 * 2048, 512, 2048, 2048, WDN + (size_t)le * 2048 * 512, 32 * nb, scr, kb, nb, F.lane); }
    }
    float* WRT = (float*)(KWS + WS_WRT);
    for (int i = blockIdx.x * 512 + F.tid; i < 2 * NLOG * 2048; i += F.G * 512) {
        const int l = i / (NLOG * 2048), c = (i / 2048) % NLOG, k = i % 2048;
        float w = 0.f;
        if (c < 4) w = KIN(11)[((size_t)l * 2048 + k) * 4 + c]; else if (c < 36) w = KIN(13)[((size_t)l * 2048 + k) * 32 + (c - 4)];
        WRT[i] = w * KIN(10)[l * 2048 + k];
    }
}

constexpr int WGT_LD = 2052;
__device__ __forceinline__ void p0_norm_gl(Frame& F) {
    LAS float* wgt = (LAS float*)(F.lds);
    LAS float* glc = (LAS float*)(F.lds + 16 * WGT_LD * 4);
    static_assert(16 * WGT_LD * 4 + 64 * 16 * 4 <= MISC_OFF, "p0 LDS");
    const float* w_in = KIN(2);
    for (int idx = F.tid; idx < 2048 * 16; idx += 512) { const int k = idx >> 4, r = idx & 15; wgt[r * WGT_LD + k] = w_in[(size_t)k * GIN + GINM + r]; }
    __syncthreads();
    const float* x = KIN(0); const float* wn = KIN(1); bf16* HN = (bf16*)(KWS + WS_HN); float* BC = (float*)(KWS + WS_BC);
    const float* w2 = KIN(3); const float* bgk = KIN(4);
    for (int ch = blockIdx.x; ch < NCHUNK; ch += F.G) {
        for (int rr = 0; rr < 8; ++rr) {
            const int rl = F.wave * 8 + rr, row = ch * CHK + rl;
            const f32x4* xr = (const f32x4*)(x + (size_t)row * D) + F.lane;
            float s = 0.f;
#pragma unroll
            for (int j = 0; j < 8; ++j) { const f32x4 v = xr[64 * j]; s += (v.x * v.x + v.y * v.y) + (v.z * v.z + v.w * v.w); }
            const float rstd = 1.0f / sqrtf(wave_sum(s) * (1.0f / D) + EPS);
            float ga[16];
#pragma unroll
            for (int r = 0; r < 16; ++r) ga[r] = 0.f;
            v2u* o8 = (v2u*)(HN + (size_t)row * D) + F.lane;
#pragma unroll 1
            for (int j = 0; j < 8; ++j) { const f32x4 w = ((const f32x4*)wn)[F.lane + 64 * j]; const f32x4 v = xr[64 * j] * rstd * w;
                v2u o; o.x = pk2(v.x, v.y); o.y = pk2(v.z, v.w); o8[64 * j] = o;
#pragma unroll
                for (int r = 0; r < 16; ++r) { const f32x4 g = *(const LAS f32x4*)(wgt + r * WGT_LD + 4 * F.lane + 256 * j); ga[r] += (v.x * g.x + v.y * g.y) + (v.z * g.z + v.w * g.w); } }
#pragma unroll
            for (int r = 0; r < 16; ++r) ga[r] = wave_sum(ga[r]);
            if (F.lane == 0) {
#pragma unroll
                for (int r = 0; r < 16; ++r) glc[rl * 16 + r] = ga[r]; }
        }
        __syncthreads();
#pragma unroll
        for (int hh = 0; hh < 2; ++hh) {
            const int c = F.tid + 512 * hh; float w2r[16];
#pragma unroll
            for (int r = 0; r < 16; ++r) w2r[r] = w2[r * KD + c];
            const float bias = bgk[c]; float cum = 0.f;
            for (int t = 0; t < CHK; ++t) {
                float z = bias;
#pragma unroll
                for (int r = 0; r < 16; ++r) z += glc[t * 16 + r] * w2r[r];
                const float ls = fminf(z, 0.f) - log1pf(expf(-fabsf(z)));
                cum += ls * (1.0f / 16.0f);
                BC[(size_t)(ch * CHK + t) * KD + c] = cum;
            }
        }
        __syncthreads();
    }
}

__device__ __forceinline__ void ph_gla_naive(Frame& F) {
    const bf16* QP = (const bf16*)(KWS + WS_QP); const bf16* KP = (const bf16*)(KWS + WS_KP); const bf16* VB = (const bf16*)(KWS + WS_VB);
    const float* BC = (const float*)(KWS + WS_BC); float* O = (float*)(KWS + WS_O);
    for (int u = blockIdx.x; u < 128; u += F.G) {
        const int h = u >> 5, col0 = (u & 31) * 16, ds = F.tid & 31, col = F.tid >> 5;
        float R[8];
#pragma unroll
        for (int i = 0; i < 8; ++i) R[i] = 0.f;
        const bf16* qp = QP + h * DKH + ds * 8; const bf16* kp = KP + h * DKH + ds * 8; const bf16* vp = VB + h * DVH + col0 + col;
        const float* bp = BC + h * DKH + ds * 8; float* op = O + h * DVH + col0 + col;
        for (int t0 = 0; t0 < T; t0 += 8) {
            v4u kk[8], qq[8]; unsigned short vv[8];
#pragma unroll
            for (int j = 0; j < 8; ++j) { kk[j] = *(const v4u*)(kp + (size_t)(t0 + j) * KD); qq[j] = *(const v4u*)(qp + (size_t)(t0 + j) * KD); vv[j] = vp[(size_t)(t0 + j) * VD]; }
#pragma unroll
            for (int j = 0; j < 8; ++j) {
                const float v = __uint_as_float(((unsigned)vv[j]) << 16);
                float po = 0.f;
#pragma unroll
                for (int i = 0; i < 4; ++i) { const unsigned kw = kk[j][i], qw = qq[j][i];
                    R[2 * i] += bflo(kw) * v; R[2 * i + 1] += bfhi(kw) * v; po += bflo(qw) * R[2 * i] + bfhi(qw) * R[2 * i + 1]; }
                po += __shfl_xor(po, 1); po += __shfl_xor(po, 2); po += __shfl_xor(po, 4); po += __shfl_xor(po, 8); po += __shfl_xor(po, 16);
                if (ds == 0) op[(size_t)(t0 + j) * VD] = po;
            }
            if (((t0 + 8) & 63) == 0) { const f32x4 b0 = *(const f32x4*)(bp + (size_t)(t0 + 7) * KD), b1 = *(const f32x4*)(bp + (size_t)(t0 + 7) * KD + 4);
#pragma unroll
                for (int i = 0; i < 4; ++i) { R[i] *= expf(b0[i]); R[4 + i] *= expf(b1[i]); } }
        }
    }
}

namespace gla {
typedef short bf16x8 __attribute__((ext_vector_type(8)));
typedef short s16x4 __attribute__((ext_vector_type(4)));
typedef short v4i16_t __attribute__((ext_vector_type(4)));
typedef float f32x2_t __attribute__((ext_vector_type(2))); typedef __bf16 bf16x2_t __attribute__((ext_vector_type(2)));
__device__ __forceinline__ unsigned cvtpk(float lo, float hi) { f32x2_t v = {lo, hi}; bf16x2_t b = __builtin_convertvector(v, bf16x2_t); return __builtin_bit_cast(unsigned, b); }
__device__ __forceinline__ s16x4 trread(const LAS unsigned char* p) { return __builtin_bit_cast(s16x4, __builtin_amdgcn_ds_read_tr16_b64_v4i16((LAS v4i16_t*)p)); }
__device__ __forceinline__ bf16x8 cat4(s16x4 a, s16x4 b) { bf16x8 r; r[0] = a[0]; r[1] = a[1]; r[2] = a[2]; r[3] = a[3]; r[4] = b[0]; r[5] = b[1]; r[6] = b[2]; r[7] = b[3]; return r; }
constexpr int QS = 528, VS = 272, PS = 144;
constexpr int OFF_Q = 0, OFF_K = 64 * QS, OFF_V = 2 * 64 * QS, OFF_P = OFF_V + 64 * VS, OFF_G = OFF_P + 64 * PS, LDS_END = OFF_G + 1024;
static_assert(LDS_END <= RING_BYTES, "gla LDS");
constexpr int NPART = 16, CPP = NCHUNK / NPART;
struct Stage { v4u q[4], k[4], v[2]; float g; };
template <bool NEEDQ>
__device__ __forceinline__ void issue_loads(Stage& st, const bf16* QP, const bf16* KP, const bf16* VB, const float* BC, int tok0, int h, int s, int tid) {
#pragma unroll
    for (int i = 0; i < 4; ++i) { const int id = tid + 512 * i, row = id >> 5, cc = id & 31; const size_t o = (size_t)(tok0 + row) * KD + h * DKH + cc * 8;
        if (NEEDQ) st.q[i] = *(const v4u*)(QP + o); st.k[i] = *(const v4u*)(KP + o); }
#pragma unroll
    for (int i = 0; i < 2; ++i) { const int id = tid + 512 * i, row = id >> 4, cc = id & 15; st.v[i] = *(const v4u*)(VB + (size_t)(tok0 + row) * VD + h * DVH + s * 128 + cc * 8); }
    st.g = BC[(size_t)(tok0 + 63) * KD + h * DKH + (tid & 255)];
}
template <bool NEEDQ>
__device__ __forceinline__ void write_stage(LAS unsigned char* lds, const Stage& st, int tid) {
#pragma unroll
    for (int i = 0; i < 4; ++i) { const int id = tid + 512 * i, row = id >> 5, cc = id & 31;
        if (NEEDQ) *(LAS v4u*)(lds + OFF_Q + row * QS + cc * 16) = st.q[i]; *(LAS v4u*)(lds + OFF_K + row * QS + cc * 16) = st.k[i]; }
#pragma unroll
    for (int i = 0; i < 2; ++i) { const int id = tid + 512 * i, row = id >> 4, cc = id & 15; *(LAS v4u*)(lds + OFF_V + row * VS + cc * 16) = st.v[i]; }
    if (tid < 256) *(LAS float*)(lds + OFF_G + 4 * tid) = expf(st.g);
}
template <int PASS>
__device__ __forceinline__ void unit(LAS unsigned char* lds, int tid, int lane, int w, int p, int h, int s, const bf16* QP, const bf16* KP, const bf16* VB, const float* BC, float* O, f32x4* SEND, float* GTOT) {
    const int r = lane & 15, q = lane >> 4, qq = r >> 2, pp = r & 3;
    f32x4 S[16];
#pragma unroll
    for (int dt = 0; dt < 16; ++dt) S[dt] = (f32x4){0.f, 0.f, 0.f, 0.f};
    if (PASS == 2) {
        for (int pj = 0; pj < p; ++pj) {
            const f32x4* se = SEND + ((((size_t)pj * 4 + h) * 4 + s) * 8 + w) * 16 * 64 + lane; const float* gt = GTOT + ((size_t)pj * 4 + h) * DKH;
#pragma unroll
            for (int dt = 0; dt < 16; ++dt) { const f32x4 gg = *(const f32x4*)(gt + 16 * dt + 4 * q); S[dt] = S[dt] * gg + se[dt * 64]; }
        }
    }
    const int tokbase = p * CPP * CHK;
    Stage st;
    issue_loads<PASS == 2>(st, QP, KP, VB, BC, tokbase, h, s, tid);
    __syncthreads();
    write_stage<PASS == 2>(lds, st, tid);
    __syncthreads();
    const LAS unsigned char* qnat = lds + OFF_Q + r * QS + q * 16;
    const LAS unsigned char* knat = lds + OFF_K + r * QS + q * 16;
    const LAS unsigned char* qperm = lds + OFF_Q + r * QS + q * 8;
    const LAS unsigned char* ktr = lds + OFF_K + (8 * q + qq) * QS + pp * 8;
    const LAS unsigned char* vtr = lds + OFF_V + (8 * q + qq) * VS + w * 32 + pp * 8;
    const LAS unsigned char* pnat = lds + OFF_P + r * PS + q * 16;
    for (int c = 0; c < CPP; ++c) {
        const int tok0 = tokbase + c * CHK;
        if (c + 1 < CPP) issue_loads<PASS == 2>(st, QP, KP, VB, BC, tok0 + CHK, h, s, tid);
        bf16x8 vb[2];
#pragma unroll
        for (int kt = 0; kt < 2; ++kt) vb[kt] = cat4(trread(vtr + kt * 32 * VS), trread(vtr + kt * 32 * VS + 4 * VS));
        if (PASS == 2) {
            const int it = w >> 1;
#pragma unroll
            for (int j2 = 0; j2 < 2; ++j2) {
                const int jt = 2 * (w & 1) + j2; f32x4 pa = (f32x4){0.f, 0.f, 0.f, 0.f};
#pragma unroll
                for (int ks = 0; ks < 8; ++ks) { const bf16x8 a = *(const LAS bf16x8*)(knat + jt * 16 * QS + ks * 64), b = *(const LAS bf16x8*)(qnat + it * 16 * QS + ks * 64);
                    pa = __builtin_amdgcn_mfma_f32_16x16x32_bf16(a, b, pa, 0, 0, 0); }
                const int i = 16 * it + r, j0 = 16 * jt + 4 * q;
                v2u o; o.x = cvtpk(j0 + 0 <= i ? pa[0] : 0.f, j0 + 1 <= i ? pa[1] : 0.f); o.y = cvtpk(j0 + 2 <= i ? pa[2] : 0.f, j0 + 3 <= i ? pa[3] : 0.f);
                *(LAS v2u*)(lds + OFF_P + i * PS + j0 * 2) = o;
            }
            f32x4 Oa[4];
#pragma unroll
            for (int i4 = 0; i4 < 4; ++i4) Oa[i4] = (f32x4){0.f, 0.f, 0.f, 0.f};
#pragma unroll
            for (int ks = 0; ks < 8; ++ks) {
                v4u bw; bw.x = cvtpk(S[2 * ks][0], S[2 * ks][1]); bw.y = cvtpk(S[2 * ks][2], S[2 * ks][3]); bw.z = cvtpk(S[2 * ks + 1][0], S[2 * ks + 1][1]); bw.w = cvtpk(S[2 * ks + 1][2], S[2 * ks + 1][3]);
                const bf16x8 bfrag = __builtin_bit_cast(bf16x8, bw);
#pragma unroll
                for (int i4 = 0; i4 < 4; ++i4) { const bf16x8 a = cat4(*(const LAS s16x4*)(qperm + i4 * 16 * QS + ks * 64), *(const LAS s16x4*)(qperm + i4 * 16 * QS + ks * 64 + 32));
                    Oa[i4] = __builtin_amdgcn_mfma_f32_16x16x32_bf16(a, bfrag, Oa[i4], 0, 0, 0); }
            }
            __syncthreads();
#pragma unroll
            for (int i4 = 0; i4 < 4; ++i4)
#pragma unroll
                for (int kj = 0; kj < 2; ++kj) { if (kj == 1 && i4 < 2) continue;
                    const bf16x8 a = *(const LAS bf16x8*)(pnat + i4 * 16 * PS + kj * 64); Oa[i4] = __builtin_amdgcn_mfma_f32_16x16x32_bf16(a, vb[kj], Oa[i4], 0, 0, 0); }
            float* op = O + (size_t)(tok0 + 4 * q) * VD + h * DVH + s * 128 + 16 * w + r;
#pragma unroll
            for (int i4 = 0; i4 < 4; ++i4)
#pragma unroll
                for (int g = 0; g < 4; ++g) op[(size_t)(16 * i4 + g) * VD] = Oa[i4][g];
        }
#pragma unroll
        for (int dt = 0; dt < 16; ++dt) {
#pragma unroll
            for (int kt = 0; kt < 2; ++kt) { const bf16x8 a = cat4(trread(ktr + kt * 32 * QS + dt * 32), trread(ktr + kt * 32 * QS + dt * 32 + 4 * QS)); S[dt] = __builtin_amdgcn_mfma_f32_16x16x32_bf16(a, vb[kt], S[dt], 0, 0, 0); }
            S[dt] = S[dt] * *(const LAS f32x4*)(lds + OFF_G + (16 * dt + 4 * q) * 4);
        }
        __syncthreads();
        if (c + 1 < CPP) { write_stage<PASS == 2>(lds, st, tid); __syncthreads(); }
    }
    if (PASS == 1) {
        f32x4* se = SEND + ((((size_t)p * 4 + h) * 4 + s) * 8 + w) * 16 * 64 + lane;
#pragma unroll
        for (int dt = 0; dt < 16; ++dt) se[dt * 64] = S[dt];
        if (s == 0 && tid < 256) { float a = 0.f; for (int c = 0; c < CPP; ++c) a += BC[(size_t)(tokbase + c * CHK + 63) * KD + h * DKH + tid]; GTOT[((size_t)p * 4 + h) * DKH + tid] = expf(a); }
    }
}
}
template <int PASS>
__device__ __forceinline__ void ph_gla(Frame& F) {
    const bf16* QP = (const bf16*)(KWS + WS_QP); const bf16* KP = (const bf16*)(KWS + WS_KP); const bf16* VB = (const bf16*)(KWS + WS_VB);
    const float* BC = (const float*)(KWS + WS_BC); float* O = (float*)(KWS + WS_O); f32x4* SEND = (f32x4*)(KWS + WS_SEND); float* GTOT = (float*)(KWS + WS_GTOT);
    for (int u = blockIdx.x; u < 256; u += F.G) {
        const int idx = u >> 3, s = idx & 3, ph = (u & 7) * 8 + (idx >> 2), p = ph >> 2, h = ph & 3;
        if (PASS == 1 && p == gla::NPART - 1) continue;
        gla::unit<PASS>(F.lds, F.tid, F.lane, F.wave, p, h, s, QP, KP, VB, BC, O, SEND, GTOT);
    }
}

__device__ __forceinline__ void ph_headnorm(Frame& F) {
    const float* O = (const float*)(KWS + WS_O); const bf16* GB = (const bf16*)(KWS + WS_GB); bf16* OG = (bf16*)(KWS + WS_OG); const float* hnw = KIN(5);
    const int gw = blockIdx.x * NWAVES + F.wave, NGW = F.G * NWAVES;
    const f32x4 w0 = ((const f32x4*)hnw)[2 * F.lane], w1 = ((const f32x4*)hnw)[2 * F.lane + 1];
    for (int it = gw; it < T * NHEAD; it += NGW) {
        const size_t off = (size_t)(it >> 2) * VD + (it & 3) * DVH + 8 * F.lane;
        const f32x4 a = *(const f32x4*)(O + off), b = *(const f32x4*)(O + off + 4);
        const float ss = wave_sum((a.x * a.x + a.y * a.y) + (a.z * a.z + a.w * a.w) + (b.x * b.x + b.y * b.y) + (b.z * b.z + b.w * b.w));
        const float rstd = 1.0f / sqrtf(ss * (1.0f / DVH) + EPS);
        const v4u g = *(const v4u*)(GB + off);
        v4u o;
        o.x = pk2(a.x * rstd * w0.x * bflo(g.x), a.y * rstd * w0.y * bfhi(g.x)); o.y = pk2(a.z * rstd * w0.z * bflo(g.y), a.w * rstd * w0.w * bfhi(g.y));
        o.z = pk2(b.x * rstd * w1.x * bflo(g.z), b.y * rstd * w1.y * bfhi(g.z)); o.w = pk2(b.z * rstd * w1.z * bflo(g.w), b.w * rstd * w1.w * bfhi(g.w));
        *(v4u*)(OG + off) = o;
    }
}

__device__ __forceinline__ void ph_router(Frame& F, int layer, const float* H) {
    typedef float f32x4v __attribute__((ext_vector_type(4)));
    const float* WRT = (const float*)(KWS + WS_WRT) + (size_t)layer * NLOG * 2048;
    const float* wn = KIN(10) + layer * D; const float* bg = KIN(12) + layer * NGRP; const float* br = KIN(14) + layer * NE;
    bf16* HN = (bf16*)(KWS + WS_HN);
    int* TKE = (int*)(KWS + WS_TKE); int* TKS = (int*)(KWS + WS_TKS); float* TKG = (float*)(KWS + WS_TKG); int* LIST = (int*)(KWS + WS_LIST);
    unsigned* gcnt = F.ctl + CW_CNT + 64 * layer;
    LAS float* lg = (LAS float*)(F.lds + RING_OFF);
    LAS float* rs = (LAS float*)(F.lds + RING_OFF + 64 * 48 * 4);
    LAS int* sel = (LAS int*)(F.lds + RING_OFF + 64 * 48 * 4 + 256);
    LAS float* selg = (LAS float*)(F.lds + RING_OFF + 64 * 48 * 4 + 256 + 1024);
    volatile LAS int* cntl = F.MISC + MI_CNTL; volatile LAS int* basel = F.MISC + MI_BASEL;
    for (int blk = blockIdx.x; blk < T / 64; blk += F.G) {
        if (F.tid < 32) cntl[F.tid] = 0;
        if (F.wave < 4) {
            const int r = F.lane & 15, q = F.lane >> 4, row = blk * 64 + F.wave * 16 + r;
            const float* hp = H + (size_t)row * D + 4 * q;
            const float* wp0 = WRT + (size_t)r * 2048 + 4 * q; const float* wp1 = wp0 + 16 * 2048; const float* wp2 = wp0 + 32 * 2048;
            f32x4v a0 = {0.f, 0.f, 0.f, 0.f}, a1 = a0, a2 = a0; float ss = 0.f;
#pragma unroll 4
            for (int k0 = 0; k0 < D; k0 += 16) {
                const f32x4 a = *(const f32x4*)(hp + k0), b0 = *(const f32x4*)(wp0 + k0), b1 = *(const f32x4*)(wp1 + k0), b2 = *(const f32x4*)(wp2 + k0);
                ss += (a.x * a.x + a.y * a.y) + (a.z * a.z + a.w * a.w);
#pragma unroll
                for (int s = 0; s < 4; ++s) { a0 = __builtin_amdgcn_mfma_f32_16x16x4f32(a[s], b0[s], a0, 0, 0, 0); a1 = __builtin_amdgcn_mfma_f32_16x16x4f32(a[s], b1[s], a1, 0, 0, 0); a2 = __builtin_amdgcn_mfma_f32_16x16x4f32(a[s], b2[s], a2, 0, 0, 0); }
            }
            ss += __shfl_xor(ss, 16); ss += __shfl_xor(ss, 32);
            const float rstd = 1.0f / sqrtf(ss * (1.0f / D) + EPS);
            if (q == 0) rs[F.wave * 16 + r] = rstd;
#pragma unroll
            for (int j = 0; j < 4; ++j) { const int rl = F.wave * 16 + 4 * q + j; lg[rl * 48 + r] = a0[j]; lg[rl * 48 + 16 + r] = a1[j]; lg[rl * 48 + 32 + r] = a2[j]; }
        }
        __syncthreads();
        if (F.tid < 64) {
            const int rl = F.tid; const float rstd = rs[rl]; const LAS float* L = lg + rl * 48;
            float gl0 = L[0] * rstd + bg[0]; int g = 0; float gv[4]; gv[0] = gl0;
#pragma unroll
            for (int j = 1; j < 4; ++j) { gv[j] = L[j] * rstd + bg[j]; if (gv[j] > gl0) { gl0 = gv[j]; g = j; } }
            float den = 0.f;
#pragma unroll
            for (int j = 0; j < 4; ++j) den += expf(gv[j] - gl0);
            const float gp = 1.0f / den;
            float l1 = -3.0e38f, l2 = -3.0e38f; int e1 = 0, e2 = 0;
            for (int j = 0; j < 8; ++j) { const float v = L[4 + 8 * g + j] * rstd + br[8 * g + j];
                if (v > l1) { l2 = l1; e2 = e1; l1 = v; e1 = j; } else if (v > l2) { l2 = v; e2 = j; } }
            const float ex = expf(l2 - l1), p1 = 1.0f / (1.0f + ex), p2 = ex * p1;
            const int E0 = 8 * g + e1, E1 = 8 * g + e2;
            sel[rl * 4 + 0] = E0; sel[rl * 4 + 1] = E1;
            sel[rl * 4 + 2] = __hip_atomic_fetch_add((LAS int*)&cntl[E0], 1, __ATOMIC_RELAXED, __HIP_MEMORY_SCOPE_WORKGROUP); sel[rl * 4 + 3] = __hip_atomic_fetch_add((LAS int*)&cntl[E1], 1, __ATOMIC_RELAXED, __HIP_MEMORY_SCOPE_WORKGROUP);
            selg[rl * 2 + 0] = gp * p1; selg[rl * 2 + 1] = gp * p2;
        }
        __syncthreads();
        if (F.tid < 32) basel[F.tid] = (int)__hip_atomic_fetch_add(gcnt + F.tid, (unsigned)cntl[F.tid], RLX_AGENT);
        __syncthreads();
        if (F.tid < 128) {
            const int rl = F.tid >> 1, k = F.tid & 1, tk = (blk * 64 + rl) * 2 + k, e = sel[rl * 4 + k], slot = basel[e] + sel[rl * 4 + 2 + k];
            TKE[tk] = e; TKS[tk] = slot; TKG[tk] = selg[rl * 2 + k]; LIST[e * T + slot] = tk;
        }
        for (int rr = 0; rr < 8; ++rr) {
            const int rl = F.wave * 8 + rr, row = blk * 64 + rl; const float rstd = rs[rl];
            const f32x4* xr = (const f32x4*)(H + (size_t)row * D) + F.lane; v2u* o8 = (v2u*)(HN + (size_t)row * D) + F.lane;
#pragma unroll
            for (int j = 0; j < 8; ++j) { const f32x4 v = xr[64 * j] * rstd * ((const f32x4*)wn)[F.lane + 64 * j]; v2u o; o.x = pk2(v.x, v.y); o.y = pk2(v.z, v.w); o8[64 * j] = o; }
        }
        __syncthreads();
    }
}

__device__ __forceinline__ void moe_meta(Frame& F, int layer) {
    __syncthreads();
    if (F.tid == 0) {
        const unsigned* gcnt = F.ctl + CW_CNT + 64 * layer; int p = 0, nt = 0;
        for (int e = 0; e < NE; ++e) { const int c = (int)__hip_atomic_load(gcnt + e, RLX_AGENT); F.MISC[MI_PSTART + e] = p; const int tl = (c + 255) >> 8;
            F.MISC[MI_ECNT + e] = c;
            for (int j = 0; j < tl; ++j) { F.MISC[MI_TEXP + nt + j] = e; F.MISC[MI_TSLOT + nt + j] = 256 * j; } nt += tl; p += tl * 256; }
        F.MISC[MI_PSTART + NE] = p; F.MISC[MI_NRT] = nt;
    }
    __syncthreads();
}

template <bool FINAL>
__device__ __forceinline__ void ph_combine(Frame& F, const float* H, float* Hout, const float* wn) {
    const bf16* Y = (const bf16*)(KWS + WS_Y); const int* TKE = (const int*)(KWS + WS_TKE); const int* TKS = (const int*)(KWS + WS_TKS); const float* TKG = (const float*)(KWS + WS_TKG); bf16* HN = (bf16*)(KWS + WS_HN);
    const int gw = blockIdx.x * NWAVES + F.wave, NGW = F.G * NWAVES;
    for (int t = gw; t < T; t += NGW) {
        const int r0 = F.MISC[MI_PSTART + TKE[2 * t]] + TKS[2 * t], r1 = F.MISC[MI_PSTART + TKE[2 * t + 1]] + TKS[2 * t + 1]; const float g0 = TKG[2 * t], g1 = TKG[2 * t + 1];
        const f32x4* hr = (const f32x4*)(H + (size_t)t * D) + F.lane;
        const v2u* y0 = (const v2u*)(Y + (size_t)r0 * D) + F.lane; const v2u* y1 = (const v2u*)(Y + (size_t)r1 * D) + F.lane;
        f32x4 v[8]; float s = 0.f;
#pragma unroll
        for (int j = 0; j < 8; ++j) { const v2u a = y0[64 * j], b = y1[64 * j]; f32x4 h = hr[64 * j];
            h.x += g0 * bflo(a.x) + g1 * bflo(b.x); h.y += g0 * bfhi(a.x) + g1 * bfhi(b.x); h.z += g0 * bflo(a.y) + g1 * bflo(b.y); h.w += g0 * bfhi(a.y) + g1 * bfhi(b.y);
            v[j] = h; s += (h.x * h.x + h.y * h.y) + (h.z * h.z + h.w * h.w); }
        const float rstd = 1.0f / sqrtf(wave_sum(s) * (1.0f / D) + EPS);
        if (FINAL) {
            f32x4* o = (f32x4*)(KOUT + (size_t)t * D) + F.lane;
#pragma unroll
            for (int j = 0; j < 8; ++j) o[64 * j] = v[j] * rstd * ((const f32x4*)wn)[F.lane + 64 * j];
        } else {
            f32x4* ho = (f32x4*)(Hout + (size_t)t * D) + F.lane; v2u* o8 = (v2u*)(HN + (size_t)t * D) + F.lane;
#pragma unroll
            for (int j = 0; j < 8; ++j) { ho[64 * j] = v[j]; const f32x4 w = v[j] * rstd * ((const f32x4*)wn)[F.lane + 64 * j]; v2u o; o.x = pk2(w.x, w.y); o.y = pk2(w.z, w.w); o8[64 * j] = o; }
        }
    }
}

__device__ __forceinline__ void ph_conv(Frame& F) {
    const bf16* BG = (const bf16*)(KWS + WS_VB); const bf16* U = (const bf16*)(KWS + WS_GB); bf16* OG = (bf16*)(KWS + WS_OG); const float* cw = KIN(8);
    const size_t n8 = (size_t)T * D / 8;
    for (size_t i = (size_t)blockIdx.x * 512 + F.tid; i < n8; i += (size_t)F.G * 512) {
        const int t = (int)(i >> 8), c = (int)(i & 255) * 8; const size_t off = (size_t)t * D + c;
        const v4u u0 = *(const v4u*)(U + off); const v4u zero = {0u, 0u, 0u, 0u};
        const v4u u1 = t >= 1 ? *(const v4u*)(U + off - D) : zero; const v4u u2 = t >= 2 ? *(const v4u*)(U + off - 2 * D) : zero;
        const v4u b = *(const v4u*)(BG + off);
        const f32x4 wa0 = *(const f32x4*)(cw + c), wa1 = *(const f32x4*)(cw + c + 4), wb0 = *(const f32x4*)(cw + D + c), wb1 = *(const f32x4*)(cw + D + c + 4), wc0 = *(const f32x4*)(cw + 2 * D + c), wc1 = *(const f32x4*)(cw + 2 * D + c + 4);
        v4u o;
        o.x = pk2(bflo(b.x) * (wa0.x * bflo(u2.x) + wb0.x * bflo(u1.x) + wc0.x * bflo(u0.x)), bfhi(b.x) * (wa0.y * bfhi(u2.x) + wb0.y * bfhi(u1.x) + wc0.y * bfhi(u0.x)));
        o.y = pk2(bflo(b.y) * (wa0.z * bflo(u2.y) + wb0.z * bflo(u1.y) + wc0.z * bflo(u0.y)), bfhi(b.y) * (wa0.w * bfhi(u2.y) + wb0.w * bfhi(u1.y) + wc0.w * bfhi(u0.y)));
        o.z = pk2(bflo(b.z) * (wa1.x * bflo(u2.z) + wb1.x * bflo(u1.z) + wc1.x * bflo(u0.z)), bfhi(b.z) * (wa1.y * bfhi(u2.z) + wb1.y * bfhi(u1.z) + wc1.y * bfhi(u0.z)));
        o.w = pk2(bflo(b.w) * (wa1.z * bflo(u2.w) + wb1.z * bflo(u1.w) + wc1.z * bflo(u0.w)), bfhi(b.w) * (wa1.w * bfhi(u2.w) + wb1.w * bfhi(u1.w) + wc1.w * bfhi(u0.w)));
        *(v4u*)(OG + off) = o;
    }
}

#ifndef PH_MASK
#define PH_MASK 0xFFFFFFFFu
#endif
#define IN(k) (((PH_MASK >> (k)) & 1u) && lo <= (k) && (k) < hi)
#define BOTH(k) (IN(k) && IN((k) + 1))
#ifndef DUP_MASK
#define DUP_MASK 0u
#endif
#define NREP(k) ((((unsigned)DUP_MASK >> (k)) & 1u) ? 2 : 1)
#define GRID_BAR() do { if (N_LAUNCHES == 1) xcd_barrier(bar); } while (0)
template <int LAYER>
__device__ __forceinline__ void moe_block(Frame& F, const int lo, const int hi, const XcdBarrier& bar) {
    constexpr int pb = LAYER ? 13 : 6;
    float* H1 = (float*)(KWS + WS_H1); float* H2 = (float*)(KWS + WS_H2);
    if (IN(pb + 0)) { ph_router(F, LAYER, H1); if (BOTH(pb + 0)) GRID_BAR(); }
    if (IN(pb + 1)) {
        moe_meta(F, LAYER);
        const int nrt = F.MISC[MI_NRT];
        pg8::Gemm g{(const bf16*)(KWS + WS_HN), (const bf16*)(KWS + WS_WGU) + (size_t)LAYER * NE * 1024 * 2048, nrt * 256, 1024, D};
        pg8::MoeOrder<true> S{nrt, 4, nrt * 4, F.G, (int)blockIdx.x, (size_t)1024 * 2048 * 2, (const volatile LAS int*)F.MISC, (const int*)(KWS + WS_LIST)};
        pg8::EpiGateUp E{(bf16*)(KWS + WS_ACT)};
        for (int rep = 0; rep < NREP(pb + 1); ++rep) { pg8::gemm_phase<pg8::EpiGateUp, pg8::MoeOrder<true>, true>(F.lds + RING_OFF, g, S, E); if (rep + 1 < NREP(pb + 1)) GRID_BAR(); }
        if (BOTH(pb + 1)) GRID_BAR();
    }
    if (IN(pb + 2)) {
        moe_meta(F, LAYER);
        const int nrt = F.MISC[MI_NRT];
        pg8::Gemm g{(const bf16*)(KWS + WS_ACT), (const bf16*)(KWS + WS_WDN) + (size_t)LAYER * NE * 2048 * 512, nrt * 256, 2048, FF};
        pg8::MoeOrder<false> S{nrt, 8, nrt * 8, F.G, (int)blockIdx.x, (size_t)2048 * 512 * 2, (const volatile LAS int*)F.MISC, (const int*)(KWS + WS_LIST)};
        pg8::EpiDown E{(bf16*)(KWS + WS_Y)};
        for (int rep = 0; rep < NREP(pb + 2); ++rep) { pg8::gemm_phase<pg8::EpiDown, pg8::MoeOrder<false>, true>(F.lds + RING_OFF, g, S, E); if (rep + 1 < NREP(pb + 2)) GRID_BAR(); }
        if (BOTH(pb + 2)) GRID_BAR();
    }
    if (IN(pb + 3)) {
        moe_meta(F, LAYER);
        if (LAYER == 0) { for (int rep = 0; rep < NREP(pb + 3); ++rep) { ph_combine<false>(F, H1, H2, KIN(1) + D); if (rep + 1 < NREP(pb + 3)) GRID_BAR(); } if (BOTH(pb + 3)) GRID_BAR(); }
        else for (int rep = 0; rep < NREP(pb + 3); ++rep) { ph_combine<true>(F, H1, nullptr, KIN(17)); if (rep + 1 < NREP(pb + 3)) GRID_BAR(); }
    }
}

struct Args { const float* in[18]; float* out; unsigned char* ws; int ph_lo, ph_hi, li, pad; };
__global__ void __launch_bounds__(NWAVES * 64, 2) mega_fwd(Args args) {
    extern __shared__ __attribute__((aligned(16))) unsigned char lds[];
    Frame F;
    F.lds = (LAS unsigned char*)lds;
    F.MISC = (volatile LAS int*)(F.lds + MISC_OFF);
    F.tid = threadIdx.x; F.lane = F.tid & 63; F.wave = __builtin_amdgcn_readfirstlane(F.tid >> 6);
    F.G = gridDim.x;
    F.ka = (__attribute__((address_space(4))) const unsigned char*)__builtin_amdgcn_kernarg_segment_ptr();
    F.ctl = (unsigned*)(args.ws + WS_CTL);
    for (int u = F.tid; u < MISC_BYTES / 4; u += NWAVES * 64) F.MISC[u] = 0;
    __syncthreads();
    XcdBarrier bar; bar.bar = F.ctl + CW_BAR; bar.x = 0; bar.st = nullptr;
    if (N_LAUNCHES == 1) bar = xcd_barrier_post(F.ctl + CW_BAR, (volatile LAS unsigned*)(F.MISC + 8));
    const int lo = args.ph_lo, hi = args.ph_hi;
    bf16* HN = (bf16*)(KWS + WS_HN); float* H1 = (float*)(KWS + WS_H1); float* H2 = (float*)(KWS + WS_H2);

    if (IN(0)) { for (int rep = 0; rep < NREP(0); ++rep) { p0_convert(F); __syncthreads(); if (rep + 1 < NREP(0)) GRID_BAR(); } for (int rep = 0; rep < NREP(17); ++rep) { p0_norm_gl(F); if (rep + 1 < NREP(17)) GRID_BAR(); } if (BOTH(0)) GRID_BAR(); }
    if (IN(1)) {
        pg8::Gemm g{HN, (const bf16*)(KWS + WS_WGI), T, GINM, D}; pg8::StaticOrder S; S.init(T, GINM, F.G, (int)blockIdx.x);
        pg8::EpiGlaIn E{(bf16*)(KWS + WS_QP), (bf16*)(KWS + WS_KP), (bf16*)(KWS + WS_VB), (bf16*)(KWS + WS_GB), (const float*)(KWS + WS_BC)};
        for (int rep = 0; rep < NREP(1); ++rep) { pg8::gemm_phase<pg8::EpiGlaIn, pg8::StaticOrder, true>(F.lds + RING_OFF, g, S, E); if (rep + 1 < NREP(1)) GRID_BAR(); }
        if (BOTH(1)) GRID_BAR();
    }
#ifdef GLA_NAIVE
    if (IN(2)) { if (BOTH(2)) GRID_BAR(); }
    if (IN(3)) { ph_gla_naive(F); if (BOTH(3)) GRID_BAR(); }
#else
    if (IN(2)) { for (int rep = 0; rep < NREP(2); ++rep) { ph_gla<1>(F); if (rep + 1 < NREP(2)) GRID_BAR(); } if (BOTH(2)) GRID_BAR(); }
    if (IN(3)) { for (int rep = 0; rep < NREP(3); ++rep) { ph_gla<2>(F); if (rep + 1 < NREP(3)) GRID_BAR(); } if (BOTH(3)) GRID_BAR(); }
#endif
    if (IN(4)) { for (int rep = 0; rep < NREP(4); ++rep) { ph_headnorm(F); if (rep + 1 < NREP(4)) GRID_BAR(); } if (BOTH(4)) GRID_BAR(); }
    if (IN(5)) {
        pg8::Gemm g{(const bf16*)(KWS + WS_OG), (const bf16*)(KWS + WS_WGO), T, D, D}; pg8::StaticOrder S; S.init(T, D, F.G, (int)blockIdx.x);
        pg8::EpiRes E{KIN(0), H1, D};
        for (int rep = 0; rep < NREP(5); ++rep) { pg8::gemm_phase<pg8::EpiRes, pg8::StaticOrder, true>(F.lds + RING_OFF, g, S, E); if (rep + 1 < NREP(5)) GRID_BAR(); }
        if (BOTH(5)) GRID_BAR();
    }
    moe_block<0>(F, lo, hi, bar);
    if (IN(10)) {
        pg8::Gemm g{HN, (const bf16*)(KWS + WS_WCI), T, 6144, D}; pg8::StaticOrder S; S.init(T, 6144, F.G, (int)blockIdx.x);
        pg8::EpiConvIn E{(bf16*)(KWS + WS_VB), (bf16*)(KWS + WS_GB)};
        for (int rep = 0; rep < NREP(10); ++rep) { pg8::gemm_phase<pg8::EpiConvIn, pg8::StaticOrder, true>(F.lds + RING_OFF, g, S, E); if (rep + 1 < NREP(10)) GRID_BAR(); }
        if (BOTH(10)) GRID_BAR();
    }
    if (IN(11)) { for (int rep = 0; rep < NREP(11); ++rep) { ph_conv(F); if (rep + 1 < NREP(11)) GRID_BAR(); } if (BOTH(11)) GRID_BAR(); }
    if (IN(12)) {
        pg8::Gemm g{(const bf16*)(KWS + WS_OG), (const bf16*)(KWS + WS_WCO), T, D, D}; pg8::StaticOrder S; S.init(T, D, F.G, (int)blockIdx.x);
        pg8::EpiRes E{H2, H1, D};
        for (int rep = 0; rep < NREP(12); ++rep) { pg8::gemm_phase<pg8::EpiRes, pg8::StaticOrder, true>(F.lds + RING_OFF, g, S, E); if (rep + 1 < NREP(12)) GRID_BAR(); }
        if (BOTH(12)) GRID_BAR();
    }
    moe_block<1>(F, lo, hi, bar);
#undef IN
#undef BOTH
#undef GRID_BAR
}

extern "C" void kernel_launch(void* const* d_in, const int* in_sizes, int n_in, void* d_out, int out_size, void* d_ws, size_t ws_size, hipStream_t stream) {
    static int grid = 0;
    if (grid == 0) {
        if (n_in != 18 || in_sizes[0] != T * D || out_size != T * D || ws_size < WS_END) { fprintf(stderr, "kernel_launch: unexpected shapes (n_in %d, in0 %d, out %d, ws %zu)\n", n_in, n_in > 0 ? in_sizes[0] : -1, out_size, ws_size); grid = -1; return; }
        int dev = 0, cus = 0, per_cu = 0;
        if (hipGetDevice(&dev) != hipSuccess || hipDeviceGetAttribute(&cus, hipDeviceAttributeMultiprocessorCount, dev) != hipSuccess) { grid = -1; return; }
        if (hipFuncSetAttribute((const void*)mega_fwd, hipFuncAttributeMaxDynamicSharedMemorySize, LDS_BYTES) != hipSuccess) { fprintf(stderr, "kernel_launch: hipFuncSetAttribute failed\n"); grid = -1; return; }
        if (hipOccupancyMaxActiveBlocksPerMultiprocessor(&per_cu, (const void*)mega_fwd, NWAVES * 64, LDS_BYTES) != hipSuccess || per_cu < 1) { fprintf(stderr, "kernel_launch: occupancy query reports %d\n", per_cu); }
        (void)hipGetLastError();
        grid = cus;
    }
    if (grid < 0) return;
    if (hipMemsetAsync((char*)d_ws + WS_CTL, 0, CTL_ZERO_BYTES, stream) != hipSuccess) return;
    Args a{};
    for (int i = 0; i < 18; ++i) a.in[i] = (const float*)d_in[i];
    a.out = (float*)d_out; a.ws = (unsigned char*)d_ws;
    for (int li = 0; li < N_LAUNCHES; ++li) {
        a.ph_lo = (N_LAUNCHES == 1) ? 0 : li; a.ph_hi = (N_LAUNCHES == 1) ? NPH : li + 1; a.li = li; a.pad = 0;
        hipLaunchKernelGGL(mega_fwd, dim3(grid), dim3(NWAVES * 64), LDS_BYTES, stream, a);
        const hipError_t le = hipPeekAtLastError();
        if (le != hipSuccess) { fprintf(stderr, "kernel_launch: launch %d failed: %s\n", li, hipGetErrorName(le)); break; }
    }
}
```

```cpp
#include <hip/hip_runtime.h>
#include <cstdio>
#include <cstdint>

#ifndef MK_N_LAUNCHES
#define MK_N_LAUNCHES 1
#endif

namespace pg8 {
#define PG8_LAS __attribute__((address_space(3)))
typedef unsigned short bf16_t;
typedef short bf16x8 __attribute__((ext_vector_type(8)));
typedef float f32x4 __attribute__((ext_vector_type(4)));
typedef unsigned u32x4 __attribute__((ext_vector_type(4)));
constexpr int BM = 256, BK = 64, HALF = 128, HTB = HALF * BK * 2, STAGE_BYTES = 8 * HTB, NXCD = 8, WGM = 8;

__host__ __device__ __forceinline__ int lds_byte(int r, int c) { const int st = (r >> 4) * 2 + (c >> 5), rr = r & 15, cc = c & 31, ob = rr * 64 + cc * 2; return st * 1024 + (ob ^ (((ob >> 9) & 1) << 5)); }
__host__ __device__ __forceinline__ void stage_rc(int b, int& R, int& C) { const int st = b / 1024, sb = b % 1024, swz = sb ^ (((sb >> 9) & 1) << 5); R = (st >> 1) * 16 + swz / 64; C = (st & 1) * 32 + (swz % 64) / 2; }
__host__ __device__ __forceinline__ int perm32(int rho) { const int n = rho >> 4, i = rho & 15; return 8 * (i >> 2) + 4 * n + (i & 3); }

struct Unit { int pm, pn; size_t boff; int e, s0, cnt; };
struct Gemm { const bf16_t* A; const bf16_t* Bt; int M, N, K; };

struct StaticOrder {
    static constexpr bool GATHER = false;
    int nM, nN, nwg, G, c;
    __host__ __device__ void init(int M, int N, int G_, int c_) { nM = M / BM; nN = N / BM; nwg = nM * nN; G = G_; c = c_; }
    __host__ __device__ bool next(int i, Unit& u) const {
        const long L = (long)i * G + c; if (L >= nwg) return false;
        int wgid = (int)L; { const int q = nwg / NXCD, r = nwg % NXCD, xcd = wgid % NXCD, off = wgid / NXCD; wgid = (xcd < r ? xcd * (q + 1) : r * (q + 1) + (xcd - r) * q) + off; }
        const int nig = WGM * nN, gid = wgid / nig, fm = gid * WGM, gsz = (nM - fm) < WGM ? (nM - fm) : WGM;
        u.pm = fm + ((wgid % nig) % gsz); u.pn = (wgid % nig) / gsz; u.boff = 0; u.e = 0; u.s0 = 0; u.cnt = 0; return true;
    }
    __device__ __forceinline__ int arow(const Unit& u, int r) const { return u.pm * BM + r; }
    __device__ __forceinline__ void a_ready(const Unit&) const {}
    __device__ __forceinline__ void done(const Unit&) const {}
};
template <bool GATHER_>
struct MoeOrder {
    static constexpr bool GATHER = GATHER_;
    int nrt, NT, nwg, G, c; size_t estride; const volatile PG8_LAS int* misc; const int* list;
    __device__ __forceinline__ bool next(int i, Unit& u) const {
        const long L = (long)i * G + c; if (L >= nwg) return false;
        int wgid = (int)L; { const int q = nwg / NXCD, r = nwg % NXCD, xcd = wgid % NXCD, off = wgid / NXCD; wgid = (xcd < r ? xcd * (q + 1) : r * (q + 1) + (xcd - r) * q) + off; }
        u.pm = wgid / NT; u.pn = wgid % NT;
        u.e = __builtin_amdgcn_readfirstlane(misc[64 + u.pm]); u.s0 = __builtin_amdgcn_readfirstlane(misc[320 + u.pm]); u.cnt = __builtin_amdgcn_readfirstlane(misc[480 + u.e]);
        u.boff = (size_t)u.e * estride; return true;
    }
    __device__ __forceinline__ int arow(const Unit& u, int r) const { if (!GATHER_) return u.pm * BM + r; const int slot = u.s0 + r; const int tk = slot < u.cnt ? list[u.e * 16384 + slot] : 0; return tk >> 1; }
    __device__ __forceinline__ void a_ready(const Unit&) const {}
    __device__ __forceinline__ void done(const Unit&) const {}
};

__device__ __forceinline__ unsigned cvt_pk_bf16(float lo, float hi) { unsigned r; asm volatile("v_cvt_pk_bf16_f32 %0, %1, %2" : "=v"(r) : "v"(lo), "v"(hi)); return r; }
__device__ __forceinline__ u32x4 pack8(const f32x4& v0, const f32x4& v1) { u32x4 w; w.x = cvt_pk_bf16(v0[0], v0[1]); w.y = cvt_pk_bf16(v0[2], v0[3]); w.z = cvt_pk_bf16(v1[0], v1[1]); w.w = cvt_pk_bf16(v1[2], v1[3]); return w; }
__device__ __forceinline__ float fexp(float x) { return __builtin_amdgcn_exp2f(x * 1.44269504089f); }
__device__ __forceinline__ float silu_f(float x) { return x * __builtin_amdgcn_rcpf(1.0f + fexp(-x)); }

struct EpiRes {
    static constexpr bool PERM = false, AFTER_DRAIN = false;
    const float* base; float* out; int ldc;
    __device__ __forceinline__ void operator()(const f32x4 (&acc)[2][2][4][2], const Unit& u, int wr, int wc, int fr, int fq) const {
        const int row0 = u.pm * BM + wr * 64 + fr, col0 = u.pn * BM + wc * 32 + 4 * fq;
#pragma unroll
        for (int ai = 0; ai < 2; ++ai)
#pragma unroll
            for (int m = 0; m < 4; ++m) { const size_t off = (size_t)(row0 + ai * HALF + m * 16) * ldc + col0;
#pragma unroll
                for (int bj = 0; bj < 2; ++bj)
#pragma unroll
                    for (int n = 0; n < 2; ++n) { const f32x4 bs = *(const f32x4*)(base + off + bj * HALF + n * 16); *(f32x4*)(out + off + bj * HALF + n * 16) = bs + acc[ai][bj][m][n]; } }
    }
};
struct EpiGlaIn {
    static constexpr bool PERM = true, AFTER_DRAIN = false;
    bf16_t *Qp, *Kp, *Vb, *Gb; const float* Bc;
    __device__ __forceinline__ void operator()(const f32x4 (&acc)[2][2][4][2], const Unit& u, int wr, int wc, int fr, int fq) const {
        const int row0 = u.pm * BM + wr * 64 + fr, cl = wc * 32 + 8 * fq, ct = u.pn;
        if (ct < 8) {
            const bool isq = ct < 4; const int cb = (ct & 3) * 256 + cl; bf16_t* dst = isq ? Qp : Kp; const float sgn = isq ? 1.0f : -1.0f, mul = isq ? 0.0625f : 1.0f;
#pragma unroll
            for (int ai = 0; ai < 2; ++ai)
#pragma unroll
                for (int m = 0; m < 4; ++m) { const size_t ro = (size_t)(row0 + ai * HALF + m * 16) * 1024;
#pragma unroll
                    for (int bj = 0; bj < 2; ++bj) { const int c = cb + bj * HALF; const f32x4 b0 = *(const f32x4*)(Bc + ro + c), b1 = *(const f32x4*)(Bc + ro + c + 4);
                        f32x4 v0 = acc[ai][bj][m][0], v1 = acc[ai][bj][m][1];
#pragma unroll
                        for (int j = 0; j < 4; ++j) { v0[j] *= fexp(sgn * b0[j]) * mul; v1[j] *= fexp(sgn * b1[j]) * mul; }
                        *(u32x4*)(dst + ro + c) = pack8(v0, v1); } }
        } else if (ct < 16) {
            const int cb = (ct - 8) * 256 + cl;
#pragma unroll
            for (int ai = 0; ai < 2; ++ai)
#pragma unroll
                for (int m = 0; m < 4; ++m) { const size_t ro = (size_t)(row0 + ai * HALF + m * 16) * 2048;
#pragma unroll
                    for (int bj = 0; bj < 2; ++bj) *(u32x4*)(Vb + ro + cb + bj * HALF) = pack8(acc[ai][bj][m][0], acc[ai][bj][m][1]); }
        } else {
            const int cb = (ct - 16) * 256 + cl;
#pragma unroll
            for (int ai = 0; ai < 2; ++ai)
#pragma unroll
                for (int m = 0; m < 4; ++m) { const size_t ro = (size_t)(row0 + ai * HALF + m * 16) * 2048;
#pragma unroll
                    for (int bj = 0; bj < 2; ++bj) { f32x4 v0 = acc[ai][bj][m][0], v1 = acc[ai][bj][m][1];
#pragma unroll
                        for (int j = 0; j < 4; ++j) { v0[j] = silu_f(v0[j]); v1[j] = silu_f(v1[j]); }
                        *(u32x4*)(Gb + ro + cb + bj * HALF) = pack8(v0, v1); } }
        }
    }
};
struct EpiConvIn {
    static constexpr bool PERM = true, AFTER_DRAIN = false;
    bf16_t *BG, *U;
    __device__ __forceinline__ void operator()(const f32x4 (&acc)[2][2][4][2], const Unit& u, int wr, int wc, int fr, int fq) const {
        const int row0 = u.pm * BM + wr * 64 + fr, cl = wc * 32 + 8 * fq, ct = u.pn;
        if (ct < 8) {
            const int cb = ct * 256 + cl;
#pragma unroll
            for (int ai = 0; ai < 2; ++ai)
#pragma unroll
                for (int m = 0; m < 4; ++m) { const size_t ro = (size_t)(row0 + ai * HALF + m * 16) * 2048;
#pragma unroll
                    for (int bj = 0; bj < 2; ++bj) *(u32x4*)(BG + ro + cb + bj * HALF) = pack8(acc[ai][bj][m][0], acc[ai][bj][m][1]); }
        } else {
            const int cb = (ct - 8) * 128 + cl;
#pragma unroll
            for (int ai = 0; ai < 2; ++ai)
#pragma unroll
                for (int m = 0; m < 4; ++m) { const size_t ro = (size_t)(row0 + ai * HALF + m * 16) * 2048;
                    *(u32x4*)(U + ro + cb) = pack8(acc[ai][0][m][0] * acc[ai][1][m][0], acc[ai][0][m][1] * acc[ai][1][m][1]); }
        }
    }
};
struct EpiGateUp {
    static constexpr bool PERM = true, AFTER_DRAIN = false;
    bf16_t* ACT;
    __device__ __forceinline__ void operator()(const f32x4 (&acc)[2][2][4][2], const Unit& u, int wr, int wc, int fr, int fq) const {
        const int row0 = u.pm * BM + wr * 64 + fr, cb = u.pn * 128 + wc * 32 + 8 * fq;
#pragma unroll
        for (int ai = 0; ai < 2; ++ai)
#pragma unroll
            for (int m = 0; m < 4; ++m) { const size_t ro = (size_t)(row0 + ai * HALF + m * 16) * 512;
                f32x4 v0 = acc[ai][0][m][0], v1 = acc[ai][0][m][1];
#pragma unroll
                for (int j = 0; j < 4; ++j) { v0[j] = silu_f(v0[j]) * acc[ai][1][m][0][j]; v1[j] = silu_f(v1[j]) * acc[ai][1][m][1][j]; }
                *(u32x4*)(ACT + ro + cb) = pack8(v0, v1); }
    }
};
struct EpiDown {
    static constexpr bool PERM = true, AFTER_DRAIN = false;
    bf16_t* Y;
    __device__ __forceinline__ void operator()(const f32x4 (&acc)[2][2][4][2], const Unit& u, int wr, int wc, int fr, int fq) const {
        const int row0 = u.pm * BM + wr * 64 + fr, cb = u.pn * 256 + wc * 32 + 8 * fq;
#pragma unroll
        for (int ai = 0; ai < 2; ++ai)
#pragma unroll
            for (int m = 0; m < 4; ++m) { const size_t ro = (size_t)(row0 + ai * HALF + m * 16) * 2048;
#pragma unroll
                for (int bj = 0; bj < 2; ++bj) *(u32x4*)(Y + ro + cb + bj * HALF) = pack8(acc[ai][bj][m][0], acc[ai][bj][m][1]); }
    }
};

template <class Epi, class Sched, bool ALIGN_EPI = false>
__device__ __forceinline__ void gemm_phase(PG8_LAS unsigned char* lds, const Gemm g, const Sched& S, const Epi& E) {
    const int tid = threadIdx.x, wid = __builtin_amdgcn_readfirstlane(tid >> 6), lane = tid & 63, wr = wid >> 2, wc = wid & 3, fr = lane & 15, fq = lane >> 4;
    const int K = g.K, nt = K / BK;
    unsigned voffA[2], voffB[2]; int RA[2], CA[2];
#pragma unroll
    for (int i = 0; i < 2; ++i) { int R, C; stage_rc(tid * 16 + i * 8192, R, C); const int Rb = Epi::PERM ? ((R & ~31) + perm32(R & 31)) : R; RA[i] = R; CA[i] = C;
        voffA[i] = (unsigned)(R * K + C) * 2u; voffB[i] = (unsigned)(Rb * K + C) * 2u; }
    const size_t kstep = (size_t)(BK * 2);
    const size_t hstep = (size_t)HALF * K * 2;
    const size_t tstep = 2 * hstep;
    const size_t hstepA = Sched::GATHER ? 0 : hstep;
    const unsigned ldsw = (unsigned)wid * 1024u;
    const int aoff = lds_byte(wr * 64 + fr, fq * 8), boff = lds_byte(wc * 32 + fr, fq * 8);
#define PG8_SA(b, h) (((b) * 2 + (h)) * HTB)
#define PG8_SB(b, h) ((4 + (b) * 2 + (h)) * HTB)
#define PG8_STAGE(bufoff, gbase, voff) do { _Pragma("unroll") for (int _i = 0; _i < 2; ++_i) \
        __builtin_amdgcn_global_load_lds((const unsigned*)((const char*)(gbase) + (voff)[_i]), (PG8_LAS unsigned*)(lds + (bufoff) + ldsw + _i * 8192), 16, 0, 0); } while (0)
#define PG8_LDA(dst, b, h) do { _Pragma("unroll") for (int m = 0; m < 4; ++m) _Pragma("unroll") for (int k = 0; k < 2; ++k) dst[m][k] = *(const PG8_LAS bf16x8*)(lds + PG8_SA(b, h) + aoff + m * 2048 + k * 1024); } while (0)
#define PG8_LDB(dst, b, h) do { _Pragma("unroll") for (int n = 0; n < 2; ++n) _Pragma("unroll") for (int k = 0; k < 2; ++k) dst[n][k] = *(const PG8_LAS bf16x8*)(lds + PG8_SB(b, h) + boff + n * 2048 + k * 1024); } while (0)
#define PG8_MMA(ai, bj, At, Bt) do { __builtin_amdgcn_s_setprio(1); _Pragma("unroll") for (int m = 0; m < 4; ++m) _Pragma("unroll") for (int n = 0; n < 2; ++n) _Pragma("unroll") for (int k = 0; k < 2; ++k) \
        acc[ai][bj][m][n] = __builtin_amdgcn_mfma_f32_16x16x32_bf16(Bt[n][k], At[m][k], acc[ai][bj][m][n], 0, 0, 0); __builtin_amdgcn_s_setprio(0); } while (0)
#define PG8_WAIT_V(n) asm volatile("s_waitcnt vmcnt(" #n ")" ::: "memory")
#define PG8_WAIT_L(n) asm volatile("s_waitcnt lgkmcnt(" #n ")" ::: "memory")
#define PG8_BAR __builtin_amdgcn_s_barrier()
#define PG8_SCHED __builtin_amdgcn_sched_barrier(0)
    Unit cur, nxt; int ui = 0;
    if (!S.next(0, cur)) return;
    f32x4 acc[2][2][4][2];
#pragma unroll
    for (int a = 0; a < 2; ++a)
#pragma unroll
        for (int b = 0; b < 2; ++b)
#pragma unroll
            for (int m = 0; m < 4; ++m)
#pragma unroll
                for (int n = 0; n < 2; ++n) acc[a][b][m][n] = (f32x4){0.f, 0.f, 0.f, 0.f};
    bf16x8 At[4][2], B0[2][2], B1[2][2];
    unsigned vc0[2], vc1[2], vn0[2], vn1[2];
    if constexpr (Sched::GATHER) {
#pragma unroll
        for (int i = 0; i < 2; ++i) { vc0[i] = (unsigned)(S.arow(cur, RA[i]) * K + CA[i]) * 2u; vc1[i] = (unsigned)(S.arow(cur, RA[i] + HALF) * K + CA[i]) * 2u; vn0[i] = vc0[i]; vn1[i] = vc1[i]; }
    } else {
#pragma unroll
        for (int i = 0; i < 2; ++i) { vc0[i] = voffA[i]; vc1[i] = voffA[i]; vn0[i] = voffA[i]; vn1[i] = voffA[i]; }
    }
    const char* cA = Sched::GATHER ? (const char*)g.A : (const char*)g.A + (size_t)cur.pm * tstep; const char* cB = (const char*)g.Bt + cur.boff + (size_t)cur.pn * tstep;
    S.a_ready(cur);
    PG8_STAGE(PG8_SB(0, 0), cB, voffB); PG8_STAGE(PG8_SB(0, 1), cB + hstep, voffB); PG8_STAGE(PG8_SA(0, 0), cA, vc0); PG8_STAGE(PG8_SA(0, 1), cA + hstepA, vc1);
    if (wr == 1) PG8_BAR;
    PG8_WAIT_V(2); PG8_BAR;
    PG8_STAGE(PG8_SB(1, 0), cB + kstep, voffB); PG8_STAGE(PG8_SA(1, 0), cA + kstep, vc0); PG8_STAGE(PG8_SB(1, 1), cB + hstep + kstep, voffB);
    PG8_WAIT_V(6); PG8_BAR;
    for (;;) {
        const bool has_next = S.next(ui + 1, nxt);
        if constexpr (Sched::GATHER) { if (has_next) {
#pragma unroll
            for (int i = 0; i < 2; ++i) { vn0[i] = (unsigned)(S.arow(nxt, RA[i]) * K + CA[i]) * 2u; vn1[i] = (unsigned)(S.arow(nxt, RA[i] + HALF) * K + CA[i]) * 2u; } } }
        const char* nA = Sched::GATHER ? (const char*)g.A : (has_next ? (const char*)g.A + (size_t)nxt.pm * tstep : cA); const char* nB = has_next ? (const char*)g.Bt + nxt.boff + (size_t)nxt.pn * tstep : cB;
        for (int t = 0; t < nt; t += 2) {
            const bool last = (t == nt - 2);
            const char* a1 = cA + (size_t)(t + 1) * kstep;
            const char* a2 = last ? nA : cA + (size_t)(t + 2) * kstep; const char* b2 = last ? nB : cB + (size_t)(t + 2) * kstep;
            const char* a3 = a2 + kstep; const char* b3 = b2 + kstep;
            unsigned w0[2], w1[2];
#pragma unroll
            for (int i = 0; i < 2; ++i) { w0[i] = (Sched::GATHER && last) ? vn0[i] : vc0[i]; w1[i] = (Sched::GATHER && last) ? vn1[i] : vc1[i]; }
            if (last && has_next) S.a_ready(nxt);
            PG8_LDB(B0, 0, 0); PG8_LDB(B1, 0, 1); PG8_SCHED; PG8_LDA(At, 0, 0); PG8_STAGE(PG8_SA(1, 1), a1 + hstepA, vc1);
            PG8_WAIT_V(8); PG8_WAIT_L(0); PG8_BAR; PG8_MMA(0, 0, At, B0); PG8_MMA(0, 1, At, B1); PG8_BAR; PG8_SCHED;
            PG8_LDA(At, 0, 1); PG8_STAGE(PG8_SB(0, 0), b2, voffB); PG8_STAGE(PG8_SB(0, 1), b2 + hstep, voffB); PG8_STAGE(PG8_SA(0, 0), a2, w0);
            PG8_WAIT_V(8); PG8_WAIT_L(0); PG8_BAR; PG8_MMA(1, 0, At, B0); PG8_MMA(1, 1, At, B1); PG8_BAR; PG8_SCHED;
            PG8_LDB(B0, 1, 0); PG8_LDB(B1, 1, 1); PG8_SCHED; PG8_LDA(At, 1, 0); PG8_STAGE(PG8_SA(0, 1), a2 + hstepA, w1);
            PG8_WAIT_V(8); PG8_WAIT_L(0); PG8_BAR; PG8_MMA(0, 0, At, B0); PG8_MMA(0, 1, At, B1); PG8_BAR; PG8_SCHED;
            PG8_LDA(At, 1, 1); PG8_STAGE(PG8_SB(1, 0), b3, voffB); PG8_STAGE(PG8_SB(1, 1), b3 + hstep, voffB); PG8_STAGE(PG8_SA(1, 0), a3, w0);
            PG8_WAIT_V(8); PG8_WAIT_L(0); PG8_BAR; PG8_MMA(1, 0, At, B0); PG8_MMA(1, 1, At, B1); PG8_BAR; PG8_SCHED;
        }
        if constexpr (ALIGN_EPI) { if (wr == 0) PG8_BAR; }
        if constexpr (!Epi::AFTER_DRAIN) { E(acc, cur, wr, wc, fr, fq); S.done(cur); }
        if (!has_next) break;
#pragma unroll
        for (int a = 0; a < 2; ++a)
#pragma unroll
            for (int b = 0; b < 2; ++b)
#pragma unroll
                for (int m = 0; m < 4; ++m)
#pragma unroll
                    for (int n = 0; n < 2; ++n) acc[a][b][m][n] = (f32x4){0.f, 0.f, 0.f, 0.f};
        cur = nxt; cA = nA; cB = nB; ++ui;
        if constexpr (Sched::GATHER) {
#pragma unroll
            for (int i = 0; i < 2; ++i) { vc0[i] = vn0[i]; vc1[i] = vn1[i]; } }
        if constexpr (ALIGN_EPI) { if (wr == 1) PG8_BAR; }
    }
    PG8_WAIT_V(0);
    if constexpr (!ALIGN_EPI) { if (wr == 0) PG8_BAR; }
    PG8_BAR;
#undef PG8_SA
#undef PG8_SB
#undef PG8_STAGE
#undef PG8_LDA
#undef PG8_LDB
#undef PG8_MMA
#undef PG8_WAIT_V
#undef PG8_WAIT_L
#undef PG8_BAR
#undef PG8_SCHED
}
}

constexpr int NWAVES = 8;
constexpr int NPH = 17;
constexpr int N_LAUNCHES = (MK_N_LAUNCHES == 1) ? 1 : NPH;

constexpr int T = 16384, D = 2048;
constexpr int KD = 1024, VD = 2048, GIN = 6160, GINM = 6144, DKH = 256, DVH = 512, NHEAD = 4, CHK = 64, NCHUNK = T / CHK, RANK = 16;
constexpr int NE = 32, FF = 512, NGRP = 4, EPG = 8, NLOG = 48;
constexpr int MAX_RT = 160;
constexpr float EPS = 1e-6f;

constexpr size_t MiB = 1u << 20;
constexpr size_t WS_CTL = 0, CTL_ZERO_BYTES = 65536;
constexpr size_t WS_GL = 1 * MiB;
constexpr size_t WS_TKE = 2 * MiB;
constexpr size_t WS_TKS = WS_TKE + 131072;
constexpr size_t WS_TKG = WS_TKS + 131072;
constexpr size_t WS_RGATE = WS_TKG + 131072;
constexpr size_t WS_LIST = 3 * MiB;
constexpr size_t WS_WRT = 5 * MiB;
constexpr size_t WS_WGI = 8 * MiB;
constexpr size_t WS_WGO = 32 * MiB;
constexpr size_t WS_WCI = 40 * MiB;
constexpr size_t WS_WCO = 64 * MiB;
constexpr size_t WS_WGU = 72 * MiB;
constexpr size_t WS_WDN = 328 * MiB;
constexpr size_t WS_HN = 456 * MiB;
constexpr size_t WS_BC = 520 * MiB;
constexpr size_t WS_QP = 584 * MiB;
constexpr size_t WS_KP = 616 * MiB;
constexpr size_t WS_VB = 648 * MiB;
constexpr size_t WS_GB = 712 * MiB;
constexpr size_t WS_O = 776 * MiB;
constexpr size_t WS_OG = 904 * MiB;
constexpr size_t WS_H1 = 968 * MiB;
constexpr size_t WS_H2 = 1096 * MiB;
constexpr size_t WS_XS = 1224 * MiB;
constexpr size_t WS_ACT = 1384 * MiB;
constexpr size_t WS_Y = 1424 * MiB;
constexpr size_t WS_SEND = 1584 * MiB;
constexpr size_t WS_GTOT = 1616 * MiB;
constexpr size_t WS_END = 1617 * MiB;
constexpr int CW_TMO = 0, CW_CODE = 1;
constexpr int CW_BAR = 4096;
constexpr int CW_CNT = 8192;

constexpr int RING_OFF = 0, RING_BYTES = 131072;
constexpr int SCR_OFF = 131072, SCR_BYTES = 8192;
constexpr int MISC_OFF = SCR_OFF + SCR_BYTES;
constexpr int MISC_BYTES = 2048;
constexpr int LDS_BYTES = 147456;
static_assert(MISC_OFF + MISC_BYTES <= LDS_BYTES, "LDS map");
constexpr int MI_PSTART = 16, MI_NRT = 49, MI_TEXP = 64, MI_CNTL = 256, MI_BASEL = 288, MI_TSLOT = 320, MI_ECNT = 480;
static_assert(MI_TEXP == 64 && MI_TSLOT == 320 && MI_ECNT == 480, "pg8::MoeOrder reads these words by number");

#define GAS __attribute__((address_space(1)))
#define LAS __attribute__((address_space(3)))
typedef unsigned short bf16;
typedef unsigned v4u __attribute__((ext_vector_type(4)));
typedef unsigned v2u __attribute__((ext_vector_type(2)));
typedef float f32x4 __attribute__((ext_vector_type(4)));
typedef GAS unsigned gu32;
#define RLX_AGENT __ATOMIC_RELAXED, __HIP_MEMORY_SCOPE_AGENT
#define LDS_WAIT() asm volatile("s_waitcnt lgkmcnt(0)" ::: "memory")
#define VM_WAIT() asm volatile("s_waitcnt vmcnt(0)" ::: "memory")
__device__ __forceinline__ unsigned f2bf(float f) { unsigned u = __builtin_bit_cast(unsigned, f); return (u + 0x7fffu + ((u >> 16) & 1u)) >> 16; }
__device__ __forceinline__ unsigned pk2(float lo, float hi) { return f2bf(lo) | (f2bf(hi) << 16); }
__device__ __forceinline__ float bflo(unsigned w) { return __uint_as_float(w << 16); }
__device__ __forceinline__ float bfhi(unsigned w) { return __uint_as_float(w & 0xffff0000u); }

#define XB_TMO      128
#define XB_XCNT(j)  (256  + 64 * (j))
#define XB_XSUB(j)  (1280 + 64 * (j))
#define XB_XGEN(j)  (2304 + 64 * (j))
#define XB_TOP      3328
#define XB_TOPGEN   3392
#define XCD_BAR_WORDS 3456
#define XB_SPIN_CAP (1u << 22)
__device__ __forceinline__ unsigned xb_ld(unsigned* p)              { return __hip_atomic_load(p, __ATOMIC_RELAXED, __HIP_MEMORY_SCOPE_AGENT); }
__device__ __forceinline__ unsigned xb_add(unsigned* p, unsigned v) { return __hip_atomic_fetch_add(p, v, __ATOMIC_RELAXED, __HIP_MEMORY_SCOPE_AGENT); }
__device__ __forceinline__ unsigned xb_xcc_id() { return (unsigned)__builtin_amdgcn_s_getreg((3 << 11) | 20) & 0xFu; }
#define XB_SPIN(cond, bar) do { unsigned _sp = 0; while (cond) { __builtin_amdgcn_s_sleep(1); \
    if ((++_sp & 255u) == 0u) { if (xb_ld(&(bar)[XB_TMO])) break; if (_sp > XB_SPIN_CAP) { atomicAdd(&(bar)[XB_TMO], 1u); break; } } } } while (0)
struct XcdBarrier { unsigned* bar; unsigned x; volatile LAS unsigned* st; };
__device__ __forceinline__ XcdBarrier xcd_barrier_post(unsigned* bar, volatile LAS unsigned* st) {
    XcdBarrier b; b.bar = bar; b.x = xb_xcc_id(); b.st = st;
    if (threadIdx.x == 0) (void)xb_add(&bar[XB_XCNT(b.x)], 1u);
    return b;
}
__device__ __forceinline__ void xcd_barrier_complete(unsigned* bar, unsigned x, unsigned& nloc, unsigned& nx) {
    const unsigned G = gridDim.x * gridDim.y * gridDim.z;
    unsigned sum, cnt, mine, sp = 0u;
    for (;;) {
        sum = 0u; cnt = 0u; mine = 0u;
#pragma unroll
        for (unsigned j = 0; j < 16; ++j) { const unsigned c = xb_ld(&bar[XB_XCNT(j)]); sum += c; cnt += (c > 0u) ? 1u : 0u; mine = (j == x) ? c : mine; }
        if (sum == G) break;
        __builtin_amdgcn_s_sleep(1);
        if ((++sp & 255u) == 0u) { if (xb_ld(&bar[XB_TMO])) break; if (sp > XB_SPIN_CAP) { atomicAdd(&bar[XB_TMO], 1u); break; } }
    }
    nloc = mine > 0u ? mine : 1u; nx = cnt > 0u ? cnt : 1u;
}
__device__ __forceinline__ void xcd_barrier(const XcdBarrier& b) {
    asm volatile("s_waitcnt vmcnt(0)" ::: "memory");
    __syncthreads();
    if (threadIdx.x == 0) {
        unsigned* bar = b.bar;
        __builtin_amdgcn_s_waitcnt(0);
        unsigned nloc = b.st[0], nx = b.st[1];
        if (nloc == 0u) { xcd_barrier_complete(bar, b.x, nloc, nx); b.st[0] = nloc; b.st[1] = nx; }
        const unsigned old = xb_add(&bar[XB_XSUB(b.x)], 1u);
        const unsigned gen = old / nloc;
        if (old + 1u == (gen + 1u) * nloc) {
            __builtin_amdgcn_fence(__ATOMIC_RELEASE, "agent");
            asm volatile("s_waitcnt vmcnt(0)" ::: "memory");
            const unsigned og = xb_add(&bar[XB_TOP], 1u);
            const unsigned tg = og / nx;
            if (og + 1u == (tg + 1u) * nx) xb_add(&bar[XB_TOPGEN], 1u);
            else XB_SPIN(xb_ld(&bar[XB_TOPGEN]) == tg, bar);
            __builtin_amdgcn_fence(__ATOMIC_ACQUIRE, "agent");
            xb_add(&bar[XB_XGEN(b.x)], 1u);
            asm volatile("s_waitcnt vmcnt(0)" ::: "memory");
        } else {
            XB_SPIN(xb_ld(&bar[XB_XGEN(b.x)]) == gen, bar);
            __builtin_amdgcn_fence(__ATOMIC_ACQUIRE, "agent");
            asm volatile("s_waitcnt vmcnt(0)" ::: "memory");
        }
    }
    __syncthreads();
}

struct Frame {
    LAS unsigned char* lds;
    volatile LAS int* MISC;
    unsigned* ctl;
    int tid, lane, wave, G;
    __attribute__((address_space(4))) const unsigned char* ka;
};
#define KIN(i) (*(const float* const __attribute__((address_space(4)))*)(F.ka + 8 * (i)))
#define KOUT   (*(float* const __attribute__((address_space(4)))*)(F.ka + 8 * 18))
#define KWS    (*(unsigned char* const __attribute__((address_space(4)))*)(F.ka + 8 * 19))
__device__ __forceinline__ float wave_sum(float v) {
#pragma unroll
    for (int o = 1; o < 64; o <<= 1) v += __shfl_xor(v, o);
    return v;
}

__device__ __forceinline__ void transpose_item(const float* W, int K, int ldw, int ncols, bf16* WT, int destrow0, LAS float* scr, int kb, int nb, int lane) {
    const int k0 = 64 * kb, n0 = 32 * nb; (void)ncols;
#pragma unroll 8
    for (int i = 0; i < 32; ++i) { const int kk = 2 * i + (lane >> 5); scr[kk * 33 + (lane & 31)] = W[(size_t)(k0 + kk) * ldw + n0 + (lane & 31)]; }
    LDS_WAIT(); asm volatile("" ::: "memory");
    const int c = lane & 7;
#pragma unroll
    for (int j = 0; j < 4; ++j) { const int n = (lane >> 3) + 8 * j; const LAS float* s = scr + (8 * c) * 33 + n;
        v4u o; o.x = pk2(s[0 * 33], s[1 * 33]); o.y = pk2(s[2 * 33], s[3 * 33]); o.z = pk2(s[4 * 33], s[5 * 33]); o.w = pk2(s[6 * 33], s[7 * 33]);
        *(v4u*)(WT + (size_t)(destrow0 + n) * K + k0 + 8 * c) = o; }
    LDS_WAIT(); asm volatile("" ::: "memory");
}
__device__ __forceinline__ int conv_in_row(int n) { if (n < 2048) return n; const int s = (n - 2048) >> 11, f = (n - 2048) & 2047; return 2048 + 256 * (f >> 7) + 128 * s + (f & 127); }
__device__ __forceinline__ int gate_up_row(int n) { const int s = n >> 9, f = n & 511; return 256 * (f >> 7) + 128 * s + (f & 127); }

__device__ __forceinline__ void p0_convert(Frame& F) {
    LAS float* scr = (LAS float*)(F.lds + RING_OFF + F.wave * 16384);
    const int gw = blockIdx.x * NWAVES + F.wave, NGW = F.G * NWAVES;
    constexpr int I_GI = 32 * 192, I_GO = 32 * 64, I_CI = 32 * 192, I_CO = 32 * 64, I_GU1 = 32 * 32, I_DN1 = 8 * 64;
    constexpr int I_GU = I_GU1 * 64, I_DN = I_DN1 * 64;
    constexpr int NITEMS = I_GI + I_GO + I_CI + I_CO + I_GU + I_DN;
    bf16* WGI = (bf16*)(KWS + WS_WGI); bf16* WGO = (bf16*)(KWS + WS_WGO); bf16* WCI = (bf16*)(KWS + WS_WCI); bf16* WCO = (bf16*)(KWS + WS_WCO);
    bf16* WGU = (bf16*)(KWS + WS_WGU); bf16* WDN = (bf16*)(KWS + WS_WDN);
    for (int it = gw; it < NITEMS; it += NGW) {
        int r = it;
        if (r < I_GI) { const int kb = r / 192, nb = r % 192; transpose_item(KIN(2), 2048, GIN, GINM, WGI, 32 * nb, scr, kb, nb, F.lane); continue; } r -= I_GI;
        if (r < I_GO) { const int kb = r / 64, nb = r % 64; transpose_item(KIN(6), 2048, 2048, 2048, WGO, 32 * nb, scr, kb, nb, F.lane); continue; } r -= I_GO;
        if (r < I_CI) { const int kb = r / 192, nb = r % 192; transpose_item(KIN(7), 2048, 6144, 6144, WCI, conv_in_row(32 * nb), scr, kb, nb, F.lane); continue; } r -= I_CI;
        if (r < I_CO) { const int kb = r / 64, nb = r % 64; transpose_item(KIN(9), 2048, 2048, 2048, WCO, 32 * nb, scr, kb, nb, F.lane); continue; } r -= I_CO;
        if (r < I_GU) { const int le = r / I_GU1, q = r % I_GU1, kb = q / 32, nb = q % 32;
            transpose_item(KIN(15) + (size_t)le * 2048 * 1024, 2048, 1024, 1024, WGU + (size_t)le * 1024 * 2048, gate_up_row(32 * nb), scr, kb, nb, F.lane); continue; } r -= I_GU;
        { const int le = r / I_DN1, q = r % I_DN1, kb = q / 64, nb = q % 64;
            transpose_item(KIN(16) + (size_t)le * 512 * 2048, 512, 2048, 2048, WDN + (size_t)le * 2048 * 512, 32 * nb, scr, kb, nb, F.lane); }
    }
    float* WRT = (float*)(KWS + WS_WRT);
    for (int i = blockIdx.x * 512 + F.tid; i < 2 * NLOG * 2048; i += F.G * 512) {
        const int l = i / (NLOG * 2048), c = (i / 2048) % NLOG, k = i % 2048;
        float w = 0.f;
        if (c < 4) w = KIN(11)[((size_t)l * 2048 + k) * 4 + c]; else if (c < 36) w = KIN(13)[((size_t)l * 2048 + k) * 32 + (c - 4)];
        WRT[i] = w * KIN(10)[l * 2048 + k];
    }
}

constexpr int WGT_LD = 2052;
__device__ __forceinline__ void p0_norm_gl(Frame& F) {
    LAS float* wgt = (LAS float*)(F.lds);
    LAS float* glc = (LAS float*)(F.lds + 16 * WGT_LD * 4);
    static_assert(16 * WGT_LD * 4 + 64 * 16 * 4 <= MISC_OFF, "p0 LDS");
    const float* w_in = KIN(2);
    for (int idx = F.tid; idx < 2048 * 16; idx += 512) { const int k = idx >> 4, r = idx & 15; wgt[r * WGT_LD + k] = w_in[(size_t)k * GIN + GINM + r]; }
    __syncthreads();
    const float* x = KIN(0); const float* wn = KIN(1); bf16* HN = (bf16*)(KWS + WS_HN); float* BC = (float*)(KWS + WS_BC);
    const float* w2 = KIN(3); const float* bgk = KIN(4);
    for (int ch = blockIdx.x; ch < NCHUNK; ch += F.G) {
        for (int rr = 0; rr < 8; ++rr) {
            const int rl = F.wave * 8 + rr, row = ch * CHK + rl;
            const f32x4* xr = (const f32x4*)(x + (size_t)row * D) + F.lane;
            float s = 0.f;
#pragma unroll
            for (int j = 0; j < 8; ++j) { const f32x4 v = xr[64 * j]; s += (v.x * v.x + v.y * v.y) + (v.z * v.z + v.w * v.w); }
            const float rstd = 1.0f / sqrtf(wave_sum(s) * (1.0f / D) + EPS);
            float ga[16];
#pragma unroll
            for (int r = 0; r < 16; ++r) ga[r] = 0.f;
            v2u* o8 = (v2u*)(HN + (size_t)row * D) + F.lane;
#pragma unroll 1
            for (int j = 0; j < 8; ++j) { const f32x4 w = ((const f32x4*)wn)[F.lane + 64 * j]; const f32x4 v = xr[64 * j] * rstd * w;
                v2u o; o.x = pk2(v.x, v.y); o.y = pk2(v.z, v.w); o8[64 * j] = o;
#pragma unroll
                for (int r = 0; r < 16; ++r) { const f32x4 g = *(const LAS f32x4*)(wgt + r * WGT_LD + 4 * F.lane + 256 * j); ga[r] += (v.x * g.x + v.y * g.y) + (v.z * g.z + v.w * g.w); } }
#pragma unroll
            for (int r = 0; r < 16; ++r) ga[r] = wave_sum(ga[r]);
            if (F.lane == 0) {
#pragma unroll
                for (int r = 0; r < 16; ++r) glc[rl * 16 + r] = ga[r]; }
        }
        __syncthreads();
#pragma unroll
        for (int hh = 0; hh < 2; ++hh) {
            const int c = F.tid + 512 * hh; float w2r[16];
#pragma unroll
            for (int r = 0; r < 16; ++r) w2r[r] = w2[r * KD + c];
            const float bias = bgk[c]; float cum = 0.f;
            for (int t = 0; t < CHK; ++t) {
                float z = bias;
#pragma unroll
                for (int r = 0; r < 16; ++r) z += glc[t * 16 + r] * w2r[r];
                const float ls = fminf(z, 0.f) - log1pf(expf(-fabsf(z)));
                cum += ls * (1.0f / 16.0f);
                BC[(size_t)(ch * CHK + t) * KD + c] = cum;
            }
        }
        __syncthreads();
    }
}

__device__ __forceinline__ void ph_gla_naive(Frame& F) {
    const bf16* QP = (const bf16*)(KWS + WS_QP); const bf16* KP = (const bf16*)(KWS + WS_KP); const bf16* VB = (const bf16*)(KWS + WS_VB);
    const float* BC = (const float*)(KWS + WS_BC); float* O = (float*)(KWS + WS_O);
    for (int u = blockIdx.x; u < 128; u += F.G) {
        const int h = u >> 5, col0 = (u & 31) * 16, ds = F.tid & 31, col = F.tid >> 5;
        float R[8];
#pragma unroll
        for (int i = 0; i < 8; ++i) R[i] = 0.f;
        const bf16* qp = QP + h * DKH + ds * 8; const bf16* kp = KP + h * DKH + ds * 8; const bf16* vp = VB + h * DVH + col0 + col;
        const float* bp = BC + h * DKH + ds * 8; float* op = O + h * DVH + col0 + col;
        for (int t0 = 0; t0 < T; t0 += 8) {
            v4u kk[8], qq[8]; unsigned short vv[8];
#pragma unroll
            for (int j = 0; j < 8; ++j) { kk[j] = *(const v4u*)(kp + (size_t)(t0 + j) * KD); qq[j] = *(const v4u*)(qp + (size_t)(t0 + j) * KD); vv[j] = vp[(size_t)(t0 + j) * VD]; }
#pragma unroll
            for (int j = 0; j < 8; ++j) {
                const float v = __uint_as_float(((unsigned)vv[j]) << 16);
                float po = 0.f;
#pragma unroll
                for (int i = 0; i < 4; ++i) { const unsigned kw = kk[j][i], qw = qq[j][i];
                    R[2 * i] += bflo(kw) * v; R[2 * i + 1] += bfhi(kw) * v; po += bflo(qw) * R[2 * i] + bfhi(qw) * R[2 * i + 1]; }
                po += __shfl_xor(po, 1); po += __shfl_xor(po, 2); po += __shfl_xor(po, 4); po += __shfl_xor(po, 8); po += __shfl_xor(po, 16);
                if (ds == 0) op[(size_t)(t0 + j) * VD] = po;
            }
            if (((t0 + 8) & 63) == 0) { const f32x4 b0 = *(const f32x4*)(bp + (size_t)(t0 + 7) * KD), b1 = *(const f32x4*)(bp + (size_t)(t0 + 7) * KD + 4);
#pragma unroll
                for (int i = 0; i < 4; ++i) { R[i] *= expf(b0[i]); R[4 + i] *= expf(b1[i]); } }
        }
    }
}

namespace gla {
typedef short bf16x8 __attribute__((ext_vector_type(8)));
typedef short s16x4 __attribute__((ext_vector_type(4)));
typedef short v4i16_t __attribute__((ext_vector_type(4)));
typedef float f32x2_t __attribute__((ext_vector_type(2))); typedef __bf16 bf16x2_t __attribute__((ext_vector_type(2)));
__device__ __forceinline__ unsigned cvtpk(float lo, float hi) { f32x2_t v = {lo, hi}; bf16x2_t b = __builtin_convertvector(v, bf16x2_t); return __builtin_bit_cast(unsigned, b); }
__device__ __forceinline__ s16x4 trread(const LAS unsigned char* p) { return __builtin_bit_cast(s16x4, __builtin_amdgcn_ds_read_tr16_b64_v4i16((LAS v4i16_t*)p)); }
__device__ __forceinline__ bf16x8 cat4(s16x4 a, s16x4 b) { bf16x8 r; r[0] = a[0]; r[1] = a[1]; r[2] = a[2]; r[3] = a[3]; r[4] = b[0]; r[5] = b[1]; r[6] = b[2]; r[7] = b[3]; return r; }
constexpr int QS = 528, VS = 272, PS = 144;
constexpr int OFF_Q = 0, OFF_K = 64 * QS, OFF_V = 2 * 64 * QS, OFF_P = OFF_V + 64 * VS, OFF_G = OFF_P + 64 * PS, LDS_END = OFF_G + 1024;
static_assert(LDS_END <= RING_BYTES, "gla LDS");
constexpr int NPART = 16, CPP = NCHUNK / NPART;
struct Stage { v4u q[4], k[4], v[2]; float g; };
template <bool NEEDQ>
__device__ __forceinline__ void issue_loads(Stage& st, const bf16* QP, const bf16* KP, const bf16* VB, const float* BC, int tok0, int h, int s, int tid) {
#pragma unroll
    for (int i = 0; i < 4; ++i) { const int id = tid + 512 * i, row = id >> 5, cc = id & 31; const size_t o = (size_t)(tok0 + row) * KD + h * DKH + cc * 8;
        if (NEEDQ) st.q[i] = *(const v4u*)(QP + o); st.k[i] = *(const v4u*)(KP + o); }
#pragma unroll
    for (int i = 0; i < 2; ++i) { const int id = tid + 512 * i, row = id >> 4, cc = id & 15; st.v[i] = *(const v4u*)(VB + (size_t)(tok0 + row) * VD + h * DVH + s * 128 + cc * 8); }
    st.g = BC[(size_t)(tok0 + 63) * KD + h * DKH + (tid & 255)];
}
template <bool NEEDQ>
__device__ __forceinline__ void write_stage(LAS unsigned char* lds, const Stage& st, int tid) {
#pragma unroll
    for (int i = 0; i < 4; ++i) { const int id = tid + 512 * i, row = id >> 5, cc = id & 31;
        if (NEEDQ) *(LAS v4u*)(lds + OFF_Q + row * QS + cc * 16) = st.q[i]; *(LAS v4u*)(lds + OFF_K + row * QS + cc * 16) = st.k[i]; }
#pragma unroll
    for (int i = 0; i < 2; ++i) { const int id = tid + 512 * i, row = id >> 4, cc = id & 15; *(LAS v4u*)(lds + OFF_V + row * VS + cc * 16) = st.v[i]; }
    if (tid < 256) *(LAS float*)(lds + OFF_G + 4 * tid) = expf(st.g);
}
template <int PASS>
__device__ __forceinline__ void unit(LAS unsigned char* lds, int tid, int lane, int w, int p, int h, int s, const bf16* QP, const bf16* KP, const bf16* VB, const float* BC, float* O, f32x4* SEND, float* GTOT) {
    constexpr bool NQ = (PASS == 2);
    const int r = lane & 15, q = lane >> 4, qq = r >> 2, pp = r & 3;
    f32x4 S[16];
#pragma unroll
    for (int dt = 0; dt < 16; ++dt) S[dt] = (f32x4){0.f, 0.f, 0.f, 0.f};
    const int tokbase = p * CPP * CHK;
    Stage st0, st1;
    issue_loads<NQ>(st0, QP, KP, VB, BC, tokbase, h, s, tid);
    __syncthreads();
    if (PASS == 2 && p > 0) {
        LAS int* cw = (LAS int*)(lds + OFF_P);
        if (tid == 0) *cw = 1 << 30;
        __syncthreads();
        if (tid < 256) { float prod = 1.f; int j0 = 0; for (int j = p - 1; j >= 1; --j) { prod *= GTOT[((size_t)j * 4 + h) * DKH + tid]; if (prod == 0.f) { j0 = j; break; } }
            __hip_atomic_fetch_min(cw, j0, __ATOMIC_RELAXED, __HIP_MEMORY_SCOPE_WORKGROUP); }
        __syncthreads();
        const int p0 = *cw;
        for (int pj = p0; pj < p; ++pj) {
            const f32x4* se = SEND + ((((size_t)pj * 4 + h) * 4 + s) * 8 + w) * 16 * 64 + lane; const float* gt = GTOT + ((size_t)pj * 4 + h) * DKH;
#pragma unroll
            for (int dt = 0; dt < 16; ++dt) { const f32x4 gg = *(const f32x4*)(gt + 16 * dt + 4 * q); S[dt] = S[dt] * gg + se[dt * 64]; }
        }
        __syncthreads();
    }
    write_stage<NQ>(lds, st0, tid);
    if (CPP > 1) issue_loads<NQ>(st0, QP, KP, VB, BC, tokbase + CHK, h, s, tid);
    if (PASS == 1 && CPP > 2) issue_loads<NQ>(st1, QP, KP, VB, BC, tokbase + 2 * CHK, h, s, tid);
    __syncthreads();
    const LAS unsigned char* qnat = lds + OFF_Q + r * QS + q * 16;
    const LAS unsigned char* knat = lds + OFF_K + r * QS + q * 16;
    const LAS unsigned char* qperm = lds + OFF_Q + r * QS + q * 8;
    const LAS unsigned char* ktr = lds + OFF_K + (8 * q + qq) * QS + pp * 8;
    const LAS unsigned char* vtr = lds + OFF_V + (8 * q + qq) * VS + w * 32 + pp * 8;
    const LAS unsigned char* pnat = lds + OFF_P + r * PS + q * 16;
    const LAS unsigned char* gbase = lds + OFF_G + 16 * q;
#define GLA_FENCE() asm volatile("" ::: "memory")
#define GLA_BAR() do { asm volatile("s_waitcnt lgkmcnt(0)" ::: "memory"); __builtin_amdgcn_s_barrier(); asm volatile("" ::: "memory"); } while (0)
#pragma unroll 1
    for (int c = 0; c < CPP; ++c) {
        const int tok0 = tokbase + c * CHK;
        bf16x8 vb[2];
#pragma unroll
        for (int kt = 0; kt < 2; ++kt) vb[kt] = cat4(trread(vtr + kt * 32 * VS), trread(vtr + kt * 32 * VS + 4 * VS));
        if (PASS == 2) {
            const int it = w >> 1, jt0 = 2 * (w & 1);
            f32x4 pa0 = (f32x4){0.f, 0.f, 0.f, 0.f}, pa1 = pa0;
            bf16x8 fb[4], fa0[4], fa1[4];
#define P_LOAD(sl, ks) do { fb[sl] = *(const LAS bf16x8*)(qnat + it * 16 * QS + (ks) * 64); fa0[sl] = *(const LAS bf16x8*)(knat + jt0 * 16 * QS + (ks) * 64); fa1[sl] = *(const LAS bf16x8*)(knat + (jt0 + 1) * 16 * QS + (ks) * 64); } while (0)
            P_LOAD(0, 0); P_LOAD(1, 1); P_LOAD(2, 2);
#pragma unroll
            for (int ks = 0; ks < 8; ++ks) { if (ks + 3 < 8) P_LOAD((ks + 3) & 3, ks + 3); GLA_FENCE();
                pa0 = __builtin_amdgcn_mfma_f32_16x16x32_bf16(fa0[ks & 3], fb[ks & 3], pa0, 0, 0, 0); pa1 = __builtin_amdgcn_mfma_f32_16x16x32_bf16(fa1[ks & 3], fb[ks & 3], pa1, 0, 0, 0); }
#undef P_LOAD
            { const int i = 16 * it + r, j0 = 16 * jt0 + 4 * q; v2u o;
              o.x = cvtpk(j0 + 0 <= i ? pa0[0] : 0.f, j0 + 1 <= i ? pa0[1] : 0.f); o.y = cvtpk(j0 + 2 <= i ? pa0[2] : 0.f, j0 + 3 <= i ? pa0[3] : 0.f);
              *(LAS v2u*)(lds + OFF_P + i * PS + j0 * 2) = o;
              o.x = cvtpk(j0 + 16 <= i ? pa1[0] : 0.f, j0 + 17 <= i ? pa1[1] : 0.f); o.y = cvtpk(j0 + 18 <= i ? pa1[2] : 0.f, j0 + 19 <= i ? pa1[3] : 0.f);
              *(LAS v2u*)(lds + OFF_P + i * PS + (j0 + 16) * 2) = o; }
            f32x4 Oa[4];
#pragma unroll
            for (int i4 = 0; i4 < 4; ++i4) Oa[i4] = (f32x4){0.f, 0.f, 0.f, 0.f};
            bf16x8 qa[2][4];
#define Q_LOAD(sl, ks) do { _Pragma("unroll") for (int i4 = 0; i4 < 4; ++i4) qa[sl][i4] = cat4(*(const LAS s16x4*)(qperm + i4 * 16 * QS + (ks) * 64), *(const LAS s16x4*)(qperm + i4 * 16 * QS + (ks) * 64 + 32)); } while (0)
            Q_LOAD(0, 0);
#pragma unroll
            for (int ks = 0; ks < 8; ++ks) {
                if (ks + 1 < 8) Q_LOAD((ks + 1) & 1, ks + 1);
                GLA_FENCE();
                v4u bw; bw.x = cvtpk(S[2 * ks][0], S[2 * ks][1]); bw.y = cvtpk(S[2 * ks][2], S[2 * ks][3]); bw.z = cvtpk(S[2 * ks + 1][0], S[2 * ks + 1][1]); bw.w = cvtpk(S[2 * ks + 1][2], S[2 * ks + 1][3]);
                const bf16x8 bfrag = __builtin_bit_cast(bf16x8, bw);
#pragma unroll
                for (int i4 = 0; i4 < 4; ++i4) Oa[i4] = __builtin_amdgcn_mfma_f32_16x16x32_bf16(qa[ks & 1][i4], bfrag, Oa[i4], 0, 0, 0);
            }
#undef Q_LOAD
            GLA_BAR();
            { bf16x8 pf[6];
              pf[0] = *(const LAS bf16x8*)(pnat); pf[1] = *(const LAS bf16x8*)(pnat + 16 * PS); pf[2] = *(const LAS bf16x8*)(pnat + 32 * PS); pf[3] = *(const LAS bf16x8*)(pnat + 32 * PS + 64);
              pf[4] = *(const LAS bf16x8*)(pnat + 48 * PS); pf[5] = *(const LAS bf16x8*)(pnat + 48 * PS + 64);
              Oa[0] = __builtin_amdgcn_mfma_f32_16x16x32_bf16(pf[0], vb[0], Oa[0], 0, 0, 0); Oa[1] = __builtin_amdgcn_mfma_f32_16x16x32_bf16(pf[1], vb[0], Oa[1], 0, 0, 0);
              Oa[2] = __builtin_amdgcn_mfma_f32_16x16x32_bf16(pf[2], vb[0], Oa[2], 0, 0, 0); Oa[2] = __builtin_amdgcn_mfma_f32_16x16x32_bf16(pf[3], vb[1], Oa[2], 0, 0, 0);
              Oa[3] = __builtin_amdgcn_mfma_f32_16x16x32_bf16(pf[4], vb[0], Oa[3], 0, 0, 0); Oa[3] = __builtin_amdgcn_mfma_f32_16x16x32_bf16(pf[5], vb[1], Oa[3], 0, 0, 0); }
            float* op = O + (size_t)(tok0 + 4 * q) * VD + h * DVH + s * 128 + 16 * w + r;
#pragma unroll
            for (int i4 = 0; i4 < 4; ++i4)
#pragma unroll
                for (int g = 0; g < 4; ++g) op[(size_t)(16 * i4 + g) * VD] = Oa[i4][g];
        }
        { bf16x8 ka0[4], ka1[4]; f32x4 gg[4];
#define KV_LOAD(sl, dt) do { ka0[sl] = cat4(trread(ktr + (dt) * 32), trread(ktr + (dt) * 32 + 4 * QS)); ka1[sl] = cat4(trread(ktr + 32 * QS + (dt) * 32), trread(ktr + 32 * QS + (dt) * 32 + 4 * QS)); gg[sl] = *(const LAS f32x4*)(gbase + (dt) * 64); } while (0)
          KV_LOAD(0, 0); KV_LOAD(1, 1); KV_LOAD(2, 2);
#pragma unroll
          for (int dt = 0; dt < 16; ++dt) { if (dt + 3 < 16) KV_LOAD((dt + 3) & 3, dt + 3); GLA_FENCE();
              S[dt] = __builtin_amdgcn_mfma_f32_16x16x32_bf16(ka0[dt & 3], vb[0], S[dt], 0, 0, 0); S[dt] = __builtin_amdgcn_mfma_f32_16x16x32_bf16(ka1[dt & 3], vb[1], S[dt], 0, 0, 0);
              S[dt] = S[dt] * gg[dt & 3]; }
#undef KV_LOAD
        }
        GLA_BAR();
        if (c + 1 < CPP) {
            if (PASS == 1) {
                if ((c & 1) == 0) { write_stage<NQ>(lds, st0, tid); if (c + 3 < CPP) issue_loads<NQ>(st0, QP, KP, VB, BC, tok0 + 3 * CHK, h, s, tid); }
                else { write_stage<NQ>(lds, st1, tid); if (c + 3 < CPP) issue_loads<NQ>(st1, QP, KP, VB, BC, tok0 + 3 * CHK, h, s, tid); }
            } else { write_stage<NQ>(lds, st0, tid); if (c + 2 < CPP) issue_loads<NQ>(st0, QP, KP, VB, BC, tok0 + 2 * CHK, h, s, tid); }
            GLA_BAR();
        }
    }
#undef GLA_FENCE
#undef GLA_BAR
    if (PASS == 1) {
        f32x4* se = SEND + ((((size_t)p * 4 + h) * 4 + s) * 8 + w) * 16 * 64 + lane;
#pragma unroll
        for (int dt = 0; dt < 16; ++dt) se[dt * 64] = S[dt];
        if (s == 0 && tid < 256) { float a = 0.f; for (int c = 0; c < CPP; ++c) a += BC[(size_t)(tokbase + c * CHK + 63) * KD + h * DKH + tid]; GTOT[((size_t)p * 4 + h) * DKH + tid] = expf(a); }
    }
}
}
template <int PASS>
__device__ __forceinline__ void ph_gla(Frame& F) {
    const bf16* QP = (const bf16*)(KWS + WS_QP); const bf16* KP = (const bf16*)(KWS + WS_KP); const bf16* VB = (const bf16*)(KWS + WS_VB);
    const float* BC = (const float*)(KWS + WS_BC); float* O = (float*)(KWS + WS_O); f32x4* SEND = (f32x4*)(KWS + WS_SEND); float* GTOT = (float*)(KWS + WS_GTOT);
    for (int u = blockIdx.x; u < 256; u += F.G) {
        const int idx = u >> 3, s = idx & 3, ph = (u & 7) * 8 + (idx >> 2), p = ph >> 2, h = ph & 3;
        if (PASS == 1 && p == gla::NPART - 1) continue;
        gla::unit<PASS>(F.lds, F.tid, F.lane, F.wave, p, h, s, QP, KP, VB, BC, O, SEND, GTOT);
    }
}

__device__ __forceinline__ void ph_headnorm(Frame& F) {
    const float* O = (const float*)(KWS + WS_O); const bf16* GB = (const bf16*)(KWS + WS_GB); bf16* OG = (bf16*)(KWS + WS_OG); const float* hnw = KIN(5);
    const int gw = blockIdx.x * NWAVES + F.wave, NGW = F.G * NWAVES;
    const f32x4 w0 = ((const f32x4*)hnw)[2 * F.lane], w1 = ((const f32x4*)hnw)[2 * F.lane + 1];
    for (int it = gw; it < T * NHEAD; it += NGW) {
        const size_t off = (size_t)(it >> 2) * VD + (it & 3) * DVH + 8 * F.lane;
        const f32x4 a = *(const f32x4*)(O + off), b = *(const f32x4*)(O + off + 4);
        const float ss = wave_sum((a.x * a.x + a.y * a.y) + (a.z * a.z + a.w * a.w) + (b.x * b.x + b.y * b.y) + (b.z * b.z + b.w * b.w));
        const float rstd = 1.0f / sqrtf(ss * (1.0f / DVH) + EPS);
        const v4u g = *(const v4u*)(GB + off);
        v4u o;
        o.x = pk2(a.x * rstd * w0.x * bflo(g.x), a.y * rstd * w0.y * bfhi(g.x)); o.y = pk2(a.z * rstd * w0.z * bflo(g.y), a.w * rstd * w0.w * bfhi(g.y));
        o.z = pk2(b.x * rstd * w1.x * bflo(g.z), b.y * rstd * w1.y * bfhi(g.z)); o.w = pk2(b.z * rstd * w1.z * bflo(g.w), b.w * rstd * w1.w * bfhi(g.w));
        *(v4u*)(OG + off) = o;
    }
}

__device__ __forceinline__ void ph_router(Frame& F, int layer, const float* H) {
    typedef float f32x4v __attribute__((ext_vector_type(4)));
    const float* WRT = (const float*)(KWS + WS_WRT) + (size_t)layer * NLOG * 2048;
    const float* wn = KIN(10) + layer * D; const float* bg = KIN(12) + layer * NGRP; const float* br = KIN(14) + layer * NE;
    bf16* HN = (bf16*)(KWS + WS_HN);
    int* TKE = (int*)(KWS + WS_TKE); int* TKS = (int*)(KWS + WS_TKS); float* TKG = (float*)(KWS + WS_TKG); int* LIST = (int*)(KWS + WS_LIST);
    unsigned* gcnt = F.ctl + CW_CNT + 64 * layer;
    LAS float* lg = (LAS float*)(F.lds + RING_OFF);
    LAS float* rs = (LAS float*)(F.lds + RING_OFF + 64 * 48 * 4);
    LAS int* sel = (LAS int*)(F.lds + RING_OFF + 64 * 48 * 4 + 256);
    LAS float* selg = (LAS float*)(F.lds + RING_OFF + 64 * 48 * 4 + 256 + 1024);
    volatile LAS int* cntl = F.MISC + MI_CNTL; volatile LAS int* basel = F.MISC + MI_BASEL;
    for (int blk = blockIdx.x; blk < T / 64; blk += F.G) {
        if (F.tid < 32) cntl[F.tid] = 0;
        if (F.wave < 4) {
            const int r = F.lane & 15, q = F.lane >> 4, row = blk * 64 + F.wave * 16 + r;
            const float* hp = H + (size_t)row * D + 4 * q;
            const float* wp0 = WRT + (size_t)r * 2048 + 4 * q; const float* wp1 = wp0 + 16 * 2048; const float* wp2 = wp0 + 32 * 2048;
            f32x4v a0 = {0.f, 0.f, 0.f, 0.f}, a1 = a0, a2 = a0; float ss = 0.f;
#pragma unroll 4
            for (int k0 = 0; k0 < D; k0 += 16) {
                const f32x4 a = *(const f32x4*)(hp + k0), b0 = *(const f32x4*)(wp0 + k0), b1 = *(const f32x4*)(wp1 + k0), b2 = *(const f32x4*)(wp2 + k0);
                ss += (a.x * a.x + a.y * a.y) + (a.z * a.z + a.w * a.w);
#pragma unroll
                for (int s = 0; s < 4; ++s) { a0 = __builtin_amdgcn_mfma_f32_16x16x4f32(a[s], b0[s], a0, 0, 0, 0); a1 = __builtin_amdgcn_mfma_f32_16x16x4f32(a[s], b1[s], a1, 0, 0, 0); a2 = __builtin_amdgcn_mfma_f32_16x16x4f32(a[s], b2[s], a2, 0, 0, 0); }
            }
            ss += __shfl_xor(ss, 16); ss += __shfl_xor(ss, 32);
            const float rstd = 1.0f / sqrtf(ss * (1.0f / D) + EPS);
            if (q == 0) rs[F.wave * 16 + r] = rstd;
#pragma unroll
            for (int j = 0; j < 4; ++j) { const int rl = F.wave * 16 + 4 * q + j; lg[rl * 48 + r] = a0[j]; lg[rl * 48 + 16 + r] = a1[j]; lg[rl * 48 + 32 + r] = a2[j]; }
        }
        __syncthreads();
        if (F.tid < 64) {
            const int rl = F.tid; const float rstd = rs[rl]; const LAS float* L = lg + rl * 48;
            float gl0 = L[0] * rstd + bg[0]; int g = 0; float gv[4]; gv[0] = gl0;
#pragma unroll
            for (int j = 1; j < 4; ++j) { gv[j] = L[j] * rstd + bg[j]; if (gv[j] > gl0) { gl0 = gv[j]; g = j; } }
            float den = 0.f;
#pragma unroll
            for (int j = 0; j < 4; ++j) den += expf(gv[j] - gl0);
            const float gp = 1.0f / den;
            float l1 = -3.0e38f, l2 = -3.0e38f; int e1 = 0, e2 = 0;
            for (int j = 0; j < 8; ++j) { const float v = L[4 + 8 * g + j] * rstd + br[8 * g + j];
                if (v > l1) { l2 = l1; e2 = e1; l1 = v; e1 = j; } else if (v > l2) { l2 = v; e2 = j; } }
            const float ex = expf(l2 - l1), p1 = 1.0f / (1.0f + ex), p2 = ex * p1;
            const int E0 = 8 * g + e1, E1 = 8 * g + e2;
            sel[rl * 4 + 0] = E0; sel[rl * 4 + 1] = E1;
            sel[rl * 4 + 2] = __hip_atomic_fetch_add((LAS int*)&cntl[E0], 1, __ATOMIC_RELAXED, __HIP_MEMORY_SCOPE_WORKGROUP); sel[rl * 4 + 3] = __hip_atomic_fetch_add((LAS int*)&cntl[E1], 1, __ATOMIC_RELAXED, __HIP_MEMORY_SCOPE_WORKGROUP);
            selg[rl * 2 + 0] = gp * p1; selg[rl * 2 + 1] = gp * p2;
        }
        __syncthreads();
        if (F.tid < 32) basel[F.tid] = (int)__hip_atomic_fetch_add(gcnt + F.tid, (unsigned)cntl[F.tid], RLX_AGENT);
        __syncthreads();
        if (F.tid < 128) {
            const int rl = F.tid >> 1, k = F.tid & 1, tk = (blk * 64 + rl) * 2 + k, e = sel[rl * 4 + k], slot = basel[e] + sel[rl * 4 + 2 + k];
            TKE[tk] = e; TKS[tk] = slot; TKG[tk] = selg[rl * 2 + k]; LIST[e * T + slot] = tk;
        }
        for (int rr = 0; rr < 8; ++rr) {
            const int rl = F.wave * 8 + rr, row = blk * 64 + rl; const float rstd = rs[rl];
            const f32x4* xr = (const f32x4*)(H + (size_t)row * D) + F.lane; v2u* o8 = (v2u*)(HN + (size_t)row * D) + F.lane;
#pragma unroll
            for (int j = 0; j < 8; ++j) { const f32x4 v = xr[64 * j] * rstd * ((const f32x4*)wn)[F.lane + 64 * j]; v2u o; o.x = pk2(v.x, v.y); o.y = pk2(v.z, v.w); o8[64 * j] = o; }
        }
        __syncthreads();
    }
}

__device__ __forceinline__ void moe_meta(Frame& F, int layer) {
    __syncthreads();
    if (F.tid == 0) {
        const unsigned* gcnt = F.ctl + CW_CNT + 64 * layer; int p = 0, nt = 0;
        for (int e = 0; e < NE; ++e) { const int c = (int)__hip_atomic_load(gcnt + e, RLX_AGENT); F.MISC[MI_PSTART + e] = p; const int tl = (c + 255) >> 8;
            F.MISC[MI_ECNT + e] = c;
            for (int j = 0; j < tl; ++j) { F.MISC[MI_TEXP + nt + j] = e; F.MISC[MI_TSLOT + nt + j] = 256 * j; } nt += tl; p += tl * 256; }
        F.MISC[MI_PSTART + NE] = p; F.MISC[MI_NRT] = nt;
    }
    __syncthreads();
}

template <bool FINAL>
__device__ __forceinline__ void ph_combine(Frame& F, const float* H, float* Hout, const float* wn) {
    const bf16* Y = (const bf16*)(KWS + WS_Y); const int* TKE = (const int*)(KWS + WS_TKE); const int* TKS = (const int*)(KWS + WS_TKS); const float* TKG = (const float*)(KWS + WS_TKG); bf16* HN = (bf16*)(KWS + WS_HN);
    const int gw = blockIdx.x * NWAVES + F.wave, NGW = F.G * NWAVES;
    for (int t = gw; t < T; t += NGW) {
        const int r0 = F.MISC[MI_PSTART + TKE[2 * t]] + TKS[2 * t], r1 = F.MISC[MI_PSTART + TKE[2 * t + 1]] + TKS[2 * t + 1]; const float g0 = TKG[2 * t], g1 = TKG[2 * t + 1];
        const f32x4* hr = (const f32x4*)(H + (size_t)t * D) + F.lane;
        const v2u* y0 = (const v2u*)(Y + (size_t)r0 * D) + F.lane; const v2u* y1 = (const v2u*)(Y + (size_t)r1 * D) + F.lane;
        f32x4 v[8]; float s = 0.f;
#pragma unroll
        for (int j = 0; j < 8; ++j) { const v2u a = y0[64 * j], b = y1[64 * j]; f32x4 h = hr[64 * j];
            h.x += g0 * bflo(a.x) + g1 * bflo(b.x); h.y += g0 * bfhi(a.x) + g1 * bfhi(b.x); h.z += g0 * bflo(a.y) + g1 * bflo(b.y); h.w += g0 * bfhi(a.y) + g1 * bfhi(b.y);
            v[j] = h; s += (h.x * h.x + h.y * h.y) + (h.z * h.z + h.w * h.w); }
        const float rstd = 1.0f / sqrtf(wave_sum(s) * (1.0f / D) + EPS);
        if (FINAL) {
            f32x4* o = (f32x4*)(KOUT + (size_t)t * D) + F.lane;
#pragma unroll
            for (int j = 0; j < 8; ++j) o[64 * j] = v[j] * rstd * ((const f32x4*)wn)[F.lane + 64 * j];
        } else {
            f32x4* ho = (f32x4*)(Hout + (size_t)t * D) + F.lane; v2u* o8 = (v2u*)(HN + (size_t)t * D) + F.lane;
#pragma unroll
            for (int j = 0; j < 8; ++j) { ho[64 * j] = v[j]; const f32x4 w = v[j] * rstd * ((const f32x4*)wn)[F.lane + 64 * j]; v2u o; o.x = pk2(w.x, w.y); o.y = pk2(w.z, w.w); o8[64 * j] = o; }
        }
    }
}

__device__ __forceinline__ void ph_conv(Frame& F) {
    const bf16* BG = (const bf16*)(KWS + WS_VB); const bf16* U = (const bf16*)(KWS + WS_GB); bf16* OG = (bf16*)(KWS + WS_OG); const float* cw = KIN(8);
    const size_t n8 = (size_t)T * D / 8;
    for (size_t i = (size_t)blockIdx.x * 512 + F.tid; i < n8; i += (size_t)F.G * 512) {
        const int t = (int)(i >> 8), c = (int)(i & 255) * 8; const size_t off = (size_t)t * D + c;
        const v4u u0 = *(const v4u*)(U + off); const v4u zero = {0u, 0u, 0u, 0u};
        const v4u u1 = t >= 1 ? *(const v4u*)(U + off - D) : zero; const v4u u2 = t >= 2 ? *(const v4u*)(U + off - 2 * D) : zero;
        const v4u b = *(const v4u*)(BG + off);
        const f32x4 wa0 = *(const f32x4*)(cw + c), wa1 = *(const f32x4*)(cw + c + 4), wb0 = *(const f32x4*)(cw + D + c), wb1 = *(const f32x4*)(cw + D + c + 4), wc0 = *(const f32x4*)(cw + 2 * D + c), wc1 = *(const f32x4*)(cw + 2 * D + c + 4);
        v4u o;
        o.x = pk2(bflo(b.x) * (wa0.x * bflo(u2.x) + wb0.x * bflo(u1.x) + wc0.x * bflo(u0.x)), bfhi(b.x) * (wa0.y * bfhi(u2.x) + wb0.y * bfhi(u1.x) + wc0.y * bfhi(u0.x)));
        o.y = pk2(bflo(b.y) * (wa0.z * bflo(u2.y) + wb0.z * bflo(u1.y) + wc0.z * bflo(u0.y)), bfhi(b.y) * (wa0.w * bfhi(u2.y) + wb0.w * bfhi(u1.y) + wc0.w * bfhi(u0.y)));
        o.z = pk2(bflo(b.z) * (wa1.x * bflo(u2.z) + wb1.x * bflo(u1.z) + wc1.x * bflo(u0.z)), bfhi(b.z) * (wa1.y * bfhi(u2.z) + wb1.y * bfhi(u1.z) + wc1.y * bfhi(u0.z)));
        o.w = pk2(bflo(b.w) * (wa1.z * bflo(u2.w) + wb1.z * bflo(u1.w) + wc1.z * bflo(u0.w)), bfhi(b.w) * (wa1.w * bfhi(u2.w) + wb1.w * bfhi(u1.w) + wc1.w * bfhi(u0.w)));
        *(v4u*)(OG + off) = o;
    }
}

#ifndef PH_MASK
#define PH_MASK 0xFFFFFFFFu
#endif
#define IN(k) (((PH_MASK >> (k)) & 1u) && lo <= (k) && (k) < hi)
#define BOTH(k) (IN(k) && IN((k) + 1))
#ifndef DUP_MASK
#define DUP_MASK 0u
#endif
#define NREP(k) ((((unsigned)DUP_MASK >> (k)) & 1u) ? 2 : 1)
#define GRID_BAR() do { if (N_LAUNCHES == 1) xcd_barrier(bar); } while (0)
template <int LAYER>
__device__ __forceinline__ void moe_block(Frame& F, const int lo, const int hi, const XcdBarrier& bar) {
    constexpr int pb = LAYER ? 13 : 6;
    float* H1 = (float*)(KWS + WS_H1); float* H2 = (float*)(KWS + WS_H2);
    if (IN(pb + 0)) { ph_router(F, LAYER, H1); if (BOTH(pb + 0)) GRID_BAR(); }
    if (IN(pb + 1)) {
        moe_meta(F, LAYER);
        const int nrt = F.MISC[MI_NRT];
        pg8::Gemm g{(const bf16*)(KWS + WS_HN), (const bf16*)(KWS + WS_WGU) + (size_t)LAYER * NE * 1024 * 2048, nrt * 256, 1024, D};
        pg8::MoeOrder<true> S{nrt, 4, nrt * 4, F.G, (int)blockIdx.x, (size_t)1024 * 2048 * 2, (const volatile LAS int*)F.MISC, (const int*)(KWS + WS_LIST)};
        pg8::EpiGateUp E{(bf16*)(KWS + WS_ACT)};
        for (int rep = 0; rep < NREP(pb + 1); ++rep) { pg8::gemm_phase<pg8::EpiGateUp, pg8::MoeOrder<true>, true>(F.lds + RING_OFF, g, S, E); if (rep + 1 < NREP(pb + 1)) GRID_BAR(); }
        if (BOTH(pb + 1)) GRID_BAR();
    }
    if (IN(pb + 2)) {
        moe_meta(F, LAYER);
        const int nrt = F.MISC[MI_NRT];
        pg8::Gemm g{(const bf16*)(KWS + WS_ACT), (const bf16*)(KWS + WS_WDN) + (size_t)LAYER * NE * 2048 * 512, nrt * 256, 2048, FF};
        pg8::MoeOrder<false> S{nrt, 8, nrt * 8, F.G, (int)blockIdx.x, (size_t)2048 * 512 * 2, (const volatile LAS int*)F.MISC, (const int*)(KWS + WS_LIST)};
        pg8::EpiDown E{(bf16*)(KWS + WS_Y)};
        for (int rep = 0; rep < NREP(pb + 2); ++rep) { pg8::gemm_phase<pg8::EpiDown, pg8::MoeOrder<false>, true>(F.lds + RING_OFF, g, S, E); if (rep + 1 < NREP(pb + 2)) GRID_BAR(); }
        if (BOTH(pb + 2)) GRID_BAR();
    }
    if (IN(pb + 3)) {
        moe_meta(F, LAYER);
        if (LAYER == 0) { for (int rep = 0; rep < NREP(pb + 3); ++rep) { ph_combine<false>(F, H1, H2, KIN(1) + D); if (rep + 1 < NREP(pb + 3)) GRID_BAR(); } if (BOTH(pb + 3)) GRID_BAR(); }
        else for (int rep = 0; rep < NREP(pb + 3); ++rep) { ph_combine<true>(F, H1, nullptr, KIN(17)); if (rep + 1 < NREP(pb + 3)) GRID_BAR(); }
    }
}

struct Args { const float* in[18]; float* out; unsigned char* ws; int ph_lo, ph_hi, li, pad; };
__global__ void __launch_bounds__(NWAVES * 64, 2) mega_fwd(Args args) {
    extern __shared__ __attribute__((aligned(16))) unsigned char lds[];
    Frame F;
    F.lds = (LAS unsigned char*)lds;
    F.MISC = (volatile LAS int*)(F.lds + MISC_OFF);
    F.tid = threadIdx.x; F.lane = F.tid & 63; F.wave = __builtin_amdgcn_readfirstlane(F.tid >> 6);
    F.G = gridDim.x;
    F.ka = (__attribute__((address_space(4))) const unsigned char*)__builtin_amdgcn_kernarg_segment_ptr();
    F.ctl = (unsigned*)(args.ws + WS_CTL);
    for (int u = F.tid; u < MISC_BYTES / 4; u += NWAVES * 64) F.MISC[u] = 0;
    __syncthreads();
    XcdBarrier bar; bar.bar = F.ctl + CW_BAR; bar.x = 0; bar.st = nullptr;
    if (N_LAUNCHES == 1) bar = xcd_barrier_post(F.ctl + CW_BAR, (volatile LAS unsigned*)(F.MISC + 8));
    const int lo = args.ph_lo, hi = args.ph_hi;
    bf16* HN = (bf16*)(KWS + WS_HN); float* H1 = (float*)(KWS + WS_H1); float* H2 = (float*)(KWS + WS_H2);

    if (IN(0)) { for (int rep = 0; rep < NREP(0); ++rep) { p0_convert(F); __syncthreads(); if (rep + 1 < NREP(0)) GRID_BAR(); } for (int rep = 0; rep < NREP(17); ++rep) { p0_norm_gl(F); if (rep + 1 < NREP(17)) GRID_BAR(); } if (BOTH(0)) GRID_BAR(); }
    if (IN(1)) {
        pg8::Gemm g{HN, (const bf16*)(KWS + WS_WGI), T, GINM, D}; pg8::StaticOrder S; S.init(T, GINM, F.G, (int)blockIdx.x);
        pg8::EpiGlaIn E{(bf16*)(KWS + WS_QP), (bf16*)(KWS + WS_KP), (bf16*)(KWS + WS_VB), (bf16*)(KWS + WS_GB), (const float*)(KWS + WS_BC)};
        for (int rep = 0; rep < NREP(1); ++rep) { pg8::gemm_phase<pg8::EpiGlaIn, pg8::StaticOrder, true>(F.lds + RING_OFF, g, S, E); if (rep + 1 < NREP(1)) GRID_BAR(); }
        if (BOTH(1)) GRID_BAR();
    }
#ifdef GLA_NAIVE
    if (IN(2)) { if (BOTH(2)) GRID_BAR(); }
    if (IN(3)) { ph_gla_naive(F); if (BOTH(3)) GRID_BAR(); }
#else
    if (IN(2)) { for (int rep = 0; rep < NREP(2); ++rep) { ph_gla<1>(F); if (rep + 1 < NREP(2)) GRID_BAR(); } if (BOTH(2)) GRID_BAR(); }
    if (IN(3)) { for (int rep = 0; rep < NREP(3); ++rep) { ph_gla<2>(F); if (rep + 1 < NREP(3)) GRID_BAR(); } if (BOTH(3)) GRID_BAR(); }
#endif
    if (IN(4)) { for (int rep = 0; rep < NREP(4); ++rep) { ph_headnorm(F); if (rep + 1 < NREP(4)) GRID_BAR(); } if (BOTH(4)) GRID_BAR(); }
    if (IN(5)) {
        pg8::Gemm g{(const bf16*)(KWS + WS_OG), (const bf16*)(KWS + WS_WGO), T, D, D}; pg8::StaticOrder S; S.init(T, D, F.G, (int)blockIdx.x);
        pg8::EpiRes E{KIN(0), H1, D};
        for (int rep = 0; rep < NREP(5); ++rep) { pg8::gemm_phase<pg8::EpiRes, pg8::StaticOrder, true>(F.lds + RING_OFF, g, S, E); if (rep + 1 < NREP(5)) GRID_BAR(); }
        if (BOTH(5)) GRID_BAR();
    }
    moe_block<0>(F, lo, hi, bar);
    if (IN(10)) {
        pg8::Gemm g{HN, (const bf16*)(KWS + WS_WCI), T, 6144, D}; pg8::StaticOrder S; S.init(T, 6144, F.G, (int)blockIdx.x);
        pg8::EpiConvIn E{(bf16*)(KWS + WS_VB), (bf16*)(KWS + WS_GB)};
        for (int rep = 0; rep < NREP(10); ++rep) { pg8::gemm_phase<pg8::EpiConvIn, pg8::StaticOrder, true>(F.lds + RING_OFF, g, S, E); if (rep + 1 < NREP(10)) GRID_BAR(); }
        if (BOTH(10)) GRID_BAR();
    }
    if (IN(11)) { for (int rep = 0; rep < NREP(11); ++rep) { ph_conv(F); if (rep + 1 < NREP(11)) GRID_BAR(); } if (BOTH(11)) GRID_BAR(); }
    if (IN(12)) {
        pg8::Gemm g{(const bf16*)(KWS + WS_OG), (const bf16*)(KWS + WS_WCO), T, D, D}; pg8::StaticOrder S; S.init(T, D, F.G, (int)blockIdx.x);
        pg8::EpiRes E{H2, H1, D};
        for (int rep = 0; rep < NREP(12); ++rep) { pg8::gemm_phase<pg8::EpiRes, pg8::StaticOrder, true>(F.lds + RING_OFF, g, S, E); if (rep + 1 < NREP(12)) GRID_BAR(); }
        if (BOTH(12)) GRID_BAR();
    }
    moe_block<1>(F, lo, hi, bar);
#undef IN
#undef BOTH
#undef GRID_BAR
}

extern "C" void kernel_launch(void* const* d_in, const int* in_sizes, int n_in, void* d_out, int out_size, void* d_ws, size_t ws_size, hipStream_t stream) {
    static int grid = 0;
    if (grid == 0) {
        if (n_in != 18 || in_sizes[0] != T * D || out_size != T * D || ws_size < WS_END) { fprintf(stderr, "kernel_launch: unexpected shapes (n_in %d, in0 %d, out %d, ws %zu)\n", n_in, n_in > 0 ? in_sizes[0] : -1, out_size, ws_size); grid = -1; return; }
        int dev = 0, cus = 0, per_cu = 0;
        if (hipGetDevice(&dev) != hipSuccess || hipDeviceGetAttribute(&cus, hipDeviceAttributeMultiprocessorCount, dev) != hipSuccess) { grid = -1; return; }
        if (hipFuncSetAttribute((const void*)mega_fwd, hipFuncAttributeMaxDynamicSharedMemorySize, LDS_BYTES) != hipSuccess) { fprintf(stderr, "kernel_launch: hipFuncSetAttribute failed\n"); grid = -1; return; }
        if (hipOccupancyMaxActiveBlocksPerMultiprocessor(&per_cu, (const void*)mega_fwd, NWAVES * 64, LDS_BYTES) != hipSuccess || per_cu < 1) { fprintf(stderr, "kernel_launch: occupancy query reports %d\n", per_cu); }
        (void)hipGetLastError();
        grid = cus;
    }
    if (grid < 0) return;
    if (hipMemsetAsync((char*)d_ws + WS_CTL, 0, CTL_ZERO_BYTES, stream) != hipSuccess) return;
    Args a{};
    for (int i = 0; i < 18; ++i) a.in[i] = (const float*)d_in[i];
    a.out = (float*)d_out; a.ws = (unsigned char*)d_ws;
    for (int li = 0; li < N_LAUNCHES; ++li) {
        a.ph_lo = (N_LAUNCHES == 1) ? 0 : li; a.ph_hi = (N_LAUNCHES == 1) ? NPH : li + 1; a.li = li; a.pad = 0;
        hipLaunchKernelGGL(mega_fwd, dim3(grid), dim3(NWAVES * 64), LDS_BYTES, stream, a);
        const hipError_t le = hipPeekAtLastError();
        if (le != hipSuccess) { fprintf(stderr, "kernel_launch: launch %d failed: %s\n", li, hipGetErrorName(le)); break; }
    }
}
```

```cpp
#include <hip/hip_runtime.h>
#include <cstdio>
#include <cstdint>

#ifndef MK_N_LAUNCHES
#define MK_N_LAUNCHES 1
#endif

namespace pg8 {
#define PG8_LAS __attribute__((address_space(3)))
typedef unsigned short bf16_t;
typedef short bf16x8 __attribute__((ext_vector_type(8)));
typedef float f32x4 __attribute__((ext_vector_type(4)));
typedef unsigned u32x4 __attribute__((ext_vector_type(4)));
constexpr int BM = 256, BK = 64, HALF = 128, HTB = HALF * BK * 2, STAGE_BYTES = 8 * HTB, NXCD = 8, WGM = 8;

__host__ __device__ __forceinline__ int lds_byte(int r, int c) { const int st = (r >> 4) * 2 + (c >> 5), rr = r & 15, cc = c & 31, ob = rr * 64 + cc * 2; return st * 1024 + (ob ^ (((ob >> 9) & 1) << 5)); }
__host__ __device__ __forceinline__ void stage_rc(int b, int& R, int& C) { const int st = b / 1024, sb = b % 1024, swz = sb ^ (((sb >> 9) & 1) << 5); R = (st >> 1) * 16 + swz / 64; C = (st & 1) * 32 + (swz % 64) / 2; }
__host__ __device__ __forceinline__ int perm32(int rho) { const int n = rho >> 4, i = rho & 15; return 8 * (i >> 2) + 4 * n + (i & 3); }

struct Unit { int pm, pn; size_t boff; int e, s0, cnt; };
struct Gemm { const bf16_t* A; const bf16_t* Bt; int M, N, K; };

struct StaticOrder {
    static constexpr bool GATHER = false;
    int nM, nN, nwg, G, c;
    __host__ __device__ void init(int M, int N, int G_, int c_) { nM = M / BM; nN = N / BM; nwg = nM * nN; G = G_; c = c_; }
    __host__ __device__ bool next(int i, Unit& u) const {
        const long L = (long)i * G + c; if (L >= nwg) return false;
        int wgid = (int)L; { const int q = nwg / NXCD, r = nwg % NXCD, xcd = wgid % NXCD, off = wgid / NXCD; wgid = (xcd < r ? xcd * (q + 1) : r * (q + 1) + (xcd - r) * q) + off; }
        const int nig = WGM * nN, gid = wgid / nig, fm = gid * WGM, gsz = (nM - fm) < WGM ? (nM - fm) : WGM;
        u.pm = fm + ((wgid % nig) % gsz); u.pn = (wgid % nig) / gsz; u.boff = 0; u.e = 0; u.s0 = 0; u.cnt = 0; return true;
    }
    __device__ __forceinline__ int arow(const Unit& u, int r) const { return u.pm * BM + r; }
    __device__ __forceinline__ void a_ready(const Unit&) const {}
    __device__ __forceinline__ void done(const Unit&) const {}
};
template <bool GATHER_>
struct MoeOrder {
    static constexpr bool GATHER = GATHER_;
    int nrt, NT, nwg, G, c; size_t estride; const volatile PG8_LAS int* misc; const int* list;
    __device__ __forceinline__ bool next(int i, Unit& u) const {
        const long L = (long)i * G + c; if (L >= nwg) return false;
        int wgid = (int)L; { const int q = nwg / NXCD, r = nwg % NXCD, xcd = wgid % NXCD, off = wgid / NXCD; wgid = (xcd < r ? xcd * (q + 1) : r * (q + 1) + (xcd - r) * q) + off; }
        u.pm = wgid / NT; u.pn = wgid % NT;
        u.e = __builtin_amdgcn_readfirstlane(misc[64 + u.pm]); u.s0 = __builtin_amdgcn_readfirstlane(misc[320 + u.pm]); u.cnt = __builtin_amdgcn_readfirstlane(misc[480 + u.e]);
        u.boff = (size_t)u.e * estride; return true;
    }
    __device__ __forceinline__ int arow(const Unit& u, int r) const { if (!GATHER_) return u.pm * BM + r; const int slot = u.s0 + r; const int tk = slot < u.cnt ? list[u.e * 16384 + slot] : 0; return tk >> 1; }
    __device__ __forceinline__ void a_ready(const Unit&) const {}
    __device__ __forceinline__ void done(const Unit&) const {}
};

__device__ __forceinline__ unsigned cvt_pk_bf16(float lo, float hi) { unsigned r; asm volatile("v_cvt_pk_bf16_f32 %0, %1, %2" : "=v"(r) : "v"(lo), "v"(hi)); return r; }
__device__ __forceinline__ u32x4 pack8(const f32x4& v0, const f32x4& v1) { u32x4 w; w.x = cvt_pk_bf16(v0[0], v0[1]); w.y = cvt_pk_bf16(v0[2], v0[3]); w.z = cvt_pk_bf16(v1[0], v1[1]); w.w = cvt_pk_bf16(v1[2], v1[3]); return w; }
__device__ __forceinline__ float fexp(float x) { return __builtin_amdgcn_exp2f(x * 1.44269504089f); }
__device__ __forceinline__ float silu_f(float x) { return x * __builtin_amdgcn_rcpf(1.0f + fexp(-x)); }

struct EpiRes {
    static constexpr bool PERM = false, AFTER_DRAIN = false;
    const float* base; float* out; int ldc;
    __device__ __forceinline__ void operator()(const f32x4 (&acc)[2][2][4][2], const Unit& u, int wr, int wc, int fr, int fq) const {
        const int row0 = u.pm * BM + wr * 64 + fr, col0 = u.pn * BM + wc * 32 + 4 * fq;
#pragma unroll
        for (int ai = 0; ai < 2; ++ai)
#pragma unroll
            for (int m = 0; m < 4; ++m) { const size_t off = (size_t)(row0 + ai * HALF + m * 16) * ldc + col0;
#pragma unroll
                for (int bj = 0; bj < 2; ++bj)
#pragma unroll
                    for (int n = 0; n < 2; ++n) { const f32x4 bs = *(const f32x4*)(base + off + bj * HALF + n * 16); *(f32x4*)(out + off + bj * HALF + n * 16) = bs + acc[ai][bj][m][n]; } }
    }
};
struct EpiGlaIn {
    static constexpr bool PERM = true, AFTER_DRAIN = false;
    bf16_t *Qp, *Kp, *Vb, *Gb; const float* Bc;
    __device__ __forceinline__ void operator()(const f32x4 (&acc)[2][2][4][2], const Unit& u, int wr, int wc, int fr, int fq) const {
        const int row0 = u.pm * BM + wr * 64 + fr, cl = wc * 32 + 8 * fq, ct = u.pn;
        if (ct < 8) {
            const bool isq = ct < 4; const int cb = (ct & 3) * 256 + cl; bf16_t* dst = isq ? Qp : Kp; const float sgn = isq ? 1.0f : -1.0f, mul = isq ? 0.0625f : 1.0f;
#pragma unroll
            for (int ai = 0; ai < 2; ++ai)
#pragma unroll
                for (int m = 0; m < 4; ++m) { const size_t ro = (size_t)(row0 + ai * HALF + m * 16) * 1024;
#pragma unroll
                    for (int bj = 0; bj < 2; ++bj) { const int c = cb + bj * HALF; const f32x4 b0 = *(const f32x4*)(Bc + ro + c), b1 = *(const f32x4*)(Bc + ro + c + 4);
                        f32x4 v0 = acc[ai][bj][m][0], v1 = acc[ai][bj][m][1];
#pragma unroll
                        for (int j = 0; j < 4; ++j) { v0[j] *= fexp(sgn * b0[j]) * mul; v1[j] *= fexp(sgn * b1[j]) * mul; }
                        *(u32x4*)(dst + ro + c) = pack8(v0, v1); } }
        } else if (ct < 16) {
            const int cb = (ct - 8) * 256 + cl;
#pragma unroll
            for (int ai = 0; ai < 2; ++ai)
#pragma unroll
                for (int m = 0; m < 4; ++m) { const size_t ro = (size_t)(row0 + ai * HALF + m * 16) * 2048;
#pragma unroll
                    for (int bj = 0; bj < 2; ++bj) *(u32x4*)(Vb + ro + cb + bj * HALF) = pack8(acc[ai][bj][m][0], acc[ai][bj][m][1]); }
        } else {
            const int cb = (ct - 16) * 256 + cl;
#pragma unroll
            for (int ai = 0; ai < 2; ++ai)
#pragma unroll
                for (int m = 0; m < 4; ++m) { const size_t ro = (size_t)(row0 + ai * HALF + m * 16) * 2048;
#pragma unroll
                    for (int bj = 0; bj < 2; ++bj) { f32x4 v0 = acc[ai][bj][m][0], v1 = acc[ai][bj][m][1];
#pragma unroll
                        for (int j = 0; j < 4; ++j) { v0[j] = silu_f(v0[j]); v1[j] = silu_f(v1[j]); }
                        *(u32x4*)(Gb + ro + cb + bj * HALF) = pack8(v0, v1); } }
        }
    }
};
struct EpiConvIn {
    static constexpr bool PERM = true, AFTER_DRAIN = false;
    bf16_t *BG, *U;
    __device__ __forceinline__ void operator()(const f32x4 (&acc)[2][2][4][2], const Unit& u, int wr, int wc, int fr, int fq) const {
        const int row0 = u.pm * BM + wr * 64 + fr, cl = wc * 32 + 8 * fq, ct = u.pn;
        if (ct < 8) {
            const int cb = ct * 256 + cl;
#pragma unroll
            for (int ai = 0; ai < 2; ++ai)
#pragma unroll
                for (int m = 0; m < 4; ++m) { const size_t ro = (size_t)(row0 + ai * HALF + m * 16) * 2048;
#pragma unroll
                    for (int bj = 0; bj < 2; ++bj) *(u32x4*)(BG + ro + cb + bj * HALF) = pack8(acc[ai][bj][m][0], acc[ai][bj][m][1]); }
        } else {
            const int cb = (ct - 8) * 128 + cl;
#pragma unroll
            for (int ai = 0; ai < 2; ++ai)
#pragma unroll
                for (int m = 0; m < 4; ++m) { const size_t ro = (size_t)(row0 + ai * HALF + m * 16) * 2048;
                    *(u32x4*)(U + ro + cb) = pack8(acc[ai][0][m][0] * acc[ai][1][m][0], acc[ai][0][m][1] * acc[ai][1][m][1]); }
        }
    }
};
struct EpiGateUp {
    static constexpr bool PERM = true, AFTER_DRAIN = false;
    bf16_t* ACT;
    __device__ __forceinline__ void operator()(const f32x4 (&acc)[2][2][4][2], const Unit& u, int wr, int wc, int fr, int fq) const {
        const int row0 = u.pm * BM + wr * 64 + fr, cb = u.pn * 128 + wc * 32 + 8 * fq;
#pragma unroll
        for (int ai = 0; ai < 2; ++ai)
#pragma unroll
            for (int m = 0; m < 4; ++m) { const size_t ro = (size_t)(row0 + ai * HALF + m * 16) * 512;
                f32x4 v0 = acc[ai][0][m][0], v1 = acc[ai][0][m][1];
#pragma unroll
                for (int j = 0; j < 4; ++j) { v0[j] = silu_f(v0[j]) * acc[ai][1][m][0][j]; v1[j] = silu_f(v1[j]) * acc[ai][1][m][1][j]; }
                *(u32x4*)(ACT + ro + cb) = pack8(v0, v1); }
    }
};
struct EpiDown {
    static constexpr bool PERM = true, AFTER_DRAIN = false;
    bf16_t* Y;
    __device__ __forceinline__ void operator()(const f32x4 (&acc)[2][2][4][2], const Unit& u, int wr, int wc, int fr, int fq) const {
        const int row0 = u.pm * BM + wr * 64 + fr, cb = u.pn * 256 + wc * 32 + 8 * fq;
#pragma unroll
        for (int ai = 0; ai < 2; ++ai)
#pragma unroll
            for (int m = 0; m < 4; ++m) { const size_t ro = (size_t)(row0 + ai * HALF + m * 16) * 2048;
#pragma unroll
                for (int bj = 0; bj < 2; ++bj) *(u32x4*)(Y + ro + cb + bj * HALF) = pack8(acc[ai][bj][m][0], acc[ai][bj][m][1]); }
    }
};

template <class Epi, class Sched, bool ALIGN_EPI = false>
__device__ __forceinline__ void gemm_phase(PG8_LAS unsigned char* lds, const Gemm g, const Sched& S, const Epi& E) {
    const int tid = threadIdx.x, wid = __builtin_amdgcn_readfirstlane(tid >> 6), lane = tid & 63, wr = wid >> 2, wc = wid & 3, fr = lane & 15, fq = lane >> 4;
    const int K = g.K, nt = K / BK;
    unsigned voffA[2], voffB[2]; int RA[2], CA[2];
#pragma unroll
    for (int i = 0; i < 2; ++i) { int R, C; stage_rc(tid * 16 + i * 8192, R, C); const int Rb = Epi::PERM ? ((R & ~31) + perm32(R & 31)) : R; RA[i] = R; CA[i] = C;
        voffA[i] = (unsigned)(R * K + C) * 2u; voffB[i] = (unsigned)(Rb * K + C) * 2u; }
    const size_t kstep = (size_t)(BK * 2);
    const size_t hstep = (size_t)HALF * K * 2;
    const size_t tstep = 2 * hstep;
    const size_t hstepA = Sched::GATHER ? 0 : hstep;
    const unsigned ldsw = (unsigned)wid * 1024u;
    const int aoff = lds_byte(wr * 64 + fr, fq * 8), boff = lds_byte(wc * 32 + fr, fq * 8);
#define PG8_SA(b, h) (((b) * 2 + (h)) * HTB)
#define PG8_SB(b, h) ((4 + (b) * 2 + (h)) * HTB)
#define PG8_STAGE(bufoff, gbase, voff) do { _Pragma("unroll") for (int _i = 0; _i < 2; ++_i) \
        __builtin_amdgcn_global_load_lds((const unsigned*)((const char*)(gbase) + (voff)[_i]), (PG8_LAS unsigned*)(lds + (bufoff) + ldsw + _i * 8192), 16, 0, 0); } while (0)
#define PG8_LDA(dst, b, h) do { _Pragma("unroll") for (int m = 0; m < 4; ++m) _Pragma("unroll") for (int k = 0; k < 2; ++k) dst[m][k] = *(const PG8_LAS bf16x8*)(lds + PG8_SA(b, h) + aoff + m * 2048 + k * 1024); } while (0)
#define PG8_LDB(dst, b, h) do { _Pragma("unroll") for (int n = 0; n < 2; ++n) _Pragma("unroll") for (int k = 0; k < 2; ++k) dst[n][k] = *(const PG8_LAS bf16x8*)(lds + PG8_SB(b, h) + boff + n * 2048 + k * 1024); } while (0)
#define PG8_MMA(ai, bj, At, Bt) do { __builtin_amdgcn_s_setprio(1); _Pragma("unroll") for (int m = 0; m < 4; ++m) _Pragma("unroll") for (int n = 0; n < 2; ++n) _Pragma("unroll") for (int k = 0; k < 2; ++k) \
        acc[ai][bj][m][n] = __builtin_amdgcn_mfma_f32_16x16x32_bf16(Bt[n][k], At[m][k], acc[ai][bj][m][n], 0, 0, 0); __builtin_amdgcn_s_setprio(0); } while (0)
#define PG8_WAIT_V(n) asm volatile("s_waitcnt vmcnt(" #n ")" ::: "memory")
#define PG8_WAIT_L(n) asm volatile("s_waitcnt lgkmcnt(" #n ")" ::: "memory")
#define PG8_BAR __builtin_amdgcn_s_barrier()
#define PG8_SCHED __builtin_amdgcn_sched_barrier(0)
    Unit cur, nxt; int ui = 0;
    if (!S.next(0, cur)) return;
    f32x4 acc[2][2][4][2];
#pragma unroll
    for (int a = 0; a < 2; ++a)
#pragma unroll
        for (int b = 0; b < 2; ++b)
#pragma unroll
            for (int m = 0; m < 4; ++m)
#pragma unroll
                for (int n = 0; n < 2; ++n) acc[a][b][m][n] = (f32x4){0.f, 0.f, 0.f, 0.f};
    bf16x8 At[4][2], B0[2][2], B1[2][2];
    unsigned vc0[2], vc1[2], vn0[2], vn1[2];
    if constexpr (Sched::GATHER) {
#pragma unroll
        for (int i = 0; i < 2; ++i) { vc0[i] = (unsigned)(S.arow(cur, RA[i]) * K + CA[i]) * 2u; vc1[i] = (unsigned)(S.arow(cur, RA[i] + HALF) * K + CA[i]) * 2u; vn0[i] = vc0[i]; vn1[i] = vc1[i]; }
    } else {
#pragma unroll
        for (int i = 0; i < 2; ++i) { vc0[i] = voffA[i]; vc1[i] = voffA[i]; vn0[i] = voffA[i]; vn1[i] = voffA[i]; }
    }
    const char* cA = Sched::GATHER ? (const char*)g.A : (const char*)g.A + (size_t)cur.pm * tstep; const char* cB = (const char*)g.Bt + cur.boff + (size_t)cur.pn * tstep;
    S.a_ready(cur);
    PG8_STAGE(PG8_SB(0, 0), cB, voffB); PG8_STAGE(PG8_SB(0, 1), cB + hstep, voffB); PG8_STAGE(PG8_SA(0, 0), cA, vc0); PG8_STAGE(PG8_SA(0, 1), cA + hstepA, vc1);
    if (wr == 1) PG8_BAR;
    PG8_WAIT_V(2); PG8_BAR;
    PG8_STAGE(PG8_SB(1, 0), cB + kstep, voffB); PG8_STAGE(PG8_SA(1, 0), cA + kstep, vc0); PG8_STAGE(PG8_SB(1, 1), cB + hstep + kstep, voffB);
    PG8_WAIT_V(6); PG8_BAR;
    for (;;) {
        const bool has_next = S.next(ui + 1, nxt);
        if constexpr (Sched::GATHER) { if (has_next) {
#pragma unroll
            for (int i = 0; i < 2; ++i) { vn0[i] = (unsigned)(S.arow(nxt, RA[i]) * K + CA[i]) * 2u; vn1[i] = (unsigned)(S.arow(nxt, RA[i] + HALF) * K + CA[i]) * 2u; } } }
        const char* nA = Sched::GATHER ? (const char*)g.A : (has_next ? (const char*)g.A + (size_t)nxt.pm * tstep : cA); const char* nB = has_next ? (const char*)g.Bt + nxt.boff + (size_t)nxt.pn * tstep : cB;
        for (int t = 0; t < nt; t += 2) {
            const bool last = (t == nt - 2);
            const char* a1 = cA + (size_t)(t + 1) * kstep;
            const char* a2 = last ? nA : cA + (size_t)(t + 2) * kstep; const char* b2 = last ? nB : cB + (size_t)(t + 2) * kstep;
            const char* a3 = a2 + kstep; const char* b3 = b2 + kstep;
            unsigned w0[2], w1[2];
#pragma unroll
            for (int i = 0; i < 2; ++i) { w0[i] = (Sched::GATHER && last) ? vn0[i] : vc0[i]; w1[i] = (Sched::GATHER && last) ? vn1[i] : vc1[i]; }
            if (last && has_next) S.a_ready(nxt);
            PG8_LDB(B0, 0, 0); PG8_LDB(B1, 0, 1); PG8_SCHED; PG8_LDA(At, 0, 0); PG8_STAGE(PG8_SA(1, 1), a1 + hstepA, vc1);
            PG8_WAIT_V(8); PG8_WAIT_L(0); PG8_BAR; PG8_MMA(0, 0, At, B0); PG8_MMA(0, 1, At, B1); PG8_BAR; PG8_SCHED;
            PG8_LDA(At, 0, 1); PG8_STAGE(PG8_SB(0, 0), b2, voffB); PG8_STAGE(PG8_SB(0, 1), b2 + hstep, voffB); PG8_STAGE(PG8_SA(0, 0), a2, w0);
            PG8_WAIT_V(8); PG8_WAIT_L(0); PG8_BAR; PG8_MMA(1, 0, At, B0); PG8_MMA(1, 1, At, B1); PG8_BAR; PG8_SCHED;
            PG8_LDB(B0, 1, 0); PG8_LDB(B1, 1, 1); PG8_SCHED; PG8_LDA(At, 1, 0); PG8_STAGE(PG8_SA(0, 1), a2 + hstepA, w1);
            PG8_WAIT_V(8); PG8_WAIT_L(0); PG8_BAR; PG8_MMA(0, 0, At, B0); PG8_MMA(0, 1, At, B1); PG8_BAR; PG8_SCHED;
            PG8_LDA(At, 1, 1); PG8_STAGE(PG8_SB(1, 0), b3, voffB); PG8_STAGE(PG8_SB(1, 1), b3 + hstep, voffB); PG8_STAGE(PG8_SA(1, 0), a3, w0);
            PG8_WAIT_V(8); PG8_WAIT_L(0); PG8_BAR; PG8_MMA(1, 0, At, B0); PG8_MMA(1, 1, At, B1); PG8_BAR; PG8_SCHED;
        }
        if constexpr (ALIGN_EPI) { if (wr == 0) PG8_BAR; }
        if constexpr (!Epi::AFTER_DRAIN) { E(acc, cur, wr, wc, fr, fq); S.done(cur); }
        if (!has_next) break;
#pragma unroll
        for (int a = 0; a < 2; ++a)
#pragma unroll
            for (int b = 0; b < 2; ++b)
#pragma unroll
                for (int m = 0; m < 4; ++m)
#pragma unroll
                    for (int n = 0; n < 2; ++n) acc[a][b][m][n] = (f32x4){0.f, 0.f, 0.f, 0.f};
        cur = nxt; cA = nA; cB = nB; ++ui;
        if constexpr (Sched::GATHER) {
#pragma unroll
            for (int i = 0; i < 2; ++i) { vc0[i] = vn0[i]; vc1[i] = vn1[i]; } }
        if constexpr (ALIGN_EPI) { if (wr == 1) PG8_BAR; }
    }
    PG8_WAIT_V(0);
    if constexpr (!ALIGN_EPI) { if (wr == 0) PG8_BAR; }
    PG8_BAR;
#undef PG8_SA
#undef PG8_SB
#undef PG8_STAGE
#undef PG8_LDA
#undef PG8_LDB
#undef PG8_MMA
#undef PG8_WAIT_V
#undef PG8_WAIT_L
#undef PG8_BAR
#undef PG8_SCHED
}
}

constexpr int NWAVES = 8;
constexpr int NPH = 17;
constexpr int N_LAUNCHES = (MK_N_LAUNCHES == 1) ? 1 : NPH;

constexpr int T = 16384, D = 2048;
constexpr int KD = 1024, VD = 2048, GIN = 6160, GINM = 6144, DKH = 256, DVH = 512, NHEAD = 4, CHK = 64, NCHUNK = T / CHK, RANK = 16;
constexpr int NE = 32, FF = 512, NGRP = 4, EPG = 8, NLOG = 48;
constexpr int MAX_RT = 160;
constexpr float EPS = 1e-6f;

constexpr size_t MiB = 1u << 20;
constexpr size_t WS_CTL = 0, CTL_ZERO_BYTES = 65536;
constexpr size_t WS_GL = 1 * MiB;
constexpr size_t WS_TKE = 2 * MiB;
constexpr size_t WS_TKS = WS_TKE + 131072;
constexpr size_t WS_TKG = WS_TKS + 131072;
constexpr size_t WS_RGATE = WS_TKG + 131072;
constexpr size_t WS_LIST = 3 * MiB;
constexpr size_t WS_WRT = 5 * MiB;
constexpr size_t WS_WGI = 8 * MiB;
constexpr size_t WS_WGO = 32 * MiB;
constexpr size_t WS_WCI = 40 * MiB;
constexpr size_t WS_WCO = 64 * MiB;
constexpr size_t WS_WGU = 72 * MiB;
constexpr size_t WS_WDN = 328 * MiB;
constexpr size_t WS_HN = 456 * MiB;
constexpr size_t WS_BC = 520 * MiB;
constexpr size_t WS_QP = 584 * MiB;
constexpr size_t WS_KP = 616 * MiB;
constexpr size_t WS_VB = 648 * MiB;
constexpr size_t WS_GB = 712 * MiB;
constexpr size_t WS_O = 776 * MiB;
constexpr size_t WS_OG = 904 * MiB;
constexpr size_t WS_H1 = 968 * MiB;
constexpr size_t WS_H2 = 1096 * MiB;
constexpr size_t WS_XS = 1224 * MiB;
constexpr size_t WS_ACT = 1384 * MiB;
constexpr size_t WS_Y = 1424 * MiB;
constexpr size_t WS_SEND = 1584 * MiB;
constexpr size_t WS_GTOT = 1616 * MiB;
constexpr size_t WS_END = 1617 * MiB;
constexpr int CW_TMO = 0, CW_CODE = 1;
constexpr int CW_BAR = 4096;
constexpr int CW_CNT = 8192;

constexpr int RING_OFF = 0, RING_BYTES = 131072;
constexpr int SCR_OFF = 131072, SCR_BYTES = 8192;
constexpr int MISC_OFF = SCR_OFF + SCR_BYTES;
constexpr int MISC_BYTES = 2048;
constexpr int LDS_BYTES = 147456;
static_assert(MISC_OFF + MISC_BYTES <= LDS_BYTES, "LDS map");
constexpr int MI_PSTART = 16, MI_NRT = 49, MI_TEXP = 64, MI_CNTL = 256, MI_BASEL = 288, MI_TSLOT = 320, MI_ECNT = 480;
static_assert(MI_TEXP == 64 && MI_TSLOT == 320 && MI_ECNT == 480, "pg8::MoeOrder reads these words by number");

#define GAS __attribute__((address_space(1)))
#define LAS __attribute__((address_space(3)))
typedef unsigned short bf16;
typedef unsigned v4u __attribute__((ext_vector_type(4)));
typedef unsigned v2u __attribute__((ext_vector_type(2)));
typedef float f32x4 __attribute__((ext_vector_type(4)));
typedef GAS unsigned gu32;
#define RLX_AGENT __ATOMIC_RELAXED, __HIP_MEMORY_SCOPE_AGENT
#define LDS_WAIT() asm volatile("s_waitcnt lgkmcnt(0)" ::: "memory")
#define VM_WAIT() asm volatile("s_waitcnt vmcnt(0)" ::: "memory")
__device__ __forceinline__ unsigned f2bf(float f) { unsigned u = __builtin_bit_cast(unsigned, f); return (u + 0x7fffu + ((u >> 16) & 1u)) >> 16; }
__device__ __forceinline__ unsigned pk2(float lo, float hi) { return f2bf(lo) | (f2bf(hi) << 16); }
__device__ __forceinline__ float bflo(unsigned w) { return __uint_as_float(w << 16); }
__device__ __forceinline__ float bfhi(unsigned w) { return __uint_as_float(w & 0xffff0000u); }

#define XB_TMO      128
#define XB_XCNT(j)  (256  + 64 * (j))
#define XB_XSUB(j)  (1280 + 64 * (j))
#define XB_XGEN(j)  (2304 + 64 * (j))
#define XB_TOP      3328
#define XB_TOPGEN   3392
#define XCD_BAR_WORDS 3456
#define XB_SPIN_CAP (1u << 22)
__device__ __forceinline__ unsigned xb_ld(unsigned* p)              { return __hip_atomic_load(p, __ATOMIC_RELAXED, __HIP_MEMORY_SCOPE_AGENT); }
__device__ __forceinline__ unsigned xb_add(unsigned* p, unsigned v) { return __hip_atomic_fetch_add(p, v, __ATOMIC_RELAXED, __HIP_MEMORY_SCOPE_AGENT); }
__device__ __forceinline__ unsigned xb_xcc_id() { return (unsigned)__builtin_amdgcn_s_getreg((3 << 11) | 20) & 0xFu; }
#define XB_SPIN(cond, bar) do { unsigned _sp = 0; while (cond) { __builtin_amdgcn_s_sleep(1); \
    if ((++_sp & 255u) == 0u) { if (xb_ld(&(bar)[XB_TMO])) break; if (_sp > XB_SPIN_CAP) { atomicAdd(&(bar)[XB_TMO], 1u); break; } } } } while (0)
struct XcdBarrier { unsigned* bar; unsigned x; volatile LAS unsigned* st; };
__device__ __forceinline__ XcdBarrier xcd_barrier_post(unsigned* bar, volatile LAS unsigned* st) {
    XcdBarrier b; b.bar = bar; b.x = xb_xcc_id(); b.st = st;
    if (threadIdx.x == 0) (void)xb_add(&bar[XB_XCNT(b.x)], 1u);
    return b;
}
__device__ __forceinline__ void xcd_barrier_complete(unsigned* bar, unsigned x, unsigned& nloc, unsigned& nx) {
    const unsigned G = gridDim.x * gridDim.y * gridDim.z;
    unsigned sum, cnt, mine, sp = 0u;
    for (;;) {
        sum = 0u; cnt = 0u; mine = 0u;
#pragma unroll
        for (unsigned j = 0; j < 16; ++j) { const unsigned c = xb_ld(&bar[XB_XCNT(j)]); sum += c; cnt += (c > 0u) ? 1u : 0u; mine = (j == x) ? c : mine; }
        if (sum == G) break;
        __builtin_amdgcn_s_sleep(1);
        if ((++sp & 255u) == 0u) { if (xb_ld(&bar[XB_TMO])) break; if (sp > XB_SPIN_CAP) { atomicAdd(&bar[XB_TMO], 1u); break; } }
    }
    nloc = mine > 0u ? mine : 1u; nx = cnt > 0u ? cnt : 1u;
}
__device__ __forceinline__ void xcd_barrier(const XcdBarrier& b) {
    asm volatile("s_waitcnt vmcnt(0)" ::: "memory");
    __syncthreads();
    if (threadIdx.x == 0) {
        unsigned* bar = b.bar;
        __builtin_amdgcn_s_waitcnt(0);
        unsigned nloc = b.st[0], nx = b.st[1];
        if (nloc == 0u) { xcd_barrier_complete(bar, b.x, nloc, nx); b.st[0] = nloc; b.st[1] = nx; }
        const unsigned old = xb_add(&bar[XB_XSUB(b.x)], 1u);
        const unsigned gen = old / nloc;
        if (old + 1u == (gen + 1u) * nloc) {
            __builtin_amdgcn_fence(__ATOMIC_RELEASE, "agent");
            asm volatile("s_waitcnt vmcnt(0)" ::: "memory");
            const unsigned og = xb_add(&bar[XB_TOP], 1u);
            const unsigned tg = og / nx;
            if (og + 1u == (tg + 1u) * nx) xb_add(&bar[XB_TOPGEN], 1u);
            else XB_SPIN(xb_ld(&bar[XB_TOPGEN]) == tg, bar);
            __builtin_amdgcn_fence(__ATOMIC_ACQUIRE, "agent");
            xb_add(&bar[XB_XGEN(b.x)], 1u);
            asm volatile("s_waitcnt vmcnt(0)" ::: "memory");
        } else {
            XB_SPIN(xb_ld(&bar[XB_XGEN(b.x)]) == gen, bar);
            __builtin_amdgcn_fence(__ATOMIC_ACQUIRE, "agent");
            asm volatile("s_waitcnt vmcnt(0)" ::: "memory");
        }
    }
    __syncthreads();
}

struct Frame {
    LAS unsigned char* lds;
    volatile LAS int* MISC;
    unsigned* ctl;
    int tid, lane, wave, G;
    __attribute__((address_space(4))) const unsigned char* ka;
};
#define KIN(i) (*(const float* const __attribute__((address_space(4)))*)(F.ka + 8 * (i)))
#define KOUT   (*(float* const __attribute__((address_space(4)))*)(F.ka + 8 * 18))
#define KWS    (*(unsigned char* const __attribute__((address_space(4)))*)(F.ka + 8 * 19))
__device__ __forceinline__ float wave_sum(float v) {
#pragma unroll
    for (int o = 1; o < 64; o <<= 1) v += __shfl_xor(v, o);
    return v;
}

__device__ __forceinline__ void transpose_item(const float* W, int K, int ldw, int ncols, bf16* WT, int destrow0, LAS float* scr, int kb, int nb, int lane) {
    const int k0 = 64 * kb, n0 = 32 * nb; (void)ncols;
#pragma unroll 8
    for (int i = 0; i < 32; ++i) { const int kk = 2 * i + (lane >> 5); scr[kk * 33 + (lane & 31)] = W[(size_t)(k0 + kk) * ldw + n0 + (lane & 31)]; }
    LDS_WAIT(); asm volatile("" ::: "memory");
    const int c = lane & 7;
#pragma unroll
    for (int j = 0; j < 4; ++j) { const int n = (lane >> 3) + 8 * j; const LAS float* s = scr + (8 * c) * 33 + n;
        v4u o; o.x = pk2(s[0 * 33], s[1 * 33]); o.y = pk2(s[2 * 33], s[3 * 33]); o.z = pk2(s[4 * 33], s[5 * 33]); o.w = pk2(s[6 * 33], s[7 * 33]);
        *(v4u*)(WT + (size_t)(destrow0 + n) * K + k0 + 8 * c) = o; }
    LDS_WAIT(); asm volatile("" ::: "memory");
}
__device__ __forceinline__ int conv_in_row(int n) { if (n < 2048) return n; const int s = (n - 2048) >> 11, f = (n - 2048) & 2047; return 2048 + 256 * (f >> 7) + 128 * s + (f & 127); }
__device__ __forceinline__ int gate_up_row(int n) { const int s = n >> 9, f = n & 511; return 256 * (f >> 7) + 128 * s + (f & 127); }

__device__ __forceinline__ void p0_convert(Frame& F) {
    LAS float* scr = (LAS float*)(F.lds + RING_OFF + F.wave * 16384);
    const int gw = blockIdx.x * NWAVES + F.wave, NGW = F.G * NWAVES;
    constexpr int I_GI = 32 * 192, I_GO = 32 * 64, I_CI = 32 * 192, I_CO = 32 * 64, I_GU1 = 32 * 32, I_DN1 = 8 * 64;
    constexpr int I_GU = I_GU1 * 64, I_DN = I_DN1 * 64;
    constexpr int NITEMS = I_GI + I_GO + I_CI + I_CO + I_GU + I_DN;
    bf16* WGI = (bf16*)(KWS + WS_WGI); bf16* WGO = (bf16*)(KWS + WS_WGO); bf16* WCI = (bf16*)(KWS + WS_WCI); bf16* WCO = (bf16*)(KWS + WS_WCO);
    bf16* WGU = (bf16*)(KWS + WS_WGU); bf16* WDN = (bf16*)(KWS + WS_WDN);
    for (int it = gw; it < NITEMS; it += NGW) {
        int r = it;
        if (r < I_GI) { const int kb = r / 192, nb = r % 192; transpose_item(KIN(2), 2048, GIN, GINM, WGI, 32 * nb, scr, kb, nb, F.lane); continue; } r -= I_GI;
        if (r < I_GO) { const int kb = r / 64, nb = r % 64; transpose_item(KIN(6), 2048, 2048, 2048, WGO, 32 * nb, scr, kb, nb, F.lane); continue; } r -= I_GO;
        if (r < I_CI) { const int kb = r / 192, nb = r % 192; transpose_item(KIN(7), 2048, 6144, 6144, WCI, conv_in_row(32 * nb), scr, kb, nb, F.lane); continue; } r -= I_CI;
        if (r < I_CO) { const int kb = r / 64, nb = r % 64; transpose_item(KIN(9), 2048, 2048, 2048, WCO, 32 * nb, scr, kb, nb, F.lane); continue; } r -= I_CO;
        if (r < I_GU) { const int le = r / I_GU1, q = r % I_GU1, kb = q / 32, nb = q % 32;
            transpose_item(KIN(15) + (size_t)le * 2048 * 1024, 2048, 1024, 1024, WGU + (size_t)le * 1024 * 2048, gate_up_row(32 * nb), scr, kb, nb, F.lane); continue; } r -= I_GU;
        { const int le = r / I_DN1, q = r % I_DN1, kb = q / 64, nb = q % 64;
            transpose_item(KIN(16) + (size_t)le * 512 * 2048, 512, 2048, 2048, WDN + (size_t)le * 2048 * 512, 32 * nb, scr, kb, nb, F.lane); }
    }
    float* WRT = (float*)(KWS + WS_WRT);
    for (int i = blockIdx.x * 512 + F.tid; i < 2 * NLOG * 2048; i += F.G * 512) {
        const int l = i / (NLOG * 2048), c = (i / 2048) % NLOG, k = i % 2048;
        float w = 0.f;
        if (c < 4) w = KIN(11)[((size_t)l * 2048 + k) * 4 + c]; else if (c < 36) w = KIN(13)[((size_t)l * 2048 + k) * 32 + (c - 4)];
        WRT[i] = w * KIN(10)[l * 2048 + k];
    }
}

constexpr int WGT_LD = 2052;
__device__ __forceinline__ void p0_norm_gl(Frame& F) {
    LAS float* wgt = (LAS float*)(F.lds);
    LAS float* glc = (LAS float*)(F.lds + 16 * WGT_LD * 4);
    static_assert(16 * WGT_LD * 4 + 64 * 16 * 4 <= MISC_OFF, "p0 LDS");
    const float* w_in = KIN(2);
    for (int idx = F.tid; idx < 2048 * 16; idx += 512) { const int k = idx >> 4, r = idx & 15; wgt[r * WGT_LD + k] = w_in[(size_t)k * GIN + GINM + r]; }
    __syncthreads();
    const float* x = KIN(0); const float* wn = KIN(1); bf16* HN = (bf16*)(KWS + WS_HN); float* BC = (float*)(KWS + WS_BC);
    const float* w2 = KIN(3); const float* bgk = KIN(4);
    for (int ch = blockIdx.x; ch < NCHUNK; ch += F.G) {
        for (int rr = 0; rr < 8; ++rr) {
            const int rl = F.wave * 8 + rr, row = ch * CHK + rl;
            const f32x4* xr = (const f32x4*)(x + (size_t)row * D) + F.lane;
            float s = 0.f;
#pragma unroll
            for (int j = 0; j < 8; ++j) { const f32x4 v = xr[64 * j]; s += (v.x * v.x + v.y * v.y) + (v.z * v.z + v.w * v.w); }
            const float rstd = 1.0f / sqrtf(wave_sum(s) * (1.0f / D) + EPS);
            float ga[16];
#pragma unroll
            for (int r = 0; r < 16; ++r) ga[r] = 0.f;
            v2u* o8 = (v2u*)(HN + (size_t)row * D) + F.lane;
#pragma unroll 1
            for (int j = 0; j < 8; ++j) { const f32x4 w = ((const f32x4*)wn)[F.lane + 64 * j]; const f32x4 v = xr[64 * j] * rstd * w;
                v2u o; o.x = pk2(v.x, v.y); o.y = pk2(v.z, v.w); o8[64 * j] = o;
#pragma unroll
                for (int r = 0; r < 16; ++r) { const f32x4 g = *(const LAS f32x4*)(wgt + r * WGT_LD + 4 * F.lane + 256 * j); ga[r] += (v.x * g.x + v.y * g.y) + (v.z * g.z + v.w * g.w); } }
#pragma unroll
            for (int r = 0; r < 16; ++r) ga[r] = wave_sum(ga[r]);
            if (F.lane == 0) {
#pragma unroll
                for (int r = 0; r < 16; ++r) glc[rl * 16 + r] = ga[r]; }
        }
        __syncthreads();
#pragma unroll
        for (int hh = 0; hh < 2; ++hh) {
            const int c = F.tid + 512 * hh; float w2r[16];
#pragma unroll
            for (int r = 0; r < 16; ++r) w2r[r] = w2[r * KD + c];
            const float bias = bgk[c]; float cum = 0.f;
            for (int t = 0; t < CHK; ++t) {
                float z = bias;
#pragma unroll
                for (int r = 0; r < 16; ++r) z += glc[t * 16 + r] * w2r[r];
                const float ls = fminf(z, 0.f) - log1pf(expf(-fabsf(z)));
                cum += ls * (1.0f / 16.0f);
                BC[(size_t)(ch * CHK + t) * KD + c] = cum;
            }
        }
        __syncthreads();
    }
}

__device__ __forceinline__ void ph_gla_naive(Frame& F) {
    const bf16* QP = (const bf16*)(KWS + WS_QP); const bf16* KP = (const bf16*)(KWS + WS_KP); const bf16* VB = (const bf16*)(KWS + WS_VB);
    const float* BC = (const float*)(KWS + WS_BC); float* O = (float*)(KWS + WS_O);
    for (int u = blockIdx.x; u < 128; u += F.G) {
        const int h = u >> 5, col0 = (u & 31) * 16, ds = F.tid & 31, col = F.tid >> 5;
        float R[8];
#pragma unroll
        for (int i = 0; i < 8; ++i) R[i] = 0.f;
        const bf16* qp = QP + h * DKH + ds * 8; const bf16* kp = KP + h * DKH + ds * 8; const bf16* vp = VB + h * DVH + col0 + col;
        const float* bp = BC + h * DKH + ds * 8; float* op = O + h * DVH + col0 + col;
        for (int t0 = 0; t0 < T; t0 += 8) {
            v4u kk[8], qq[8]; unsigned short vv[8];
#pragma unroll
            for (int j = 0; j < 8; ++j) { kk[j] = *(const v4u*)(kp + (size_t)(t0 + j) * KD); qq[j] = *(const v4u*)(qp + (size_t)(t0 + j) * KD); vv[j] = vp[(size_t)(t0 + j) * VD]; }
#pragma unroll
            for (int j = 0; j < 8; ++j) {
                const float v = __uint_as_float(((unsigned)vv[j]) << 16);
                float po = 0.f;
#pragma unroll
                for (int i = 0; i < 4; ++i) { const unsigned kw = kk[j][i], qw = qq[j][i];
                    R[2 * i] += bflo(kw) * v; R[2 * i + 1] += bfhi(kw) * v; po += bflo(qw) * R[2 * i] + bfhi(qw) * R[2 * i + 1]; }
                po += __shfl_xor(po, 1); po += __shfl_xor(po, 2); po += __shfl_xor(po, 4); po += __shfl_xor(po, 8); po += __shfl_xor(po, 16);
                if (ds == 0) op[(size_t)(t0 + j) * VD] = po;
            }
            if (((t0 + 8) & 63) == 0) { const f32x4 b0 = *(const f32x4*)(bp + (size_t)(t0 + 7) * KD), b1 = *(const f32x4*)(bp + (size_t)(t0 + 7) * KD + 4);
#pragma unroll
                for (int i = 0; i < 4; ++i) { R[i] *= expf(b0[i]); R[4 + i] *= expf(b1[i]); } }
        }
    }
}

namespace gla {
typedef short bf16x8 __attribute__((ext_vector_type(8)));
typedef short s16x4 __attribute__((ext_vector_type(4)));
typedef short v4i16_t __attribute__((ext_vector_type(4)));
typedef float f32x2_t __attribute__((ext_vector_type(2))); typedef __bf16 bf16x2_t __attribute__((ext_vector_type(2)));
__device__ __forceinline__ unsigned cvtpk(float lo, float hi) { f32x2_t v = {lo, hi}; bf16x2_t b = __builtin_convertvector(v, bf16x2_t); return __builtin_bit_cast(unsigned, b); }
__device__ __forceinline__ s16x4 trread(const LAS unsigned char* p) { return __builtin_bit_cast(s16x4, __builtin_amdgcn_ds_read_tr16_b64_v4i16((LAS v4i16_t*)p)); }
__device__ __forceinline__ bf16x8 cat4(s16x4 a, s16x4 b) { bf16x8 r; r[0] = a[0]; r[1] = a[1]; r[2] = a[2]; r[3] = a[3]; r[4] = b[0]; r[5] = b[1]; r[6] = b[2]; r[7] = b[3]; return r; }
constexpr int QS = 528, VS = 272, PS = 144;
constexpr int OFF_Q = 0, OFF_K = 64 * QS, OFF_V = 2 * 64 * QS, OFF_P = OFF_V + 64 * VS, OFF_G = OFF_P + 64 * PS, OFF_O = OFF_G + 1024, LDS_END = OFF_O + 64 * VS;
static_assert(LDS_END <= RING_BYTES, "gla LDS");
constexpr int NPART = 16, CPP = NCHUNK / NPART;
struct Stage { v4u q[4], k[4], v[2]; float g; };
template <bool NEEDQ>
__device__ __forceinline__ void issue_loads(Stage& st, const bf16* QP, const bf16* KP, const bf16* VB, const float* BC, int tok0, int h, int s, int tid) {
#pragma unroll
    for (int i = 0; i < 4; ++i) { const int id = tid + 512 * i, row = id >> 5, cc = id & 31; const size_t o = (size_t)(tok0 + row) * KD + h * DKH + cc * 8;
        if (NEEDQ) st.q[i] = *(const v4u*)(QP + o); st.k[i] = *(const v4u*)(KP + o); }
#pragma unroll
    for (int i = 0; i < 2; ++i) { const int id = tid + 512 * i, row = id >> 4, cc = id & 15; st.v[i] = *(const v4u*)(VB + (size_t)(tok0 + row) * VD + h * DVH + s * 128 + cc * 8); }
    st.g = BC[(size_t)(tok0 + 63) * KD + h * DKH + (tid & 255)];
}
template <bool NEEDQ>
__device__ __forceinline__ void write_stage(LAS unsigned char* lds, const Stage& st, int tid) {
#pragma unroll
    for (int i = 0; i < 4; ++i) { const int id = tid + 512 * i, row = id >> 5, cc = id & 31;
        if (NEEDQ) *(LAS v4u*)(lds + OFF_Q + row * QS + cc * 16) = st.q[i]; *(LAS v4u*)(lds + OFF_K + row * QS + cc * 16) = st.k[i]; }
#pragma unroll
    for (int i = 0; i < 2; ++i) { const int id = tid + 512 * i, row = id >> 4, cc = id & 15; *(LAS v4u*)(lds + OFF_V + row * VS + cc * 16) = st.v[i]; }
    if (tid < 256) *(LAS float*)(lds + OFF_G + 4 * tid) = expf(st.g);
}
template <int PASS>
__device__ __forceinline__ void unit(LAS unsigned char* lds, int tid, int lane, int w, int p, int h, int s, const bf16* QP, const bf16* KP, const bf16* VB, const float* BC, bf16* O, f32x4* SEND, float* GTOT) {
    constexpr bool NQ = (PASS == 2);
    const int r = lane & 15, q = lane >> 4, qq = r >> 2, pp = r & 3;
    f32x4 S[16];
#pragma unroll
    for (int dt = 0; dt < 16; ++dt) S[dt] = (f32x4){0.f, 0.f, 0.f, 0.f};
    const int tokbase = p * CPP * CHK;
    Stage st0, st1;
    issue_loads<NQ>(st0, QP, KP, VB, BC, tokbase, h, s, tid);
    __syncthreads();
    if (PASS == 2 && p > 0) {
        LAS int* cw = (LAS int*)(lds + OFF_P);
        if (tid == 0) *cw = 1 << 30;
        __syncthreads();
        if (tid < 256) { float prod = 1.f; int j0 = 0; for (int j = p - 1; j >= 1; --j) { prod *= GTOT[((size_t)j * 4 + h) * DKH + tid]; if (prod == 0.f) { j0 = j; break; } }
            __hip_atomic_fetch_min(cw, j0, __ATOMIC_RELAXED, __HIP_MEMORY_SCOPE_WORKGROUP); }
        __syncthreads();
        const int p0 = *cw;
        for (int pj = p0; pj < p; ++pj) {
            const f32x4* se = SEND + ((((size_t)pj * 4 + h) * 4 + s) * 8 + w) * 16 * 64 + lane; const float* gt = GTOT + ((size_t)pj * 4 + h) * DKH;
#pragma unroll
            for (int dt = 0; dt < 16; ++dt) { const f32x4 gg = *(const f32x4*)(gt + 16 * dt + 4 * q); S[dt] = S[dt] * gg + se[dt * 64]; }
        }
        __syncthreads();
    }
    write_stage<NQ>(lds, st0, tid);
    if (CPP > 1) issue_loads<NQ>(st0, QP, KP, VB, BC, tokbase + CHK, h, s, tid);
    if (PASS == 1 && CPP > 2) issue_loads<NQ>(st1, QP, KP, VB, BC, tokbase + 2 * CHK, h, s, tid);
    __syncthreads();
    const LAS unsigned char* qnat = lds + OFF_Q + r * QS + q * 16;
    const LAS unsigned char* knat = lds + OFF_K + r * QS + q * 16;
    const LAS unsigned char* qperm = lds + OFF_Q + r * QS + q * 8;
    const LAS unsigned char* ktr = lds + OFF_K + (8 * q + qq) * QS + pp * 8;
    const LAS unsigned char* vtr = lds + OFF_V + (8 * q + qq) * VS + w * 32 + pp * 8;
    const LAS unsigned char* pnat = lds + OFF_P + r * PS + q * 16;
    const LAS unsigned char* gbase = lds + OFF_G + 16 * q;
#define GLA_FENCE() asm volatile("" ::: "memory")
#define GLA_BAR() do { asm volatile("s_waitcnt lgkmcnt(0)" ::: "memory"); __builtin_amdgcn_s_barrier(); asm volatile("" ::: "memory"); } while (0)
#pragma unroll 1
    for (int c = 0; c < CPP; ++c) {
        const int tok0 = tokbase + c * CHK;
        bf16x8 vb[2];
#pragma unroll
        for (int kt = 0; kt < 2; ++kt) vb[kt] = cat4(trread(vtr + kt * 32 * VS), trread(vtr + kt * 32 * VS + 4 * VS));
        if (PASS == 2) {
            const int it = w >> 1, jt0 = 2 * (w & 1);
            f32x4 pa0 = (f32x4){0.f, 0.f, 0.f, 0.f}, pa1 = pa0;
            bf16x8 fb[4], fa0[4], fa1[4];
#define P_LOAD(sl, ks) do { fb[sl] = *(const LAS bf16x8*)(qnat + it * 16 * QS + (ks) * 64); fa0[sl] = *(const LAS bf16x8*)(knat + jt0 * 16 * QS + (ks) * 64); fa1[sl] = *(const LAS bf16x8*)(knat + (jt0 + 1) * 16 * QS + (ks) * 64); } while (0)
            P_LOAD(0, 0); P_LOAD(1, 1); P_LOAD(2, 2);
#pragma unroll
            for (int ks = 0; ks < 8; ++ks) { if (ks + 3 < 8) P_LOAD((ks + 3) & 3, ks + 3); GLA_FENCE();
                pa0 = __builtin_amdgcn_mfma_f32_16x16x32_bf16(fa0[ks & 3], fb[ks & 3], pa0, 0, 0, 0); pa1 = __builtin_amdgcn_mfma_f32_16x16x32_bf16(fa1[ks & 3], fb[ks & 3], pa1, 0, 0, 0); }
#undef P_LOAD
            { const int i = 16 * it + r, j0 = 16 * jt0 + 4 * q; v2u o;
              o.x = cvtpk(j0 + 0 <= i ? pa0[0] : 0.f, j0 + 1 <= i ? pa0[1] : 0.f); o.y = cvtpk(j0 + 2 <= i ? pa0[2] : 0.f, j0 + 3 <= i ? pa0[3] : 0.f);
              *(LAS v2u*)(lds + OFF_P + i * PS + j0 * 2) = o;
              o.x = cvtpk(j0 + 16 <= i ? pa1[0] : 0.f, j0 + 17 <= i ? pa1[1] : 0.f); o.y = cvtpk(j0 + 18 <= i ? pa1[2] : 0.f, j0 + 19 <= i ? pa1[3] : 0.f);
              *(LAS v2u*)(lds + OFF_P + i * PS + (j0 + 16) * 2) = o; }
            f32x4 Oa[4];
#pragma unroll
            for (int i4 = 0; i4 < 4; ++i4) Oa[i4] = (f32x4){0.f, 0.f, 0.f, 0.f};
            bf16x8 qa[2][4];
#define Q_LOAD(sl, ks) do { _Pragma("unroll") for (int i4 = 0; i4 < 4; ++i4) qa[sl][i4] = cat4(*(const LAS s16x4*)(qperm + i4 * 16 * QS + (ks) * 64), *(const LAS s16x4*)(qperm + i4 * 16 * QS + (ks) * 64 + 32)); } while (0)
            Q_LOAD(0, 0);
#pragma unroll
            for (int ks = 0; ks < 8; ++ks) {
                if (ks + 1 < 8) Q_LOAD((ks + 1) & 1, ks + 1);
                GLA_FENCE();
                v4u bw; bw.x = cvtpk(S[2 * ks][0], S[2 * ks][1]); bw.y = cvtpk(S[2 * ks][2], S[2 * ks][3]); bw.z = cvtpk(S[2 * ks + 1][0], S[2 * ks + 1][1]); bw.w = cvtpk(S[2 * ks + 1][2], S[2 * ks + 1][3]);
                const bf16x8 bfrag = __builtin_bit_cast(bf16x8, bw);
#pragma unroll
                for (int i4 = 0; i4 < 4; ++i4) Oa[i4] = __builtin_amdgcn_mfma_f32_16x16x32_bf16(bfrag, qa[ks & 1][i4], Oa[i4], 0, 0, 0);
            }
#undef Q_LOAD
            GLA_BAR();
            { bf16x8 pf[6];
              pf[0] = *(const LAS bf16x8*)(pnat); pf[1] = *(const LAS bf16x8*)(pnat + 16 * PS); pf[2] = *(const LAS bf16x8*)(pnat + 32 * PS); pf[3] = *(const LAS bf16x8*)(pnat + 32 * PS + 64);
              pf[4] = *(const LAS bf16x8*)(pnat + 48 * PS); pf[5] = *(const LAS bf16x8*)(pnat + 48 * PS + 64);
              Oa[0] = __builtin_amdgcn_mfma_f32_16x16x32_bf16(vb[0], pf[0], Oa[0], 0, 0, 0); Oa[1] = __builtin_amdgcn_mfma_f32_16x16x32_bf16(vb[0], pf[1], Oa[1], 0, 0, 0);
              Oa[2] = __builtin_amdgcn_mfma_f32_16x16x32_bf16(vb[0], pf[2], Oa[2], 0, 0, 0); Oa[2] = __builtin_amdgcn_mfma_f32_16x16x32_bf16(vb[1], pf[3], Oa[2], 0, 0, 0);
              Oa[3] = __builtin_amdgcn_mfma_f32_16x16x32_bf16(vb[0], pf[4], Oa[3], 0, 0, 0); Oa[3] = __builtin_amdgcn_mfma_f32_16x16x32_bf16(vb[1], pf[5], Oa[3], 0, 0, 0); }
#pragma unroll
            for (int i4 = 0; i4 < 4; ++i4) { v2u o; o.x = cvtpk(Oa[i4][0], Oa[i4][1]); o.y = cvtpk(Oa[i4][2], Oa[i4][3]); *(LAS v2u*)(lds + OFF_O + (16 * i4 + r) * VS + (16 * w + 4 * q) * 2) = o; }
        }
        { bf16x8 ka0[4], ka1[4]; f32x4 gg[4];
#define KV_LOAD(sl, dt) do { ka0[sl] = cat4(trread(ktr + (dt) * 32), trread(ktr + (dt) * 32 + 4 * QS)); ka1[sl] = cat4(trread(ktr + 32 * QS + (dt) * 32), trread(ktr + 32 * QS + (dt) * 32 + 4 * QS)); gg[sl] = *(const LAS f32x4*)(gbase + (dt) * 64); } while (0)
          KV_LOAD(0, 0); KV_LOAD(1, 1); KV_LOAD(2, 2);
#pragma unroll
          for (int dt = 0; dt < 16; ++dt) { if (dt + 3 < 16) KV_LOAD((dt + 3) & 3, dt + 3); GLA_FENCE();
              S[dt] = __builtin_amdgcn_mfma_f32_16x16x32_bf16(ka0[dt & 3], vb[0], S[dt], 0, 0, 0); S[dt] = __builtin_amdgcn_mfma_f32_16x16x32_bf16(ka1[dt & 3], vb[1], S[dt], 0, 0, 0);
              S[dt] = S[dt] * gg[dt & 3]; }
#undef KV_LOAD
        }
        GLA_BAR();
        if (PASS == 2) {
#pragma unroll
            for (int i = 0; i < 2; ++i) { const int id = tid + 512 * i, row = id >> 4, cc = id & 15;
                *(v4u*)(O + (size_t)(tok0 + row) * VD + h * DVH + s * 128 + cc * 8) = *(const LAS v4u*)(lds + OFF_O + row * VS + cc * 16); }
        }
        if (c + 1 < CPP) {
            if (PASS == 1) {
                if ((c & 1) == 0) { write_stage<NQ>(lds, st0, tid); if (c + 3 < CPP) issue_loads<NQ>(st0, QP, KP, VB, BC, tok0 + 3 * CHK, h, s, tid); }
                else { write_stage<NQ>(lds, st1, tid); if (c + 3 < CPP) issue_loads<NQ>(st1, QP, KP, VB, BC, tok0 + 3 * CHK, h, s, tid); }
            } else { write_stage<NQ>(lds, st0, tid); if (c + 2 < CPP) issue_loads<NQ>(st0, QP, KP, VB, BC, tok0 + 2 * CHK, h, s, tid); }
            GLA_BAR();
        }
    }
#undef GLA_FENCE
#undef GLA_BAR
    if (PASS == 1) {
        f32x4* se = SEND + ((((size_t)p * 4 + h) * 4 + s) * 8 + w) * 16 * 64 + lane;
#pragma unroll
        for (int dt = 0; dt < 16; ++dt) se[dt * 64] = S[dt];
        if (s == 0 && tid < 256) { float a = 0.f; for (int c = 0; c < CPP; ++c) a += BC[(size_t)(tokbase + c * CHK + 63) * KD + h * DKH + tid]; GTOT[((size_t)p * 4 + h) * DKH + tid] = expf(a); }
    }
}
}
template <int PASS>
__device__ __forceinline__ void ph_gla(Frame& F) {
    const bf16* QP = (const bf16*)(KWS + WS_QP); const bf16* KP = (const bf16*)(KWS + WS_KP); const bf16* VB = (const bf16*)(KWS + WS_VB);
    const float* BC = (const float*)(KWS + WS_BC); bf16* O = (bf16*)(KWS + WS_O); f32x4* SEND = (f32x4*)(KWS + WS_SEND); float* GTOT = (float*)(KWS + WS_GTOT);
    for (int u = blockIdx.x; u < 256; u += F.G) {
        const int idx = u >> 3, s = idx & 3, ph = (u & 7) * 8 + (idx >> 2), p = ph >> 2, h = ph & 3;
        if (PASS == 1 && p == gla::NPART - 1) continue;
        gla::unit<PASS>(F.lds, F.tid, F.lane, F.wave, p, h, s, QP, KP, VB, BC, O, SEND, GTOT);
    }
}

__device__ __forceinline__ void ph_headnorm(Frame& F) {
    const bf16* O = (const bf16*)(KWS + WS_O); const bf16* GB = (const bf16*)(KWS + WS_GB); bf16* OG = (bf16*)(KWS + WS_OG); const float* hnw = KIN(5);
    const int gw = blockIdx.x * NWAVES + F.wave, NGW = F.G * NWAVES;
    const f32x4 w0 = ((const f32x4*)hnw)[2 * F.lane], w1 = ((const f32x4*)hnw)[2 * F.lane + 1];
    for (int it = gw; it < T * NHEAD; it += NGW) {
        const size_t off = (size_t)(it >> 2) * VD + (it & 3) * DVH + 8 * F.lane;
        const v4u ov = *(const v4u*)(O + off); const v4u g = *(const v4u*)(GB + off);
        const f32x4 a = {bflo(ov.x), bfhi(ov.x), bflo(ov.y), bfhi(ov.y)}, b = {bflo(ov.z), bfhi(ov.z), bflo(ov.w), bfhi(ov.w)};
        const float ss = wave_sum((a.x * a.x + a.y * a.y) + (a.z * a.z + a.w * a.w) + (b.x * b.x + b.y * b.y) + (b.z * b.z + b.w * b.w));
        const float rstd = 1.0f / sqrtf(ss * (1.0f / DVH) + EPS);
        v4u o;
        o.x = pk2(a.x * rstd * w0.x * bflo(g.x), a.y * rstd * w0.y * bfhi(g.x)); o.y = pk2(a.z * rstd * w0.z * bflo(g.y), a.w * rstd * w0.w * bfhi(g.y));
        o.z = pk2(b.x * rstd * w1.x * bflo(g.z), b.y * rstd * w1.y * bfhi(g.z)); o.w = pk2(b.z * rstd * w1.z * bflo(g.w), b.w * rstd * w1.w * bfhi(g.w));
        *(v4u*)(OG + off) = o;
    }
}

__device__ __forceinline__ void ph_router(Frame& F, int layer, const float* H) {
    typedef float f32x4v __attribute__((ext_vector_type(4)));
    const float* WRT = (const float*)(KWS + WS_WRT) + (size_t)layer * NLOG * 2048;
    const float* wn = KIN(10) + layer * D; const float* bg = KIN(12) + layer * NGRP; const float* br = KIN(14) + layer * NE;
    bf16* HN = (bf16*)(KWS + WS_HN);
    int* TKE = (int*)(KWS + WS_TKE); int* TKS = (int*)(KWS + WS_TKS); float* TKG = (float*)(KWS + WS_TKG); int* LIST = (int*)(KWS + WS_LIST);
    unsigned* gcnt = F.ctl + CW_CNT + 64 * layer;
    LAS float* lg = (LAS float*)(F.lds + RING_OFF);
    LAS float* rs = (LAS float*)(F.lds + RING_OFF + 64 * 48 * 4);
    LAS int* sel = (LAS int*)(F.lds + RING_OFF + 64 * 48 * 4 + 256);
    LAS float* selg = (LAS float*)(F.lds + RING_OFF + 64 * 48 * 4 + 256 + 1024);
    volatile LAS int* cntl = F.MISC + MI_CNTL; volatile LAS int* basel = F.MISC + MI_BASEL;
    for (int blk = blockIdx.x; blk < T / 64; blk += F.G) {
        if (F.tid < 32) cntl[F.tid] = 0;
        if (F.wave < 4) {
            const int r = F.lane & 15, q = F.lane >> 4, row = blk * 64 + F.wave * 16 + r;
            const float* hp = H + (size_t)row * D + 4 * q;
            const float* wp0 = WRT + (size_t)r * 2048 + 4 * q; const float* wp1 = wp0 + 16 * 2048; const float* wp2 = wp0 + 32 * 2048;
            f32x4v a0 = {0.f, 0.f, 0.f, 0.f}, a1 = a0, a2 = a0; float ss = 0.f;
#pragma unroll 4
            for (int k0 = 0; k0 < D; k0 += 16) {
                const f32x4 a = *(const f32x4*)(hp + k0), b0 = *(const f32x4*)(wp0 + k0), b1 = *(const f32x4*)(wp1 + k0), b2 = *(const f32x4*)(wp2 + k0);
                ss += (a.x * a.x + a.y * a.y) + (a.z * a.z + a.w * a.w);
#pragma unroll
                for (int s = 0; s < 4; ++s) { a0 = __builtin_amdgcn_mfma_f32_16x16x4f32(a[s], b0[s], a0, 0, 0, 0); a1 = __builtin_amdgcn_mfma_f32_16x16x4f32(a[s], b1[s], a1, 0, 0, 0); a2 = __builtin_amdgcn_mfma_f32_16x16x4f32(a[s], b2[s], a2, 0, 0, 0); }
            }
            ss += __shfl_xor(ss, 16); ss += __shfl_xor(ss, 32);
            const float rstd = 1.0f / sqrtf(ss * (1.0f / D) + EPS);
            if (q == 0) rs[F.wave * 16 + r] = rstd;
#pragma unroll
            for (int j = 0; j < 4; ++j) { const int rl = F.wave * 16 + 4 * q + j; lg[rl * 48 + r] = a0[j]; lg[rl * 48 + 16 + r] = a1[j]; lg[rl * 48 + 32 + r] = a2[j]; }
        }
        __syncthreads();
        if (F.tid < 64) {
            const int rl = F.tid; const float rstd = rs[rl]; const LAS float* L = lg + rl * 48;
            float gl0 = L[0] * rstd + bg[0]; int g = 0; float gv[4]; gv[0] = gl0;
#pragma unroll
            for (int j = 1; j < 4; ++j) { gv[j] = L[j] * rstd + bg[j]; if (gv[j] > gl0) { gl0 = gv[j]; g = j; } }
            float den = 0.f;
#pragma unroll
            for (int j = 0; j < 4; ++j) den += expf(gv[j] - gl0);
            const float gp = 1.0f / den;
            float l1 = -3.0e38f, l2 = -3.0e38f; int e1 = 0, e2 = 0;
            for (int j = 0; j < 8; ++j) { const float v = L[4 + 8 * g + j] * rstd + br[8 * g + j];
                if (v > l1) { l2 = l1; e2 = e1; l1 = v; e1 = j; } else if (v > l2) { l2 = v; e2 = j; } }
            const float ex = expf(l2 - l1), p1 = 1.0f / (1.0f + ex), p2 = ex * p1;
            const int E0 = 8 * g + e1, E1 = 8 * g + e2;
            sel[rl * 4 + 0] = E0; sel[rl * 4 + 1] = E1;
            sel[rl * 4 + 2] = __hip_atomic_fetch_add((LAS int*)&cntl[E0], 1, __ATOMIC_RELAXED, __HIP_MEMORY_SCOPE_WORKGROUP); sel[rl * 4 + 3] = __hip_atomic_fetch_add((LAS int*)&cntl[E1], 1, __ATOMIC_RELAXED, __HIP_MEMORY_SCOPE_WORKGROUP);
            selg[rl * 2 + 0] = gp * p1; selg[rl * 2 + 1] = gp * p2;
        }
        __syncthreads();
        if (F.tid < 32) basel[F.tid] = (int)__hip_atomic_fetch_add(gcnt + F.tid, (unsigned)cntl[F.tid], RLX_AGENT);
        __syncthreads();
        if (F.tid < 128) {
            const int rl = F.tid >> 1, k = F.tid & 1, tk = (blk * 64 + rl) * 2 + k, e = sel[rl * 4 + k], slot = basel[e] + sel[rl * 4 + 2 + k];
            TKE[tk] = e; TKS[tk] = slot; TKG[tk] = selg[rl * 2 + k]; LIST[e * T + slot] = tk;
        }
        for (int rr = 0; rr < 8; ++rr) {
            const int rl = F.wave * 8 + rr, row = blk * 64 + rl; const float rstd = rs[rl];
            const f32x4* xr = (const f32x4*)(H + (size_t)row * D) + F.lane; v2u* o8 = (v2u*)(HN + (size_t)row * D) + F.lane;
#pragma unroll
            for (int j = 0; j < 8; ++j) { const f32x4 v = xr[64 * j] * rstd * ((const f32x4*)wn)[F.lane + 64 * j]; v2u o; o.x = pk2(v.x, v.y); o.y = pk2(v.z, v.w); o8[64 * j] = o; }
        }
        __syncthreads();
    }
}

__device__ __forceinline__ void moe_meta(Frame& F, int layer) {
    __syncthreads();
    if (F.tid == 0) {
        const unsigned* gcnt = F.ctl + CW_CNT + 64 * layer; int p = 0, nt = 0;
        for (int e = 0; e < NE; ++e) { const int c = (int)__hip_atomic_load(gcnt + e, RLX_AGENT); F.MISC[MI_PSTART + e] = p; const int tl = (c + 255) >> 8;
            F.MISC[MI_ECNT + e] = c;
            for (int j = 0; j < tl; ++j) { F.MISC[MI_TEXP + nt + j] = e; F.MISC[MI_TSLOT + nt + j] = 256 * j; } nt += tl; p += tl * 256; }
        F.MISC[MI_PSTART + NE] = p; F.MISC[MI_NRT] = nt;
    }
    __syncthreads();
}

template <bool FINAL>
__device__ __forceinline__ void ph_combine(Frame& F, const float* H, float* Hout, const float* wn) {
    const bf16* Y = (const bf16*)(KWS + WS_Y); const int* TKE = (const int*)(KWS + WS_TKE); const int* TKS = (const int*)(KWS + WS_TKS); const float* TKG = (const float*)(KWS + WS_TKG); bf16* HN = (bf16*)(KWS + WS_HN);
    const int gw = blockIdx.x * NWAVES + F.wave, NGW = F.G * NWAVES;
    for (int t = gw; t < T; t += NGW) {
        const int r0 = F.MISC[MI_PSTART + TKE[2 * t]] + TKS[2 * t], r1 = F.MISC[MI_PSTART + TKE[2 * t + 1]] + TKS[2 * t + 1]; const float g0 = TKG[2 * t], g1 = TKG[2 * t + 1];
        const f32x4* hr = (const f32x4*)(H + (size_t)t * D) + F.lane;
        const v2u* y0 = (const v2u*)(Y + (size_t)r0 * D) + F.lane; const v2u* y1 = (const v2u*)(Y + (size_t)r1 * D) + F.lane;
        f32x4 v[8]; float s = 0.f;
#pragma unroll
        for (int j = 0; j < 8; ++j) { const v2u a = y0[64 * j], b = y1[64 * j]; f32x4 h = hr[64 * j];
            h.x += g0 * bflo(a.x) + g1 * bflo(b.x); h.y += g0 * bfhi(a.x) + g1 * bfhi(b.x); h.z += g0 * bflo(a.y) + g1 * bflo(b.y); h.w += g0 * bfhi(a.y) + g1 * bfhi(b.y);
            v[j] = h; s += (h.x * h.x + h.y * h.y) + (h.z * h.z + h.w * h.w); }
        const float rstd = 1.0f / sqrtf(wave_sum(s) * (1.0f / D) + EPS);
        if (FINAL) {
            f32x4* o = (f32x4*)(KOUT + (size_t)t * D) + F.lane;
#pragma unroll
            for (int j = 0; j < 8; ++j) o[64 * j] = v[j] * rstd * ((const f32x4*)wn)[F.lane + 64 * j];
        } else {
            f32x4* ho = (f32x4*)(Hout + (size_t)t * D) + F.lane; v2u* o8 = (v2u*)(HN + (size_t)t * D) + F.lane;
#pragma unroll
            for (int j = 0; j < 8; ++j) { ho[64 * j] = v[j]; const f32x4 w = v[j] * rstd * ((const f32x4*)wn)[F.lane + 64 * j]; v2u o; o.x = pk2(w.x, w.y); o.y = pk2(w.z, w.w); o8[64 * j] = o; }
        }
    }
}

__device__ __forceinline__ void ph_conv(Frame& F) {
    const bf16* BG = (const bf16*)(KWS + WS_VB); const bf16* U = (const bf16*)(KWS + WS_GB); bf16* OG = (bf16*)(KWS + WS_OG); const float* cw = KIN(8);
    const size_t n8 = (size_t)T * D / 8;
    for (size_t i = (size_t)blockIdx.x * 512 + F.tid; i < n8; i += (size_t)F.G * 512) {
        const int t = (int)(i >> 8), c = (int)(i & 255) * 8; const size_t off = (size_t)t * D + c;
        const v4u u0 = *(const v4u*)(U + off); const v4u zero = {0u, 0u, 0u, 0u};
        const v4u u1 = t >= 1 ? *(const v4u*)(U + off - D) : zero; const v4u u2 = t >= 2 ? *(const v4u*)(U + off - 2 * D) : zero;
        const v4u b = *(const v4u*)(BG + off);
        const f32x4 wa0 = *(const f32x4*)(cw + c), wa1 = *(const f32x4*)(cw + c + 4), wb0 = *(const f32x4*)(cw + D + c), wb1 = *(const f32x4*)(cw + D + c + 4), wc0 = *(const f32x4*)(cw + 2 * D + c), wc1 = *(const f32x4*)(cw + 2 * D + c + 4);
        v4u o;
        o.x = pk2(bflo(b.x) * (wa0.x * bflo(u2.x) + wb0.x * bflo(u1.x) + wc0.x * bflo(u0.x)), bfhi(b.x) * (wa0.y * bfhi(u2.x) + wb0.y * bfhi(u1.x) + wc0.y * bfhi(u0.x)));
        o.y = pk2(bflo(b.y) * (wa0.z * bflo(u2.y) + wb0.z * bflo(u1.y) + wc0.z * bflo(u0.y)), bfhi(b.y) * (wa0.w * bfhi(u2.y) + wb0.w * bfhi(u1.y) + wc0.w * bfhi(u0.y)));
        o.z = pk2(bflo(b.z) * (wa1.x * bflo(u2.z) + wb1.x * bflo(u1.z) + wc1.x * bflo(u0.z)), bfhi(b.z) * (wa1.y * bfhi(u2.z) + wb1.y * bfhi(u1.z) + wc1.y * bfhi(u0.z)));
        o.w = pk2(bflo(b.w) * (wa1.z * bflo(u2.w) + wb1.z * bflo(u1.w) + wc1.z * bflo(u0.w)), bfhi(b.w) * (wa1.w * bfhi(u2.w) + wb1.w * bfhi(u1.w) + wc1.w * bfhi(u0.w)));
        *(v4u*)(OG + off) = o;
    }
}

#ifndef PH_MASK
#define PH_MASK 0xFFFFFFFFu
#endif
#define IN(k) (((PH_MASK >> (k)) & 1u) && lo <= (k) && (k) < hi)
#define BOTH(k) (IN(k) && IN((k) + 1))
#ifndef DUP_MASK
#define DUP_MASK 0u
#endif
#define NREP(k) ((((unsigned)DUP_MASK >> (k)) & 1u) ? 2 : 1)
#define GRID_BAR() do { if (N_LAUNCHES == 1) xcd_barrier(bar); } while (0)
template <int LAYER>
__device__ __forceinline__ void moe_block(Frame& F, const int lo, const int hi, const XcdBarrier& bar) {
    constexpr int pb = LAYER ? 13 : 6;
    float* H1 = (float*)(KWS + WS_H1); float* H2 = (float*)(KWS + WS_H2);
    if (IN(pb + 0)) { ph_router(F, LAYER, H1); if (BOTH(pb + 0)) GRID_BAR(); }
    if (IN(pb + 1)) {
        moe_meta(F, LAYER);
        const int nrt = F.MISC[MI_NRT];
        pg8::Gemm g{(const bf16*)(KWS + WS_HN), (const bf16*)(KWS + WS_WGU) + (size_t)LAYER * NE * 1024 * 2048, nrt * 256, 1024, D};
        pg8::MoeOrder<true> S{nrt, 4, nrt * 4, F.G, (int)blockIdx.x, (size_t)1024 * 2048 * 2, (const volatile LAS int*)F.MISC, (const int*)(KWS + WS_LIST)};
        pg8::EpiGateUp E{(bf16*)(KWS + WS_ACT)};
        for (int rep = 0; rep < NREP(pb + 1); ++rep) { pg8::gemm_phase<pg8::EpiGateUp, pg8::MoeOrder<true>, true>(F.lds + RING_OFF, g, S, E); if (rep + 1 < NREP(pb + 1)) GRID_BAR(); }
        if (BOTH(pb + 1)) GRID_BAR();
    }
    if (IN(pb + 2)) {
        moe_meta(F, LAYER);
        const int nrt = F.MISC[MI_NRT];
        pg8::Gemm g{(const bf16*)(KWS + WS_ACT), (const bf16*)(KWS + WS_WDN) + (size_t)LAYER * NE * 2048 * 512, nrt * 256, 2048, FF};
        pg8::MoeOrder<false> S{nrt, 8, nrt * 8, F.G, (int)blockIdx.x, (size_t)2048 * 512 * 2, (const volatile LAS int*)F.MISC, (const int*)(KWS + WS_LIST)};
        pg8::EpiDown E{(bf16*)(KWS + WS_Y)};
        for (int rep = 0; rep < NREP(pb + 2); ++rep) { pg8::gemm_phase<pg8::EpiDown, pg8::MoeOrder<false>, true>(F.lds + RING_OFF, g, S, E); if (rep + 1 < NREP(pb + 2)) GRID_BAR(); }
        if (BOTH(pb + 2)) GRID_BAR();
    }
    if (IN(pb + 3)) {
        moe_meta(F, LAYER);
        if (LAYER == 0) { for (int rep = 0; rep < NREP(pb + 3); ++rep) { ph_combine<false>(F, H1, H2, KIN(1) + D); if (rep + 1 < NREP(pb + 3)) GRID_BAR(); } if (BOTH(pb + 3)) GRID_BAR(); }
        else for (int rep = 0; rep < NREP(pb + 3); ++rep) { ph_combine<true>(F, H1, nullptr, KIN(17)); if (rep + 1 < NREP(pb + 3)) GRID_BAR(); }
    }
}

struct Args { const float* in[18]; float* out; unsigned char* ws; int ph_lo, ph_hi, li, pad; };
__global__ void __launch_bounds__(NWAVES * 64, 2) mega_fwd(Args args) {
    extern __shared__ __attribute__((aligned(16))) unsigned char lds[];
    Frame F;
    F.lds = (LAS unsigned char*)lds;
    F.MISC = (volatile LAS int*)(F.lds + MISC_OFF);
    F.tid = threadIdx.x; F.lane = F.tid & 63; F.wave = __builtin_amdgcn_readfirstlane(F.tid >> 6);
    F.G = gridDim.x;
    F.ka = (__attribute__((address_space(4))) const unsigned char*)__builtin_amdgcn_kernarg_segment_ptr();
    F.ctl = (unsigned*)(args.ws + WS_CTL);
    for (int u = F.tid; u < MISC_BYTES / 4; u += NWAVES * 64) F.MISC[u] = 0;
    __syncthreads();
    XcdBarrier bar; bar.bar = F.ctl + CW_BAR; bar.x = 0; bar.st = nullptr;
    if (N_LAUNCHES == 1) bar = xcd_barrier_post(F.ctl + CW_BAR, (volatile LAS unsigned*)(F.MISC + 8));
    const int lo = args.ph_lo, hi = args.ph_hi;
    bf16* HN = (bf16*)(KWS + WS_HN); float* H1 = (float*)(KWS + WS_H1); float* H2 = (float*)(KWS + WS_H2);

    if (IN(0)) { for (int rep = 0; rep < NREP(0); ++rep) { p0_convert(F); __syncthreads(); if (rep + 1 < NREP(0)) GRID_BAR(); } for (int rep = 0; rep < NREP(17); ++rep) { p0_norm_gl(F); if (rep + 1 < NREP(17)) GRID_BAR(); } if (BOTH(0)) GRID_BAR(); }
    if (IN(1)) {
        pg8::Gemm g{HN, (const bf16*)(KWS + WS_WGI), T, GINM, D}; pg8::StaticOrder S; S.init(T, GINM, F.G, (int)blockIdx.x);
        pg8::EpiGlaIn E{(bf16*)(KWS + WS_QP), (bf16*)(KWS + WS_KP), (bf16*)(KWS + WS_VB), (bf16*)(KWS + WS_GB), (const float*)(KWS + WS_BC)};
        for (int rep = 0; rep < NREP(1); ++rep) { pg8::gemm_phase<pg8::EpiGlaIn, pg8::StaticOrder, true>(F.lds + RING_OFF, g, S, E); if (rep + 1 < NREP(1)) GRID_BAR(); }
        if (BOTH(1)) GRID_BAR();
    }
#ifdef GLA_NAIVE
    if (IN(2)) { if (BOTH(2)) GRID_BAR(); }
    if (IN(3)) { ph_gla_naive(F); if (BOTH(3)) GRID_BAR(); }
#else
    if (IN(2)) { for (int rep = 0; rep < NREP(2); ++rep) { ph_gla<1>(F); if (rep + 1 < NREP(2)) GRID_BAR(); } if (BOTH(2)) GRID_BAR(); }
    if (IN(3)) { for (int rep = 0; rep < NREP(3); ++rep) { ph_gla<2>(F); if (rep + 1 < NREP(3)) GRID_BAR(); } if (BOTH(3)) GRID_BAR(); }
#endif
    if (IN(4)) { for (int rep = 0; rep < NREP(4); ++rep) { ph_headnorm(F); if (rep + 1 < NREP(4)) GRID_BAR(); } if (BOTH(4)) GRID_BAR(); }
    if (IN(5)) {
        pg8::Gemm g{(const bf16*)(KWS + WS_OG), (const bf16*)(KWS + WS_WGO), T, D, D}; pg8::StaticOrder S; S.init(T, D, F.G, (int)blockIdx.x);
        pg8::EpiRes E{KIN(0), H1, D};
        for (int rep = 0; rep < NREP(5); ++rep) { pg8::gemm_phase<pg8::EpiRes, pg8::StaticOrder, true>(F.lds + RING_OFF, g, S, E); if (rep + 1 < NREP(5)) GRID_BAR(); }
        if (BOTH(5)) GRID_BAR();
    }
    moe_block<0>(F, lo, hi, bar);
    if (IN(10)) {
        pg8::Gemm g{HN, (const bf16*)(KWS + WS_WCI), T, 6144, D}; pg8::StaticOrder S; S.init(T, 6144, F.G, (int)blockIdx.x);
        pg8::EpiConvIn E{(bf16*)(KWS + WS_VB), (bf16*)(KWS + WS_GB)};
        for (int rep = 0; rep < NREP(10); ++rep) { pg8::gemm_phase<pg8::EpiConvIn, pg8::StaticOrder, true>(F.lds + RING_OFF, g, S, E); if (rep + 1 < NREP(10)) GRID_BAR(); }
        if (BOTH(10)) GRID_BAR();
    }
    if (IN(11)) { for (int rep = 0; rep < NREP(11); ++rep) { ph_conv(F); if (rep + 1 < NREP(11)) GRID_BAR(); } if (BOTH(11)) GRID_BAR(); }
    if (IN(12)) {
        pg8::Gemm g{(const bf16*)(KWS + WS_OG), (const bf16*)(KWS + WS_WCO), T, D, D}; pg8::StaticOrder S; S.init(T, D, F.G, (int)blockIdx.x);
        pg8::EpiRes E{H2, H1, D};
        for (int rep = 0; rep < NREP(12); ++rep) { pg8::gemm_phase<pg8::EpiRes, pg8::StaticOrder, true>(F.lds + RING_OFF, g, S, E); if (rep + 1 < NREP(12)) GRID_BAR(); }
        if (BOTH(12)) GRID_BAR();
    }
    moe_block<1>(F, lo, hi, bar);
#undef IN
#undef BOTH
#undef GRID_BAR
}

extern "C" void kernel_launch(void* const* d_in, const int* in_sizes, int n_in, void* d_out, int out_size, void* d_ws, size_t ws_size, hipStream_t stream) {
    static int grid = 0;
    if (grid == 0) {
        if (n_in != 18 || in_sizes[0] != T * D || out_size != T * D || ws_size < WS_END) { fprintf(stderr, "kernel_launch: unexpected shapes (n_in %d, in0 %d, out %d, ws %zu)\n", n_in, n_in > 0 ? in_sizes[0] : -1, out_size, ws_size); grid = -1; return; }
        int dev = 0, cus = 0, per_cu = 0;
        if (hipGetDevice(&dev) != hipSuccess || hipDeviceGetAttribute(&cus, hipDeviceAttributeMultiprocessorCount, dev) != hipSuccess) { grid = -1; return; }
        if (hipFuncSetAttribute((const void*)mega_fwd, hipFuncAttributeMaxDynamicSharedMemorySize, LDS_BYTES) != hipSuccess) { fprintf(stderr, "kernel_launch: hipFuncSetAttribute failed\n"); grid = -1; return; }
        if (hipOccupancyMaxActiveBlocksPerMultiprocessor(&per_cu, (const void*)mega_fwd, NWAVES * 64, LDS_BYTES) != hipSuccess || per_cu < 1) { fprintf(stderr, "kernel_launch: occupancy query reports %d\n", per_cu); }
        (void)hipGetLastError();
        grid = cus;
    }
    if (grid < 0) return;
    if (hipMemsetAsync((char*)d_ws + WS_CTL, 0, CTL_ZERO_BYTES, stream) != hipSuccess) return;
    Args a{};
    for (int i = 0; i < 18; ++i) a.in[i] = (const float*)d_in[i];
    a.out = (float*)d_out; a.ws = (unsigned char*)d_ws;
    for (int li = 0; li < N_LAUNCHES; ++li) {
        a.ph_lo = (N_LAUNCHES == 1) ? 0 : li; a.ph_hi = (N_LAUNCHES == 1) ? NPH : li + 1; a.li = li; a.pad = 0;
        hipLaunchKernelGGL(mega_fwd, dim3(grid), dim3(NWAVES * 64), LDS_BYTES, stream, a);
        const hipError_t le = hipPeekAtLastError();
        if (le != hipSuccess) { fprintf(stderr, "kernel_launch: launch %d failed: %s\n", li, hipGetErrorName(le)); break; }
    }
}
```

```cpp
#include <hip/hip_runtime.h>
#include <cstdio>
#include <cstdint>

#ifndef MK_N_LAUNCHES
#define MK_N_LAUNCHES 1
#endif

namespace pg8 {
#define PG8_LAS __attribute__((address_space(3)))
typedef unsigned short bf16_t;
typedef short bf16x8 __attribute__((ext_vector_type(8)));
typedef float f32x4 __attribute__((ext_vector_type(4)));
typedef unsigned u32x4 __attribute__((ext_vector_type(4)));
constexpr int BM = 256, BK = 64, HALF = 128, HTB = HALF * BK * 2, STAGE_BYTES = 8 * HTB, NXCD = 8, WGM = 8;

__host__ __device__ __forceinline__ int lds_byte(int r, int c) { const int st = (r >> 4) * 2 + (c >> 5), rr = r & 15, cc = c & 31, ob = rr * 64 + cc * 2; return st * 1024 + (ob ^ (((ob >> 9) & 1) << 5)); }
__host__ __device__ __forceinline__ void stage_rc(int b, int& R, int& C) { const int st = b / 1024, sb = b % 1024, swz = sb ^ (((sb >> 9) & 1) << 5); R = (st >> 1) * 16 + swz / 64; C = (st & 1) * 32 + (swz % 64) / 2; }
__host__ __device__ __forceinline__ int perm32(int rho) { const int n = rho >> 4, i = rho & 15; return 8 * (i >> 2) + 4 * n + (i & 3); }

struct Unit { int pm, pn; size_t boff; int e, s0, cnt; };
struct Gemm { const bf16_t* A; const bf16_t* Bt; int M, N, K; };

struct StaticOrder {
    static constexpr bool GATHER = false;
    int nM, nN, nwg, G, c;
    __host__ __device__ void init(int M, int N, int G_, int c_) { nM = M / BM; nN = N / BM; nwg = nM * nN; G = G_; c = c_; }
    __host__ __device__ bool next(int i, Unit& u) const {
        const long L = (long)i * G + c; if (L >= nwg) return false;
        int wgid = (int)L; { const int q = nwg / NXCD, r = nwg % NXCD, xcd = wgid % NXCD, off = wgid / NXCD; wgid = (xcd < r ? xcd * (q + 1) : r * (q + 1) + (xcd - r) * q) + off; }
        const int nig = WGM * nN, gid = wgid / nig, fm = gid * WGM, gsz = (nM - fm) < WGM ? (nM - fm) : WGM;
        u.pm = fm + ((wgid % nig) % gsz); u.pn = (wgid % nig) / gsz; u.boff = 0; u.e = 0; u.s0 = 0; u.cnt = 0; return true;
    }
    __device__ __forceinline__ int arow(const Unit& u, int r) const { return u.pm * BM + r; }
    __device__ __forceinline__ void a_ready(const Unit&) const {}
    __device__ __forceinline__ void done(const Unit&) const {}
};
template <bool GATHER_>
struct MoeOrder {
    static constexpr bool GATHER = GATHER_;
    int nrt, NT, nwg, G, c; size_t estride; const volatile PG8_LAS int* misc; const int* list;
    int mode, r_lo, r_hi;
    __device__ __forceinline__ bool next(int i, Unit& u) const {
        int rt, pn;
        if (mode == 0) {
            const long L = (long)i * G + c; if (L >= nwg) return false;
            int wgid = (int)L; { const int q = nwg / NXCD, r = nwg % NXCD, xcd = wgid % NXCD, off = wgid / NXCD; wgid = (xcd < r ? xcd * (q + 1) : r * (q + 1) + (xcd - r) * q) + off; }
            rt = wgid / NT; pn = wgid % NT;
        } else {
            const int x = c & 7, j = c >> 3;
            if (mode == 1) { const int round = r_lo + i; if (round >= r_hi) return false; rt = 64 * round + 8 * x + (j >> 2); pn = j & 3; if (rt >= nrt) return false; }
            else {
                const int lt = nrt > 128 ? nrt - 128 : 0;
                int lightBefore = 0, nLight = 0, hcx = 0;
                for (int xx = 0; xx < 8; ++xx) { int hc = 4 * (lt - 8 * xx); hc = hc < 0 ? 0 : (hc > 32 ? 32 : hc); if (xx < x) lightBefore += 32 - hc; if (xx == x) hcx = hc; nLight += 32 - hc; }
                int u2;
                if (mode == 2) { if (j < hcx || i >= 4) return false; u2 = i * nLight + lightBefore + (j - hcx); if (u2 >= 1024) return false; }
                else u2 = (4 * nLight < 1024 ? 4 * nLight : 1024) + i * 256 + x * 32 + j;
                if (u2 >= nwg) return false;
                rt = u2 >> 3; pn = u2 & 7;
            }
        }
        u.pm = rt; u.pn = pn;
        u.e = __builtin_amdgcn_readfirstlane(misc[64 + u.pm]); u.s0 = __builtin_amdgcn_readfirstlane(misc[320 + u.pm]); u.cnt = __builtin_amdgcn_readfirstlane(misc[480 + u.e]);
        u.boff = (size_t)u.e * estride; return true;
    }
    __device__ __forceinline__ int arow(const Unit& u, int r) const { if (!GATHER_) return u.pm * BM + r; const int slot = u.s0 + r; const int tk = slot < u.cnt ? list[u.e * 16384 + slot] : 0; return tk >> 1; }
    __device__ __forceinline__ void a_ready(const Unit&) const {}
    __device__ __forceinline__ void done(const Unit&) const {}
};

__device__ __forceinline__ unsigned cvt_pk_bf16(float lo, float hi) { unsigned r; asm volatile("v_cvt_pk_bf16_f32 %0, %1, %2" : "=v"(r) : "v"(lo), "v"(hi)); return r; }
__device__ __forceinline__ u32x4 pack8(const f32x4& v0, const f32x4& v1) { u32x4 w; w.x = cvt_pk_bf16(v0[0], v0[1]); w.y = cvt_pk_bf16(v0[2], v0[3]); w.z = cvt_pk_bf16(v1[0], v1[1]); w.w = cvt_pk_bf16(v1[2], v1[3]); return w; }
__device__ __forceinline__ float fexp(float x) { return __builtin_amdgcn_exp2f(x * 1.44269504089f); }
__device__ __forceinline__ float silu_f(float x) { return x * __builtin_amdgcn_rcpf(1.0f + fexp(-x)); }

struct NoPre {};
template <bool BASE_BF16>
struct EpiRes {
    static constexpr bool PERM = true, AFTER_DRAIN = false, KSCALE = false;
    const void* base; bf16_t* out; int ldc;
    typedef NoPre Pre; __device__ __forceinline__ Pre pre(const Unit&, int, int) const { return Pre{}; }
    __device__ __forceinline__ void operator()(const f32x4 (&acc)[2][2][4][2], const Unit& u, int wr, int wc, int fr, int fq, const Pre&) const {
        const int row0 = u.pm * BM + wr * 64 + fr, col0 = u.pn * BM + wc * 32 + 8 * fq;
        static_assert(BASE_BF16, "only the bf16 residual base is in use");
#pragma unroll
        for (int ai = 0; ai < 2; ++ai) {
            u32x4 bw[4][2];
#pragma unroll
            for (int m = 0; m < 4; ++m) { const size_t off = (size_t)(row0 + ai * HALF + m * 16) * ldc + col0;
#pragma unroll
                for (int bj = 0; bj < 2; ++bj) bw[m][bj] = *(const u32x4*)((const bf16_t*)base + off + bj * HALF); }
            asm volatile("" ::: "memory");
#pragma unroll
            for (int m = 0; m < 4; ++m) { const size_t off = (size_t)(row0 + ai * HALF + m * 16) * ldc + col0;
#pragma unroll
                for (int bj = 0; bj < 2; ++bj) { const u32x4 w = bw[m][bj];
                    const f32x4 b0 = (f32x4){__uint_as_float(w.x << 16), __uint_as_float(w.x & 0xffff0000u), __uint_as_float(w.y << 16), __uint_as_float(w.y & 0xffff0000u)};
                    const f32x4 b1 = (f32x4){__uint_as_float(w.z << 16), __uint_as_float(w.z & 0xffff0000u), __uint_as_float(w.w << 16), __uint_as_float(w.w & 0xffff0000u)};
                    *(u32x4*)(out + off + bj * HALF) = pack8(b0 + acc[ai][bj][m][0], b1 + acc[ai][bj][m][1]); } }
            asm volatile("" ::: "memory");
        }
    }
};
struct EpiResHead {
    static constexpr bool PERM = true, AFTER_DRAIN = false, KSCALE = true;
    const bf16_t* base; bf16_t* out; int ldc; const float* SS;
    struct Pre { const PG8_LAS float* tab; };
    __device__ __forceinline__ Pre pre2(const Unit& u, PG8_LAS unsigned char* lds, int ui, int tid) const {
        PG8_LAS float* tab = (PG8_LAS float*)(lds + 131072 + (ui & 1) * 4096);
        if (tid < 256) { const size_t row = (size_t)u.pm * BM + tid; float r[4];
#pragma unroll
            for (int h = 0; h < 4; ++h) { const f32x4 p = *(const f32x4*)(SS + row * 16 + h * 4); r[h] = 1.0f / sqrtf(((p.x + p.y) + (p.z + p.w)) * (1.0f / 512.0f) + 1e-6f); }
            *(PG8_LAS f32x4*)(tab + tid * 4) = (f32x4){r[0] / r[1], r[1] / r[2], r[2] / r[3], r[3]}; }
        return Pre{tab};
    }
    __device__ __forceinline__ void kscale(f32x4 (&acc)[2][2][4][2], const Pre& pf, int b, int wr, int fr) const {
#pragma unroll
        for (int ai = 0; ai < 2; ++ai)
#pragma unroll
            for (int m = 0; m < 4; ++m) { const float f = pf.tab[(ai * HALF + wr * 64 + m * 16 + fr) * 4 + b];
#pragma unroll
                for (int bj = 0; bj < 2; ++bj)
#pragma unroll
                    for (int n = 0; n < 2; ++n) acc[ai][bj][m][n] = acc[ai][bj][m][n] * f; }
    }
    __device__ __forceinline__ void operator()(const f32x4 (&acc)[2][2][4][2], const Unit& u, int wr, int wc, int fr, int fq, const Pre& pf) const {
        const int row0 = u.pm * BM + wr * 64 + fr, col0 = u.pn * BM + wc * 32 + 8 * fq;
#pragma unroll
        for (int ai = 0; ai < 2; ++ai) {
            u32x4 bw[4][2]; float ff[4];
#pragma unroll
            for (int m = 0; m < 4; ++m) { const size_t off = (size_t)(row0 + ai * HALF + m * 16) * ldc + col0; ff[m] = pf.tab[(ai * HALF + wr * 64 + m * 16 + fr) * 4 + 3];
#pragma unroll
                for (int bj = 0; bj < 2; ++bj) bw[m][bj] = *(const u32x4*)(base + off + bj * HALF); }
            asm volatile("" ::: "memory");
#pragma unroll
            for (int m = 0; m < 4; ++m) { const size_t off = (size_t)(row0 + ai * HALF + m * 16) * ldc + col0; const float f = ff[m];
#pragma unroll
                for (int bj = 0; bj < 2; ++bj) { const u32x4 w = bw[m][bj];
                    const f32x4 b0 = (f32x4){__uint_as_float(w.x << 16), __uint_as_float(w.x & 0xffff0000u), __uint_as_float(w.y << 16), __uint_as_float(w.y & 0xffff0000u)};
                    const f32x4 b1 = (f32x4){__uint_as_float(w.z << 16), __uint_as_float(w.z & 0xffff0000u), __uint_as_float(w.w << 16), __uint_as_float(w.w & 0xffff0000u)};
                    *(u32x4*)(out + off + bj * HALF) = pack8(b0 + acc[ai][bj][m][0] * f, b1 + acc[ai][bj][m][1] * f); } }
            asm volatile("" ::: "memory");
        }
    }
};
struct EpiGlaIn {
    static constexpr bool PERM = true, AFTER_DRAIN = false, KSCALE = false;
    bf16_t *Qp, *Kp, *Vb, *Gb; const float* Bc; const float* rstd;
    struct Pre { float rs[2][4]; };
    __device__ __forceinline__ Pre pre(const Unit& u, int wr, int fr) const { Pre p; const int row0 = u.pm * BM + wr * 64 + fr;
#pragma unroll
        for (int ai = 0; ai < 2; ++ai)
#pragma unroll
            for (int m = 0; m < 4; ++m) p.rs[ai][m] = rstd[row0 + ai * HALF + m * 16];
        return p; }
    __device__ __forceinline__ void operator()(const f32x4 (&acc)[2][2][4][2], const Unit& u, int wr, int wc, int fr, int fq, const Pre& pf) const {
        const int row0 = u.pm * BM + wr * 64 + fr, cl = wc * 32 + 8 * fq, ct = u.pn;
        float rs[2][4];
#pragma unroll
        for (int ai = 0; ai < 2; ++ai)
#pragma unroll
            for (int m = 0; m < 4; ++m) rs[ai][m] = pf.rs[ai][m];
        if (ct < 8) {
            const bool isq = ct < 4; const int cb = (ct & 3) * 256 + cl; bf16_t* dst = isq ? Qp : Kp; const float sgn = isq ? 1.4426950408889634f : -1.4426950408889634f, mul = isq ? 0.0625f : 1.0f;
#pragma unroll
            for (int ai = 0; ai < 2; ++ai) {
                f32x4 bb[4][2][2];
#pragma unroll
                for (int m = 0; m < 4; ++m) { const size_t ro = (size_t)(row0 + ai * HALF + m * 16) * 1024;
#pragma unroll
                    for (int bj = 0; bj < 2; ++bj) { bb[m][bj][0] = *(const f32x4*)(Bc + ro + cb + bj * HALF); bb[m][bj][1] = *(const f32x4*)(Bc + ro + cb + bj * HALF + 4); } }
                asm volatile("" ::: "memory");
#pragma unroll
                for (int m = 0; m < 4; ++m) { const size_t ro = (size_t)(row0 + ai * HALF + m * 16) * 1024; const float rm = rs[ai][m] * mul;
#pragma unroll
                    for (int bj = 0; bj < 2; ++bj) { f32x4 v0 = acc[ai][bj][m][0], v1 = acc[ai][bj][m][1];
#pragma unroll
                        for (int j = 0; j < 4; ++j) { v0[j] *= __builtin_amdgcn_exp2f(sgn * bb[m][bj][0][j]) * rm; v1[j] *= __builtin_amdgcn_exp2f(sgn * bb[m][bj][1][j]) * rm; }
                        *(u32x4*)(dst + ro + cb + bj * HALF) = pack8(v0, v1); } }
                asm volatile("" ::: "memory");
            }
        } else if (ct < 16) {
            const int cb = (ct - 8) * 256 + cl;
#pragma unroll
            for (int ai = 0; ai < 2; ++ai)
#pragma unroll
                for (int m = 0; m < 4; ++m) { const size_t ro = (size_t)(row0 + ai * HALF + m * 16) * 2048;
#pragma unroll
                    for (int bj = 0; bj < 2; ++bj) *(u32x4*)(Vb + ro + cb + bj * HALF) = pack8(acc[ai][bj][m][0] * rs[ai][m], acc[ai][bj][m][1] * rs[ai][m]); }
        } else {
            const int cb = (ct - 16) * 256 + cl;
#pragma unroll
            for (int ai = 0; ai < 2; ++ai)
#pragma unroll
                for (int m = 0; m < 4; ++m) { const size_t ro = (size_t)(row0 + ai * HALF + m * 16) * 2048;
#pragma unroll
                    for (int bj = 0; bj < 2; ++bj) { f32x4 v0 = acc[ai][bj][m][0] * rs[ai][m], v1 = acc[ai][bj][m][1] * rs[ai][m];
#pragma unroll
                        for (int j = 0; j < 4; ++j) { v0[j] = silu_f(v0[j]); v1[j] = silu_f(v1[j]); }
                        *(u32x4*)(Gb + ro + cb + bj * HALF) = pack8(v0, v1); } }
        }
    }
};
struct EpiConvIn {
    static constexpr bool PERM = true, AFTER_DRAIN = false, KSCALE = false;
    bf16_t *BG, *U; const float* rstd;
    struct Pre { float rs[2][4]; };
    __device__ __forceinline__ Pre pre(const Unit& u, int wr, int fr) const { Pre p; const int row0 = u.pm * BM + wr * 64 + fr;
#pragma unroll
        for (int ai = 0; ai < 2; ++ai)
#pragma unroll
            for (int m = 0; m < 4; ++m) p.rs[ai][m] = rstd[row0 + ai * HALF + m * 16];
        return p; }
    __device__ __forceinline__ void operator()(const f32x4 (&acc)[2][2][4][2], const Unit& u, int wr, int wc, int fr, int fq, const Pre& pf) const {
        const int row0 = u.pm * BM + wr * 64 + fr, cl = wc * 32 + 8 * fq, ct = u.pn;
        float rs[2][4];
#pragma unroll
        for (int ai = 0; ai < 2; ++ai)
#pragma unroll
            for (int m = 0; m < 4; ++m) rs[ai][m] = pf.rs[ai][m];
        if (ct < 8) {
            const int cb = ct * 256 + cl;
#pragma unroll
            for (int ai = 0; ai < 2; ++ai)
#pragma unroll
                for (int m = 0; m < 4; ++m) { const size_t ro = (size_t)(row0 + ai * HALF + m * 16) * 2048;
#pragma unroll
                    for (int bj = 0; bj < 2; ++bj) *(u32x4*)(BG + ro + cb + bj * HALF) = pack8(acc[ai][bj][m][0] * rs[ai][m], acc[ai][bj][m][1] * rs[ai][m]); }
        } else {
            const int cb = (ct - 8) * 128 + cl;
#pragma unroll
            for (int ai = 0; ai < 2; ++ai)
#pragma unroll
                for (int m = 0; m < 4; ++m) { const size_t ro = (size_t)(row0 + ai * HALF + m * 16) * 2048; const float r2 = rs[ai][m] * rs[ai][m];
                    *(u32x4*)(U + ro + cb) = pack8(acc[ai][0][m][0] * acc[ai][1][m][0] * r2, acc[ai][0][m][1] * acc[ai][1][m][1] * r2); }
        }
    }
};
struct EpiGateUp {
    static constexpr bool PERM = true, AFTER_DRAIN = false, KSCALE = false;
    bf16_t* ACT; const int* list; const float* rstd;
    struct Pre { float rs[2][4]; };
    __device__ __forceinline__ Pre pre(const Unit& u, int wr, int fr) const { Pre p; const int rl0 = wr * 64 + fr;
#pragma unroll
        for (int ai = 0; ai < 2; ++ai)
#pragma unroll
            for (int m = 0; m < 4; ++m) { const int slot = u.s0 + rl0 + ai * HALF + m * 16; const int tk = slot < u.cnt ? list[u.e * 16384 + slot] : 0; p.rs[ai][m] = rstd[tk >> 1]; }
        return p; }
    __device__ __forceinline__ void operator()(const f32x4 (&acc)[2][2][4][2], const Unit& u, int wr, int wc, int fr, int fq, const Pre& pf) const {
        const int rl0 = wr * 64 + fr, row0 = u.pm * BM + rl0, cb = u.pn * 128 + wc * 32 + 8 * fq;
        float rs[2][4];
#pragma unroll
        for (int ai = 0; ai < 2; ++ai)
#pragma unroll
            for (int m = 0; m < 4; ++m) rs[ai][m] = pf.rs[ai][m];
#pragma unroll
        for (int ai = 0; ai < 2; ++ai)
#pragma unroll
            for (int m = 0; m < 4; ++m) { const size_t ro = (size_t)(row0 + ai * HALF + m * 16) * 512; const float r = rs[ai][m];
                f32x4 v0 = acc[ai][0][m][0] * r, v1 = acc[ai][0][m][1] * r;
#pragma unroll
                for (int j = 0; j < 4; ++j) { v0[j] = silu_f(v0[j]) * (acc[ai][1][m][0][j] * r); v1[j] = silu_f(v1[j]) * (acc[ai][1][m][1][j] * r); }
                *(u32x4*)(ACT + ro + cb) = pack8(v0, v1); }
    }
};
struct EpiDown {
    static constexpr bool PERM = true, AFTER_DRAIN = false, KSCALE = false;
    bf16_t* Y;
    typedef NoPre Pre; __device__ __forceinline__ Pre pre(const Unit&, int, int) const { return Pre{}; }
    __device__ __forceinline__ void operator()(const f32x4 (&acc)[2][2][4][2], const Unit& u, int wr, int wc, int fr, int fq, const Pre&) const {
        const int rl0 = wr * 64 + fr, row0 = u.pm * BM + rl0, cb = u.pn * 256 + wc * 32 + 8 * fq, nvalid = u.cnt - u.s0;
#pragma unroll
        for (int ai = 0; ai < 2; ++ai)
#pragma unroll
            for (int m = 0; m < 4; ++m) { if (rl0 + ai * HALF + m * 16 >= nvalid) continue; const size_t ro = (size_t)(row0 + ai * HALF + m * 16) * 2048;
#pragma unroll
                for (int bj = 0; bj < 2; ++bj) *(u32x4*)(Y + ro + cb + bj * HALF) = pack8(acc[ai][bj][m][0], acc[ai][bj][m][1]); }
    }
};

template <class Epi, class Sched, bool ALIGN_EPI = false>
__device__ __forceinline__ void gemm_phase(PG8_LAS unsigned char* lds, const Gemm g, const Sched& S, const Epi& E) {
    const int tid = threadIdx.x, wid = __builtin_amdgcn_readfirstlane(tid >> 6), lane = tid & 63, wr = wid >> 2, wc = wid & 3, fr = lane & 15, fq = lane >> 4;
    const int K = g.K, nt = K / BK;
    unsigned voffA[2], voffB[2]; int RA[2], CA[2];
#pragma unroll
    for (int i = 0; i < 2; ++i) { int R, C; stage_rc(tid * 16 + i * 8192, R, C); const int Rb = Epi::PERM ? ((R & ~31) + perm32(R & 31)) : R; RA[i] = R; CA[i] = C;
        voffA[i] = (unsigned)(R * K + C) * 2u; voffB[i] = (unsigned)(Rb * K + C) * 2u; }
    const size_t kstep = (size_t)(BK * 2);
    const size_t hstep = (size_t)HALF * K * 2;
    const size_t tstep = 2 * hstep;
    const size_t hstepA = Sched::GATHER ? 0 : hstep;
    const unsigned ldsw = (unsigned)wid * 1024u;
    const int aoff = lds_byte(wr * 64 + fr, fq * 8), boff = lds_byte(wc * 32 + fr, fq * 8);
#define PG8_SA(b, h) (((b) * 2 + (h)) * HTB)
#define PG8_SB(b, h) ((4 + (b) * 2 + (h)) * HTB)
#define PG8_STAGE(bufoff, gbase, voff) do { _Pragma("unroll") for (int _i = 0; _i < 2; ++_i) \
        __builtin_amdgcn_global_load_lds((const unsigned*)((const char*)(gbase) + (voff)[_i]), (PG8_LAS unsigned*)(lds + (bufoff) + ldsw + _i * 8192), 16, 0, 0); } while (0)
#define PG8_LDA(dst, b, h) do { _Pragma("unroll") for (int m = 0; m < 4; ++m) _Pragma("unroll") for (int k = 0; k < 2; ++k) dst[m][k] = *(const PG8_LAS bf16x8*)(lds + PG8_SA(b, h) + aoff + m * 2048 + k * 1024); } while (0)
#define PG8_LDB(dst, b, h) do { _Pragma("unroll") for (int n = 0; n < 2; ++n) _Pragma("unroll") for (int k = 0; k < 2; ++k) dst[n][k] = *(const PG8_LAS bf16x8*)(lds + PG8_SB(b, h) + boff + n * 2048 + k * 1024); } while (0)
#define PG8_MMA(ai, bj, At, Bt) do { __builtin_amdgcn_s_setprio(1); _Pragma("unroll") for (int m = 0; m < 4; ++m) _Pragma("unroll") for (int n = 0; n < 2; ++n) _Pragma("unroll") for (int k = 0; k < 2; ++k) \
        acc[ai][bj][m][n] = __builtin_amdgcn_mfma_f32_16x16x32_bf16(Bt[n][k], At[m][k], acc[ai][bj][m][n], 0, 0, 0); __builtin_amdgcn_s_setprio(0); } while (0)
#define PG8_WAIT_V(n) asm volatile("s_waitcnt vmcnt(" #n ")" ::: "memory")
#define PG8_WAIT_L(n) asm volatile("s_waitcnt lgkmcnt(" #n ")" ::: "memory")
#define PG8_BAR __builtin_amdgcn_s_barrier()
#define PG8_SCHED __builtin_amdgcn_sched_barrier(0)
    Unit cur, nxt; int ui = 0;
    if (!S.next(0, cur)) return;
    f32x4 acc[2][2][4][2];
#pragma unroll
    for (int a = 0; a < 2; ++a)
#pragma unroll
        for (int b = 0; b < 2; ++b)
#pragma unroll
            for (int m = 0; m < 4; ++m)
#pragma unroll
                for (int n = 0; n < 2; ++n) acc[a][b][m][n] = (f32x4){0.f, 0.f, 0.f, 0.f};
    bf16x8 At[4][2], B0[2][2], B1[2][2];
    unsigned vc0[2], vc1[2], vn0[2], vn1[2];
    if constexpr (Sched::GATHER) {
#pragma unroll
        for (int i = 0; i < 2; ++i) { vc0[i] = (unsigned)(S.arow(cur, RA[i]) * K + CA[i]) * 2u; vc1[i] = (unsigned)(S.arow(cur, RA[i] + HALF) * K + CA[i]) * 2u; vn0[i] = vc0[i]; vn1[i] = vc1[i]; }
    } else {
#pragma unroll
        for (int i = 0; i < 2; ++i) { vc0[i] = voffA[i]; vc1[i] = voffA[i]; vn0[i] = voffA[i]; vn1[i] = voffA[i]; }
    }
    const char* cA = Sched::GATHER ? (const char*)g.A : (const char*)g.A + (size_t)cur.pm * tstep; const char* cB = (const char*)g.Bt + cur.boff + (size_t)cur.pn * tstep;
    S.a_ready(cur);
    PG8_STAGE(PG8_SB(0, 0), cB, voffB); PG8_STAGE(PG8_SB(0, 1), cB + hstep, voffB); PG8_STAGE(PG8_SA(0, 0), cA, vc0); PG8_STAGE(PG8_SA(0, 1), cA + hstepA, vc1);
    if (wr == 1) PG8_BAR;
    PG8_WAIT_V(2); PG8_BAR;
    PG8_STAGE(PG8_SB(1, 0), cB + kstep, voffB); PG8_STAGE(PG8_SA(1, 0), cA + kstep, vc0); PG8_STAGE(PG8_SB(1, 1), cB + hstep + kstep, voffB);
    PG8_WAIT_V(6); PG8_BAR;
    for (;;) {
        typename Epi::Pre pf;
        if constexpr (Epi::KSCALE) pf = E.pre2(cur, lds, ui, tid); else pf = E.pre(cur, wr, fr);
        const bool has_next = S.next(ui + 1, nxt);
        if constexpr (Sched::GATHER) { if (has_next) {
#pragma unroll
            for (int i = 0; i < 2; ++i) { vn0[i] = (unsigned)(S.arow(nxt, RA[i]) * K + CA[i]) * 2u; vn1[i] = (unsigned)(S.arow(nxt, RA[i] + HALF) * K + CA[i]) * 2u; } } }
        const char* nA = Sched::GATHER ? (const char*)g.A : (has_next ? (const char*)g.A + (size_t)nxt.pm * tstep : cA); const char* nB = has_next ? (const char*)g.Bt + nxt.boff + (size_t)nxt.pn * tstep : cB;
        for (int t = 0; t < nt; t += 2) {
            const bool last = (t == nt - 2);
            const char* a1 = cA + (size_t)(t + 1) * kstep;
            const char* a2 = last ? nA : cA + (size_t)(t + 2) * kstep; const char* b2 = last ? nB : cB + (size_t)(t + 2) * kstep;
            const char* a3 = a2 + kstep; const char* b3 = b2 + kstep;
            unsigned w0[2], w1[2];
#pragma unroll
            for (int i = 0; i < 2; ++i) { w0[i] = (Sched::GATHER && last) ? vn0[i] : vc0[i]; w1[i] = (Sched::GATHER && last) ? vn1[i] : vc1[i]; }
            if (last && has_next) S.a_ready(nxt);
            PG8_LDB(B0, 0, 0); PG8_LDB(B1, 0, 1); PG8_SCHED; PG8_LDA(At, 0, 0); PG8_STAGE(PG8_SA(1, 1), a1 + hstepA, vc1);
            PG8_WAIT_V(8); PG8_WAIT_L(0); PG8_BAR; PG8_MMA(0, 0, At, B0); PG8_MMA(0, 1, At, B1); PG8_BAR; PG8_SCHED;
            PG8_LDA(At, 0, 1); PG8_STAGE(PG8_SB(0, 0), b2, voffB); PG8_STAGE(PG8_SB(0, 1), b2 + hstep, voffB); PG8_STAGE(PG8_SA(0, 0), a2, w0);
            PG8_WAIT_V(8); PG8_WAIT_L(0); PG8_BAR; PG8_MMA(1, 0, At, B0); PG8_MMA(1, 1, At, B1); PG8_BAR; PG8_SCHED;
            PG8_LDB(B0, 1, 0); PG8_LDB(B1, 1, 1); PG8_SCHED; PG8_LDA(At, 1, 0); PG8_STAGE(PG8_SA(0, 1), a2 + hstepA, w1);
            PG8_WAIT_V(8); PG8_WAIT_L(0); PG8_BAR; PG8_MMA(0, 0, At, B0); PG8_MMA(0, 1, At, B1); PG8_BAR; PG8_SCHED;
            PG8_LDA(At, 1, 1); PG8_STAGE(PG8_SB(1, 0), b3, voffB); PG8_STAGE(PG8_SB(1, 1), b3 + hstep, voffB); PG8_STAGE(PG8_SA(1, 0), a3, w0);
            PG8_WAIT_V(8); PG8_WAIT_L(0); PG8_BAR; PG8_MMA(1, 0, At, B0); PG8_MMA(1, 1, At, B1); PG8_BAR; PG8_SCHED;
            if constexpr (Epi::KSCALE) { if (((t + 2) & 7) == 0 && t + 2 < nt) { E.kscale(acc, pf, ((t + 2) >> 3) - 1, wr, fr); PG8_SCHED; } }
        }
        if constexpr (ALIGN_EPI) { if (wr == 0) PG8_BAR; }
        if constexpr (!Epi::AFTER_DRAIN) { E(acc, cur, wr, wc, fr, fq, pf); S.done(cur); }
        if (!has_next) break;
#pragma unroll
        for (int a = 0; a < 2; ++a)
#pragma unroll
            for (int b = 0; b < 2; ++b)
#pragma unroll
                for (int m = 0; m < 4; ++m)
#pragma unroll
                    for (int n = 0; n < 2; ++n) acc[a][b][m][n] = (f32x4){0.f, 0.f, 0.f, 0.f};
        cur = nxt; cA = nA; cB = nB; ++ui;
        if constexpr (Sched::GATHER) {
#pragma unroll
            for (int i = 0; i < 2; ++i) { vc0[i] = vn0[i]; vc1[i] = vn1[i]; } }
        if constexpr (ALIGN_EPI) { if (wr == 1) PG8_BAR; }
    }
    PG8_WAIT_V(0);
    if constexpr (!ALIGN_EPI) { if (wr == 0) PG8_BAR; }
    PG8_BAR;
#undef PG8_SA
#undef PG8_SB
#undef PG8_STAGE
#undef PG8_LDA
#undef PG8_LDB
#undef PG8_MMA
#undef PG8_WAIT_V
#undef PG8_WAIT_L
#undef PG8_BAR
#undef PG8_SCHED
}
}

constexpr int NWAVES = 8;
enum { PH_CONV = 0, PH_NORM0, PH_GIN, PH_GLA1, PH_GLA2, PH_HNORM, PH_GOUT, PH_MOE0  , PH_CIN = PH_MOE0 + 5, PH_CONVE, PH_COUT, PH_MOE1, NPH = PH_MOE1 + 5 };
constexpr int N_LAUNCHES = (MK_N_LAUNCHES == 1) ? 1 : NPH;

constexpr int T = 16384, D = 2048;
constexpr int KD = 1024, VD = 2048, GIN = 6160, GINM = 6144, DKH = 256, DVH = 512, NHEAD = 4, CHK = 64, NCHUNK = T / CHK, RANK = 16;
constexpr int NE = 32, FF = 512, NGRP = 4, EPG = 8, NLOG = 48;
constexpr int MAX_RT = 160;
constexpr float EPS = 1e-6f;

constexpr size_t MiB = 1u << 20;
constexpr size_t WS_CTL = 0, CTL_ZERO_BYTES = 65536;
constexpr size_t WS_SS = 1 * MiB;
constexpr size_t WS_TKE = 2 * MiB;
constexpr size_t WS_TKS = WS_TKE + 131072;
constexpr size_t WS_TKG = WS_TKS + 131072;
constexpr size_t WS_RSTD = WS_TKG + 131072;
constexpr size_t WS_LIST = 3 * MiB;
constexpr size_t WS_WRT = 5 * MiB;
constexpr size_t WS_WRH = 6 * MiB;
constexpr size_t WS_WRL = WS_WRH + 393216;
constexpr size_t WS_WGH = 7 * MiB;
constexpr size_t WS_WGL = WS_WGH + 65536;
constexpr size_t WS_WGI = 8 * MiB;
constexpr size_t WS_WGO = 32 * MiB;
constexpr size_t WS_WCI = 40 * MiB;
constexpr size_t WS_WCO = 64 * MiB;
constexpr size_t WS_WGU = 72 * MiB;
constexpr size_t WS_WDN = 328 * MiB;
constexpr size_t WS_HN = 456 * MiB;
constexpr size_t WS_BC = 520 * MiB;
constexpr size_t WS_QP = 584 * MiB;
constexpr size_t WS_KP = 616 * MiB;
constexpr size_t WS_VB = 648 * MiB;
constexpr size_t WS_GB = 712 * MiB;
constexpr size_t WS_O = 776 * MiB;
constexpr size_t WS_OG = 904 * MiB;
constexpr size_t WS_H1 = 968 * MiB;
constexpr size_t WS_H2 = 1096 * MiB;
constexpr size_t WS_XS = 1224 * MiB;
constexpr size_t WS_ACT = 1384 * MiB;
constexpr size_t WS_Y = 1424 * MiB;
constexpr size_t WS_SEND = 1584 * MiB;
constexpr size_t WS_GTOT = 1616 * MiB;
constexpr size_t WS_END = 1617 * MiB;
constexpr int CW_TMO = 0, CW_CODE = 1;
constexpr int CW_BAR = 4096;
constexpr int CW_CNT = 8192;

constexpr int RING_OFF = 0, RING_BYTES = 131072;
constexpr int SCR_OFF = 131072, SCR_BYTES = 8192;
constexpr int MISC_OFF = SCR_OFF + SCR_BYTES;
constexpr int MISC_BYTES = 2048;
constexpr int LDS_BYTES = 147456;
static_assert(MISC_OFF + MISC_BYTES <= LDS_BYTES, "LDS map");
constexpr int MI_PSTART = 16, MI_NRT = 49, MI_TEXP = 64, MI_CNTL = 256, MI_BASEL = 288, MI_TSLOT = 320, MI_ECNT = 480;
static_assert(MI_TEXP == 64 && MI_TSLOT == 320 && MI_ECNT == 480, "pg8::MoeOrder reads these words by number");

#define GAS __attribute__((address_space(1)))
#define LAS __attribute__((address_space(3)))
typedef unsigned short bf16;
typedef unsigned v4u __attribute__((ext_vector_type(4)));
typedef unsigned v2u __attribute__((ext_vector_type(2)));
typedef float f32x4 __attribute__((ext_vector_type(4)));
typedef GAS unsigned gu32;
#define RLX_AGENT __ATOMIC_RELAXED, __HIP_MEMORY_SCOPE_AGENT
#define LDS_WAIT() asm volatile("s_waitcnt lgkmcnt(0)" ::: "memory")
#define VM_WAIT() asm volatile("s_waitcnt vmcnt(0)" ::: "memory")
__device__ __forceinline__ unsigned f2bf(float f) { unsigned u = __builtin_bit_cast(unsigned, f); return (u + 0x7fffu + ((u >> 16) & 1u)) >> 16; }
__device__ __forceinline__ unsigned pk2(float lo, float hi) { return f2bf(lo) | (f2bf(hi) << 16); }
__device__ __forceinline__ float bflo(unsigned w) { return __uint_as_float(w << 16); }
__device__ __forceinline__ float bfhi(unsigned w) { return __uint_as_float(w & 0xffff0000u); }
__device__ __forceinline__ f32x4 bf4lo(const v4u& w) { return (f32x4){bflo(w.x), bfhi(w.x), bflo(w.y), bfhi(w.y)}; }
__device__ __forceinline__ f32x4 bf4hi(const v4u& w) { return (f32x4){bflo(w.z), bfhi(w.z), bflo(w.w), bfhi(w.w)}; }

#define XB_TMO      128
#define XB_XCNT(j)  (256  + 64 * (j))
#define XB_XSUB(j)  (1280 + 64 * (j))
#define XB_XGEN(j)  (2304 + 64 * (j))
#define XB_TOP      3328
#define XB_TOPGEN   3392
#define XCD_BAR_WORDS 3456
#define XB_SPIN_CAP (1u << 22)
__device__ __forceinline__ unsigned xb_ld(unsigned* p)              { return __hip_atomic_load(p, __ATOMIC_RELAXED, __HIP_MEMORY_SCOPE_AGENT); }
__device__ __forceinline__ unsigned xb_add(unsigned* p, unsigned v) { return __hip_atomic_fetch_add(p, v, __ATOMIC_RELAXED, __HIP_MEMORY_SCOPE_AGENT); }
__device__ __forceinline__ unsigned xb_xcc_id() { return (unsigned)__builtin_amdgcn_s_getreg((3 << 11) | 20) & 0xFu; }
#define XB_SPIN(cond, bar) do { unsigned _sp = 0; while (cond) { __builtin_amdgcn_s_sleep(1); \
    if ((++_sp & 255u) == 0u) { if (xb_ld(&(bar)[XB_TMO])) break; if (_sp > XB_SPIN_CAP) { atomicAdd(&(bar)[XB_TMO], 1u); break; } } } } while (0)
struct XcdBarrier { unsigned* bar; unsigned x; volatile LAS unsigned* st; };
__device__ __forceinline__ XcdBarrier xcd_barrier_post(unsigned* bar, volatile LAS unsigned* st) {
    XcdBarrier b; b.bar = bar; b.x = xb_xcc_id(); b.st = st;
    if (threadIdx.x == 0) (void)xb_add(&bar[XB_XCNT(b.x)], 1u);
    return b;
}
__device__ __forceinline__ void xcd_barrier_complete(unsigned* bar, unsigned x, unsigned& nloc, unsigned& nx) {
    const unsigned G = gridDim.x * gridDim.y * gridDim.z;
    unsigned sum, cnt, mine, sp = 0u;
    for (;;) {
        sum = 0u; cnt = 0u; mine = 0u;
#pragma unroll
        for (unsigned j = 0; j < 16; ++j) { const unsigned c = xb_ld(&bar[XB_XCNT(j)]); sum += c; cnt += (c > 0u) ? 1u : 0u; mine = (j == x) ? c : mine; }
        if (sum == G) break;
        __builtin_amdgcn_s_sleep(1);
        if ((++sp & 255u) == 0u) { if (xb_ld(&bar[XB_TMO])) break; if (sp > XB_SPIN_CAP) { atomicAdd(&bar[XB_TMO], 1u); break; } }
    }
    nloc = mine > 0u ? mine : 1u; nx = cnt > 0u ? cnt : 1u;
}
__device__ __forceinline__ void xcd_barrier(const XcdBarrier& b) {
    asm volatile("s_waitcnt vmcnt(0)" ::: "memory");
    __syncthreads();
    if (threadIdx.x == 0) {
        unsigned* bar = b.bar;
        __builtin_amdgcn_s_waitcnt(0);
        unsigned nloc = b.st[0], nx = b.st[1];
        if (nloc == 0u) { xcd_barrier_complete(bar, b.x, nloc, nx); b.st[0] = nloc; b.st[1] = nx; }
        const unsigned old = xb_add(&bar[XB_XSUB(b.x)], 1u);
        const unsigned gen = old / nloc;
        if (old + 1u == (gen + 1u) * nloc) {
            __builtin_amdgcn_fence(__ATOMIC_RELEASE, "agent");
            asm volatile("s_waitcnt vmcnt(0)" ::: "memory");
            const unsigned og = xb_add(&bar[XB_TOP], 1u);
            const unsigned tg = og / nx;
            if (og + 1u == (tg + 1u) * nx) xb_add(&bar[XB_TOPGEN], 1u);
            else XB_SPIN(xb_ld(&bar[XB_TOPGEN]) == tg, bar);
            __builtin_amdgcn_fence(__ATOMIC_ACQUIRE, "agent");
            xb_add(&bar[XB_XGEN(b.x)], 1u);
            asm volatile("s_waitcnt vmcnt(0)" ::: "memory");
        } else {
            XB_SPIN(xb_ld(&bar[XB_XGEN(b.x)]) == gen, bar);
            __builtin_amdgcn_fence(__ATOMIC_ACQUIRE, "agent");
            asm volatile("s_waitcnt vmcnt(0)" ::: "memory");
        }
    }
    __syncthreads();
}

struct Frame {
    LAS unsigned char* lds;
    volatile LAS int* MISC;
    unsigned* ctl;
    int tid, lane, wave, G;
    unsigned long long tp_t0, tp_acc;
    __attribute__((address_space(4))) const unsigned char* ka;
};
#define KIN(i) (*(const float* const __attribute__((address_space(4)))*)(F.ka + 8 * (i)))
#define KOUT   (*(float* const __attribute__((address_space(4)))*)(F.ka + 8 * 18))
#define KWS    (*(unsigned char* const __attribute__((address_space(4)))*)(F.ka + 8 * 19))
#define TPROBE_MASK 0u
#define TPROBE_MULT 4
#define TP_BEGIN(k) do { if ((TPROBE_MASK >> (k)) & 1u) { if (F.tid == 0) F.MISC[50] = (int)__builtin_amdgcn_s_memrealtime(); } } while (0)
#define TP_END(k) do { if ((TPROBE_MASK >> (k)) & 1u) { if (F.tid == 0) F.MISC[51] = F.MISC[51] + ((int)__builtin_amdgcn_s_memrealtime() - F.MISC[50]); } } while (0)
__device__ __forceinline__ float wave_sum(float v) {
#pragma unroll
    for (int o = 1; o < 64; o <<= 1) v += __shfl_xor(v, o);
    return v;
}

struct XTile { const float* W; bf16* WT; const float* ks; int K, ldw, kb, nb, kind; };
constexpr int XT_LD = 257;
__device__ __forceinline__ void xtile_load(const XTile& t, f32x4 (&v)[16], int w, int lane) {
    const float* p = t.W + (size_t)(128 * t.kb + 16 * w) * t.ldw + 256 * t.nb + 4 * lane;
#pragma unroll
    for (int i = 0; i < 16; ++i) v[i] = __builtin_nontemporal_load((const f32x4*)(p + (size_t)i * t.ldw));
}
__device__ __forceinline__ void xtile_to_lds(const XTile& t, const f32x4 (&v)[16], LAS unsigned* buf, int w, int lane) {
    float sc[16];
#pragma unroll
    for (int i = 0; i < 16; ++i) sc[i] = t.ks ? t.ks[128 * t.kb + 16 * w + i] : 1.0f;
#pragma unroll
    for (int i = 0; i < 8; ++i) { LAS unsigned* d = buf + (8 * w + i) * XT_LD + 4 * lane; const f32x4 a = v[2 * i] * sc[2 * i], b = v[2 * i + 1] * sc[2 * i + 1];
        d[0] = pk2(a.x, b.x); d[1] = pk2(a.y, b.y); d[2] = pk2(a.z, b.z); d[3] = pk2(a.w, b.w); }
}
__device__ __forceinline__ int conv_in_row(int n) { if (n < 2048) return n; const int s = (n - 2048) >> 11, f = (n - 2048) & 2047; return 2048 + 256 * (f >> 7) + 128 * s + (f & 127); }
__device__ __forceinline__ int gate_up_row(int n) { const int s = n >> 9, f = n & 511; return 256 * (f >> 7) + 128 * s + (f & 127); }

__device__ __forceinline__ XTile xtile_decode(Frame& F, int r) {
    constexpr int T_GI = 16 * 24, T_GO = 16 * 8, T_CI = 16 * 24, T_CO = 16 * 8, T_GU1 = 16 * 4, T_DN1 = 4 * 8, T_GU = T_GU1 * 64;
    bf16* WGI = (bf16*)(KWS + WS_WGI); bf16* WGO = (bf16*)(KWS + WS_WGO); bf16* WCI = (bf16*)(KWS + WS_WCI); bf16* WCO = (bf16*)(KWS + WS_WCO);
    bf16* WGU = (bf16*)(KWS + WS_WGU); bf16* WDN = (bf16*)(KWS + WS_WDN);
    XTile t; t.kind = 0; t.ks = nullptr;
    if (r < T_GI) { t.kb = r / 24; t.nb = r % 24; t.W = KIN(2); t.K = 2048; t.ldw = GIN; t.WT = WGI; t.ks = KIN(1); return t; } r -= T_GI;
    if (r < T_GO) { t.kb = r / 8; t.nb = r % 8; t.W = KIN(6); t.K = 2048; t.ldw = 2048; t.WT = WGO; return t; } r -= T_GO;
    if (r < T_CI) { t.kb = r / 24; t.nb = r % 24; t.W = KIN(7); t.K = 2048; t.ldw = 6144; t.WT = WCI; t.kind = 1; t.ks = KIN(1) + D; return t; } r -= T_CI;
    if (r < T_CO) { t.kb = r / 8; t.nb = r % 8; t.W = KIN(9); t.K = 2048; t.ldw = 2048; t.WT = WCO; return t; } r -= T_CO;
    if (r < T_GU) { const int le = r / T_GU1, q = r % T_GU1; t.kb = q / 4; t.nb = q % 4; t.W = KIN(15) + (size_t)le * 2048 * 1024; t.K = 2048; t.ldw = 1024; t.WT = WGU + (size_t)le * 1024 * 2048; t.kind = 2; t.ks = KIN(10) + (le >> 5) * D; return t; } r -= T_GU;
    { const int le = r / T_DN1, q = r % T_DN1; t.kb = q / 8; t.nb = q % 8; t.W = KIN(16) + (size_t)le * 512 * 2048; t.K = 512; t.ldw = 2048; t.WT = WDN + (size_t)le * 2048 * 512; return t; }
}
__device__ __forceinline__ void xtile_store(const XTile& t, const LAS unsigned* buf, int w, int lane) {
    const int n0 = 256 * t.nb + 32 * w, dr0 = t.kind == 1 ? conv_in_row(n0) : t.kind == 2 ? gate_up_row(n0) : n0;
    const int c = lane & 15, k0 = 128 * t.kb;
#pragma unroll
    for (int j = 0; j < 8; ++j) { const int n = (lane >> 4) + 4 * j; const LAS unsigned* s = buf + (4 * c) * XT_LD + 32 * w + n;
        v4u o; o.x = s[0]; o.y = s[XT_LD]; o.z = s[2 * XT_LD]; o.w = s[3 * XT_LD];
        __builtin_nontemporal_store(o, (v4u*)(t.WT + (size_t)(dr0 + n) * t.K + k0 + 8 * c)); }
}
__device__ __forceinline__ void p0_convert(Frame& F) {
    constexpr int NTILES = 16 * 24 + 16 * 8 + 16 * 24 + 16 * 8 + 16 * 4 * 64 + 4 * 8 * 64;
    static_assert(2 * 64 * XT_LD * 4 <= MISC_OFF, "convert LDS");
    {
        f32x4 v[16]; XTile cur, nxt; int i = 0;
        int t = blockIdx.x;
        if (t < NTILES) { cur = xtile_decode(F, t); xtile_load(cur, v, F.wave, F.lane); }
        for (; t < NTILES; t += F.G, ++i) {
            LAS unsigned* buf = (LAS unsigned*)(F.lds) + (i & 1) * 64 * XT_LD;
            xtile_to_lds(cur, v, buf, F.wave, F.lane);
            asm volatile("s_waitcnt lgkmcnt(0)" ::: "memory"); __builtin_amdgcn_s_barrier(); asm volatile("" ::: "memory");
            const bool hn = t + F.G < NTILES;
            if (hn) { nxt = xtile_decode(F, t + F.G); xtile_load(nxt, v, F.wave, F.lane); }
            asm volatile("" ::: "memory");
            xtile_store(cur, buf, F.wave, F.lane);
            if (hn) cur = nxt;
        }
        __syncthreads();
    }
    bf16* WRH = (bf16*)(KWS + WS_WRH); bf16* WRL = (bf16*)(KWS + WS_WRL);
    for (int i = blockIdx.x * 512 + F.tid; i < 2 * NLOG * 2048; i += F.G * 512) {
        const int l = i / (NLOG * 2048), c = (i / 2048) % NLOG, k = i % 2048;
        float w = 0.f;
        if (c < 4) w = KIN(11)[((size_t)l * 2048 + k) * 4 + c]; else if (c < 36) w = KIN(13)[((size_t)l * 2048 + k) * 32 + (c - 4)];
        w *= KIN(10)[l * 2048 + k];
        const unsigned h = f2bf(w); WRH[i] = (bf16)h; WRL[i] = (bf16)f2bf(w - __uint_as_float(h << 16));
    }
    bf16* WGH = (bf16*)(KWS + WS_WGH); bf16* WGL = (bf16*)(KWS + WS_WGL);
    for (int i = blockIdx.x * 512 + F.tid; i < 16 * 2048; i += F.G * 512) {
        const int k = i >> 4, r = i & 15; const float w = KIN(2)[(size_t)k * GIN + GINM + r] * KIN(1)[k];
        const unsigned h = f2bf(w); WGH[r * 2048 + k] = (bf16)h; WGL[r * 2048 + k] = (bf16)f2bf(w - __uint_as_float(h << 16));
    }
}

typedef short rb_bf16x8 __attribute__((ext_vector_type(8)));
typedef float rb_f32x2 __attribute__((ext_vector_type(2))); typedef __bf16 rb_bf16x2 __attribute__((ext_vector_type(2)));
__device__ __forceinline__ unsigned rb_cvtpk(float lo, float hi) { rb_f32x2 v = {lo, hi}; rb_bf16x2 b = __builtin_convertvector(v, rb_bf16x2); return __builtin_bit_cast(unsigned, b); }
constexpr int RB_LD = 1040;
template <int NC>
__device__ __forceinline__ void rowblock_mfma(Frame& F, const float* X, const bf16* WH, const bf16* WL, LAS float* part, LAS float* sqp, bf16* HNrows) {
    const int w = F.wave, lane = F.lane, r = lane & 15, q = lane >> 4;
    LAS unsigned char* img = F.lds;
    f32x4 acc[4][NC]; float ss[4];
#pragma unroll
    for (int rt = 0; rt < 4; ++rt) { ss[rt] = 0.f;
#pragma unroll
        for (int c = 0; c < NC; ++c) acc[rt][c] = (f32x4){0.f, 0.f, 0.f, 0.f}; }
    const GAS char* xb = (const GAS char*)X; const GAS char* whb = (const GAS char*)WH; const GAS char* wlb = (const GAS char*)WL; GAS char* hb = (GAS char*)HNrows;
    const unsigned xo = (unsigned)((8 * w) * D + 4 * lane) * 4u;
    const unsigned wo = (unsigned)(r * 2048 + w * 32 + 8 * q) * 2u;
    f32x4 xr[8]; rb_bf16x8 bh[NC], bl[NC], bhn[NC], bln[NC];
#pragma unroll
    for (int i = 0; i < 8; ++i) xr[i] = __builtin_nontemporal_load((const GAS f32x4*)(xb + i * D * 4 + xo));
#pragma unroll
    for (int c = 0; c < NC; ++c) { bhn[c] = *(const GAS rb_bf16x8*)(whb + c * 16 * 2048 * 2 + wo); bln[c] = *(const GAS rb_bf16x8*)(wlb + c * 16 * 2048 * 2 + wo); }
    __syncthreads();
#pragma unroll 1
    for (int ch = 0; ch < 8; ++ch) {
#pragma unroll
        for (int i = 0; i < 8; ++i) { *(LAS f32x4*)(img + (8 * w + i) * RB_LD + 16 * lane) = xr[i];
            const f32x4 y = xr[i]; v2u o; o.x = rb_cvtpk(y.x, y.y); o.y = rb_cvtpk(y.z, y.w); *(GAS v2u*)(hb + (8 * w + i) * D * 2 + (unsigned)(ch * 256 + 4 * lane) * 2u) = o; }
#pragma unroll
        for (int c = 0; c < NC; ++c) { bh[c] = bhn[c]; bl[c] = bln[c]; }
        asm volatile("s_waitcnt lgkmcnt(0)" ::: "memory"); __builtin_amdgcn_s_barrier(); asm volatile("" ::: "memory");
        if (ch + 1 < 8) {
#pragma unroll
            for (int i = 0; i < 8; ++i) xr[i] = __builtin_nontemporal_load((const GAS f32x4*)(xb + i * D * 4 + (xo + (ch + 1) * 1024)));
#pragma unroll
            for (int c = 0; c < NC; ++c) { bhn[c] = *(const GAS rb_bf16x8*)(whb + c * 16 * 2048 * 2 + (wo + (ch + 1) * 512)); bln[c] = *(const GAS rb_bf16x8*)(wlb + c * 16 * 2048 * 2 + (wo + (ch + 1) * 512)); }
        }
        asm volatile("" ::: "memory");
#pragma unroll
        for (int rt = 0; rt < 4; ++rt) {
            const LAS unsigned char* fp = img + (16 * rt + r) * RB_LD + w * 128 + q * 32;
            const f32x4 a = *(const LAS f32x4*)fp, b = *(const LAS f32x4*)(fp + 16);
            ss[rt] += (a.x * a.x + a.y * a.y) + (a.z * a.z + a.w * a.w) + (b.x * b.x + b.y * b.y) + (b.z * b.z + b.w * b.w);
            v4u h; h.x = rb_cvtpk(a.x, a.y); h.y = rb_cvtpk(a.z, a.w); h.z = rb_cvtpk(b.x, b.y); h.w = rb_cvtpk(b.z, b.w);
            v4u l; l.x = rb_cvtpk(a.x - bflo(h.x), a.y - bfhi(h.x)); l.y = rb_cvtpk(a.z - bflo(h.y), a.w - bfhi(h.y)); l.z = rb_cvtpk(b.x - bflo(h.z), b.y - bfhi(h.z)); l.w = rb_cvtpk(b.z - bflo(h.w), b.w - bfhi(h.w));
            const rb_bf16x8 ah = __builtin_bit_cast(rb_bf16x8, h), al = __builtin_bit_cast(rb_bf16x8, l);
#pragma unroll
            for (int c = 0; c < NC; ++c) { acc[rt][c] = __builtin_amdgcn_mfma_f32_16x16x32_bf16(ah, bh[c], acc[rt][c], 0, 0, 0); acc[rt][c] = __builtin_amdgcn_mfma_f32_16x16x32_bf16(ah, bl[c], acc[rt][c], 0, 0, 0);
                acc[rt][c] = __builtin_amdgcn_mfma_f32_16x16x32_bf16(al, bh[c], acc[rt][c], 0, 0, 0); }
        }
        asm volatile("s_waitcnt lgkmcnt(0)" ::: "memory"); __builtin_amdgcn_s_barrier(); asm volatile("" ::: "memory");
    }
#pragma unroll
    for (int rt = 0; rt < 4; ++rt) {
#pragma unroll
        for (int c = 0; c < NC; ++c)
#pragma unroll
            for (int j = 0; j < 4; ++j) part[(w * 64 + rt * 16 + 4 * q + j) * (NC * 16) + c * 16 + r] = acc[rt][c][j];
        float t = ss[rt]; t += __shfl_xor(t, 16); t += __shfl_xor(t, 32);
        if (q == 0) sqp[w * 64 + rt * 16 + r] = t;
    }
}

constexpr int RBB_LD = 528;
template <int NC>
__device__ __forceinline__ void rowblock_bf16(Frame& F, const bf16* X, const bf16* WH, const bf16* WL, LAS float* part, LAS float* sqp) {
    const int w = F.wave, lane = F.lane, r = lane & 15, q = lane >> 4;
    LAS unsigned char* img = F.lds;
    f32x4 acc[4][NC]; float ss[4];
#pragma unroll
    for (int rt = 0; rt < 4; ++rt) { ss[rt] = 0.f;
#pragma unroll
        for (int c = 0; c < NC; ++c) acc[rt][c] = (f32x4){0.f, 0.f, 0.f, 0.f}; }
    const GAS char* xb = (const GAS char*)X; const GAS char* whb = (const GAS char*)WH; const GAS char* wlb = (const GAS char*)WL;
    const int lr = lane >> 5, lc = lane & 31;
    const unsigned xo = (unsigned)((8 * w + lr) * D + 8 * lc) * 2u;
    const unsigned wo = (unsigned)(r * 2048 + w * 32 + 8 * q) * 2u;
    v4u xr[4]; rb_bf16x8 bh[NC], bl[NC], bhn[NC], bln[NC];
#pragma unroll
    for (int i = 0; i < 4; ++i) xr[i] = *(const GAS v4u*)(xb + i * 2 * D * 2 + xo);
#pragma unroll
    for (int c = 0; c < NC; ++c) { bhn[c] = *(const GAS rb_bf16x8*)(whb + c * 16 * 2048 * 2 + wo); bln[c] = *(const GAS rb_bf16x8*)(wlb + c * 16 * 2048 * 2 + wo); }
    __syncthreads();
#pragma unroll 1
    for (int ch = 0; ch < 8; ++ch) {
#pragma unroll
        for (int i = 0; i < 4; ++i) *(LAS v4u*)(img + (8 * w + 2 * i + lr) * RBB_LD + 16 * lc) = xr[i];
#pragma unroll
        for (int c = 0; c < NC; ++c) { bh[c] = bhn[c]; bl[c] = bln[c]; }
        asm volatile("s_waitcnt lgkmcnt(0)" ::: "memory"); __builtin_amdgcn_s_barrier(); asm volatile("" ::: "memory");
        if (ch + 1 < 8) {
#pragma unroll
            for (int i = 0; i < 4; ++i) xr[i] = *(const GAS v4u*)(xb + i * 2 * D * 2 + (xo + (ch + 1) * 512));
#pragma unroll
            for (int c = 0; c < NC; ++c) { bhn[c] = *(const GAS rb_bf16x8*)(whb + c * 16 * 2048 * 2 + (wo + (ch + 1) * 512)); bln[c] = *(const GAS rb_bf16x8*)(wlb + c * 16 * 2048 * 2 + (wo + (ch + 1) * 512)); }
        }
        asm volatile("" ::: "memory");
#pragma unroll
        for (int rt = 0; rt < 4; ++rt) {
            const v4u a = *(const LAS v4u*)(img + (16 * rt + r) * RBB_LD + w * 64 + q * 16);
            { const float e0 = bflo(a.x), e1 = bfhi(a.x), e2 = bflo(a.y), e3 = bfhi(a.y), e4 = bflo(a.z), e5 = bfhi(a.z), e6 = bflo(a.w), e7 = bfhi(a.w);
              ss[rt] += (e0 * e0 + e1 * e1) + (e2 * e2 + e3 * e3) + (e4 * e4 + e5 * e5) + (e6 * e6 + e7 * e7); }
            const rb_bf16x8 ah = __builtin_bit_cast(rb_bf16x8, a);
#pragma unroll
            for (int c = 0; c < NC; ++c) { acc[rt][c] = __builtin_amdgcn_mfma_f32_16x16x32_bf16(ah, bh[c], acc[rt][c], 0, 0, 0); acc[rt][c] = __builtin_amdgcn_mfma_f32_16x16x32_bf16(ah, bl[c], acc[rt][c], 0, 0, 0); }
        }
        asm volatile("s_waitcnt lgkmcnt(0)" ::: "memory"); __builtin_amdgcn_s_barrier(); asm volatile("" ::: "memory");
    }
#pragma unroll
    for (int rt = 0; rt < 4; ++rt) {
#pragma unroll
        for (int c = 0; c < NC; ++c)
#pragma unroll
            for (int j = 0; j < 4; ++j) part[(w * 64 + rt * 16 + 4 * q + j) * (NC * 16) + c * 16 + r] = acc[rt][c][j];
        float t = ss[rt]; t += __shfl_xor(t, 16); t += __shfl_xor(t, 32);
        if (q == 0) sqp[w * 64 + rt * 16 + r] = t;
    }
}

__device__ __forceinline__ void p0_norm_gl(Frame& F) {
    LAS float* part = (LAS float*)(F.lds);
    LAS float* sqp = (LAS float*)(F.lds + 32768);
    LAS float* glc = (LAS float*)(F.lds + 32768 + 2048);
    LAS float* rs = (LAS float*)(F.lds + 32768 + 2048 + 4096);
    const float* x = KIN(0); const float* wn = KIN(1); bf16* HN = (bf16*)(KWS + WS_HN); float* BC = (float*)(KWS + WS_BC); float* RSTD = (float*)(KWS + WS_RSTD);
    const float* w2 = KIN(3); const float* bgk = KIN(4);
    for (int ch = blockIdx.x; ch < NCHUNK; ch += F.G) {
        TP_BEGIN(22); rowblock_mfma<1>(F, x + (size_t)ch * CHK * D, (const bf16*)(KWS + WS_WGH), (const bf16*)(KWS + WS_WGL), part, sqp, HN + (size_t)ch * CHK * D);
        __syncthreads(); TP_END(22); TP_BEGIN(23);
        if (F.tid < 64) { float t = 0.f;
#pragma unroll
            for (int w = 0; w < 8; ++w) t += sqp[w * 64 + F.tid];
            const float rstd = 1.0f / sqrtf(t * (1.0f / D) + EPS); rs[F.tid] = rstd; RSTD[ch * CHK + F.tid] = rstd; }
        __syncthreads();
#pragma unroll
        for (int i = 0; i < 2; ++i) { const int idx = F.tid + 512 * i; float t = 0.f;
#pragma unroll
            for (int w = 0; w < 8; ++w) t += part[w * 1024 + idx];
            glc[idx] = t * rs[idx >> 4]; }
        __syncthreads();
        {
            const int c0 = F.tid, c1 = F.tid + 512; float wa[16], wb[16];
#pragma unroll
            for (int r = 0; r < 16; ++r) { wa[r] = w2[r * KD + c0]; wb[r] = w2[r * KD + c1]; }
            const float ba = bgk[c0], bb = bgk[c1]; float cuma = 0.f, cumb = 0.f;
#pragma unroll 2
            for (int t = 0; t < CHK; ++t) {
                float za = ba, zb = bb;
#pragma unroll
                for (int r = 0; r < 16; ++r) { const float g = glc[t * 16 + r]; za += g * wa[r]; zb += g * wb[r]; }
                const float la = fminf(za, 0.f) - __logf(1.0f + __expf(-fabsf(za))), lb = fminf(zb, 0.f) - __logf(1.0f + __expf(-fabsf(zb)));
                cuma += la * (1.0f / 16.0f); cumb += lb * (1.0f / 16.0f);
                BC[(size_t)(ch * CHK + t) * KD + c0] = cuma; BC[(size_t)(ch * CHK + t) * KD + c1] = cumb;
            }
        }
        __syncthreads(); TP_END(23);
    }
}

__device__ __forceinline__ void ph_gla_naive(Frame& F) {
    const bf16* QP = (const bf16*)(KWS + WS_QP); const bf16* KP = (const bf16*)(KWS + WS_KP); const bf16* VB = (const bf16*)(KWS + WS_VB);
    const float* BC = (const float*)(KWS + WS_BC); float* O = (float*)(KWS + WS_O);
    for (int u = blockIdx.x; u < 128; u += F.G) {
        const int h = u >> 5, col0 = (u & 31) * 16, ds = F.tid & 31, col = F.tid >> 5;
        float R[8];
#pragma unroll
        for (int i = 0; i < 8; ++i) R[i] = 0.f;
        const bf16* qp = QP + h * DKH + ds * 8; const bf16* kp = KP + h * DKH + ds * 8; const bf16* vp = VB + h * DVH + col0 + col;
        const float* bp = BC + h * DKH + ds * 8; float* op = O + h * DVH + col0 + col;
        for (int t0 = 0; t0 < T; t0 += 8) {
            v4u kk[8], qq[8]; unsigned short vv[8];
#pragma unroll
            for (int j = 0; j < 8; ++j) { kk[j] = *(const v4u*)(kp + (size_t)(t0 + j) * KD); qq[j] = *(const v4u*)(qp + (size_t)(t0 + j) * KD); vv[j] = vp[(size_t)(t0 + j) * VD]; }
#pragma unroll
            for (int j = 0; j < 8; ++j) {
                const float v = __uint_as_float(((unsigned)vv[j]) << 16);
                float po = 0.f;
#pragma unroll
                for (int i = 0; i < 4; ++i) { const unsigned kw = kk[j][i], qw = qq[j][i];
                    R[2 * i] += bflo(kw) * v; R[2 * i + 1] += bfhi(kw) * v; po += bflo(qw) * R[2 * i] + bfhi(qw) * R[2 * i + 1]; }
                po += __shfl_xor(po, 1); po += __shfl_xor(po, 2); po += __shfl_xor(po, 4); po += __shfl_xor(po, 8); po += __shfl_xor(po, 16);
                if (ds == 0) op[(size_t)(t0 + j) * VD] = po;
            }
            if (((t0 + 8) & 63) == 0) { const f32x4 b0 = *(const f32x4*)(bp + (size_t)(t0 + 7) * KD), b1 = *(const f32x4*)(bp + (size_t)(t0 + 7) * KD + 4);
#pragma unroll
                for (int i = 0; i < 4; ++i) { R[i] *= expf(b0[i]); R[4 + i] *= expf(b1[i]); } }
        }
    }
}

namespace gla {
typedef short bf16x8 __attribute__((ext_vector_type(8)));
typedef short s16x4 __attribute__((ext_vector_type(4)));
typedef short v4i16_t __attribute__((ext_vector_type(4)));
typedef float f32x2_t __attribute__((ext_vector_type(2))); typedef __bf16 bf16x2_t __attribute__((ext_vector_type(2)));
__device__ __forceinline__ unsigned cvtpk(float lo, float hi) { f32x2_t v = {lo, hi}; bf16x2_t b = __builtin_convertvector(v, bf16x2_t); return __builtin_bit_cast(unsigned, b); }
__device__ __forceinline__ s16x4 trread(const LAS unsigned char* p) { return __builtin_bit_cast(s16x4, __builtin_amdgcn_ds_read_tr16_b64_v4i16((LAS v4i16_t*)p)); }
__device__ __forceinline__ bf16x8 cat4(s16x4 a, s16x4 b) { bf16x8 r; r[0] = a[0]; r[1] = a[1]; r[2] = a[2]; r[3] = a[3]; r[4] = b[0]; r[5] = b[1]; r[6] = b[2]; r[7] = b[3]; return r; }
constexpr int QS = 528, KS = 544, VS = 288, OS = 272, PS = 144;
constexpr int OFF_Q = 0, OFF_K = 64 * QS, OFF_V = OFF_K + 64 * KS, OFF_P = OFF_V + 64 * VS, OFF_G = OFF_P + 64 * PS, OFF_O = OFF_G + 1024, LDS_END = OFF_O + 64 * OS;
static_assert(LDS_END <= RING_BYTES, "gla LDS");
constexpr int NPART = 16, CPP = NCHUNK / NPART;
struct Stage { v4u q[4], k[4], v[2]; float g; };
template <bool NEEDQ>
__device__ __forceinline__ void issue_loads(Stage& st, const bf16* QP, const bf16* KP, const bf16* VB, const float* BC, int tok0, int h, int s, int tid, unsigned qkoff, unsigned voff) {
    const GAS char* qb = (const GAS char*)QP + (size_t)tok0 * KD * 2; const GAS char* kb = (const GAS char*)KP + (size_t)tok0 * KD * 2; const GAS char* vb = (const GAS char*)VB + (size_t)tok0 * VD * 2;
#pragma unroll
    for (int i = 0; i < 4; ++i) { if (NEEDQ) { st.q[i] = __builtin_nontemporal_load((const GAS v4u*)(qb + i * 16 * KD * 2 + qkoff)); st.k[i] = __builtin_nontemporal_load((const GAS v4u*)(kb + i * 16 * KD * 2 + qkoff)); } else st.k[i] = *(const GAS v4u*)(kb + i * 16 * KD * 2 + qkoff); }
#pragma unroll
    for (int i = 0; i < 2; ++i) st.v[i] = NEEDQ ? __builtin_nontemporal_load((const GAS v4u*)(vb + i * 32 * VD * 2 + voff)) : *(const GAS v4u*)(vb + i * 32 * VD * 2 + voff);
    st.g = *(const GAS float*)((const GAS char*)BC + (size_t)(tok0 + 63) * KD * 4 + (unsigned)(h * DKH + (tid & 255)) * 4u);
    (void)s;
}
template <bool NEEDQ>
__device__ __forceinline__ void write_stage(LAS unsigned char* lds, const Stage& st, int tid) {
#pragma unroll
    for (int i = 0; i < 4; ++i) { const int id = tid + 512 * i, row = id >> 5, cc = id & 31;
        if (NEEDQ) *(LAS v4u*)(lds + OFF_Q + row * QS + cc * 16) = st.q[i]; *(LAS v4u*)(lds + OFF_K + row * KS + ((cc * 16) ^ (((row >> 3) & 1) << 7))) = st.k[i]; }
#pragma unroll
    for (int i = 0; i < 2; ++i) { const int id = tid + 512 * i, row = id >> 4, cc = id & 15; *(LAS v4u*)(lds + OFF_V + row * VS + ((cc * 16) ^ (((row >> 3) & 1) << 7))) = st.v[i]; }
    if (tid < 256) *(LAS float*)(lds + OFF_G + 4 * tid) = expf(st.g);
}
template <int PASS>
__device__ __forceinline__ void unit(LAS unsigned char* lds, int tid, int lane, int w, int p, int h, int s, const bf16* QP, const bf16* KP, const bf16* VB, const float* BC, bf16* OG, f32x4* SEND, float* GTOT, const bf16* GB, const float* hnw, float* SS, unsigned long long& tp_t0, unsigned long long& tp_acc) {
#define GTP_BEGIN(k) do { if ((TPROBE_MASK >> (k)) & 1u) { if (tid == 0) ((volatile LAS int*)(lds + MISC_OFF))[50] = (int)__builtin_amdgcn_s_memrealtime(); } } while (0)
#define GTP_END(k) do { if ((TPROBE_MASK >> (k)) & 1u) { if (tid == 0) { volatile LAS int* m_ = (volatile LAS int*)(lds + MISC_OFF); m_[51] = m_[51] + ((int)__builtin_amdgcn_s_memrealtime() - m_[50]); } } } while (0)
    constexpr bool NQ = (PASS == 2);
    const int r = lane & 15, q = lane >> 4, qq = r >> 2, pp = r & 3;
    f32x4 S[16];
#pragma unroll
    for (int dt = 0; dt < 16; ++dt) S[dt] = (f32x4){0.f, 0.f, 0.f, 0.f};
    const int tokbase = p * CPP * CHK;
    const unsigned qkoff = (unsigned)((tid >> 5) * KD + h * DKH + (tid & 31) * 8) * 2u, voff = (unsigned)((tid >> 4) * VD + h * DVH + s * 128 + (tid & 15) * 8) * 2u;
    Stage st0, st1;
    issue_loads<NQ>(st0, QP, KP, VB, BC, tokbase, h, s, tid, qkoff, voff);
    __syncthreads();
    if (PASS == 2 && p > 0) {
        LAS int* cw = (LAS int*)(lds + OFF_P);
        if (tid == 0) *cw = 1 << 30;
        __syncthreads();
        if (tid < 256) { float prod = 1.f; int j0 = 0; for (int j = p - 1; j >= 1; --j) { prod *= GTOT[((size_t)j * 4 + h) * DKH + tid]; if (prod == 0.f) { j0 = j; break; } }
            __hip_atomic_fetch_min(cw, j0, __ATOMIC_RELAXED, __HIP_MEMORY_SCOPE_WORKGROUP); }
        __syncthreads();
        const int p0 = *cw;
        for (int pj = p0; pj < p; ++pj) {
            const f32x4* se = SEND + ((((size_t)pj * 4 + h) * 4 + s) * 8 + w) * 16 * 64 + lane; const float* gt = GTOT + ((size_t)pj * 4 + h) * DKH;
#pragma unroll
            for (int hf = 0; hf < 2; ++hf) {
                f32x4 gg[8], ee[8];
#pragma unroll
                for (int d8 = 0; d8 < 8; ++d8) { const int dt = 8 * hf + d8; gg[d8] = *(const f32x4*)(gt + 16 * dt + 4 * q); ee[d8] = se[dt * 64]; }
                asm volatile("" ::: "memory");
#pragma unroll
                for (int d8 = 0; d8 < 8; ++d8) { const int dt = 8 * hf + d8; S[dt] = S[dt] * gg[d8] + ee[d8]; }
                asm volatile("" ::: "memory");
            }
        }
        __syncthreads();
    }
    write_stage<NQ>(lds, st0, tid);
    if (CPP > 1) issue_loads<NQ>(st0, QP, KP, VB, BC, tokbase + CHK, h, s, tid, qkoff, voff);
    if (PASS == 1 && CPP > 2) issue_loads<NQ>(st1, QP, KP, VB, BC, tokbase + 2 * CHK, h, s, tid, qkoff, voff);
    __syncthreads();
    const LAS unsigned char* qnat = lds + OFF_Q + r * QS + q * 16;
    const int kd = ((r >> 3) & 1) << 7;
    const LAS unsigned char* knatP = lds + OFF_K + r * KS + q * 16 + kd; const LAS unsigned char* knatM = lds + OFF_K + r * KS + q * 16 - kd;
    const LAS unsigned char* qperm = lds + OFF_Q + r * QS + q * 8;
    const LAS unsigned char* qperm2 = qperm + 32; asm volatile("" : "+v"(qperm2));
    const int td = (q & 1) << 7;
    const LAS unsigned char* ktrP = lds + OFF_K + (8 * q + qq) * KS + pp * 8 + td; const LAS unsigned char* ktrM = lds + OFF_K + (8 * q + qq) * KS + pp * 8 - td;
    const LAS unsigned char* vtr = lds + OFF_V + (8 * q + qq) * VS + ((w * 32 + pp * 8) ^ td);
    const LAS unsigned char* pnat = lds + OFF_P + r * PS + q * 16;
    const LAS unsigned char* gbase = lds + OFF_G + 16 * q;
#define GLA_FENCE() asm volatile("" ::: "memory")
#define GLA_BAR() do { asm volatile("s_waitcnt lgkmcnt(0)" ::: "memory"); __builtin_amdgcn_s_barrier(); asm volatile("" ::: "memory"); } while (0)
#pragma unroll 1
    for (int c = 0; c < CPP; ++c) {
        const int tok0 = tokbase + c * CHK;
        bf16x8 vb[2]; v4u gpre[2];
        if (PASS == 2) GTP_BEGIN(24);
#pragma unroll
        for (int kt = 0; kt < 2; ++kt) vb[kt] = cat4(trread(vtr + kt * 32 * VS), trread(vtr + kt * 32 * VS + 4 * VS));
        if (PASS == 2) {
            const int it = w >> 1, jt0 = 2 * (w & 1);
            f32x4 pa0 = (f32x4){0.f, 0.f, 0.f, 0.f}, pa1 = pa0;
            bf16x8 fb[4], fa0[4], fa1[4];
#define P_LOAD(sl, ks) do { fb[sl] = *(const LAS bf16x8*)(qnat + it * 16 * QS + (ks) * 64); fa0[sl] = *(const LAS bf16x8*)((((ks) & 2) ? knatM : knatP) + jt0 * 16 * KS + (ks) * 64); fa1[sl] = *(const LAS bf16x8*)((((ks) & 2) ? knatM : knatP) + (jt0 + 1) * 16 * KS + (ks) * 64); } while (0)
            P_LOAD(0, 0); P_LOAD(1, 1); P_LOAD(2, 2);
#pragma unroll
            for (int ks = 0; ks < 8; ++ks) { if (ks + 3 < 8) P_LOAD((ks + 3) & 3, ks + 3); GLA_FENCE();
                pa0 = __builtin_amdgcn_mfma_f32_16x16x32_bf16(fa0[ks & 3], fb[ks & 3], pa0, 0, 0, 0); pa1 = __builtin_amdgcn_mfma_f32_16x16x32_bf16(fa1[ks & 3], fb[ks & 3], pa1, 0, 0, 0); }
#undef P_LOAD
            { const int i = 16 * it + r, j0 = 16 * jt0 + 4 * q; v2u o;
              o.x = cvtpk(j0 + 0 <= i ? pa0[0] : 0.f, j0 + 1 <= i ? pa0[1] : 0.f); o.y = cvtpk(j0 + 2 <= i ? pa0[2] : 0.f, j0 + 3 <= i ? pa0[3] : 0.f);
              *(LAS v2u*)(lds + OFF_P + i * PS + j0 * 2) = o;
              o.x = cvtpk(j0 + 16 <= i ? pa1[0] : 0.f, j0 + 17 <= i ? pa1[1] : 0.f); o.y = cvtpk(j0 + 18 <= i ? pa1[2] : 0.f, j0 + 19 <= i ? pa1[3] : 0.f);
              *(LAS v2u*)(lds + OFF_P + i * PS + (j0 + 16) * 2) = o; }
            f32x4 Oa[4];
#pragma unroll
            for (int i4 = 0; i4 < 4; ++i4) Oa[i4] = (f32x4){0.f, 0.f, 0.f, 0.f};
            bf16x8 qa[2][4];
#define Q_LOAD(sl, ks) do { _Pragma("unroll") for (int i4 = 0; i4 < 4; ++i4) qa[sl][i4] = cat4(*(const LAS s16x4*)(qperm + i4 * 16 * QS + (ks) * 64), *(const LAS s16x4*)(qperm2 + i4 * 16 * QS + (ks) * 64)); } while (0)
            Q_LOAD(0, 0);
#pragma unroll
            for (int ks = 0; ks < 8; ++ks) {
                if (ks + 1 < 8) Q_LOAD((ks + 1) & 1, ks + 1);
                GLA_FENCE();
                v4u bw; bw.x = cvtpk(S[2 * ks][0], S[2 * ks][1]); bw.y = cvtpk(S[2 * ks][2], S[2 * ks][3]); bw.z = cvtpk(S[2 * ks + 1][0], S[2 * ks + 1][1]); bw.w = cvtpk(S[2 * ks + 1][2], S[2 * ks + 1][3]);
                const bf16x8 bfrag = __builtin_bit_cast(bf16x8, bw);
#pragma unroll
                for (int i4 = 0; i4 < 4; ++i4) Oa[i4] = __builtin_amdgcn_mfma_f32_16x16x32_bf16(bfrag, qa[ks & 1][i4], Oa[i4], 0, 0, 0);
            }
#undef Q_LOAD
            GLA_BAR();
            GTP_END(24); GTP_BEGIN(25);
#pragma unroll
            for (int i = 0; i < 2; ++i) gpre[i] = __builtin_nontemporal_load((const GAS v4u*)((const GAS char*)GB + (size_t)tok0 * VD * 2 + i * 32 * VD * 2 + voff));
            { bf16x8 pf[6];
              pf[0] = *(const LAS bf16x8*)(pnat); pf[1] = *(const LAS bf16x8*)(pnat + 16 * PS); pf[2] = *(const LAS bf16x8*)(pnat + 32 * PS); pf[3] = *(const LAS bf16x8*)(pnat + 32 * PS + 64);
              pf[4] = *(const LAS bf16x8*)(pnat + 48 * PS); pf[5] = *(const LAS bf16x8*)(pnat + 48 * PS + 64);
              Oa[0] = __builtin_amdgcn_mfma_f32_16x16x32_bf16(vb[0], pf[0], Oa[0], 0, 0, 0); Oa[1] = __builtin_amdgcn_mfma_f32_16x16x32_bf16(vb[0], pf[1], Oa[1], 0, 0, 0);
              Oa[2] = __builtin_amdgcn_mfma_f32_16x16x32_bf16(vb[0], pf[2], Oa[2], 0, 0, 0); Oa[2] = __builtin_amdgcn_mfma_f32_16x16x32_bf16(vb[1], pf[3], Oa[2], 0, 0, 0);
              Oa[3] = __builtin_amdgcn_mfma_f32_16x16x32_bf16(vb[0], pf[4], Oa[3], 0, 0, 0); Oa[3] = __builtin_amdgcn_mfma_f32_16x16x32_bf16(vb[1], pf[5], Oa[3], 0, 0, 0); }
#pragma unroll
            for (int i4 = 0; i4 < 4; ++i4) { v2u o; o.x = cvtpk(Oa[i4][0], Oa[i4][1]); o.y = cvtpk(Oa[i4][2], Oa[i4][3]); *(LAS v2u*)(lds + OFF_O + (16 * i4 + r) * OS + (16 * w + 4 * q) * 2) = o; }
        }
        if (PASS == 2) { GTP_END(25); GTP_BEGIN(26); }
        { constexpr int RD = (PASS == 1) ? 4 : 2;
          bf16x8 ka0[RD], ka1[RD]; f32x4 gg[RD];
#define KV_LOAD(sl, dt) do { const LAS unsigned char* kb_ = (((dt) & 4) ? ktrM : ktrP) + (dt) * 32; ka0[sl] = cat4(trread(kb_), trread(kb_ + 4 * KS)); ka1[sl] = cat4(trread(kb_ + 32 * KS), trread(kb_ + 32 * KS + 4 * KS)); gg[sl] = *(const LAS f32x4*)(gbase + (dt) * 64); } while (0)
#pragma unroll
          for (int d0 = 0; d0 < RD - 1; ++d0) KV_LOAD(d0, d0);
#pragma unroll
          for (int dt = 0; dt < 16; ++dt) { if (dt + RD - 1 < 16) KV_LOAD((dt + RD - 1) % RD, dt + RD - 1); GLA_FENCE();
              S[dt] = __builtin_amdgcn_mfma_f32_16x16x32_bf16(ka0[dt % RD], vb[0], S[dt], 0, 0, 0); S[dt] = __builtin_amdgcn_mfma_f32_16x16x32_bf16(ka1[dt % RD], vb[1], S[dt], 0, 0, 0);
              S[dt] = S[dt] * gg[dt % RD]; }
#undef KV_LOAD
        }
        if (PASS == 2) { GTP_END(26); GTP_BEGIN(27); }
        GLA_BAR();
        if (PASS == 2) {
            const f32x4 hw0 = *(const f32x4*)(hnw + s * 128 + (tid & 15) * 8), hw1 = *(const f32x4*)(hnw + s * 128 + (tid & 15) * 8 + 4);
#pragma unroll
            for (int i = 0; i < 2; ++i) { const int id = tid + 512 * i, row = id >> 4, cc = id & 15;
                const v4u ov = *(const LAS v4u*)(lds + OFF_O + row * OS + cc * 16);
                const f32x4 a = bf4lo(ov), b = bf4hi(ov), ga = bf4lo(gpre[i]), gb = bf4hi(gpre[i]);
                float ss = (a.x * a.x + a.y * a.y) + (a.z * a.z + a.w * a.w) + (b.x * b.x + b.y * b.y) + (b.z * b.z + b.w * b.w);
                ss += __shfl_xor(ss, 1); ss += __shfl_xor(ss, 2); ss += __shfl_xor(ss, 4); ss += __shfl_xor(ss, 8);
                if (cc == 0) SS[(size_t)(tok0 + row) * 16 + h * 4 + s] = ss;
                const f32x4 ya = a * ga * hw0, yb = b * gb * hw1;
                v4u o; o.x = cvtpk(ya.x, ya.y); o.y = cvtpk(ya.z, ya.w); o.z = cvtpk(yb.x, yb.y); o.w = cvtpk(yb.z, yb.w);
                *(GAS v4u*)((GAS char*)OG + (size_t)tok0 * VD * 2 + i * 32 * VD * 2 + voff) = o; }
        }
        if (c + 1 < CPP) {
            if (PASS == 1) {
                if ((c & 1) == 0) { write_stage<NQ>(lds, st0, tid); if (c + 3 < CPP) issue_loads<NQ>(st0, QP, KP, VB, BC, tok0 + 3 * CHK, h, s, tid, qkoff, voff); }
                else { write_stage<NQ>(lds, st1, tid); if (c + 3 < CPP) issue_loads<NQ>(st1, QP, KP, VB, BC, tok0 + 3 * CHK, h, s, tid, qkoff, voff); }
            } else { write_stage<NQ>(lds, st0, tid); if (c + 2 < CPP) issue_loads<NQ>(st0, QP, KP, VB, BC, tok0 + 2 * CHK, h, s, tid, qkoff, voff); }
            GLA_BAR();
        }
        if (PASS == 2) GTP_END(27);
    }
#undef GLA_FENCE
#undef GLA_BAR
    if (PASS == 1) {
        f32x4* se = SEND + ((((size_t)p * 4 + h) * 4 + s) * 8 + w) * 16 * 64 + lane;
#pragma unroll
        for (int dt = 0; dt < 16; ++dt) se[dt * 64] = S[dt];
        if (s == 0 && tid < 256) { float a = 0.f; for (int c = 0; c < CPP; ++c) a += BC[(size_t)(tokbase + c * CHK + 63) * KD + h * DKH + tid]; GTOT[((size_t)p * 4 + h) * DKH + tid] = expf(a); }
    }
}
}
template <int PASS>
__device__ __forceinline__ void ph_gla(Frame& F) {
    const bf16* QP = (const bf16*)(KWS + WS_QP); const bf16* KP = (const bf16*)(KWS + WS_KP); const bf16* VB = (const bf16*)(KWS + WS_VB);
    const float* BC = (const float*)(KWS + WS_BC); bf16* OG = (bf16*)(KWS + WS_OG); f32x4* SEND = (f32x4*)(KWS + WS_SEND); float* GTOT = (float*)(KWS + WS_GTOT);
    for (int u = blockIdx.x; u < 256; u += F.G) {
        const int idx = u >> 3, s = idx & 3, ph = (u & 7) * 8 + (idx >> 2), p = ph >> 2, h = ph & 3;
        if (PASS == 1 && p == gla::NPART - 1) continue;
        gla::unit<PASS>(F.lds, F.tid, F.lane, F.wave, p, h, s, QP, KP, VB, BC, OG, SEND, GTOT, (const bf16*)(KWS + WS_GB), KIN(5), (float*)(KWS + WS_SS), F.tp_t0, F.tp_acc);
    }
}

__device__ __forceinline__ void ph_headnorm(Frame& F) {
    const bf16* O = (const bf16*)(KWS + WS_O); const bf16* GB = (const bf16*)(KWS + WS_GB); bf16* OG = (bf16*)(KWS + WS_OG); const float* hnw = KIN(5);
    const int gw = blockIdx.x * NWAVES + F.wave, NGW = F.G * NWAVES;
    const f32x4 w0 = ((const f32x4*)hnw)[2 * F.lane], w1 = ((const f32x4*)hnw)[2 * F.lane + 1];
    for (int it = gw; it < T * NHEAD; it += 4 * NGW) {
        v4u ov[4], gv[4]; size_t off[4];
#pragma unroll
        for (int k = 0; k < 4; ++k) { const int i2 = it + k * NGW; const int ic = i2 < T * NHEAD ? i2 : it; off[k] = (size_t)(ic >> 2) * VD + (ic & 3) * DVH + 8 * F.lane; ov[k] = *(const v4u*)(O + off[k]); gv[k] = *(const v4u*)(GB + off[k]); }
#pragma unroll
        for (int k = 0; k < 4; ++k) {
            const f32x4 a = bf4lo(ov[k]), b = bf4hi(ov[k]), ga = bf4lo(gv[k]), gb = bf4hi(gv[k]);
            const float ss = wave_sum((a.x * a.x + a.y * a.y) + (a.z * a.z + a.w * a.w) + (b.x * b.x + b.y * b.y) + (b.z * b.z + b.w * b.w));
            const float rstd = 1.0f / sqrtf(ss * (1.0f / DVH) + EPS);
            const f32x4 ya = a * rstd * w0 * ga, yb = b * rstd * w1 * gb;
            v4u o; o.x = pk2(ya.x, ya.y); o.y = pk2(ya.z, ya.w); o.z = pk2(yb.x, yb.y); o.w = pk2(yb.z, yb.w);
            if (it + k * NGW < T * NHEAD) *(v4u*)(OG + off[k]) = o;
        }
    }
}

__device__ __forceinline__ void ph_router(Frame& F, int layer, const bf16* H) {
    const bf16* WH = (const bf16*)(KWS + WS_WRH) + (size_t)layer * NLOG * 2048; const bf16* WL = (const bf16*)(KWS + WS_WRL) + (size_t)layer * NLOG * 2048;
    const float* wn = KIN(10) + layer * D; const float* bg = KIN(12) + layer * NGRP; const float* br = KIN(14) + layer * NE;
    bf16* HN = (bf16*)(KWS + WS_HN);
    int* TKE = (int*)(KWS + WS_TKE); int* TKS = (int*)(KWS + WS_TKS); float* TKG = (float*)(KWS + WS_TKG); int* LIST = (int*)(KWS + WS_LIST);
    unsigned* gcnt = F.ctl + CW_CNT + 2048 * layer;
    LAS float* part = (LAS float*)(F.lds);
    LAS float* sqp = (LAS float*)(F.lds + 98304);
    LAS float* lg = (LAS float*)(F.lds + 98304 + 2048);
    LAS float* rs = (LAS float*)(F.lds + 98304 + 2048 + 12288);
    LAS int* sel = (LAS int*)(F.lds + 98304 + 2048 + 12288 + 256);
    LAS float* selg = (LAS float*)(F.lds + 98304 + 2048 + 12288 + 256 + 1024);
    static_assert(98304 + 2048 + 12288 + 256 + 1024 + 512 <= RING_BYTES, "router LDS");
    volatile LAS int* cntl = F.MISC + MI_CNTL; volatile LAS int* basel = F.MISC + MI_BASEL;
    for (int blk = blockIdx.x; blk < T / 64; blk += F.G) {
        if (F.tid < 32) cntl[F.tid] = 0;
        TP_BEGIN(20); rowblock_bf16<3>(F, H + (size_t)blk * 64 * D, WH, WL, part, sqp);
        __syncthreads(); TP_END(20); TP_BEGIN(21);
        if (F.tid < 64) { float t = 0.f;
#pragma unroll
            for (int w = 0; w < 8; ++w) t += sqp[w * 64 + F.tid];
            const float rstd = 1.0f / sqrtf(t * (1.0f / D) + EPS); rs[F.tid] = rstd; ((float*)(KWS + WS_RSTD))[blk * 64 + F.tid] = rstd; }
#pragma unroll
        for (int i = 0; i < 6; ++i) { const int idx = F.tid + 512 * i; float t = 0.f;
#pragma unroll
            for (int w = 0; w < 8; ++w) t += part[w * 3072 + idx];
            lg[idx] = t; }
        __syncthreads();
        if (F.tid < 64) {
            const int rl = F.tid; const float rstd = rs[rl]; const LAS float* L = lg + rl * 48;
            float gl0 = L[0] * rstd + bg[0]; int g = 0; float gv[4]; gv[0] = gl0;
#pragma unroll
            for (int j = 1; j < 4; ++j) { gv[j] = L[j] * rstd + bg[j]; if (gv[j] > gl0) { gl0 = gv[j]; g = j; } }
            float den = 0.f;
#pragma unroll
            for (int j = 0; j < 4; ++j) den += expf(gv[j] - gl0);
            const float gp = 1.0f / den;
            float l1 = -3.0e38f, l2 = -3.0e38f; int e1 = 0, e2 = 0;
            for (int j = 0; j < 8; ++j) { const float v = L[4 + 8 * g + j] * rstd + br[8 * g + j];
                if (v > l1) { l2 = l1; e2 = e1; l1 = v; e1 = j; } else if (v > l2) { l2 = v; e2 = j; } }
            const float ex = expf(l2 - l1), p1 = 1.0f / (1.0f + ex), p2 = ex * p1;
            const int E0 = 8 * g + e1, E1 = 8 * g + e2;
            sel[rl * 4 + 0] = E0; sel[rl * 4 + 1] = E1;
            sel[rl * 4 + 2] = __hip_atomic_fetch_add((LAS int*)&cntl[E0], 1, __ATOMIC_RELAXED, __HIP_MEMORY_SCOPE_WORKGROUP); sel[rl * 4 + 3] = __hip_atomic_fetch_add((LAS int*)&cntl[E1], 1, __ATOMIC_RELAXED, __HIP_MEMORY_SCOPE_WORKGROUP);
            selg[rl * 2 + 0] = gp * p1; selg[rl * 2 + 1] = gp * p2;
        }
        __syncthreads();
        if (F.tid < 32) basel[F.tid] = (int)__hip_atomic_fetch_add(gcnt + 64 * F.tid, (unsigned)cntl[F.tid], RLX_AGENT);
        __syncthreads();
        if (F.tid < 128) {
            const int rl = F.tid >> 1, k = F.tid & 1, tk = (blk * 64 + rl) * 2 + k, e = sel[rl * 4 + k], slot = basel[e] + sel[rl * 4 + 2 + k];
            TKE[tk] = e; TKS[tk] = slot; TKG[tk] = selg[rl * 2 + k]; LIST[e * T + slot] = tk;
        }
        __syncthreads(); TP_END(21);
    }
}

__device__ __forceinline__ void moe_meta(Frame& F, int layer) {
    __syncthreads();
    if (F.tid < 64) {
        const unsigned* gcnt = F.ctl + CW_CNT + 2048 * layer;
        const int e = F.tid, c = e < NE ? (int)__hip_atomic_load(gcnt + 64 * (e & 31), RLX_AGENT) : 0, tl = e < NE ? (c + 255) >> 8 : 0;
        int sc = tl;
#pragma unroll
        for (int o = 1; o < 32; o <<= 1) { const int v = __shfl_up(sc, o); if (F.lane >= o) sc += v; }
        const int t0 = sc - tl;
        if (e < NE) { F.MISC[MI_PSTART + e] = t0 * 256; F.MISC[MI_ECNT + e] = c;
            for (int j = 0; j < tl; ++j) { F.MISC[MI_TEXP + t0 + j] = e; F.MISC[MI_TSLOT + t0 + j] = 256 * j; } }
        if (e == NE - 1) { F.MISC[MI_PSTART + NE] = sc * 256; F.MISC[MI_NRT] = sc; }
    }
    __syncthreads();
}

template <bool FINAL>
__device__ __forceinline__ void ph_combine(Frame& F, const bf16* H, bf16* Hout, const float* wn) {
    const bf16* Y = (const bf16*)(KWS + WS_Y); const int* TKE = (const int*)(KWS + WS_TKE); const int* TKS = (const int*)(KWS + WS_TKS); const float* TKG = (const float*)(KWS + WS_TKG); float* RSTD = (float*)(KWS + WS_RSTD);
    const int gw = blockIdx.x * NWAVES + F.wave, NGW = F.G * NWAVES;
    for (int t = gw; t < T; t += NGW) {
        const int r0 = F.MISC[MI_PSTART + TKE[2 * t]] + TKS[2 * t], r1 = F.MISC[MI_PSTART + TKE[2 * t + 1]] + TKS[2 * t + 1]; const float g0 = TKG[2 * t], g1 = TKG[2 * t + 1];
        const v2u* hr = (const v2u*)(H + (size_t)t * D) + F.lane;
        const v2u* y0 = (const v2u*)(Y + (size_t)r0 * D) + F.lane; const v2u* y1 = (const v2u*)(Y + (size_t)r1 * D) + F.lane;
        f32x4 v[8]; float s = 0.f;
#pragma unroll
        for (int j = 0; j < 8; ++j) { const v2u a = __builtin_nontemporal_load(y0 + 64 * j), b = __builtin_nontemporal_load(y1 + 64 * j), hh = __builtin_nontemporal_load(hr + 64 * j); f32x4 h = {bflo(hh.x), bfhi(hh.x), bflo(hh.y), bfhi(hh.y)};
            h.x += g0 * bflo(a.x) + g1 * bflo(b.x); h.y += g0 * bfhi(a.x) + g1 * bfhi(b.x); h.z += g0 * bflo(a.y) + g1 * bflo(b.y); h.w += g0 * bfhi(a.y) + g1 * bfhi(b.y);
            v[j] = h; s += (h.x * h.x + h.y * h.y) + (h.z * h.z + h.w * h.w); }
        const float rstd = 1.0f / sqrtf(wave_sum(s) * (1.0f / D) + EPS);
        if (FINAL) {
            f32x4* o = (f32x4*)(KOUT + (size_t)t * D) + F.lane;
#pragma unroll
            for (int j = 0; j < 8; ++j) __builtin_nontemporal_store(v[j] * rstd * ((const f32x4*)wn)[F.lane + 64 * j], o + 64 * j);
        } else {
            v2u* ho = (v2u*)(Hout + (size_t)t * D) + F.lane;
#pragma unroll
            for (int j = 0; j < 8; ++j) { v2u o; o.x = pk2(v[j].x, v[j].y); o.y = pk2(v[j].z, v[j].w); ho[64 * j] = o; }
            if (F.lane == 0) RSTD[t] = rstd;
        }
    }
}

__device__ __forceinline__ void ph_conv(Frame& F) {
    const bf16* BG = (const bf16*)(KWS + WS_VB); const bf16* U = (const bf16*)(KWS + WS_GB); bf16* OG = (bf16*)(KWS + WS_OG); const float* cw = KIN(8);
    const int c = (F.tid & 255) * 8, rh = F.tid >> 8;
    const f32x4 wa0 = *(const f32x4*)(cw + c), wa1 = *(const f32x4*)(cw + c + 4), wb0 = *(const f32x4*)(cw + D + c), wb1 = *(const f32x4*)(cw + D + c + 4), wc0 = *(const f32x4*)(cw + 2 * D + c), wc1 = *(const f32x4*)(cw + 2 * D + c + 4);
    for (int blk = blockIdx.x; blk < T / 64; blk += F.G) {
        const int t0 = blk * 64 + rh * 32;
        const v4u zero = {0u, 0u, 0u, 0u};
        v4u p2 = t0 >= 2 ? *(const v4u*)(U + (size_t)(t0 - 2) * D + c) : zero, p1 = t0 >= 1 ? *(const v4u*)(U + (size_t)(t0 - 1) * D + c) : zero;
        f32x4 u2l = bf4lo(p2), u2h = bf4hi(p2), u1l = bf4lo(p1), u1h = bf4hi(p1);
#pragma unroll 1
        for (int tb = 0; tb < 32; tb += 8) {
            v4u uu[8], bb[8];
#pragma unroll
            for (int j = 0; j < 8; ++j) { const size_t off = (size_t)(t0 + tb + j) * D + c; uu[j] = __builtin_nontemporal_load((const v4u*)(U + off)); bb[j] = __builtin_nontemporal_load((const v4u*)(BG + off)); }
#pragma unroll
            for (int j = 0; j < 8; ++j) {
                const f32x4 u0l = bf4lo(uu[j]), u0h = bf4hi(uu[j]), bl = bf4lo(bb[j]), bh = bf4hi(bb[j]);
                const f32x4 yl = bl * (wa0 * u2l + wb0 * u1l + wc0 * u0l), yh = bh * (wa1 * u2h + wb1 * u1h + wc1 * u0h);
                v4u o; o.x = pk2(yl.x, yl.y); o.y = pk2(yl.z, yl.w); o.z = pk2(yh.x, yh.y); o.w = pk2(yh.z, yh.w);
                *(v4u*)(OG + (size_t)(t0 + tb + j) * D + c) = o;
                u2l = u1l; u2h = u1h; u1l = u0l; u1h = u0h;
            }
        }
    }
}

#ifndef PH_MASK
#define PH_MASK 0xFFFFFFFFu
#endif
#define IN(k) (((PH_MASK >> (k)) & 1u) && lo <= (k) && (k) < hi)
#define BOTH(k) (IN(k) && IN((k) + 1))
#ifndef DUP_MASK
#define DUP_MASK 0u
#endif
#define NREP(k) ((((unsigned)DUP_MASK >> (k)) & 1u) ? 2 : 1)
#define GRID_BAR() do { if (N_LAUNCHES == 1) xcd_barrier(bar); } while (0)
template <int LAYER>
__device__ __forceinline__ void moe_block(Frame& F, const int lo, const int hi, const XcdBarrier& bar) {
    constexpr int pb = LAYER ? PH_MOE1 : PH_MOE0;
    bf16* H1 = (bf16*)(KWS + WS_H1); bf16* H2 = (bf16*)(KWS + WS_H2);
    TP_BEGIN(pb + 0);
    if (IN(pb + 0)) { ph_router(F, LAYER, H1); if (BOTH(pb + 0)) GRID_BAR(); }
    TP_END(pb + 0);
    const bool split = (F.G == 256);
    TP_BEGIN(pb + 1);
    if (IN(pb + 1)) {
        moe_meta(F, LAYER);
        const int nrt = F.MISC[MI_NRT];
        pg8::Gemm g{(const bf16*)H1, (const bf16*)(KWS + WS_WGU) + (size_t)LAYER * NE * 1024 * 2048, nrt * 256, 1024, D};
        pg8::MoeOrder<true> S{nrt, 4, nrt * 4, F.G, (int)blockIdx.x, (size_t)1024 * 2048 * 2, (const volatile LAS int*)F.MISC, (const int*)(KWS + WS_LIST), split ? 1 : 0, 0, 2};
        pg8::EpiGateUp E{(bf16*)(KWS + WS_ACT), (const int*)(KWS + WS_LIST), (const float*)(KWS + WS_RSTD)};
        for (int rep = 0; rep < NREP(pb + 1); ++rep) { pg8::gemm_phase<pg8::EpiGateUp, pg8::MoeOrder<true>, true>(F.lds + RING_OFF, g, S, E); if (rep + 1 < NREP(pb + 1)) GRID_BAR(); }
        if (BOTH(pb + 1)) GRID_BAR();
    }
    TP_END(pb + 1);
    TP_BEGIN(pb + 2);
    if (IN(pb + 2)) {
        if (split) {
            if (N_LAUNCHES != 1) moe_meta(F, LAYER);
            const int nrt = F.MISC[MI_NRT];
            { pg8::Gemm g{(const bf16*)H1, (const bf16*)(KWS + WS_WGU) + (size_t)LAYER * NE * 1024 * 2048, nrt * 256, 1024, D};
              pg8::MoeOrder<true> S{nrt, 4, nrt * 4, F.G, (int)blockIdx.x, (size_t)1024 * 2048 * 2, (const volatile LAS int*)F.MISC, (const int*)(KWS + WS_LIST), 1, 2, 3};
              pg8::EpiGateUp E{(bf16*)(KWS + WS_ACT), (const int*)(KWS + WS_LIST), (const float*)(KWS + WS_RSTD)};
              pg8::gemm_phase<pg8::EpiGateUp, pg8::MoeOrder<true>, true>(F.lds + RING_OFF, g, S, E); }
            { pg8::Gemm g{(const bf16*)(KWS + WS_ACT), (const bf16*)(KWS + WS_WDN) + (size_t)LAYER * NE * 2048 * 512, nrt * 256, 2048, FF};
              pg8::MoeOrder<false> S{nrt, 8, nrt * 8, F.G, (int)blockIdx.x, (size_t)2048 * 512 * 2, (const volatile LAS int*)F.MISC, (const int*)(KWS + WS_LIST), 2, 0, 0};
              pg8::EpiDown E{(bf16*)(KWS + WS_Y)};
              pg8::gemm_phase<pg8::EpiDown, pg8::MoeOrder<false>, true>(F.lds + RING_OFF, g, S, E); }
        }
        if (BOTH(pb + 2)) GRID_BAR();
    }
    TP_END(pb + 2);
    TP_BEGIN(pb + 3);
    if (IN(pb + 3)) {
        if (N_LAUNCHES != 1) moe_meta(F, LAYER);
        const int nrt = F.MISC[MI_NRT];
        pg8::Gemm g{(const bf16*)(KWS + WS_ACT), (const bf16*)(KWS + WS_WDN) + (size_t)LAYER * NE * 2048 * 512, nrt * 256, 2048, FF};
        pg8::MoeOrder<false> S{nrt, 8, nrt * 8, F.G, (int)blockIdx.x, (size_t)2048 * 512 * 2, (const volatile LAS int*)F.MISC, (const int*)(KWS + WS_LIST), split ? 3 : 0, 0, 0};
        pg8::EpiDown E{(bf16*)(KWS + WS_Y)};
        for (int rep = 0; rep < NREP(pb + 3); ++rep) { pg8::gemm_phase<pg8::EpiDown, pg8::MoeOrder<false>, true>(F.lds + RING_OFF, g, S, E); if (rep + 1 < NREP(pb + 3)) GRID_BAR(); }
        if (BOTH(pb + 3)) GRID_BAR();
    }
    TP_END(pb + 3);
    TP_BEGIN(pb + 4);
    if (IN(pb + 4)) {
        if (N_LAUNCHES != 1) moe_meta(F, LAYER);
        if (LAYER == 0) { for (int rep = 0; rep < NREP(pb + 4); ++rep) { ph_combine<false>(F, H1, H2, nullptr); if (rep + 1 < NREP(pb + 4)) GRID_BAR(); } if (BOTH(pb + 4)) GRID_BAR(); }
        else for (int rep = 0; rep < NREP(pb + 4); ++rep) { ph_combine<true>(F, H1, nullptr, KIN(17)); if (rep + 1 < NREP(pb + 4)) GRID_BAR(); }
    }
    TP_END(pb + 4);
}

struct Args { const float* in[18]; float* out; unsigned char* ws; int ph_lo, ph_hi, li, pad; };
__global__ void __launch_bounds__(NWAVES * 64, 2) mega_fwd(Args args) {
    extern __shared__ __attribute__((aligned(16))) unsigned char lds[];
    Frame F;
    F.lds = (LAS unsigned char*)lds;
    F.MISC = (volatile LAS int*)(F.lds + MISC_OFF);
    F.tid = threadIdx.x; F.lane = F.tid & 63; F.wave = __builtin_amdgcn_readfirstlane(F.tid >> 6);
    F.G = gridDim.x; F.tp_t0 = 0; F.tp_acc = 0;
    F.ka = (__attribute__((address_space(4))) const unsigned char*)__builtin_amdgcn_kernarg_segment_ptr();
    F.ctl = (unsigned*)(args.ws + WS_CTL);
    for (int u = F.tid; u < MISC_BYTES / 4; u += NWAVES * 64) F.MISC[u] = 0;
    __syncthreads();
    XcdBarrier bar; bar.bar = F.ctl + CW_BAR; bar.x = 0; bar.st = nullptr;
    if (N_LAUNCHES == 1) bar = xcd_barrier_post(F.ctl + CW_BAR, (volatile LAS unsigned*)(F.MISC + 8));
    const int lo = args.ph_lo, hi = args.ph_hi;
    bf16* HN = (bf16*)(KWS + WS_HN); bf16* H1 = (bf16*)(KWS + WS_H1); bf16* H2 = (bf16*)(KWS + WS_H2);

    TP_BEGIN(PH_CONV);
    if (IN(PH_CONV)) { for (int rep = 0; rep < NREP(PH_CONV); ++rep) { p0_convert(F); if (rep + 1 < NREP(PH_CONV)) GRID_BAR(); } if (BOTH(PH_CONV)) GRID_BAR(); }
    TP_END(PH_CONV);
    TP_BEGIN(PH_NORM0);
    if (IN(PH_NORM0)) { for (int rep = 0; rep < NREP(PH_NORM0); ++rep) { p0_norm_gl(F); if (rep + 1 < NREP(PH_NORM0)) GRID_BAR(); } if (BOTH(PH_NORM0)) GRID_BAR(); }
    TP_END(PH_NORM0);
    TP_BEGIN(PH_GIN);
    if (IN(PH_GIN)) {
        pg8::Gemm g{HN, (const bf16*)(KWS + WS_WGI), T, GINM, D}; pg8::StaticOrder S; S.init(T, GINM, F.G, (int)blockIdx.x);
        pg8::EpiGlaIn E{(bf16*)(KWS + WS_QP), (bf16*)(KWS + WS_KP), (bf16*)(KWS + WS_VB), (bf16*)(KWS + WS_GB), (const float*)(KWS + WS_BC), (const float*)(KWS + WS_RSTD)};
        for (int rep = 0; rep < NREP(PH_GIN); ++rep) { pg8::gemm_phase<pg8::EpiGlaIn, pg8::StaticOrder, true>(F.lds + RING_OFF, g, S, E); if (rep + 1 < NREP(PH_GIN)) GRID_BAR(); }
        if (BOTH(PH_GIN)) GRID_BAR();
    }
    TP_END(PH_GIN);
    TP_BEGIN(PH_GLA1);
    if (IN(PH_GLA1)) { for (int rep = 0; rep < NREP(PH_GLA1); ++rep) { ph_gla<1>(F); if (rep + 1 < NREP(PH_GLA1)) GRID_BAR(); } if (BOTH(PH_GLA1)) GRID_BAR(); }
    TP_END(PH_GLA1);
    TP_BEGIN(PH_GLA2);
    if (IN(PH_GLA2)) { for (int rep = 0; rep < NREP(PH_GLA2); ++rep) { ph_gla<2>(F); if (rep + 1 < NREP(PH_GLA2)) GRID_BAR(); } if (BOTH(PH_GLA2)) GRID_BAR(); }
    TP_END(PH_GLA2);
    TP_BEGIN(PH_HNORM);
    if (IN(PH_HNORM)) { }
    TP_END(PH_HNORM);
    TP_BEGIN(PH_GOUT);
    if (IN(PH_GOUT)) {
        pg8::Gemm g{(const bf16*)(KWS + WS_OG), (const bf16*)(KWS + WS_WGO), T, D, D}; pg8::StaticOrder S; S.init(T, D, F.G, (int)blockIdx.x);
        pg8::EpiResHead E{HN, H1, D, (const float*)(KWS + WS_SS)};
        for (int rep = 0; rep < NREP(PH_GOUT); ++rep) { pg8::gemm_phase<pg8::EpiResHead, pg8::StaticOrder, true>(F.lds + RING_OFF, g, S, E); if (rep + 1 < NREP(PH_GOUT)) GRID_BAR(); }
        if (BOTH(PH_GOUT)) GRID_BAR();
    }
    TP_END(PH_GOUT);
    moe_block<0>(F, lo, hi, bar);
    TP_BEGIN(PH_CIN);
    if (IN(PH_CIN)) {
        pg8::Gemm g{H2, (const bf16*)(KWS + WS_WCI), T, 6144, D}; pg8::StaticOrder S; S.init(T, 6144, F.G, (int)blockIdx.x);
        pg8::EpiConvIn E{(bf16*)(KWS + WS_VB), (bf16*)(KWS + WS_GB), (const float*)(KWS + WS_RSTD)};
        for (int rep = 0; rep < NREP(PH_CIN); ++rep) { pg8::gemm_phase<pg8::EpiConvIn, pg8::StaticOrder, true>(F.lds + RING_OFF, g, S, E); if (rep + 1 < NREP(PH_CIN)) GRID_BAR(); }
        if (BOTH(PH_CIN)) GRID_BAR();
    }
    TP_END(PH_CIN);
    TP_BEGIN(PH_CONVE);
    if (IN(PH_CONVE)) { for (int rep = 0; rep < NREP(PH_CONVE); ++rep) { ph_conv(F); if (rep + 1 < NREP(PH_CONVE)) GRID_BAR(); } if (BOTH(PH_CONVE)) GRID_BAR(); }
    TP_END(PH_CONVE);
    TP_BEGIN(PH_COUT);
    if (IN(PH_COUT)) {
        pg8::Gemm g{(const bf16*)(KWS + WS_OG), (const bf16*)(KWS + WS_WCO), T, D, D}; pg8::StaticOrder S; S.init(T, D, F.G, (int)blockIdx.x);
        pg8::EpiRes<true> E{H2, H1, D};
        for (int rep = 0; rep < NREP(PH_COUT); ++rep) { pg8::gemm_phase<pg8::EpiRes<true>, pg8::StaticOrder, true>(F.lds + RING_OFF, g, S, E); if (rep + 1 < NREP(PH_COUT)) GRID_BAR(); }
        if (BOTH(PH_COUT)) GRID_BAR();
    }
    TP_END(PH_COUT);
    moe_block<1>(F, lo, hi, bar);
    if (TPROBE_MASK != 0u && blockIdx.x == 0 && F.tid == 0) { const unsigned long long t0 = __builtin_amdgcn_s_memrealtime(), w = (unsigned long long)(unsigned)F.MISC[51] * TPROBE_MULT; while (__builtin_amdgcn_s_memrealtime() - t0 < w) __builtin_amdgcn_s_sleep(8); }
#undef IN
#undef BOTH
#undef GRID_BAR
}

extern "C" void kernel_launch(void* const* d_in, const int* in_sizes, int n_in, void* d_out, int out_size, void* d_ws, size_t ws_size, hipStream_t stream) {
    static int grid = 0;
    if (grid == 0) {
        if (n_in != 18 || in_sizes[0] != T * D || out_size != T * D || ws_size < WS_END) { fprintf(stderr, "kernel_launch: unexpected shapes (n_in %d, in0 %d, out %d, ws %zu)\n", n_in, n_in > 0 ? in_sizes[0] : -1, out_size, ws_size); grid = -1; return; }
        int dev = 0, cus = 0, per_cu = 0;
        if (hipGetDevice(&dev) != hipSuccess || hipDeviceGetAttribute(&cus, hipDeviceAttributeMultiprocessorCount, dev) != hipSuccess) { grid = -1; return; }
        if (hipFuncSetAttribute((const void*)mega_fwd, hipFuncAttributeMaxDynamicSharedMemorySize, LDS_BYTES) != hipSuccess) { fprintf(stderr, "kernel_launch: hipFuncSetAttribute failed\n"); grid = -1; return; }
        if (hipOccupancyMaxActiveBlocksPerMultiprocessor(&per_cu, (const void*)mega_fwd, NWAVES * 64, LDS_BYTES) != hipSuccess || per_cu < 1) { fprintf(stderr, "kernel_launch: occupancy query reports %d\n", per_cu); }
        (void)hipGetLastError();
        grid = cus;
    }
    if (grid < 0) return;
    if (hipMemsetAsync((char*)d_ws + WS_CTL, 0, CTL_ZERO_BYTES, stream) != hipSuccess) return;
    Args a{};
    for (int i = 0; i < 18; ++i) a.in[i] = (const float*)d_in[i];
    a.out = (float*)d_out; a.ws = (unsigned char*)d_ws;
    for (int li = 0; li < N_LAUNCHES; ++li) {
        a.ph_lo = (N_LAUNCHES == 1) ? 0 : li; a.ph_hi = (N_LAUNCHES == 1) ? NPH : li + 1; a.li = li; a.pad = 0;
        hipLaunchKernelGGL(mega_fwd, dim3(grid), dim3(NWAVES * 64), LDS_BYTES, stream, a);
        const hipError_t le = hipPeekAtLastError();
        if (le != hipSuccess) { fprintf(stderr, "kernel_launch: launch %d failed: %s\n", li, hipGetErrorName(le)); break; }
    }
}
```

```cpp
#include <hip/hip_runtime.h>
#include <cstdio>
#include <cstdint>

#ifndef MK_N_LAUNCHES
#define MK_N_LAUNCHES 1
#endif

namespace pg8 {
#define PG8_LAS __attribute__((address_space(3)))
typedef unsigned short bf16_t;
typedef short bf16x8 __attribute__((ext_vector_type(8)));
typedef float f32x4 __attribute__((ext_vector_type(4)));
typedef unsigned u32x4 __attribute__((ext_vector_type(4)));
constexpr int BM = 256, BK = 64, HALF = 128, HTB = HALF * BK * 2, STAGE_BYTES = 8 * HTB, NXCD = 8, WGM = 8;

__host__ __device__ __forceinline__ int lds_byte(int r, int c) { const int st = (r >> 4) * 2 + (c >> 5), rr = r & 15, cc = c & 31, ob = rr * 64 + cc * 2; return st * 1024 + (ob ^ (((ob >> 9) & 1) << 5)); }
__host__ __device__ __forceinline__ void stage_rc(int b, int& R, int& C) { const int st = b / 1024, sb = b % 1024, swz = sb ^ (((sb >> 9) & 1) << 5); R = (st >> 1) * 16 + swz / 64; C = (st & 1) * 32 + (swz % 64) / 2; }
__host__ __device__ __forceinline__ int perm32(int rho) { const int n = rho >> 4, i = rho & 15; return 8 * (i >> 2) + 4 * n + (i & 3); }

struct Unit { int pm, pn; size_t boff; int e, s0, cnt; };
struct Gemm { const bf16_t* A; const bf16_t* Bt; int M, N, K; };

struct StaticOrder {
    static constexpr bool GATHER = false;
    int nM, nN, nwg, G, c;
    __host__ __device__ void init(int M, int N, int G_, int c_) { nM = M / BM; nN = N / BM; nwg = nM * nN; G = G_; c = c_; }
    __host__ __device__ bool next(int i, Unit& u) const {
        const long L = (long)i * G + c; if (L >= nwg) return false;
        int wgid = (int)L; { const int q = nwg / NXCD, r = nwg % NXCD, xcd = wgid % NXCD, off = wgid / NXCD; wgid = (xcd < r ? xcd * (q + 1) : r * (q + 1) + (xcd - r) * q) + off; }
        const int nig = WGM * nN, gid = wgid / nig, fm = gid * WGM, gsz = (nM - fm) < WGM ? (nM - fm) : WGM;
        u.pm = fm + ((wgid % nig) % gsz); u.pn = (wgid % nig) / gsz; u.boff = 0; u.e = 0; u.s0 = 0; u.cnt = 0; return true;
    }
    __device__ __forceinline__ int arow(const Unit& u, int r) const { return u.pm * BM + r; }
    __device__ __forceinline__ void a_ready(const Unit&) const {}
    __device__ __forceinline__ void done(const Unit&) const {}
};
template <bool GATHER_>
struct MoeOrder {
    static constexpr bool GATHER = GATHER_;
    int nrt, NT, nwg, G, c; size_t estride; const volatile PG8_LAS int* misc; const int* list;
    int mode, r_lo, r_hi;
    __device__ __forceinline__ bool next(int i, Unit& u) const {
        int rt, pn;
        if (mode == 0) {
            const long L = (long)i * G + c; if (L >= nwg) return false;
            int wgid = (int)L; { const int q = nwg / NXCD, r = nwg % NXCD, xcd = wgid % NXCD, off = wgid / NXCD; wgid = (xcd < r ? xcd * (q + 1) : r * (q + 1) + (xcd - r) * q) + off; }
            rt = wgid / NT; pn = wgid % NT;
        } else {
            const int x = c & 7, j = c >> 3;
            if (mode == 1) { const int round = r_lo + i; if (round >= r_hi) return false; rt = 64 * round + 8 * x + (j >> 2); pn = j & 3; if (rt >= nrt) return false; }
            else {
                const int lt = nrt > 128 ? nrt - 128 : 0;
                int lightBefore = 0, nLight = 0, hcx = 0;
                for (int xx = 0; xx < 8; ++xx) { int hc = 4 * (lt - 8 * xx); hc = hc < 0 ? 0 : (hc > 32 ? 32 : hc); if (xx < x) lightBefore += 32 - hc; if (xx == x) hcx = hc; nLight += 32 - hc; }
                int u2;
                if (mode == 2) { if (j < hcx || i >= 4) return false; u2 = i * nLight + lightBefore + (j - hcx); if (u2 >= 1024) return false; }
                else u2 = (4 * nLight < 1024 ? 4 * nLight : 1024) + i * 256 + x * 32 + j;
                if (u2 >= nwg) return false;
                rt = u2 >> 3; pn = u2 & 7;
            }
        }
        u.pm = rt; u.pn = pn;
        u.e = __builtin_amdgcn_readfirstlane(misc[64 + u.pm]); u.s0 = __builtin_amdgcn_readfirstlane(misc[320 + u.pm]); u.cnt = __builtin_amdgcn_readfirstlane(misc[480 + u.e]);
        u.boff = (size_t)u.e * estride; return true;
    }
    __device__ __forceinline__ int arow(const Unit& u, int r) const { if (!GATHER_) return u.pm * BM + r; const int slot = u.s0 + r; const int tk = slot < u.cnt ? list[u.e * 16384 + slot] : 0; return tk >> 1; }
    __device__ __forceinline__ void a_ready(const Unit&) const {}
    __device__ __forceinline__ void done(const Unit&) const {}
};

__device__ __forceinline__ unsigned cvt_pk_bf16(float lo, float hi) { unsigned r; asm volatile("v_cvt_pk_bf16_f32 %0, %1, %2" : "=v"(r) : "v"(lo), "v"(hi)); return r; }
__device__ __forceinline__ u32x4 pack8(const f32x4& v0, const f32x4& v1) { u32x4 w; w.x = cvt_pk_bf16(v0[0], v0[1]); w.y = cvt_pk_bf16(v0[2], v0[3]); w.z = cvt_pk_bf16(v1[0], v1[1]); w.w = cvt_pk_bf16(v1[2], v1[3]); return w; }
__device__ __forceinline__ float fexp(float x) { return __builtin_amdgcn_exp2f(x * 1.44269504089f); }
__device__ __forceinline__ float silu_f(float x) { return x * __builtin_amdgcn_rcpf(1.0f + fexp(-x)); }

struct NoPre {};
template <bool BASE_BF16>
struct EpiRes {
    static constexpr bool PERM = true, AFTER_DRAIN = false, KSCALE = false;
    const void* base; bf16_t* out; int ldc;
    typedef NoPre Pre; __device__ __forceinline__ Pre pre(const Unit&, int, int) const { return Pre{}; }
    __device__ __forceinline__ void operator()(const f32x4 (&acc)[2][2][4][2], const Unit& u, int wr, int wc, int fr, int fq, const Pre&) const {
        const int row0 = u.pm * BM + wr * 64 + fr, col0 = u.pn * BM + wc * 32 + 8 * fq;
        static_assert(BASE_BF16, "only the bf16 residual base is in use");
#pragma unroll
        for (int ai = 0; ai < 2; ++ai) {
            u32x4 bw[4][2];
#pragma unroll
            for (int m = 0; m < 4; ++m) { const size_t off = (size_t)(row0 + ai * HALF + m * 16) * ldc + col0;
#pragma unroll
                for (int bj = 0; bj < 2; ++bj) bw[m][bj] = *(const u32x4*)((const bf16_t*)base + off + bj * HALF); }
            asm volatile("" ::: "memory");
#pragma unroll
            for (int m = 0; m < 4; ++m) { const size_t off = (size_t)(row0 + ai * HALF + m * 16) * ldc + col0;
#pragma unroll
                for (int bj = 0; bj < 2; ++bj) { const u32x4 w = bw[m][bj];
                    const f32x4 b0 = (f32x4){__uint_as_float(w.x << 16), __uint_as_float(w.x & 0xffff0000u), __uint_as_float(w.y << 16), __uint_as_float(w.y & 0xffff0000u)};
                    const f32x4 b1 = (f32x4){__uint_as_float(w.z << 16), __uint_as_float(w.z & 0xffff0000u), __uint_as_float(w.w << 16), __uint_as_float(w.w & 0xffff0000u)};
                    *(u32x4*)(out + off + bj * HALF) = pack8(b0 + acc[ai][bj][m][0], b1 + acc[ai][bj][m][1]); } }
            asm volatile("" ::: "memory");
        }
    }
};
struct EpiResHead {
    static constexpr bool PERM = true, AFTER_DRAIN = false, KSCALE = true;
    const bf16_t* base; bf16_t* out; int ldc; const float* SS;
    struct Pre { const PG8_LAS float* tab; };
    __device__ __forceinline__ Pre pre2(const Unit& u, PG8_LAS unsigned char* lds, int ui, int tid) const {
        PG8_LAS float* tab = (PG8_LAS float*)(lds + 131072 + (ui & 1) * 4096);
        if (tid < 256) { const size_t row = (size_t)u.pm * BM + tid; float r[4];
#pragma unroll
            for (int h = 0; h < 4; ++h) { const f32x4 p = *(const f32x4*)(SS + row * 16 + h * 4); r[h] = 1.0f / sqrtf(((p.x + p.y) + (p.z + p.w)) * (1.0f / 512.0f) + 1e-6f); }
            *(PG8_LAS f32x4*)(tab + tid * 4) = (f32x4){r[0] / r[1], r[1] / r[2], r[2] / r[3], r[3]}; }
        return Pre{tab};
    }
    __device__ __forceinline__ void kscale(f32x4 (&acc)[2][2][4][2], const Pre& pf, int b, int wr, int fr) const {
#pragma unroll
        for (int ai = 0; ai < 2; ++ai)
#pragma unroll
            for (int m = 0; m < 4; ++m) { const float f = pf.tab[(ai * HALF + wr * 64 + m * 16 + fr) * 4 + b];
#pragma unroll
                for (int bj = 0; bj < 2; ++bj)
#pragma unroll
                    for (int n = 0; n < 2; ++n) acc[ai][bj][m][n] = acc[ai][bj][m][n] * f; }
    }
    __device__ __forceinline__ void operator()(const f32x4 (&acc)[2][2][4][2], const Unit& u, int wr, int wc, int fr, int fq, const Pre& pf) const {
        const int row0 = u.pm * BM + wr * 64 + fr, col0 = u.pn * BM + wc * 32 + 8 * fq;
#pragma unroll
        for (int ai = 0; ai < 2; ++ai) {
            u32x4 bw[4][2]; float ff[4];
#pragma unroll
            for (int m = 0; m < 4; ++m) { const size_t off = (size_t)(row0 + ai * HALF + m * 16) * ldc + col0; ff[m] = pf.tab[(ai * HALF + wr * 64 + m * 16 + fr) * 4 + 3];
#pragma unroll
                for (int bj = 0; bj < 2; ++bj) bw[m][bj] = *(const u32x4*)(base + off + bj * HALF); }
            asm volatile("" ::: "memory");
#pragma unroll
            for (int m = 0; m < 4; ++m) { const size_t off = (size_t)(row0 + ai * HALF + m * 16) * ldc + col0; const float f = ff[m];
#pragma unroll
                for (int bj = 0; bj < 2; ++bj) { const u32x4 w = bw[m][bj];
                    const f32x4 b0 = (f32x4){__uint_as_float(w.x << 16), __uint_as_float(w.x & 0xffff0000u), __uint_as_float(w.y << 16), __uint_as_float(w.y & 0xffff0000u)};
                    const f32x4 b1 = (f32x4){__uint_as_float(w.z << 16), __uint_as_float(w.z & 0xffff0000u), __uint_as_float(w.w << 16), __uint_as_float(w.w & 0xffff0000u)};
                    *(u32x4*)(out + off + bj * HALF) = pack8(b0 + acc[ai][bj][m][0] * f, b1 + acc[ai][bj][m][1] * f); } }
            asm volatile("" ::: "memory");
        }
    }
};
struct EpiGlaIn {
    static constexpr bool PERM = true, AFTER_DRAIN = false, KSCALE = false;
    bf16_t *Qp, *Kp, *Vb, *Gb; const float* Bc; const float* rstd;
    struct Pre { float rs[2][4]; };
    __device__ __forceinline__ Pre pre(const Unit& u, int wr, int fr) const { Pre p; const int row0 = u.pm * BM + wr * 64 + fr;
#pragma unroll
        for (int ai = 0; ai < 2; ++ai)
#pragma unroll
            for (int m = 0; m < 4; ++m) p.rs[ai][m] = rstd[row0 + ai * HALF + m * 16];
        return p; }
    __device__ __forceinline__ void operator()(const f32x4 (&acc)[2][2][4][2], const Unit& u, int wr, int wc, int fr, int fq, const Pre& pf) const {
        const int row0 = u.pm * BM + wr * 64 + fr, cl = wc * 32 + 8 * fq, ct = u.pn;
        float rs[2][4];
#pragma unroll
        for (int ai = 0; ai < 2; ++ai)
#pragma unroll
            for (int m = 0; m < 4; ++m) rs[ai][m] = pf.rs[ai][m];
        if (ct < 8) {
            const bool isq = ct < 4; const int cb = (ct & 3) * 256 + cl; bf16_t* dst = isq ? Qp : Kp; const float sgn = isq ? 1.4426950408889634f : -1.4426950408889634f, mul = isq ? 0.0625f : 1.0f;
#pragma unroll
            for (int ai = 0; ai < 2; ++ai) {
                f32x4 bb[4][2][2];
#pragma unroll
                for (int m = 0; m < 4; ++m) { const size_t ro = (size_t)(row0 + ai * HALF + m * 16) * 1024;
#pragma unroll
                    for (int bj = 0; bj < 2; ++bj) { bb[m][bj][0] = *(const f32x4*)(Bc + ro + cb + bj * HALF); bb[m][bj][1] = *(const f32x4*)(Bc + ro + cb + bj * HALF + 4); } }
                asm volatile("" ::: "memory");
#pragma unroll
                for (int m = 0; m < 4; ++m) { const size_t ro = (size_t)(row0 + ai * HALF + m * 16) * 1024; const float rm = rs[ai][m] * mul;
#pragma unroll
                    for (int bj = 0; bj < 2; ++bj) { f32x4 v0 = acc[ai][bj][m][0], v1 = acc[ai][bj][m][1];
#pragma unroll
                        for (int j = 0; j < 4; ++j) { v0[j] *= __builtin_amdgcn_exp2f(sgn * bb[m][bj][0][j]) * rm; v1[j] *= __builtin_amdgcn_exp2f(sgn * bb[m][bj][1][j]) * rm; }
                        *(u32x4*)(dst + ro + cb + bj * HALF) = pack8(v0, v1); } }
                asm volatile("" ::: "memory");
            }
        } else if (ct < 16) {
            const int cb = (ct - 8) * 256 + cl;
#pragma unroll
            for (int ai = 0; ai < 2; ++ai)
#pragma unroll
                for (int m = 0; m < 4; ++m) { const size_t ro = (size_t)(row0 + ai * HALF + m * 16) * 2048;
#pragma unroll
                    for (int bj = 0; bj < 2; ++bj) *(u32x4*)(Vb + ro + cb + bj * HALF) = pack8(acc[ai][bj][m][0] * rs[ai][m], acc[ai][bj][m][1] * rs[ai][m]); }
        } else {
            const int cb = (ct - 16) * 256 + cl;
#pragma unroll
            for (int ai = 0; ai < 2; ++ai)
#pragma unroll
                for (int m = 0; m < 4; ++m) { const size_t ro = (size_t)(row0 + ai * HALF + m * 16) * 2048;
#pragma unroll
                    for (int bj = 0; bj < 2; ++bj) { f32x4 v0 = acc[ai][bj][m][0] * rs[ai][m], v1 = acc[ai][bj][m][1] * rs[ai][m];
#pragma unroll
                        for (int j = 0; j < 4; ++j) { v0[j] = silu_f(v0[j]); v1[j] = silu_f(v1[j]); }
                        *(u32x4*)(Gb + ro + cb + bj * HALF) = pack8(v0, v1); } }
        }
    }
};
struct EpiConvIn {
    static constexpr bool PERM = true, AFTER_DRAIN = false, KSCALE = false;
    bf16_t *BG, *U; const float* rstd;
    struct Pre { float rs[2][4]; };
    __device__ __forceinline__ Pre pre(const Unit& u, int wr, int fr) const { Pre p; const int row0 = u.pm * BM + wr * 64 + fr;
#pragma unroll
        for (int ai = 0; ai < 2; ++ai)
#pragma unroll
            for (int m = 0; m < 4; ++m) p.rs[ai][m] = rstd[row0 + ai * HALF + m * 16];
        return p; }
    __device__ __forceinline__ void operator()(const f32x4 (&acc)[2][2][4][2], const Unit& u, int wr, int wc, int fr, int fq, const Pre& pf) const {
        const int row0 = u.pm * BM + wr * 64 + fr, cl = wc * 32 + 8 * fq, ct = u.pn;
        float rs[2][4];
#pragma unroll
        for (int ai = 0; ai < 2; ++ai)
#pragma unroll
            for (int m = 0; m < 4; ++m) rs[ai][m] = pf.rs[ai][m];
        if (ct < 8) {
            const int cb = ct * 256 + cl;
#pragma unroll
            for (int ai = 0; ai < 2; ++ai)
#pragma unroll
                for (int m = 0; m < 4; ++m) { const size_t ro = (size_t)(row0 + ai * HALF + m * 16) * 2048;
#pragma unroll
                    for (int bj = 0; bj < 2; ++bj) *(u32x4*)(BG + ro + cb + bj * HALF) = pack8(acc[ai][bj][m][0] * rs[ai][m], acc[ai][bj][m][1] * rs[ai][m]); }
        } else {
            const int cb = (ct - 8) * 128 + cl;
#pragma unroll
            for (int ai = 0; ai < 2; ++ai)
#pragma unroll
                for (int m = 0; m < 4; ++m) { const size_t ro = (size_t)(row0 + ai * HALF + m * 16) * 2048; const float r2 = rs[ai][m] * rs[ai][m];
                    *(u32x4*)(U + ro + cb) = pack8(acc[ai][0][m][0] * acc[ai][1][m][0] * r2, acc[ai][0][m][1] * acc[ai][1][m][1] * r2); }
        }
    }
};
struct EpiGateUp {
    static constexpr bool PERM = true, AFTER_DRAIN = false, KSCALE = false;
    bf16_t* ACT; const int* list; const float* rstd;
    struct Pre { float rs[2][4]; };
    __device__ __forceinline__ Pre pre(const Unit& u, int wr, int fr) const { Pre p; const int rl0 = wr * 64 + fr;
#pragma unroll
        for (int ai = 0; ai < 2; ++ai)
#pragma unroll
            for (int m = 0; m < 4; ++m) { const int slot = u.s0 + rl0 + ai * HALF + m * 16; const int tk = slot < u.cnt ? list[u.e * 16384 + slot] : 0; p.rs[ai][m] = rstd[tk >> 1]; }
        return p; }
    __device__ __forceinline__ void operator()(const f32x4 (&acc)[2][2][4][2], const Unit& u, int wr, int wc, int fr, int fq, const Pre& pf) const {
        const int rl0 = wr * 64 + fr, row0 = u.pm * BM + rl0, cb = u.pn * 128 + wc * 32 + 8 * fq;
        float rs[2][4];
#pragma unroll
        for (int ai = 0; ai < 2; ++ai)
#pragma unroll
            for (int m = 0; m < 4; ++m) rs[ai][m] = pf.rs[ai][m];
#pragma unroll
        for (int ai = 0; ai < 2; ++ai)
#pragma unroll
            for (int m = 0; m < 4; ++m) { const size_t ro = (size_t)(row0 + ai * HALF + m * 16) * 512; const float r = rs[ai][m];
                f32x4 v0 = acc[ai][0][m][0] * r, v1 = acc[ai][0][m][1] * r;
#pragma unroll
                for (int j = 0; j < 4; ++j) { v0[j] = silu_f(v0[j]) * (acc[ai][1][m][0][j] * r); v1[j] = silu_f(v1[j]) * (acc[ai][1][m][1][j] * r); }
                *(u32x4*)(ACT + ro + cb) = pack8(v0, v1); }
    }
};
struct EpiDown {
    static constexpr bool PERM = true, AFTER_DRAIN = false, KSCALE = false;
    bf16_t* Y;
    typedef NoPre Pre; __device__ __forceinline__ Pre pre(const Unit&, int, int) const { return Pre{}; }
    __device__ __forceinline__ void operator()(const f32x4 (&acc)[2][2][4][2], const Unit& u, int wr, int wc, int fr, int fq, const Pre&) const {
        const int rl0 = wr * 64 + fr, row0 = u.pm * BM + rl0, cb = u.pn * 256 + wc * 32 + 8 * fq, nvalid = u.cnt - u.s0;
#pragma unroll
        for (int ai = 0; ai < 2; ++ai)
#pragma unroll
            for (int m = 0; m < 4; ++m) { if (rl0 + ai * HALF + m * 16 >= nvalid) continue; const size_t ro = (size_t)(row0 + ai * HALF + m * 16) * 2048;
#pragma unroll
                for (int bj = 0; bj < 2; ++bj) *(u32x4*)(Y + ro + cb + bj * HALF) = pack8(acc[ai][bj][m][0], acc[ai][bj][m][1]); }
    }
};

template <class Epi, class Sched, bool ALIGN_EPI = false>
__device__ __forceinline__ void gemm_phase(PG8_LAS unsigned char* lds, const Gemm g, const Sched& S, const Epi& E) {
    const int tid = threadIdx.x, wid = __builtin_amdgcn_readfirstlane(tid >> 6), lane = tid & 63, wr = wid >> 2, wc = wid & 3, fr = lane & 15, fq = lane >> 4;
    const int K = g.K, nt = K / BK;
    unsigned voffA[2], voffB[2]; int RA[2], CA[2];
#pragma unroll
    for (int i = 0; i < 2; ++i) { int R, C; stage_rc(tid * 16 + i * 8192, R, C); const int Rb = Epi::PERM ? ((R & ~31) + perm32(R & 31)) : R; RA[i] = R; CA[i] = C;
        voffA[i] = (unsigned)(R * K + C) * 2u; voffB[i] = (unsigned)(Rb * K + C) * 2u; }
    const size_t kstep = (size_t)(BK * 2);
    const size_t hstep = (size_t)HALF * K * 2;
    const size_t tstep = 2 * hstep;
    const size_t hstepA = Sched::GATHER ? 0 : hstep;
    const unsigned ldsw = (unsigned)wid * 1024u;
    const int aoff = lds_byte(wr * 64 + fr, fq * 8), boff = lds_byte(wc * 32 + fr, fq * 8);
#define PG8_SA(b, h) (((b) * 2 + (h)) * HTB)
#define PG8_SB(b, h) ((4 + (b) * 2 + (h)) * HTB)
#define PG8_STAGE(bufoff, gbase, voff) do { _Pragma("unroll") for (int _i = 0; _i < 2; ++_i) \
        __builtin_amdgcn_global_load_lds((const unsigned*)((const char*)(gbase) + (voff)[_i]), (PG8_LAS unsigned*)(lds + (bufoff) + ldsw + _i * 8192), 16, 0, 0); } while (0)
#define PG8_LDA(dst, b, h) do { _Pragma("unroll") for (int m = 0; m < 4; ++m) _Pragma("unroll") for (int k = 0; k < 2; ++k) dst[m][k] = *(const PG8_LAS bf16x8*)(lds + PG8_SA(b, h) + aoff + m * 2048 + k * 1024); } while (0)
#define PG8_LDB(dst, b, h) do { _Pragma("unroll") for (int n = 0; n < 2; ++n) _Pragma("unroll") for (int k = 0; k < 2; ++k) dst[n][k] = *(const PG8_LAS bf16x8*)(lds + PG8_SB(b, h) + boff + n * 2048 + k * 1024); } while (0)
#define PG8_MMA(ai, bj, At, Bt) do { __builtin_amdgcn_s_setprio(1); _Pragma("unroll") for (int m = 0; m < 4; ++m) _Pragma("unroll") for (int n = 0; n < 2; ++n) _Pragma("unroll") for (int k = 0; k < 2; ++k) \
        acc[ai][bj][m][n] = __builtin_amdgcn_mfma_f32_16x16x32_bf16(Bt[n][k], At[m][k], acc[ai][bj][m][n], 0, 0, 0); __builtin_amdgcn_s_setprio(0); } while (0)
#define PG8_WAIT_V(n) asm volatile("s_waitcnt vmcnt(" #n ")" ::: "memory")
#define PG8_WAIT_L(n) asm volatile("s_waitcnt lgkmcnt(" #n ")" ::: "memory")
#define PG8_BAR __builtin_amdgcn_s_barrier()
#define PG8_SCHED __builtin_amdgcn_sched_barrier(0)
    Unit cur, nxt; int ui = 0;
    if (!S.next(0, cur)) return;
    f32x4 acc[2][2][4][2];
#pragma unroll
    for (int a = 0; a < 2; ++a)
#pragma unroll
        for (int b = 0; b < 2; ++b)
#pragma unroll
            for (int m = 0; m < 4; ++m)
#pragma unroll
                for (int n = 0; n < 2; ++n) acc[a][b][m][n] = (f32x4){0.f, 0.f, 0.f, 0.f};
    bf16x8 At[4][2], B0[2][2], B1[2][2];
    unsigned vc0[2], vc1[2], vn0[2], vn1[2];
    if constexpr (Sched::GATHER) {
#pragma unroll
        for (int i = 0; i < 2; ++i) { vc0[i] = (unsigned)(S.arow(cur, RA[i]) * K + CA[i]) * 2u; vc1[i] = (unsigned)(S.arow(cur, RA[i] + HALF) * K + CA[i]) * 2u; vn0[i] = vc0[i]; vn1[i] = vc1[i]; }
    } else {
#pragma unroll
        for (int i = 0; i < 2; ++i) { vc0[i] = voffA[i]; vc1[i] = voffA[i]; vn0[i] = voffA[i]; vn1[i] = voffA[i]; }
    }
    const char* cA = Sched::GATHER ? (const char*)g.A : (const char*)g.A + (size_t)cur.pm * tstep; const char* cB = (const char*)g.Bt + cur.boff + (size_t)cur.pn * tstep;
    S.a_ready(cur);
    PG8_STAGE(PG8_SB(0, 0), cB, voffB); PG8_STAGE(PG8_SB(0, 1), cB + hstep, voffB); PG8_STAGE(PG8_SA(0, 0), cA, vc0); PG8_STAGE(PG8_SA(0, 1), cA + hstepA, vc1);
    if (wr == 1) PG8_BAR;
    PG8_WAIT_V(2); PG8_BAR;
    PG8_STAGE(PG8_SB(1, 0), cB + kstep, voffB); PG8_STAGE(PG8_SA(1, 0), cA + kstep, vc0); PG8_STAGE(PG8_SB(1, 1), cB + hstep + kstep, voffB);
    PG8_WAIT_V(6); PG8_BAR;
    for (;;) {
        typename Epi::Pre pf;
        if constexpr (Epi::KSCALE) pf = E.pre2(cur, lds, ui, tid); else pf = E.pre(cur, wr, fr);
        const bool has_next = S.next(ui + 1, nxt);
        if constexpr (Sched::GATHER) { if (has_next) {
#pragma unroll
            for (int i = 0; i < 2; ++i) { vn0[i] = (unsigned)(S.arow(nxt, RA[i]) * K + CA[i]) * 2u; vn1[i] = (unsigned)(S.arow(nxt, RA[i] + HALF) * K + CA[i]) * 2u; } } }
        const char* nA = Sched::GATHER ? (const char*)g.A : (has_next ? (const char*)g.A + (size_t)nxt.pm * tstep : cA); const char* nB = has_next ? (const char*)g.Bt + nxt.boff + (size_t)nxt.pn * tstep : cB;
        for (int t = 0; t < nt; t += 2) {
            const bool last = (t == nt - 2);
            const char* a1 = cA + (size_t)(t + 1) * kstep;
            const char* a2 = last ? nA : cA + (size_t)(t + 2) * kstep; const char* b2 = last ? nB : cB + (size_t)(t + 2) * kstep;
            const char* a3 = a2 + kstep; const char* b3 = b2 + kstep;
            unsigned w0[2], w1[2];
#pragma unroll
            for (int i = 0; i < 2; ++i) { w0[i] = (Sched::GATHER && last) ? vn0[i] : vc0[i]; w1[i] = (Sched::GATHER && last) ? vn1[i] : vc1[i]; }
            if (last && has_next) S.a_ready(nxt);
            PG8_LDB(B0, 0, 0); PG8_LDB(B1, 0, 1); PG8_SCHED; PG8_LDA(At, 0, 0); PG8_STAGE(PG8_SA(1, 1), a1 + hstepA, vc1);
            PG8_WAIT_V(8); PG8_WAIT_L(0); PG8_BAR; PG8_MMA(0, 0, At, B0); PG8_MMA(0, 1, At, B1); PG8_BAR; PG8_SCHED;
            PG8_LDA(At, 0, 1); PG8_STAGE(PG8_SB(0, 0), b2, voffB); PG8_STAGE(PG8_SB(0, 1), b2 + hstep, voffB); PG8_STAGE(PG8_SA(0, 0), a2, w0);
            PG8_WAIT_V(8); PG8_WAIT_L(0); PG8_BAR; PG8_MMA(1, 0, At, B0); PG8_MMA(1, 1, At, B1); PG8_BAR; PG8_SCHED;
            PG8_LDB(B0, 1, 0); PG8_LDB(B1, 1, 1); PG8_SCHED; PG8_LDA(At, 1, 0); PG8_STAGE(PG8_SA(0, 1), a2 + hstepA, w1);
            PG8_WAIT_V(8); PG8_WAIT_L(0); PG8_BAR; PG8_MMA(0, 0, At, B0); PG8_MMA(0, 1, At, B1); PG8_BAR; PG8_SCHED;
            PG8_LDA(At, 1, 1); PG8_STAGE(PG8_SB(1, 0), b3, voffB); PG8_STAGE(PG8_SB(1, 1), b3 + hstep, voffB); PG8_STAGE(PG8_SA(1, 0), a3, w0);
            PG8_WAIT_V(8); PG8_WAIT_L(0); PG8_BAR; PG8_MMA(1, 0, At, B0); PG8_MMA(1, 1, At, B1); PG8_BAR; PG8_SCHED;
            if constexpr (Epi::KSCALE) { if (((t + 2) & 7) == 0 && t + 2 < nt) { E.kscale(acc, pf, ((t + 2) >> 3) - 1, wr, fr); PG8_SCHED; } }
        }
        if constexpr (ALIGN_EPI) { if (wr == 0) PG8_BAR; }
        if constexpr (!Epi::AFTER_DRAIN) { E(acc, cur, wr, wc, fr, fq, pf); S.done(cur); }
        if (!has_next) break;
#pragma unroll
        for (int a = 0; a < 2; ++a)
#pragma unroll
            for (int b = 0; b < 2; ++b)
#pragma unroll
                for (int m = 0; m < 4; ++m)
#pragma unroll
                    for (int n = 0; n < 2; ++n) acc[a][b][m][n] = (f32x4){0.f, 0.f, 0.f, 0.f};
        cur = nxt; cA = nA; cB = nB; ++ui;
        if constexpr (Sched::GATHER) {
#pragma unroll
            for (int i = 0; i < 2; ++i) { vc0[i] = vn0[i]; vc1[i] = vn1[i]; } }
        if constexpr (ALIGN_EPI) { if (wr == 1) PG8_BAR; }
    }
    PG8_WAIT_V(0);
    if constexpr (!ALIGN_EPI) { if (wr == 0) PG8_BAR; }
    PG8_BAR;
#undef PG8_SA
#undef PG8_SB
#undef PG8_STAGE
#undef PG8_LDA
#undef PG8_LDB
#undef PG8_MMA
#undef PG8_WAIT_V
#undef PG8_WAIT_L
#undef PG8_BAR
#undef PG8_SCHED
}
}

constexpr int NWAVES = 8;
enum { PH_CONV = 0, PH_NORM0, PH_GIN, PH_GLA1, PH_GLA2, PH_HNORM, PH_GOUT, PH_MOE0  , PH_CIN = PH_MOE0 + 5, PH_CONVE, PH_COUT, PH_MOE1, NPH = PH_MOE1 + 5 };
constexpr int N_LAUNCHES = (MK_N_LAUNCHES == 1) ? 1 : NPH;

constexpr int T = 16384, D = 2048;
constexpr int KD = 1024, VD = 2048, GIN = 6160, GINM = 6144, DKH = 256, DVH = 512, NHEAD = 4, CHK = 64, NCHUNK = T / CHK, RANK = 16;
constexpr int NE = 32, FF = 512, NGRP = 4, EPG = 8, NLOG = 48;
constexpr int MAX_RT = 160;
constexpr float EPS = 1e-6f;

constexpr size_t MiB = 1u << 20;
constexpr size_t WS_CTL = 0, CTL_ZERO_BYTES = 65536;
constexpr size_t WS_SS = 1 * MiB;
constexpr size_t WS_TKE = 2 * MiB;
constexpr size_t WS_TKS = WS_TKE + 131072;
constexpr size_t WS_TKG = WS_TKS + 131072;
constexpr size_t WS_RSTD = WS_TKG + 131072;
constexpr size_t WS_LIST = 3 * MiB;
constexpr size_t WS_WRT = 5 * MiB;
constexpr size_t WS_WRH = 6 * MiB;
constexpr size_t WS_WRL = WS_WRH + 393216;
constexpr size_t WS_WGH = 7 * MiB;
constexpr size_t WS_WGL = WS_WGH + 65536;
constexpr size_t WS_WGI = 8 * MiB;
constexpr size_t WS_WGO = 32 * MiB;
constexpr size_t WS_WCI = 40 * MiB;
constexpr size_t WS_WCO = 64 * MiB;
constexpr size_t WS_WGU = 72 * MiB;
constexpr size_t WS_WDN = 328 * MiB;
constexpr size_t WS_HN = 456 * MiB;
constexpr size_t WS_BC = 520 * MiB;
constexpr size_t WS_QP = 584 * MiB;
constexpr size_t WS_KP = 616 * MiB;
constexpr size_t WS_VB = 648 * MiB;
constexpr size_t WS_GB = 712 * MiB;
constexpr size_t WS_O = 776 * MiB;
constexpr size_t WS_OG = 904 * MiB;
constexpr size_t WS_H1 = 968 * MiB;
constexpr size_t WS_H2 = 1096 * MiB;
constexpr size_t WS_XS = 1224 * MiB;
constexpr size_t WS_ACT = 1384 * MiB;
constexpr size_t WS_Y = 1424 * MiB;
constexpr size_t WS_SEND = 1584 * MiB;
constexpr size_t WS_GTOT = 1616 * MiB;
constexpr size_t WS_END = 1617 * MiB;
constexpr int CW_TMO = 0, CW_CODE = 1;
constexpr int CW_BAR = 4096;
constexpr int CW_CNT = 8192;

constexpr int RING_OFF = 0, RING_BYTES = 131072;
constexpr int SCR_OFF = 131072, SCR_BYTES = 8192;
constexpr int MISC_OFF = SCR_OFF + SCR_BYTES;
constexpr int MISC_BYTES = 2048;
constexpr int LDS_BYTES = 147456;
static_assert(MISC_OFF + MISC_BYTES <= LDS_BYTES, "LDS map");
constexpr int MI_PSTART = 16, MI_NRT = 49, MI_TEXP = 64, MI_CNTL = 256, MI_BASEL = 288, MI_TSLOT = 320, MI_ECNT = 480;
static_assert(MI_TEXP == 64 && MI_TSLOT == 320 && MI_ECNT == 480, "pg8::MoeOrder reads these words by number");

#define GAS __attribute__((address_space(1)))
#define LAS __attribute__((address_space(3)))
typedef unsigned short bf16;
typedef unsigned v4u __attribute__((ext_vector_type(4)));
typedef unsigned v2u __attribute__((ext_vector_type(2)));
typedef float f32x4 __attribute__((ext_vector_type(4)));
typedef GAS unsigned gu32;
#define RLX_AGENT __ATOMIC_RELAXED, __HIP_MEMORY_SCOPE_AGENT
#define LDS_WAIT() asm volatile("s_waitcnt lgkmcnt(0)" ::: "memory")
#define VM_WAIT() asm volatile("s_waitcnt vmcnt(0)" ::: "memory")
__device__ __forceinline__ unsigned f2bf(float f) { unsigned u = __builtin_bit_cast(unsigned, f); return (u + 0x7fffu + ((u >> 16) & 1u)) >> 16; }
__device__ __forceinline__ unsigned pk2(float lo, float hi) { return f2bf(lo) | (f2bf(hi) << 16); }
__device__ __forceinline__ float bflo(unsigned w) { return __uint_as_float(w << 16); }
__device__ __forceinline__ float bfhi(unsigned w) { return __uint_as_float(w & 0xffff0000u); }
__device__ __forceinline__ f32x4 bf4lo(const v4u& w) { return (f32x4){bflo(w.x), bfhi(w.x), bflo(w.y), bfhi(w.y)}; }
__device__ __forceinline__ f32x4 bf4hi(const v4u& w) { return (f32x4){bflo(w.z), bfhi(w.z), bflo(w.w), bfhi(w.w)}; }

#define XB_TMO      128
#define XB_XCNT(j)  (256  + 64 * (j))
#define XB_XSUB(j)  (1280 + 64 * (j))
#define XB_XGEN(j)  (2304 + 64 * (j))
#define XB_TOP      3328
#define XB_TOPGEN   3392
#define XCD_BAR_WORDS 3456
#define XB_SPIN_CAP (1u << 22)
__device__ __forceinline__ unsigned xb_ld(unsigned* p)              { return __hip_atomic_load(p, __ATOMIC_RELAXED, __HIP_MEMORY_SCOPE_AGENT); }
__device__ __forceinline__ unsigned xb_add(unsigned* p, unsigned v) { return __hip_atomic_fetch_add(p, v, __ATOMIC_RELAXED, __HIP_MEMORY_SCOPE_AGENT); }
__device__ __forceinline__ unsigned xb_xcc_id() { return (unsigned)__builtin_amdgcn_s_getreg((3 << 11) | 20) & 0xFu; }
#define XB_SPIN(cond, bar) do { unsigned _sp = 0; while (cond) { __builtin_amdgcn_s_sleep(1); \
    if ((++_sp & 255u) == 0u) { if (xb_ld(&(bar)[XB_TMO])) break; if (_sp > XB_SPIN_CAP) { atomicAdd(&(bar)[XB_TMO], 1u); break; } } } } while (0)
struct XcdBarrier { unsigned* bar; unsigned x; volatile LAS unsigned* st; };
__device__ __forceinline__ XcdBarrier xcd_barrier_post(unsigned* bar, volatile LAS unsigned* st) {
    XcdBarrier b; b.bar = bar; b.x = xb_xcc_id(); b.st = st;
    if (threadIdx.x == 0) (void)xb_add(&bar[XB_XCNT(b.x)], 1u);
    return b;
}
__device__ __forceinline__ void xcd_barrier_complete(unsigned* bar, unsigned x, unsigned& nloc, unsigned& nx) {
    const unsigned G = gridDim.x * gridDim.y * gridDim.z;
    unsigned sum, cnt, mine, sp = 0u;
    for (;;) {
        sum = 0u; cnt = 0u; mine = 0u;
#pragma unroll
        for (unsigned j = 0; j < 16; ++j) { const unsigned c = xb_ld(&bar[XB_XCNT(j)]); sum += c; cnt += (c > 0u) ? 1u : 0u; mine = (j == x) ? c : mine; }
        if (sum == G) break;
        __builtin_amdgcn_s_sleep(1);
        if ((++sp & 255u) == 0u) { if (xb_ld(&bar[XB_TMO])) break; if (sp > XB_SPIN_CAP) { atomicAdd(&bar[XB_TMO], 1u); break; } }
    }
    nloc = mine > 0u ? mine : 1u; nx = cnt > 0u ? cnt : 1u;
}
__device__ __forceinline__ void xcd_barrier(const XcdBarrier& b) {
    asm volatile("s_waitcnt vmcnt(0)" ::: "memory");
    __syncthreads();
    if (threadIdx.x == 0) {
        unsigned* bar = b.bar;
        __builtin_amdgcn_s_waitcnt(0);
        unsigned nloc = b.st[0], nx = b.st[1];
        if (nloc == 0u) { xcd_barrier_complete(bar, b.x, nloc, nx); b.st[0] = nloc; b.st[1] = nx; }
        const unsigned old = xb_add(&bar[XB_XSUB(b.x)], 1u);
        const unsigned gen = old / nloc;
        if (old + 1u == (gen + 1u) * nloc) {
            __builtin_amdgcn_fence(__ATOMIC_RELEASE, "agent");
            asm volatile("s_waitcnt vmcnt(0)" ::: "memory");
            const unsigned og = xb_add(&bar[XB_TOP], 1u);
            const unsigned tg = og / nx;
            if (og + 1u == (tg + 1u) * nx) xb_add(&bar[XB_TOPGEN], 1u);
            else XB_SPIN(xb_ld(&bar[XB_TOPGEN]) == tg, bar);
            __builtin_amdgcn_fence(__ATOMIC_ACQUIRE, "agent");
            xb_add(&bar[XB_XGEN(b.x)], 1u);
            asm volatile("s_waitcnt vmcnt(0)" ::: "memory");
        } else {
            XB_SPIN(xb_ld(&bar[XB_XGEN(b.x)]) == gen, bar);
            __builtin_amdgcn_fence(__ATOMIC_ACQUIRE, "agent");
            asm volatile("s_waitcnt vmcnt(0)" ::: "memory");
        }
    }
    __syncthreads();
}

struct Frame {
    LAS unsigned char* lds;
    volatile LAS int* MISC;
    unsigned* ctl;
    int tid, lane, wave, G;
    unsigned long long tp_t0, tp_acc;
    __attribute__((address_space(4))) const unsigned char* ka;
};
#define KIN(i) (*(const float* const __attribute__((address_space(4)))*)(F.ka + 8 * (i)))
#define KOUT   (*(float* const __attribute__((address_space(4)))*)(F.ka + 8 * 18))
#define KWS    (*(unsigned char* const __attribute__((address_space(4)))*)(F.ka + 8 * 19))
#define TPROBE_MASK 0u
#define TPROBE_MULT 4
#define TP_BEGIN(k) do { if ((TPROBE_MASK >> (k)) & 1u) { if (F.tid == 0) F.MISC[50] = (int)__builtin_amdgcn_s_memrealtime(); } } while (0)
#define TP_END(k) do { if ((TPROBE_MASK >> (k)) & 1u) { if (F.tid == 0) F.MISC[51] = F.MISC[51] + ((int)__builtin_amdgcn_s_memrealtime() - F.MISC[50]); } } while (0)
__device__ __forceinline__ float wave_sum(float v) {
#pragma unroll
    for (int o = 1; o < 64; o <<= 1) v += __shfl_xor(v, o);
    return v;
}

struct XTile { const float* W; bf16* WT; const float* ks; int K, ldw, kb, nb, kind; };
constexpr int XT_LD = 257;
__device__ __forceinline__ void xtile_load(const XTile& t, f32x4 (&v)[16], int w, int lane) {
    const float* p = t.W + (size_t)(128 * t.kb + 16 * w) * t.ldw + 256 * t.nb + 4 * lane;
#pragma unroll
    for (int i = 0; i < 16; ++i) v[i] = __builtin_nontemporal_load((const f32x4*)(p + (size_t)i * t.ldw));
}
__device__ __forceinline__ void xtile_to_lds(const XTile& t, const f32x4 (&v)[16], LAS unsigned* buf, int w, int lane) {
    float sc[16];
#pragma unroll
    for (int i = 0; i < 16; ++i) sc[i] = t.ks ? t.ks[128 * t.kb + 16 * w + i] : 1.0f;
#pragma unroll
    for (int i = 0; i < 8; ++i) { LAS unsigned* d = buf + (8 * w + i) * XT_LD + 4 * lane; const f32x4 a = v[2 * i] * sc[2 * i], b = v[2 * i + 1] * sc[2 * i + 1];
        d[0] = pk2(a.x, b.x); d[1] = pk2(a.y, b.y); d[2] = pk2(a.z, b.z); d[3] = pk2(a.w, b.w); }
}
__device__ __forceinline__ int conv_in_row(int n) { if (n < 2048) return n; const int s = (n - 2048) >> 11, f = (n - 2048) & 2047; return 2048 + 256 * (f >> 7) + 128 * s + (f & 127); }
__device__ __forceinline__ int gate_up_row(int n) { const int s = n >> 9, f = n & 511; return 256 * (f >> 7) + 128 * s + (f & 127); }

__device__ __forceinline__ XTile xtile_decode(Frame& F, int r) {
    constexpr int T_GI = 16 * 24, T_GO = 16 * 8, T_CI = 16 * 24, T_CO = 16 * 8, T_GU1 = 16 * 4, T_DN1 = 4 * 8, T_GU = T_GU1 * 64;
    bf16* WGI = (bf16*)(KWS + WS_WGI); bf16* WGO = (bf16*)(KWS + WS_WGO); bf16* WCI = (bf16*)(KWS + WS_WCI); bf16* WCO = (bf16*)(KWS + WS_WCO);
    bf16* WGU = (bf16*)(KWS + WS_WGU); bf16* WDN = (bf16*)(KWS + WS_WDN);
    XTile t; t.kind = 0; t.ks = nullptr;
    if (r < T_GI) { t.kb = r / 24; t.nb = r % 24; t.W = KIN(2); t.K = 2048; t.ldw = GIN; t.WT = WGI; t.ks = KIN(1); return t; } r -= T_GI;
    if (r < T_GO) { t.kb = r / 8; t.nb = r % 8; t.W = KIN(6); t.K = 2048; t.ldw = 2048; t.WT = WGO; return t; } r -= T_GO;
    if (r < T_CI) { t.kb = r / 24; t.nb = r % 24; t.W = KIN(7); t.K = 2048; t.ldw = 6144; t.WT = WCI; t.kind = 1; t.ks = KIN(1) + D; return t; } r -= T_CI;
    if (r < T_CO) { t.kb = r / 8; t.nb = r % 8; t.W = KIN(9); t.K = 2048; t.ldw = 2048; t.WT = WCO; return t; } r -= T_CO;
    if (r < T_GU) { const int le = r / T_GU1, q = r % T_GU1; t.kb = q / 4; t.nb = q % 4; t.W = KIN(15) + (size_t)le * 2048 * 1024; t.K = 2048; t.ldw = 1024; t.WT = WGU + (size_t)le * 1024 * 2048; t.kind = 2; t.ks = KIN(10) + (le >> 5) * D; return t; } r -= T_GU;
    { const int le = r / T_DN1, q = r % T_DN1; t.kb = q / 8; t.nb = q % 8; t.W = KIN(16) + (size_t)le * 512 * 2048; t.K = 512; t.ldw = 2048; t.WT = WDN + (size_t)le * 2048 * 512; return t; }
}
__device__ __forceinline__ void xtile_store(const XTile& t, const LAS unsigned* buf, int w, int lane) {
    const int n0 = 256 * t.nb + 32 * w, dr0 = t.kind == 1 ? conv_in_row(n0) : t.kind == 2 ? gate_up_row(n0) : n0;
    const int c = lane & 15, k0 = 128 * t.kb;
#pragma unroll
    for (int j = 0; j < 8; ++j) { const int n = (lane >> 4) + 4 * j; const LAS unsigned* s = buf + (4 * c) * XT_LD + 32 * w + n;
        v4u o; o.x = s[0]; o.y = s[XT_LD]; o.z = s[2 * XT_LD]; o.w = s[3 * XT_LD];
        __builtin_nontemporal_store(o, (v4u*)(t.WT + (size_t)(dr0 + n) * t.K + k0 + 8 * c)); }
}
__device__ __forceinline__ void p0_convert(Frame& F) {
    constexpr int NTILES = 16 * 24 + 16 * 8 + 16 * 24 + 16 * 8 + 16 * 4 * 64 + 4 * 8 * 64;
    static_assert(2 * 64 * XT_LD * 4 <= MISC_OFF, "convert LDS");
    {
        f32x4 v[16]; XTile cur, nxt; int i = 0;
        int t = blockIdx.x;
        if (t < NTILES) { cur = xtile_decode(F, t); xtile_load(cur, v, F.wave, F.lane); }
        for (; t < NTILES; t += F.G, ++i) {
            LAS unsigned* buf = (LAS unsigned*)(F.lds) + (i & 1) * 64 * XT_LD;
            xtile_to_lds(cur, v, buf, F.wave, F.lane);
            asm volatile("s_waitcnt lgkmcnt(0)" ::: "memory"); __builtin_amdgcn_s_barrier(); asm volatile("" ::: "memory");
            const bool hn = t + F.G < NTILES;
            if (hn) { nxt = xtile_decode(F, t + F.G); xtile_load(nxt, v, F.wave, F.lane); }
            asm volatile("" ::: "memory");
            xtile_store(cur, buf, F.wave, F.lane);
            if (hn) cur = nxt;
        }
        __syncthreads();
    }
    bf16* WRH = (bf16*)(KWS + WS_WRH); bf16* WRL = (bf16*)(KWS + WS_WRL);
    for (int i = blockIdx.x * 512 + F.tid; i < 2 * NLOG * 2048; i += F.G * 512) {
        const int l = i / (NLOG * 2048), c = (i / 2048) % NLOG, k = i % 2048;
        float w = 0.f;
        if (c < 4) w = KIN(11)[((size_t)l * 2048 + k) * 4 + c]; else if (c < 36) w = KIN(13)[((size_t)l * 2048 + k) * 32 + (c - 4)];
        w *= KIN(10)[l * 2048 + k];
        const unsigned h = f2bf(w); WRH[i] = (bf16)h; WRL[i] = (bf16)f2bf(w - __uint_as_float(h << 16));
    }
    bf16* WGH = (bf16*)(KWS + WS_WGH); bf16* WGL = (bf16*)(KWS + WS_WGL);
    for (int i = blockIdx.x * 512 + F.tid; i < 16 * 2048; i += F.G * 512) {
        const int k = i >> 4, r = i & 15; const float w = KIN(2)[(size_t)k * GIN + GINM + r] * KIN(1)[k];
        const unsigned h = f2bf(w); WGH[r * 2048 + k] = (bf16)h; WGL[r * 2048 + k] = (bf16)f2bf(w - __uint_as_float(h << 16));
    }
}

typedef short rb_bf16x8 __attribute__((ext_vector_type(8)));
typedef float rb_f32x2 __attribute__((ext_vector_type(2))); typedef __bf16 rb_bf16x2 __attribute__((ext_vector_type(2)));
__device__ __forceinline__ unsigned rb_cvtpk(float lo, float hi) { rb_f32x2 v = {lo, hi}; rb_bf16x2 b = __builtin_convertvector(v, rb_bf16x2); return __builtin_bit_cast(unsigned, b); }
constexpr int RB_LD = 1040;
template <int NC>
__device__ __forceinline__ void rowblock_mfma(Frame& F, const float* X, const bf16* WH, const bf16* WL, LAS float* part, LAS float* sqp, bf16* HNrows) {
    const int w = F.wave, lane = F.lane, r = lane & 15, q = lane >> 4;
    LAS unsigned char* img = F.lds;
    f32x4 acc[4][NC]; float ss[4];
#pragma unroll
    for (int rt = 0; rt < 4; ++rt) { ss[rt] = 0.f;
#pragma unroll
        for (int c = 0; c < NC; ++c) acc[rt][c] = (f32x4){0.f, 0.f, 0.f, 0.f}; }
    const GAS char* xb = (const GAS char*)X; const GAS char* whb = (const GAS char*)WH; const GAS char* wlb = (const GAS char*)WL; GAS char* hb = (GAS char*)HNrows;
    const unsigned xo = (unsigned)((8 * w) * D + 4 * lane) * 4u;
    const unsigned wo = (unsigned)(r * 2048 + w * 32 + 8 * q) * 2u;
    f32x4 xr[8]; rb_bf16x8 bh[NC], bl[NC], bhn[NC], bln[NC];
#pragma unroll
    for (int i = 0; i < 8; ++i) xr[i] = __builtin_nontemporal_load((const GAS f32x4*)(xb + i * D * 4 + xo));
#pragma unroll
    for (int c = 0; c < NC; ++c) { bhn[c] = *(const GAS rb_bf16x8*)(whb + c * 16 * 2048 * 2 + wo); bln[c] = *(const GAS rb_bf16x8*)(wlb + c * 16 * 2048 * 2 + wo); }
    __syncthreads();
#pragma unroll 1
    for (int ch = 0; ch < 8; ++ch) {
#pragma unroll
        for (int i = 0; i < 8; ++i) { *(LAS f32x4*)(img + (8 * w + i) * RB_LD + 16 * lane) = xr[i];
            const f32x4 y = xr[i]; v2u o; o.x = rb_cvtpk(y.x, y.y); o.y = rb_cvtpk(y.z, y.w); *(GAS v2u*)(hb + (8 * w + i) * D * 2 + (unsigned)(ch * 256 + 4 * lane) * 2u) = o; }
#pragma unroll
        for (int c = 0; c < NC; ++c) { bh[c] = bhn[c]; bl[c] = bln[c]; }
        asm volatile("s_waitcnt lgkmcnt(0)" ::: "memory"); __builtin_amdgcn_s_barrier(); asm volatile("" ::: "memory");
        if (ch + 1 < 8) {
#pragma unroll
            for (int i = 0; i < 8; ++i) xr[i] = __builtin_nontemporal_load((const GAS f32x4*)(xb + i * D * 4 + (xo + (ch + 1) * 1024)));
#pragma unroll
            for (int c = 0; c < NC; ++c) { bhn[c] = *(const GAS rb_bf16x8*)(whb + c * 16 * 2048 * 2 + (wo + (ch + 1) * 512)); bln[c] = *(const GAS rb_bf16x8*)(wlb + c * 16 * 2048 * 2 + (wo + (ch + 1) * 512)); }
        }
        asm volatile("" ::: "memory");
#pragma unroll
        for (int rt = 0; rt < 4; ++rt) {
            const LAS unsigned char* fp = img + (16 * rt + r) * RB_LD + w * 128 + q * 32;
            const f32x4 a = *(const LAS f32x4*)fp, b = *(const LAS f32x4*)(fp + 16);
            ss[rt] += (a.x * a.x + a.y * a.y) + (a.z * a.z + a.w * a.w) + (b.x * b.x + b.y * b.y) + (b.z * b.z + b.w * b.w);
            v4u h; h.x = rb_cvtpk(a.x, a.y); h.y = rb_cvtpk(a.z, a.w); h.z = rb_cvtpk(b.x, b.y); h.w = rb_cvtpk(b.z, b.w);
            v4u l; l.x = rb_cvtpk(a.x - bflo(h.x), a.y - bfhi(h.x)); l.y = rb_cvtpk(a.z - bflo(h.y), a.w - bfhi(h.y)); l.z = rb_cvtpk(b.x - bflo(h.z), b.y - bfhi(h.z)); l.w = rb_cvtpk(b.z - bflo(h.w), b.w - bfhi(h.w));
            const rb_bf16x8 ah = __builtin_bit_cast(rb_bf16x8, h), al = __builtin_bit_cast(rb_bf16x8, l);
#pragma unroll
            for (int c = 0; c < NC; ++c) { acc[rt][c] = __builtin_amdgcn_mfma_f32_16x16x32_bf16(ah, bh[c], acc[rt][c], 0, 0, 0); acc[rt][c] = __builtin_amdgcn_mfma_f32_16x16x32_bf16(ah, bl[c], acc[rt][c], 0, 0, 0);
                acc[rt][c] = __builtin_amdgcn_mfma_f32_16x16x32_bf16(al, bh[c], acc[rt][c], 0, 0, 0); }
        }
        asm volatile("s_waitcnt lgkmcnt(0)" ::: "memory"); __builtin_amdgcn_s_barrier(); asm volatile("" ::: "memory");
    }
#pragma unroll
    for (int rt = 0; rt < 4; ++rt) {
#pragma unroll
        for (int c = 0; c < NC; ++c)
#pragma unroll
            for (int j = 0; j < 4; ++j) part[(w * 64 + rt * 16 + 4 * q + j) * (NC * 16) + c * 16 + r] = acc[rt][c][j];
        float t = ss[rt]; t += __shfl_xor(t, 16); t += __shfl_xor(t, 32);
        if (q == 0) sqp[w * 64 + rt * 16 + r] = t;
    }
}

constexpr int RBB_LD = 528;
template <int NC>
__device__ __forceinline__ void rowblock_bf16(Frame& F, const bf16* X, const bf16* WH, const bf16* WL, LAS float* part, LAS float* sqp) {
    const int w = F.wave, lane = F.lane, r = lane & 15, q = lane >> 4;
    LAS unsigned char* img = F.lds;
    f32x4 acc[4][NC]; float ss[4];
#pragma unroll
    for (int rt = 0; rt < 4; ++rt) { ss[rt] = 0.f;
#pragma unroll
        for (int c = 0; c < NC; ++c) acc[rt][c] = (f32x4){0.f, 0.f, 0.f, 0.f}; }
    const GAS char* xb = (const GAS char*)X; const GAS char* whb = (const GAS char*)WH; const GAS char* wlb = (const GAS char*)WL;
    const int lr = lane >> 5, lc = lane & 31;
    const unsigned xo = (unsigned)((8 * w + lr) * D + 8 * lc) * 2u;
    const unsigned wo = (unsigned)(r * 2048 + w * 32 + 8 * q) * 2u;
    v4u xr[4]; rb_bf16x8 bh[NC], bl[NC], bhn[NC], bln[NC];
#pragma unroll
    for (int i = 0; i < 4; ++i) xr[i] = *(const GAS v4u*)(xb + i * 2 * D * 2 + xo);
#pragma unroll
    for (int c = 0; c < NC; ++c) { bhn[c] = *(const GAS rb_bf16x8*)(whb + c * 16 * 2048 * 2 + wo); bln[c] = *(const GAS rb_bf16x8*)(wlb + c * 16 * 2048 * 2 + wo); }
    __syncthreads();
#pragma unroll 1
    for (int ch = 0; ch < 8; ++ch) {
#pragma unroll
        for (int i = 0; i < 4; ++i) *(LAS v4u*)(img + (8 * w + 2 * i + lr) * RBB_LD + 16 * lc) = xr[i];
#pragma unroll
        for (int c = 0; c < NC; ++c) { bh[c] = bhn[c]; bl[c] = bln[c]; }
        asm volatile("s_waitcnt lgkmcnt(0)" ::: "memory"); __builtin_amdgcn_s_barrier(); asm volatile("" ::: "memory");
        if (ch + 1 < 8) {
#pragma unroll
            for (int i = 0; i < 4; ++i) xr[i] = *(const GAS v4u*)(xb + i * 2 * D * 2 + (xo + (ch + 1) * 512));
#pragma unroll
            for (int c = 0; c < NC; ++c) { bhn[c] = *(const GAS rb_bf16x8*)(whb + c * 16 * 2048 * 2 + (wo + (ch + 1) * 512)); bln[c] = *(const GAS rb_bf16x8*)(wlb + c * 16 * 2048 * 2 + (wo + (ch + 1) * 512)); }
        }
        asm volatile("" ::: "memory");
#pragma unroll
        for (int rt = 0; rt < 4; ++rt) {
            const v4u a = *(const LAS v4u*)(img + (16 * rt + r) * RBB_LD + w * 64 + q * 16);
            { const float e0 = bflo(a.x), e1 = bfhi(a.x), e2 = bflo(a.y), e3 = bfhi(a.y), e4 = bflo(a.z), e5 = bfhi(a.z), e6 = bflo(a.w), e7 = bfhi(a.w);
              ss[rt] += (e0 * e0 + e1 * e1) + (e2 * e2 + e3 * e3) + (e4 * e4 + e5 * e5) + (e6 * e6 + e7 * e7); }
            const rb_bf16x8 ah = __builtin_bit_cast(rb_bf16x8, a);
#pragma unroll
            for (int c = 0; c < NC; ++c) { acc[rt][c] = __builtin_amdgcn_mfma_f32_16x16x32_bf16(ah, bh[c], acc[rt][c], 0, 0, 0); acc[rt][c] = __builtin_amdgcn_mfma_f32_16x16x32_bf16(ah, bl[c], acc[rt][c], 0, 0, 0); }
        }
        asm volatile("s_waitcnt lgkmcnt(0)" ::: "memory"); __builtin_amdgcn_s_barrier(); asm volatile("" ::: "memory");
    }
#pragma unroll
    for (int rt = 0; rt < 4; ++rt) {
#pragma unroll
        for (int c = 0; c < NC; ++c)
#pragma unroll
            for (int j = 0; j < 4; ++j) part[(w * 64 + rt * 16 + 4 * q + j) * (NC * 16) + c * 16 + r] = acc[rt][c][j];
        float t = ss[rt]; t += __shfl_xor(t, 16); t += __shfl_xor(t, 32);
        if (q == 0) sqp[w * 64 + rt * 16 + r] = t;
    }
}

__device__ __forceinline__ void p0_norm_gl(Frame& F) {
    LAS float* part = (LAS float*)(F.lds);
    LAS float* sqp = (LAS float*)(F.lds + 32768);
    LAS float* glc = (LAS float*)(F.lds + 32768 + 2048);
    LAS float* rs = (LAS float*)(F.lds + 32768 + 2048 + 4096);
    const float* x = KIN(0); const float* wn = KIN(1); bf16* HN = (bf16*)(KWS + WS_HN); float* BC = (float*)(KWS + WS_BC); float* RSTD = (float*)(KWS + WS_RSTD);
    const float* w2 = KIN(3); const float* bgk = KIN(4);
    for (int ch = blockIdx.x; ch < NCHUNK; ch += F.G) {
        TP_BEGIN(22); rowblock_mfma<1>(F, x + (size_t)ch * CHK * D, (const bf16*)(KWS + WS_WGH), (const bf16*)(KWS + WS_WGL), part, sqp, HN + (size_t)ch * CHK * D);
        __syncthreads(); TP_END(22); TP_BEGIN(23);
        if (F.tid < 64) { float t = 0.f;
#pragma unroll
            for (int w = 0; w < 8; ++w) t += sqp[w * 64 + F.tid];
            const float rstd = 1.0f / sqrtf(t * (1.0f / D) + EPS); rs[F.tid] = rstd; RSTD[ch * CHK + F.tid] = rstd; }
        __syncthreads();
#pragma unroll
        for (int i = 0; i < 2; ++i) { const int idx = F.tid + 512 * i; float t = 0.f;
#pragma unroll
            for (int w = 0; w < 8; ++w) t += part[w * 1024 + idx];
            glc[idx] = t * rs[idx >> 4]; }
        __syncthreads();
        {
            const int c0 = F.tid, c1 = F.tid + 512; float wa[16], wb[16];
#pragma unroll
            for (int r = 0; r < 16; ++r) { wa[r] = w2[r * KD + c0]; wb[r] = w2[r * KD + c1]; }
            const float ba = bgk[c0], bb = bgk[c1]; float cuma = 0.f, cumb = 0.f;
#pragma unroll 2
            for (int t = 0; t < CHK; ++t) {
                float za = ba, zb = bb;
#pragma unroll
                for (int r = 0; r < 16; ++r) { const float g = glc[t * 16 + r]; za += g * wa[r]; zb += g * wb[r]; }
                const float la = fminf(za, 0.f) - __logf(1.0f + __expf(-fabsf(za))), lb = fminf(zb, 0.f) - __logf(1.0f + __expf(-fabsf(zb)));
                cuma += la * (1.0f / 16.0f); cumb += lb * (1.0f / 16.0f);
                BC[(size_t)(ch * CHK + t) * KD + c0] = cuma; BC[(size_t)(ch * CHK + t) * KD + c1] = cumb;
            }
        }
        __syncthreads(); TP_END(23);
    }
}

__device__ __forceinline__ void ph_gla_naive(Frame& F) {
    const bf16* QP = (const bf16*)(KWS + WS_QP); const bf16* KP = (const bf16*)(KWS + WS_KP); const bf16* VB = (const bf16*)(KWS + WS_VB);
    const float* BC = (const float*)(KWS + WS_BC); float* O = (float*)(KWS + WS_O);
    for (int u = blockIdx.x; u < 128; u += F.G) {
        const int h = u >> 5, col0 = (u & 31) * 16, ds = F.tid & 31, col = F.tid >> 5;
        float R[8];
#pragma unroll
        for (int i = 0; i < 8; ++i) R[i] = 0.f;
        const bf16* qp = QP + h * DKH + ds * 8; const bf16* kp = KP + h * DKH + ds * 8; const bf16* vp = VB + h * DVH + col0 + col;
        const float* bp = BC + h * DKH + ds * 8; float* op = O + h * DVH + col0 + col;
        for (int t0 = 0; t0 < T; t0 += 8) {
            v4u kk[8], qq[8]; unsigned short vv[8];
#pragma unroll
            for (int j = 0; j < 8; ++j) { kk[j] = *(const v4u*)(kp + (size_t)(t0 + j) * KD); qq[j] = *(const v4u*)(qp + (size_t)(t0 + j) * KD); vv[j] = vp[(size_t)(t0 + j) * VD]; }
#pragma unroll
            for (int j = 0; j < 8; ++j) {
                const float v = __uint_as_float(((unsigned)vv[j]) << 16);
                float po = 0.f;
#pragma unroll
                for (int i = 0; i < 4; ++i) { const unsigned kw = kk[j][i], qw = qq[j][i];
                    R[2 * i] += bflo(kw) * v; R[2 * i + 1] += bfhi(kw) * v; po += bflo(qw) * R[2 * i] + bfhi(qw) * R[2 * i + 1]; }
                po += __shfl_xor(po, 1); po += __shfl_xor(po, 2); po += __shfl_xor(po, 4); po += __shfl_xor(po, 8); po += __shfl_xor(po, 16);
                if (ds == 0) op[(size_t)(t0 + j) * VD] = po;
            }
            if (((t0 + 8) & 63) == 0) { const f32x4 b0 = *(const f32x4*)(bp + (size_t)(t0 + 7) * KD), b1 = *(const f32x4*)(bp + (size_t)(t0 + 7) * KD + 4);
#pragma unroll
                for (int i = 0; i < 4; ++i) { R[i] *= expf(b0[i]); R[4 + i] *= expf(b1[i]); } }
        }
    }
}

namespace gla {
typedef short bf16x8 __attribute__((ext_vector_type(8)));
typedef short s16x4 __attribute__((ext_vector_type(4)));
typedef short v4i16_t __attribute__((ext_vector_type(4)));
typedef float f32x2_t __attribute__((ext_vector_type(2))); typedef __bf16 bf16x2_t __attribute__((ext_vector_type(2)));
__device__ __forceinline__ unsigned cvtpk(float lo, float hi) { f32x2_t v = {lo, hi}; bf16x2_t b = __builtin_convertvector(v, bf16x2_t); return __builtin_bit_cast(unsigned, b); }
__device__ __forceinline__ s16x4 trread(const LAS unsigned char* p) { return __builtin_bit_cast(s16x4, __builtin_amdgcn_ds_read_tr16_b64_v4i16((LAS v4i16_t*)p)); }
__device__ __forceinline__ bf16x8 cat4(s16x4 a, s16x4 b) { bf16x8 r; r[0] = a[0]; r[1] = a[1]; r[2] = a[2]; r[3] = a[3]; r[4] = b[0]; r[5] = b[1]; r[6] = b[2]; r[7] = b[3]; return r; }
constexpr int QS = 528, KS = 544, VS = 288, OS = 272, PS = 144;
constexpr int OFF_Q = 0, OFF_K = 64 * QS, OFF_V = OFF_K + 64 * KS, OFF_P = OFF_V + 64 * VS, OFF_G = OFF_P + 64 * PS, OFF_O = OFF_G + 1024, LDS_END = OFF_O + 64 * OS;
static_assert(LDS_END <= RING_BYTES, "gla LDS");
constexpr int NPART = 16, CPP = NCHUNK / NPART;
struct Stage { v4u q[4], k[4], v[2]; float g; };
template <bool NEEDQ>
__device__ __forceinline__ void issue_loads(Stage& st, const bf16* QP, const bf16* KP, const bf16* VB, const float* BC, int tok0, int h, int s, int tid, unsigned qkoff, unsigned voff) {
    const GAS char* qb = (const GAS char*)QP + (size_t)tok0 * KD * 2; const GAS char* kb = (const GAS char*)KP + (size_t)tok0 * KD * 2; const GAS char* vb = (const GAS char*)VB + (size_t)tok0 * VD * 2;
#pragma unroll
    for (int i = 0; i < 4; ++i) { if (NEEDQ) { st.q[i] = __builtin_nontemporal_load((const GAS v4u*)(qb + i * 16 * KD * 2 + qkoff)); st.k[i] = __builtin_nontemporal_load((const GAS v4u*)(kb + i * 16 * KD * 2 + qkoff)); } else st.k[i] = *(const GAS v4u*)(kb + i * 16 * KD * 2 + qkoff); }
#pragma unroll
    for (int i = 0; i < 2; ++i) st.v[i] = NEEDQ ? __builtin_nontemporal_load((const GAS v4u*)(vb + i * 32 * VD * 2 + voff)) : *(const GAS v4u*)(vb + i * 32 * VD * 2 + voff);
    st.g = *(const GAS float*)((const GAS char*)BC + (size_t)(tok0 + 63) * KD * 4 + (unsigned)(h * DKH + (tid & 255)) * 4u);
    (void)s;
}
template <bool NEEDQ>
__device__ __forceinline__ void write_stage(LAS unsigned char* lds, const Stage& st, int tid) {
#pragma unroll
    for (int i = 0; i < 4; ++i) { const int id = tid + 512 * i, row = id >> 5, cc = id & 31;
        if (NEEDQ) *(LAS v4u*)(lds + OFF_Q + row * QS + cc * 16) = st.q[i]; *(LAS v4u*)(lds + OFF_K + row * KS + ((cc * 16) ^ (((row >> 3) & 1) << 7))) = st.k[i]; }
#pragma unroll
    for (int i = 0; i < 2; ++i) { const int id = tid + 512 * i, row = id >> 4, cc = id & 15; *(LAS v4u*)(lds + OFF_V + row * VS + ((cc * 16) ^ (((row >> 3) & 1) << 7))) = st.v[i]; }
    if (tid < 256) *(LAS float*)(lds + OFF_G + 4 * tid) = expf(st.g);
}
template <int PASS>
__device__ __forceinline__ void unit(LAS unsigned char* lds, int tid, int lane, int w, int p, int h, int s, const bf16* QP, const bf16* KP, const bf16* VB, const float* BC, bf16* OG, f32x4* SEND, float* GTOT, const bf16* GB, const float* hnw, float* SS, unsigned long long& tp_t0, unsigned long long& tp_acc) {
#define GTP_BEGIN(k) do { if ((TPROBE_MASK >> (k)) & 1u) { if (tid == 0) ((volatile LAS int*)(lds + MISC_OFF))[50] = (int)__builtin_amdgcn_s_memrealtime(); } } while (0)
#define GTP_END(k) do { if ((TPROBE_MASK >> (k)) & 1u) { if (tid == 0) { volatile LAS int* m_ = (volatile LAS int*)(lds + MISC_OFF); m_[51] = m_[51] + ((int)__builtin_amdgcn_s_memrealtime() - m_[50]); } } } while (0)
    constexpr bool NQ = (PASS == 2);
    const int r = lane & 15, q = lane >> 4, qq = r >> 2, pp = r & 3;
    f32x4 S[16];
#pragma unroll
    for (int dt = 0; dt < 16; ++dt) S[dt] = (f32x4){0.f, 0.f, 0.f, 0.f};
    const int tokbase = p * CPP * CHK;
    const unsigned qkoff = (unsigned)((tid >> 5) * KD + h * DKH + (tid & 31) * 8) * 2u, voff = (unsigned)((tid >> 4) * VD + h * DVH + s * 128 + (tid & 15) * 8) * 2u;
    Stage st0, st1;
    issue_loads<NQ>(st0, QP, KP, VB, BC, tokbase, h, s, tid, qkoff, voff);
    __syncthreads();
    if (PASS == 2 && p > 0) {
        LAS int* cw = (LAS int*)(lds + OFF_P);
        if (tid == 0) *cw = 1 << 30;
        __syncthreads();
        if (tid < 256) { float prod = 1.f; int j0 = 0; for (int j = p - 1; j >= 1; --j) { prod *= GTOT[((size_t)j * 4 + h) * DKH + tid]; if (prod == 0.f) { j0 = j; break; } }
            __hip_atomic_fetch_min(cw, j0, __ATOMIC_RELAXED, __HIP_MEMORY_SCOPE_WORKGROUP); }
        __syncthreads();
        const int p0 = *cw;
        for (int pj = p0; pj < p; ++pj) {
            const f32x4* se = SEND + ((((size_t)pj * 4 + h) * 4 + s) * 8 + w) * 16 * 64 + lane; const float* gt = GTOT + ((size_t)pj * 4 + h) * DKH;
#pragma unroll
            for (int hf = 0; hf < 2; ++hf) {
                f32x4 gg[8], ee[8];
#pragma unroll
                for (int d8 = 0; d8 < 8; ++d8) { const int dt = 8 * hf + d8; gg[d8] = *(const f32x4*)(gt + 16 * dt + 4 * q); ee[d8] = se[dt * 64]; }
                asm volatile("" ::: "memory");
#pragma unroll
                for (int d8 = 0; d8 < 8; ++d8) { const int dt = 8 * hf + d8; S[dt] = S[dt] * gg[d8] + ee[d8]; }
                asm volatile("" ::: "memory");
            }
        }
        __syncthreads();
    }
    write_stage<NQ>(lds, st0, tid);
    if (CPP > 1) issue_loads<NQ>(st0, QP, KP, VB, BC, tokbase + CHK, h, s, tid, qkoff, voff);
    if (PASS == 1 && CPP > 2) issue_loads<NQ>(st1, QP, KP, VB, BC, tokbase + 2 * CHK, h, s, tid, qkoff, voff);
    __syncthreads();
    const LAS unsigned char* qnat = lds + OFF_Q + r * QS + q * 16;
    const int kd = ((r >> 3) & 1) << 7;
    const LAS unsigned char* knatP = lds + OFF_K + r * KS + q * 16 + kd; const LAS unsigned char* knatM = lds + OFF_K + r * KS + q * 16 - kd;
    const LAS unsigned char* qperm = lds + OFF_Q + r * QS + q * 8;
    const LAS unsigned char* qperm2 = qperm + 32; asm volatile("" : "+v"(qperm2));
    const int td = (q & 1) << 7;
    const LAS unsigned char* ktrP = lds + OFF_K + (8 * q + qq) * KS + pp * 8 + td; const LAS unsigned char* ktrM = lds + OFF_K + (8 * q + qq) * KS + pp * 8 - td;
    const LAS unsigned char* vtr = lds + OFF_V + (8 * q + qq) * VS + ((w * 32 + pp * 8) ^ td);
    const LAS unsigned char* pnat = lds + OFF_P + r * PS + q * 16;
    const LAS unsigned char* gbase = lds + OFF_G + 16 * q;
#define GLA_FENCE() asm volatile("" ::: "memory")
#define GLA_BAR() do { asm volatile("s_waitcnt lgkmcnt(0)" ::: "memory"); __builtin_amdgcn_s_barrier(); asm volatile("" ::: "memory"); } while (0)
#pragma unroll 1
    for (int c = 0; c < CPP; ++c) {
        const int tok0 = tokbase + c * CHK;
        bf16x8 vb[2]; v4u gpre[2];
        if (PASS == 2) GTP_BEGIN(24);
#pragma unroll
        for (int kt = 0; kt < 2; ++kt) vb[kt] = cat4(trread(vtr + kt * 32 * VS), trread(vtr + kt * 32 * VS + 4 * VS));
        if (PASS == 2) {
            const int it = w >> 1, jt0 = 2 * (w & 1);
            f32x4 pa0 = (f32x4){0.f, 0.f, 0.f, 0.f}, pa1 = pa0;
            bf16x8 fb[4], fa0[4], fa1[4];
#define P_LOAD(sl, ks) do { fb[sl] = *(const LAS bf16x8*)(qnat + it * 16 * QS + (ks) * 64); fa0[sl] = *(const LAS bf16x8*)((((ks) & 2) ? knatM : knatP) + jt0 * 16 * KS + (ks) * 64); fa1[sl] = *(const LAS bf16x8*)((((ks) & 2) ? knatM : knatP) + (jt0 + 1) * 16 * KS + (ks) * 64); } while (0)
            P_LOAD(0, 0); P_LOAD(1, 1); P_LOAD(2, 2);
#pragma unroll
            for (int ks = 0; ks < 8; ++ks) { if (ks + 3 < 8) P_LOAD((ks + 3) & 3, ks + 3); GLA_FENCE();
                pa0 = __builtin_amdgcn_mfma_f32_16x16x32_bf16(fa0[ks & 3], fb[ks & 3], pa0, 0, 0, 0); pa1 = __builtin_amdgcn_mfma_f32_16x16x32_bf16(fa1[ks & 3], fb[ks & 3], pa1, 0, 0, 0); }
#undef P_LOAD
            { const int i = 16 * it + r, j0 = 16 * jt0 + 4 * q; v2u o;
              o.x = cvtpk(j0 + 0 <= i ? pa0[0] : 0.f, j0 + 1 <= i ? pa0[1] : 0.f); o.y = cvtpk(j0 + 2 <= i ? pa0[2] : 0.f, j0 + 3 <= i ? pa0[3] : 0.f);
              *(LAS v2u*)(lds + OFF_P + i * PS + j0 * 2) = o;
              o.x = cvtpk(j0 + 16 <= i ? pa1[0] : 0.f, j0 + 17 <= i ? pa1[1] : 0.f); o.y = cvtpk(j0 + 18 <= i ? pa1[2] : 0.f, j0 + 19 <= i ? pa1[3] : 0.f);
              *(LAS v2u*)(lds + OFF_P + i * PS + (j0 + 16) * 2) = o; }
            f32x4 Oa[4];
#pragma unroll
            for (int i4 = 0; i4 < 4; ++i4) Oa[i4] = (f32x4){0.f, 0.f, 0.f, 0.f};
            bf16x8 qa[2][4];
#define Q_LOAD(sl, ks) do { _Pragma("unroll") for (int i4 = 0; i4 < 4; ++i4) qa[sl][i4] = cat4(*(const LAS s16x4*)(qperm + i4 * 16 * QS + (ks) * 64), *(const LAS s16x4*)(qperm2 + i4 * 16 * QS + (ks) * 64)); } while (0)
            Q_LOAD(0, 0); GLA_FENCE();
#pragma unroll
            for (int ks = 0; ks < 8; ++ks) {
                if (ks + 1 < 8) Q_LOAD((ks + 1) & 1, ks + 1);
                GLA_FENCE();
                v4u bw; bw.x = cvtpk(S[2 * ks][0], S[2 * ks][1]); bw.y = cvtpk(S[2 * ks][2], S[2 * ks][3]); bw.z = cvtpk(S[2 * ks + 1][0], S[2 * ks + 1][1]); bw.w = cvtpk(S[2 * ks + 1][2], S[2 * ks + 1][3]);
                const bf16x8 bfrag = __builtin_bit_cast(bf16x8, bw);
#pragma unroll
                for (int i4 = 0; i4 < 4; ++i4) Oa[i4] = __builtin_amdgcn_mfma_f32_16x16x32_bf16(bfrag, qa[ks & 1][i4], Oa[i4], 0, 0, 0);
            }
#undef Q_LOAD
            GLA_BAR();
            GTP_END(24); GTP_BEGIN(25);
#pragma unroll
            for (int i = 0; i < 2; ++i) gpre[i] = *(const GAS v4u*)((const GAS char*)GB + (size_t)tok0 * VD * 2 + i * 32 * VD * 2 + voff);
            { bf16x8 pf[6];
              pf[0] = *(const LAS bf16x8*)(pnat); pf[1] = *(const LAS bf16x8*)(pnat + 16 * PS); pf[2] = *(const LAS bf16x8*)(pnat + 32 * PS); pf[3] = *(const LAS bf16x8*)(pnat + 32 * PS + 64);
              pf[4] = *(const LAS bf16x8*)(pnat + 48 * PS); pf[5] = *(const LAS bf16x8*)(pnat + 48 * PS + 64);
              Oa[0] = __builtin_amdgcn_mfma_f32_16x16x32_bf16(vb[0], pf[0], Oa[0], 0, 0, 0); Oa[1] = __builtin_amdgcn_mfma_f32_16x16x32_bf16(vb[0], pf[1], Oa[1], 0, 0, 0);
              Oa[2] = __builtin_amdgcn_mfma_f32_16x16x32_bf16(vb[0], pf[2], Oa[2], 0, 0, 0); Oa[2] = __builtin_amdgcn_mfma_f32_16x16x32_bf16(vb[1], pf[3], Oa[2], 0, 0, 0);
              Oa[3] = __builtin_amdgcn_mfma_f32_16x16x32_bf16(vb[0], pf[4], Oa[3], 0, 0, 0); Oa[3] = __builtin_amdgcn_mfma_f32_16x16x32_bf16(vb[1], pf[5], Oa[3], 0, 0, 0); }
#pragma unroll
            for (int i4 = 0; i4 < 4; ++i4) { v2u o; o.x = cvtpk(Oa[i4][0], Oa[i4][1]); o.y = cvtpk(Oa[i4][2], Oa[i4][3]); *(LAS v2u*)(lds + OFF_O + (16 * i4 + r) * OS + (16 * w + 4 * q) * 2) = o; }
        }
        if (PASS == 2) { GTP_END(25); GTP_BEGIN(26); }
        { constexpr int RD = (PASS == 1) ? 4 : 2;
          bf16x8 ka0[RD], ka1[RD]; f32x4 gg[RD];
#define KV_LOAD(sl, dt) do { const LAS unsigned char* kb_ = (((dt) & 4) ? ktrM : ktrP) + (dt) * 32; ka0[sl] = cat4(trread(kb_), trread(kb_ + 4 * KS)); ka1[sl] = cat4(trread(kb_ + 32 * KS), trread(kb_ + 32 * KS + 4 * KS)); gg[sl] = *(const LAS f32x4*)(gbase + (dt) * 64); } while (0)
#pragma unroll
          for (int d0 = 0; d0 < RD - 1; ++d0) KV_LOAD(d0, d0);
#pragma unroll
          for (int dt = 0; dt < 16; ++dt) { if (dt + RD - 1 < 16) KV_LOAD((dt + RD - 1) % RD, dt + RD - 1); GLA_FENCE();
              S[dt] = __builtin_amdgcn_mfma_f32_16x16x32_bf16(ka0[dt % RD], vb[0], S[dt], 0, 0, 0); S[dt] = __builtin_amdgcn_mfma_f32_16x16x32_bf16(ka1[dt % RD], vb[1], S[dt], 0, 0, 0);
              S[dt] = S[dt] * gg[dt % RD]; }
#undef KV_LOAD
        }
        if (PASS == 2) { GTP_END(26); GTP_BEGIN(27); }
        GLA_BAR();
        if (PASS == 2) {
            const f32x4 hw0 = *(const f32x4*)(hnw + s * 128 + (tid & 15) * 8), hw1 = *(const f32x4*)(hnw + s * 128 + (tid & 15) * 8 + 4);
#pragma unroll
            for (int i = 0; i < 2; ++i) { const int id = tid + 512 * i, row = id >> 4, cc = id & 15;
                const v4u ov = *(const LAS v4u*)(lds + OFF_O + row * OS + cc * 16);
                const f32x4 a = bf4lo(ov), b = bf4hi(ov), ga = bf4lo(gpre[i]), gb = bf4hi(gpre[i]);
                float ss = (a.x * a.x + a.y * a.y) + (a.z * a.z + a.w * a.w) + (b.x * b.x + b.y * b.y) + (b.z * b.z + b.w * b.w);
                ss += __shfl_xor(ss, 1); ss += __shfl_xor(ss, 2); ss += __shfl_xor(ss, 4); ss += __shfl_xor(ss, 8);
                if (cc == 0) SS[(size_t)(tok0 + row) * 16 + h * 4 + s] = ss;
                const f32x4 ya = a * ga * hw0, yb = b * gb * hw1;
                v4u o; o.x = cvtpk(ya.x, ya.y); o.y = cvtpk(ya.z, ya.w); o.z = cvtpk(yb.x, yb.y); o.w = cvtpk(yb.z, yb.w);
                *(GAS v4u*)((GAS char*)OG + (size_t)tok0 * VD * 2 + i * 32 * VD * 2 + voff) = o; }
        }
        if (c + 1 < CPP) {
            if (PASS == 1) {
                if ((c & 1) == 0) { write_stage<NQ>(lds, st0, tid); if (c + 3 < CPP) issue_loads<NQ>(st0, QP, KP, VB, BC, tok0 + 3 * CHK, h, s, tid, qkoff, voff); }
                else { write_stage<NQ>(lds, st1, tid); if (c + 3 < CPP) issue_loads<NQ>(st1, QP, KP, VB, BC, tok0 + 3 * CHK, h, s, tid, qkoff, voff); }
            } else { write_stage<NQ>(lds, st0, tid); if (c + 2 < CPP) issue_loads<NQ>(st0, QP, KP, VB, BC, tok0 + 2 * CHK, h, s, tid, qkoff, voff); }
            GLA_BAR();
        }
        if (PASS == 2) GTP_END(27);
    }
#undef GLA_FENCE
#undef GLA_BAR
    if (PASS == 1) {
        f32x4* se = SEND + ((((size_t)p * 4 + h) * 4 + s) * 8 + w) * 16 * 64 + lane;
#pragma unroll
        for (int dt = 0; dt < 16; ++dt) se[dt * 64] = S[dt];
        if (s == 0 && tid < 256) { float a = 0.f; for (int c = 0; c < CPP; ++c) a += BC[(size_t)(tokbase + c * CHK + 63) * KD + h * DKH + tid]; GTOT[((size_t)p * 4 + h) * DKH + tid] = expf(a); }
    }
}
}
template <int PASS>
__device__ __forceinline__ void ph_gla(Frame& F) {
    const bf16* QP = (const bf16*)(KWS + WS_QP); const bf16* KP = (const bf16*)(KWS + WS_KP); const bf16* VB = (const bf16*)(KWS + WS_VB);
    const float* BC = (const float*)(KWS + WS_BC); bf16* OG = (bf16*)(KWS + WS_OG); f32x4* SEND = (f32x4*)(KWS + WS_SEND); float* GTOT = (float*)(KWS + WS_GTOT);
    for (int u = blockIdx.x; u < 256; u += F.G) {
        const int idx = u >> 3, s = idx & 3, ph = (u & 7) * 8 + (idx >> 2), p = ph >> 2, h = ph & 3;
        if (PASS == 1 && p == gla::NPART - 1) continue;
        gla::unit<PASS>(F.lds, F.tid, F.lane, F.wave, p, h, s, QP, KP, VB, BC, OG, SEND, GTOT, (const bf16*)(KWS + WS_GB), KIN(5), (float*)(KWS + WS_SS), F.tp_t0, F.tp_acc);
    }
}

__device__ __forceinline__ void ph_headnorm(Frame& F) {
    const bf16* O = (const bf16*)(KWS + WS_O); const bf16* GB = (const bf16*)(KWS + WS_GB); bf16* OG = (bf16*)(KWS + WS_OG); const float* hnw = KIN(5);
    const int gw = blockIdx.x * NWAVES + F.wave, NGW = F.G * NWAVES;
    const f32x4 w0 = ((const f32x4*)hnw)[2 * F.lane], w1 = ((const f32x4*)hnw)[2 * F.lane + 1];
    for (int it = gw; it < T * NHEAD; it += 4 * NGW) {
        v4u ov[4], gv[4]; size_t off[4];
#pragma unroll
        for (int k = 0; k < 4; ++k) { const int i2 = it + k * NGW; const int ic = i2 < T * NHEAD ? i2 : it; off[k] = (size_t)(ic >> 2) * VD + (ic & 3) * DVH + 8 * F.lane; ov[k] = *(const v4u*)(O + off[k]); gv[k] = *(const v4u*)(GB + off[k]); }
#pragma unroll
        for (int k = 0; k < 4; ++k) {
            const f32x4 a = bf4lo(ov[k]), b = bf4hi(ov[k]), ga = bf4lo(gv[k]), gb = bf4hi(gv[k]);
            const float ss = wave_sum((a.x * a.x + a.y * a.y) + (a.z * a.z + a.w * a.w) + (b.x * b.x + b.y * b.y) + (b.z * b.z + b.w * b.w));
            const float rstd = 1.0f / sqrtf(ss * (1.0f / DVH) + EPS);
            const f32x4 ya = a * rstd * w0 * ga, yb = b * rstd * w1 * gb;
            v4u o; o.x = pk2(ya.x, ya.y); o.y = pk2(ya.z, ya.w); o.z = pk2(yb.x, yb.y); o.w = pk2(yb.z, yb.w);
            if (it + k * NGW < T * NHEAD) *(v4u*)(OG + off[k]) = o;
        }
    }
}

__device__ __forceinline__ void ph_router(Frame& F, int layer, const bf16* H) {
    const bf16* WH = (const bf16*)(KWS + WS_WRH) + (size_t)layer * NLOG * 2048; const bf16* WL = (const bf16*)(KWS + WS_WRL) + (size_t)layer * NLOG * 2048;
    const float* wn = KIN(10) + layer * D; const float* bg = KIN(12) + layer * NGRP; const float* br = KIN(14) + layer * NE;
    bf16* HN = (bf16*)(KWS + WS_HN);
    int* TKE = (int*)(KWS + WS_TKE); int* TKS = (int*)(KWS + WS_TKS); float* TKG = (float*)(KWS + WS_TKG); int* LIST = (int*)(KWS + WS_LIST);
    unsigned* gcnt = F.ctl + CW_CNT + 2048 * layer;
    LAS float* part = (LAS float*)(F.lds);
    LAS float* sqp = (LAS float*)(F.lds + 98304);
    LAS float* lg = (LAS float*)(F.lds + 98304 + 2048);
    LAS float* rs = (LAS float*)(F.lds + 98304 + 2048 + 12288);
    LAS int* sel = (LAS int*)(F.lds + 98304 + 2048 + 12288 + 256);
    LAS float* selg = (LAS float*)(F.lds + 98304 + 2048 + 12288 + 256 + 1024);
    static_assert(98304 + 2048 + 12288 + 256 + 1024 + 512 <= RING_BYTES, "router LDS");
    volatile LAS int* cntl = F.MISC + MI_CNTL; volatile LAS int* basel = F.MISC + MI_BASEL;
    for (int blk = blockIdx.x; blk < T / 64; blk += F.G) {
        if (F.tid < 32) cntl[F.tid] = 0;
        TP_BEGIN(20); rowblock_bf16<3>(F, H + (size_t)blk * 64 * D, WH, WL, part, sqp);
        __syncthreads(); TP_END(20); TP_BEGIN(21);
        if (F.tid < 64) { float t = 0.f;
#pragma unroll
            for (int w = 0; w < 8; ++w) t += sqp[w * 64 + F.tid];
            const float rstd = 1.0f / sqrtf(t * (1.0f / D) + EPS); rs[F.tid] = rstd; ((float*)(KWS + WS_RSTD))[blk * 64 + F.tid] = rstd; }
#pragma unroll
        for (int i = 0; i < 6; ++i) { const int idx = F.tid + 512 * i; float t = 0.f;
#pragma unroll
            for (int w = 0; w < 8; ++w) t += part[w * 3072 + idx];
            lg[idx] = t; }
        __syncthreads();
        if (F.tid < 64) {
            const int rl = F.tid; const float rstd = rs[rl]; const LAS float* L = lg + rl * 48;
            float gl0 = L[0] * rstd + bg[0]; int g = 0; float gv[4]; gv[0] = gl0;
#pragma unroll
            for (int j = 1; j < 4; ++j) { gv[j] = L[j] * rstd + bg[j]; if (gv[j] > gl0) { gl0 = gv[j]; g = j; } }
            float den = 0.f;
#pragma unroll
            for (int j = 0; j < 4; ++j) den += expf(gv[j] - gl0);
            const float gp = 1.0f / den;
            float l1 = -3.0e38f, l2 = -3.0e38f; int e1 = 0, e2 = 0;
            for (int j = 0; j < 8; ++j) { const float v = L[4 + 8 * g + j] * rstd + br[8 * g + j];
                if (v > l1) { l2 = l1; e2 = e1; l1 = v; e1 = j; } else if (v > l2) { l2 = v; e2 = j; } }
            const float ex = expf(l2 - l1), p1 = 1.0f / (1.0f + ex), p2 = ex * p1;
            const int E0 = 8 * g + e1, E1 = 8 * g + e2;
            sel[rl * 4 + 0] = E0; sel[rl * 4 + 1] = E1;
            sel[rl * 4 + 2] = __hip_atomic_fetch_add((LAS int*)&cntl[E0], 1, __ATOMIC_RELAXED, __HIP_MEMORY_SCOPE_WORKGROUP); sel[rl * 4 + 3] = __hip_atomic_fetch_add((LAS int*)&cntl[E1], 1, __ATOMIC_RELAXED, __HIP_MEMORY_SCOPE_WORKGROUP);
            selg[rl * 2 + 0] = gp * p1; selg[rl * 2 + 1] = gp * p2;
        }
        __syncthreads();
        if (F.tid < 32) basel[F.tid] = (int)__hip_atomic_fetch_add(gcnt + 64 * F.tid, (unsigned)cntl[F.tid], RLX_AGENT);
        __syncthreads();
        if (F.tid < 128) {
            const int rl = F.tid >> 1, k = F.tid & 1, tk = (blk * 64 + rl) * 2 + k, e = sel[rl * 4 + k], slot = basel[e] + sel[rl * 4 + 2 + k];
            TKE[tk] = e; TKS[tk] = slot; TKG[tk] = selg[rl * 2 + k]; LIST[e * T + slot] = tk;
        }
        __syncthreads(); TP_END(21);
    }
}

__device__ __forceinline__ void moe_meta(Frame& F, int layer) {
    __syncthreads();
    if (F.tid < 64) {
        const unsigned* gcnt = F.ctl + CW_CNT + 2048 * layer;
        const int e = F.tid, c = e < NE ? (int)__hip_atomic_load(gcnt + 64 * (e & 31), RLX_AGENT) : 0, tl = e < NE ? (c + 255) >> 8 : 0;
        int sc = tl;
#pragma unroll
        for (int o = 1; o < 32; o <<= 1) { const int v = __shfl_up(sc, o); if (F.lane >= o) sc += v; }
        const int t0 = sc - tl;
        if (e < NE) { F.MISC[MI_PSTART + e] = t0 * 256; F.MISC[MI_ECNT + e] = c;
            for (int j = 0; j < tl; ++j) { F.MISC[MI_TEXP + t0 + j] = e; F.MISC[MI_TSLOT + t0 + j] = 256 * j; } }
        if (e == NE - 1) { F.MISC[MI_PSTART + NE] = sc * 256; F.MISC[MI_NRT] = sc; }
    }
    __syncthreads();
}

template <bool FINAL>
__device__ __forceinline__ void ph_combine(Frame& F, const bf16* H, bf16* Hout, const float* wn) {
    const bf16* Y = (const bf16*)(KWS + WS_Y); const int* TKE = (const int*)(KWS + WS_TKE); const int* TKS = (const int*)(KWS + WS_TKS); const float* TKG = (const float*)(KWS + WS_TKG); float* RSTD = (float*)(KWS + WS_RSTD);
    const int gw = blockIdx.x * NWAVES + F.wave, NGW = F.G * NWAVES;
    for (int t = gw; t < T; t += NGW) {
        const int r0 = F.MISC[MI_PSTART + TKE[2 * t]] + TKS[2 * t], r1 = F.MISC[MI_PSTART + TKE[2 * t + 1]] + TKS[2 * t + 1]; const float g0 = TKG[2 * t], g1 = TKG[2 * t + 1];
        const v2u* hr = (const v2u*)(H + (size_t)t * D) + F.lane;
        const v2u* y0 = (const v2u*)(Y + (size_t)r0 * D) + F.lane; const v2u* y1 = (const v2u*)(Y + (size_t)r1 * D) + F.lane;
        f32x4 v[8]; float s = 0.f;
#pragma unroll
        for (int j = 0; j < 8; ++j) { const v2u a = __builtin_nontemporal_load(y0 + 64 * j), b = __builtin_nontemporal_load(y1 + 64 * j), hh = __builtin_nontemporal_load(hr + 64 * j); f32x4 h = {bflo(hh.x), bfhi(hh.x), bflo(hh.y), bfhi(hh.y)};
            h.x += g0 * bflo(a.x) + g1 * bflo(b.x); h.y += g0 * bfhi(a.x) + g1 * bfhi(b.x); h.z += g0 * bflo(a.y) + g1 * bflo(b.y); h.w += g0 * bfhi(a.y) + g1 * bfhi(b.y);
            v[j] = h; s += (h.x * h.x + h.y * h.y) + (h.z * h.z + h.w * h.w); }
        const float rstd = 1.0f / sqrtf(wave_sum(s) * (1.0f / D) + EPS);
        if (FINAL) {
            f32x4* o = (f32x4*)(KOUT + (size_t)t * D) + F.lane;
#pragma unroll
            for (int j = 0; j < 8; ++j) __builtin_nontemporal_store(v[j] * rstd * ((const f32x4*)wn)[F.lane + 64 * j], o + 64 * j);
        } else {
            v2u* ho = (v2u*)(Hout + (size_t)t * D) + F.lane;
#pragma unroll
            for (int j = 0; j < 8; ++j) { v2u o; o.x = pk2(v[j].x, v[j].y); o.y = pk2(v[j].z, v[j].w); ho[64 * j] = o; }
            if (F.lane == 0) RSTD[t] = rstd;
        }
    }
}

__device__ __forceinline__ void ph_conv(Frame& F) {
    const bf16* BG = (const bf16*)(KWS + WS_VB); const bf16* U = (const bf16*)(KWS + WS_GB); bf16* OG = (bf16*)(KWS + WS_OG); const float* cw = KIN(8);
    const int c = (F.tid & 255) * 8, rh = F.tid >> 8;
    const f32x4 wa0 = *(const f32x4*)(cw + c), wa1 = *(const f32x4*)(cw + c + 4), wb0 = *(const f32x4*)(cw + D + c), wb1 = *(const f32x4*)(cw + D + c + 4), wc0 = *(const f32x4*)(cw + 2 * D + c), wc1 = *(const f32x4*)(cw + 2 * D + c + 4);
    for (int blk = blockIdx.x; blk < T / 64; blk += F.G) {
        const int t0 = blk * 64 + rh * 32;
        const v4u zero = {0u, 0u, 0u, 0u};
        v4u p2 = t0 >= 2 ? *(const v4u*)(U + (size_t)(t0 - 2) * D + c) : zero, p1 = t0 >= 1 ? *(const v4u*)(U + (size_t)(t0 - 1) * D + c) : zero;
        f32x4 u2l = bf4lo(p2), u2h = bf4hi(p2), u1l = bf4lo(p1), u1h = bf4hi(p1);
#pragma unroll 1
        for (int tb = 0; tb < 32; tb += 8) {
            v4u uu[8], bb[8];
#pragma unroll
            for (int j = 0; j < 8; ++j) { const size_t off = (size_t)(t0 + tb + j) * D + c; uu[j] = __builtin_nontemporal_load((const v4u*)(U + off)); bb[j] = __builtin_nontemporal_load((const v4u*)(BG + off)); }
#pragma unroll
            for (int j = 0; j < 8; ++j) {
                const f32x4 u0l = bf4lo(uu[j]), u0h = bf4hi(uu[j]), bl = bf4lo(bb[j]), bh = bf4hi(bb[j]);
                const f32x4 yl = bl * (wa0 * u2l + wb0 * u1l + wc0 * u0l), yh = bh * (wa1 * u2h + wb1 * u1h + wc1 * u0h);
                v4u o; o.x = pk2(yl.x, yl.y); o.y = pk2(yl.z, yl.w); o.z = pk2(yh.x, yh.y); o.w = pk2(yh.z, yh.w);
                *(v4u*)(OG + (size_t)(t0 + tb + j) * D + c) = o;
                u2l = u1l; u2h = u1h; u1l = u0l; u1h = u0h;
            }
        }
    }
}

#ifndef PH_MASK
#define PH_MASK 0xFFFFFFFFu
#endif
#define IN(k) (((PH_MASK >> (k)) & 1u) && lo <= (k) && (k) < hi)
#define BOTH(k) (IN(k) && IN((k) + 1))
#ifndef DUP_MASK
#define DUP_MASK 0u
#endif
#define NREP(k) ((((unsigned)DUP_MASK >> (k)) & 1u) ? 2 : 1)
#define GRID_BAR() do { if (N_LAUNCHES == 1) xcd_barrier(bar); } while (0)
template <int LAYER>
__device__ __forceinline__ void moe_block(Frame& F, const int lo, const int hi, const XcdBarrier& bar) {
    constexpr int pb = LAYER ? PH_MOE1 : PH_MOE0;
    bf16* H1 = (bf16*)(KWS + WS_H1); bf16* H2 = (bf16*)(KWS + WS_H2);
    TP_BEGIN(pb + 0);
    if (IN(pb + 0)) { ph_router(F, LAYER, H1); if (BOTH(pb + 0)) GRID_BAR(); }
    TP_END(pb + 0);
    const bool split = (F.G == 256);
    TP_BEGIN(pb + 1);
    if (IN(pb + 1)) {
        moe_meta(F, LAYER);
        const int nrt = F.MISC[MI_NRT];
        pg8::Gemm g{(const bf16*)H1, (const bf16*)(KWS + WS_WGU) + (size_t)LAYER * NE * 1024 * 2048, nrt * 256, 1024, D};
        pg8::MoeOrder<true> S{nrt, 4, nrt * 4, F.G, (int)blockIdx.x, (size_t)1024 * 2048 * 2, (const volatile LAS int*)F.MISC, (const int*)(KWS + WS_LIST), split ? 1 : 0, 0, 2};
        pg8::EpiGateUp E{(bf16*)(KWS + WS_ACT), (const int*)(KWS + WS_LIST), (const float*)(KWS + WS_RSTD)};
        for (int rep = 0; rep < NREP(pb + 1); ++rep) { pg8::gemm_phase<pg8::EpiGateUp, pg8::MoeOrder<true>, true>(F.lds + RING_OFF, g, S, E); if (rep + 1 < NREP(pb + 1)) GRID_BAR(); }
        if (BOTH(pb + 1)) GRID_BAR();
    }
    TP_END(pb + 1);
    TP_BEGIN(pb + 2);
    if (IN(pb + 2)) {
        if (split) {
            if (N_LAUNCHES != 1) moe_meta(F, LAYER);
            const int nrt = F.MISC[MI_NRT];
            { pg8::Gemm g{(const bf16*)H1, (const bf16*)(KWS + WS_WGU) + (size_t)LAYER * NE * 1024 * 2048, nrt * 256, 1024, D};
              pg8::MoeOrder<true> S{nrt, 4, nrt * 4, F.G, (int)blockIdx.x, (size_t)1024 * 2048 * 2, (const volatile LAS int*)F.MISC, (const int*)(KWS + WS_LIST), 1, 2, 3};
              pg8::EpiGateUp E{(bf16*)(KWS + WS_ACT), (const int*)(KWS + WS_LIST), (const float*)(KWS + WS_RSTD)};
              pg8::gemm_phase<pg8::EpiGateUp, pg8::MoeOrder<true>, true>(F.lds + RING_OFF, g, S, E); }
            { pg8::Gemm g{(const bf16*)(KWS + WS_ACT), (const bf16*)(KWS + WS_WDN) + (size_t)LAYER * NE * 2048 * 512, nrt * 256, 2048, FF};
              pg8::MoeOrder<false> S{nrt, 8, nrt * 8, F.G, (int)blockIdx.x, (size_t)2048 * 512 * 2, (const volatile LAS int*)F.MISC, (const int*)(KWS + WS_LIST), 2, 0, 0};
              pg8::EpiDown E{(bf16*)(KWS + WS_Y)};
              pg8::gemm_phase<pg8::EpiDown, pg8::MoeOrder<false>, true>(F.lds + RING_OFF, g, S, E); }
        }
        if (BOTH(pb + 2)) GRID_BAR();
    }
    TP_END(pb + 2);
    TP_BEGIN(pb + 3);
    if (IN(pb + 3)) {
        if (N_LAUNCHES != 1) moe_meta(F, LAYER);
        const int nrt = F.MISC[MI_NRT];
        pg8::Gemm g{(const bf16*)(KWS + WS_ACT), (const bf16*)(KWS + WS_WDN) + (size_t)LAYER * NE * 2048 * 512, nrt * 256, 2048, FF};
        pg8::MoeOrder<false> S{nrt, 8, nrt * 8, F.G, (int)blockIdx.x, (size_t)2048 * 512 * 2, (const volatile LAS int*)F.MISC, (const int*)(KWS + WS_LIST), split ? 3 : 0, 0, 0};
        pg8::EpiDown E{(bf16*)(KWS + WS_Y)};
        for (int rep = 0; rep < NREP(pb + 3); ++rep) { pg8::gemm_phase<pg8::EpiDown, pg8::MoeOrder<false>, true>(F.lds + RING_OFF, g, S, E); if (rep + 1 < NREP(pb + 3)) GRID_BAR(); }
        if (BOTH(pb + 3)) GRID_BAR();
    }
    TP_END(pb + 3);
    TP_BEGIN(pb + 4);
    if (IN(pb + 4)) {
        if (N_LAUNCHES != 1) moe_meta(F, LAYER);
        if (LAYER == 0) { for (int rep = 0; rep < NREP(pb + 4); ++rep) { ph_combine<false>(F, H1, H2, nullptr); if (rep + 1 < NREP(pb + 4)) GRID_BAR(); } if (BOTH(pb + 4)) GRID_BAR(); }
        else for (int rep = 0; rep < NREP(pb + 4); ++rep) { ph_combine<true>(F, H1, nullptr, KIN(17)); if (rep + 1 < NREP(pb + 4)) GRID_BAR(); }
    }
    TP_END(pb + 4);
}

struct Args { const float* in[18]; float* out; unsigned char* ws; int ph_lo, ph_hi, li, pad; };
__global__ void __launch_bounds__(NWAVES * 64, 2) mega_fwd(Args args) {
    extern __shared__ __attribute__((aligned(16))) unsigned char lds[];
    Frame F;
    F.lds = (LAS unsigned char*)lds;
    F.MISC = (volatile LAS int*)(F.lds + MISC_OFF);
    F.tid = threadIdx.x; F.lane = F.tid & 63; F.wave = __builtin_amdgcn_readfirstlane(F.tid >> 6);
    F.G = gridDim.x; F.tp_t0 = 0; F.tp_acc = 0;
    F.ka = (__attribute__((address_space(4))) const unsigned char*)__builtin_amdgcn_kernarg_segment_ptr();
    F.ctl = (unsigned*)(args.ws + WS_CTL);
    for (int u = F.tid; u < MISC_BYTES / 4; u += NWAVES * 64) F.MISC[u] = 0;
    __syncthreads();
    XcdBarrier bar; bar.bar = F.ctl + CW_BAR; bar.x = 0; bar.st = nullptr;
    if (N_LAUNCHES == 1) bar = xcd_barrier_post(F.ctl + CW_BAR, (volatile LAS unsigned*)(F.MISC + 8));
    const int lo = args.ph_lo, hi = args.ph_hi;
    bf16* HN = (bf16*)(KWS + WS_HN); bf16* H1 = (bf16*)(KWS + WS_H1); bf16* H2 = (bf16*)(KWS + WS_H2);

    TP_BEGIN(PH_CONV);
    if (IN(PH_CONV)) { for (int rep = 0; rep < NREP(PH_CONV); ++rep) { p0_convert(F); if (rep + 1 < NREP(PH_CONV)) GRID_BAR(); } if (BOTH(PH_CONV)) GRID_BAR(); }
    TP_END(PH_CONV);
    TP_BEGIN(PH_NORM0);
    if (IN(PH_NORM0)) { for (int rep = 0; rep < NREP(PH_NORM0); ++rep) { p0_norm_gl(F); if (rep + 1 < NREP(PH_NORM0)) GRID_BAR(); } if (BOTH(PH_NORM0)) GRID_BAR(); }
    TP_END(PH_NORM0);
    TP_BEGIN(PH_GIN);
    if (IN(PH_GIN)) {
        pg8::Gemm g{HN, (const bf16*)(KWS + WS_WGI), T, GINM, D}; pg8::StaticOrder S; S.init(T, GINM, F.G, (int)blockIdx.x);
        pg8::EpiGlaIn E{(bf16*)(KWS + WS_QP), (bf16*)(KWS + WS_KP), (bf16*)(KWS + WS_VB), (bf16*)(KWS + WS_GB), (const float*)(KWS + WS_BC), (const float*)(KWS + WS_RSTD)};
        for (int rep = 0; rep < NREP(PH_GIN); ++rep) { pg8::gemm_phase<pg8::EpiGlaIn, pg8::StaticOrder, true>(F.lds + RING_OFF, g, S, E); if (rep + 1 < NREP(PH_GIN)) GRID_BAR(); }
        if (BOTH(PH_GIN)) GRID_BAR();
    }
    TP_END(PH_GIN);
    TP_BEGIN(PH_GLA1);
    if (IN(PH_GLA1)) { for (int rep = 0; rep < NREP(PH_GLA1); ++rep) { ph_gla<1>(F); if (rep + 1 < NREP(PH_GLA1)) GRID_BAR(); } if (BOTH(PH_GLA1)) GRID_BAR(); }
    TP_END(PH_GLA1);
    TP_BEGIN(PH_GLA2);
    if (IN(PH_GLA2)) { for (int rep = 0; rep < NREP(PH_GLA2); ++rep) { ph_gla<2>(F); if (rep + 1 < NREP(PH_GLA2)) GRID_BAR(); } if (BOTH(PH_GLA2)) GRID_BAR(); }
    TP_END(PH_GLA2);
    TP_BEGIN(PH_HNORM);
    if (IN(PH_HNORM)) { }
    TP_END(PH_HNORM);
    TP_BEGIN(PH_GOUT);
    if (IN(PH_GOUT)) {
        pg8::Gemm g{(const bf16*)(KWS + WS_OG), (const bf16*)(KWS + WS_WGO), T, D, D}; pg8::StaticOrder S; S.init(T, D, F.G, (int)blockIdx.x);
        pg8::EpiResHead E{HN, H1, D, (const float*)(KWS + WS_SS)};
        for (int rep = 0; rep < NREP(PH_GOUT); ++rep) { pg8::gemm_phase<pg8::EpiResHead, pg8::StaticOrder, true>(F.lds + RING_OFF, g, S, E); if (rep + 1 < NREP(PH_GOUT)) GRID_BAR(); }
        if (BOTH(PH_GOUT)) GRID_BAR();
    }
    TP_END(PH_GOUT);
    moe_block<0>(F, lo, hi, bar);
    TP_BEGIN(PH_CIN);
    if (IN(PH_CIN)) {
        pg8::Gemm g{H2, (const bf16*)(KWS + WS_WCI), T, 6144, D}; pg8::StaticOrder S; S.init(T, 6144, F.G, (int)blockIdx.x);
        pg8::EpiConvIn E{(bf16*)(KWS + WS_VB), (bf16*)(KWS + WS_GB), (const float*)(KWS + WS_RSTD)};
        for (int rep = 0; rep < NREP(PH_CIN); ++rep) { pg8::gemm_phase<pg8::EpiConvIn, pg8::StaticOrder, true>(F.lds + RING_OFF, g, S, E); if (rep + 1 < NREP(PH_CIN)) GRID_BAR(); }
        if (BOTH(PH_CIN)) GRID_BAR();
    }
    TP_END(PH_CIN);
    TP_BEGIN(PH_CONVE);
    if (IN(PH_CONVE)) { for (int rep = 0; rep < NREP(PH_CONVE); ++rep) { ph_conv(F); if (rep + 1 < NREP(PH_CONVE)) GRID_BAR(); } if (BOTH(PH_CONVE)) GRID_BAR(); }
    TP_END(PH_CONVE);
    TP_BEGIN(PH_COUT);
    if (IN(PH_COUT)) {
        pg8::Gemm g{(const bf16*)(KWS + WS_OG), (const bf16*)(KWS + WS_WCO), T, D, D}; pg8::StaticOrder S; S.init(T, D, F.G, (int)blockIdx.x);
        pg8::EpiRes<true> E{H2, H1, D};
        for (int rep = 0; rep < NREP(PH_COUT); ++rep) { pg8::gemm_phase<pg8::EpiRes<true>, pg8::StaticOrder, true>(F.lds + RING_OFF, g, S, E); if (rep + 1 < NREP(PH_COUT)) GRID_BAR(); }
        if (BOTH(PH_COUT)) GRID_BAR();
    }
    TP_END(PH_COUT);
    moe_block<1>(F, lo, hi, bar);
    if (TPROBE_MASK != 0u && blockIdx.x == 0 && F.tid == 0) { const unsigned long long t0 = __builtin_amdgcn_s_memrealtime(), w = (unsigned long long)(unsigned)F.MISC[51] * TPROBE_MULT; while (__builtin_amdgcn_s_memrealtime() - t0 < w) __builtin_amdgcn_s_sleep(8); }
#undef IN
#undef BOTH
#undef GRID_BAR
}

extern "C" void kernel_launch(void* const* d_in, const int* in_sizes, int n_in, void* d_out, int out_size, void* d_ws, size_t ws_size, hipStream_t stream) {
    static int grid = 0;
    if (grid == 0) {
        if (n_in != 18 || in_sizes[0] != T * D || out_size != T * D || ws_size < WS_END) { fprintf(stderr, "kernel_launch: unexpected shapes (n_in %d, in0 %d, out %d, ws %zu)\n", n_in, n_in > 0 ? in_sizes[0] : -1, out_size, ws_size); grid = -1; return; }
        int dev = 0, cus = 0, per_cu = 0;
        if (hipGetDevice(&dev) != hipSuccess || hipDeviceGetAttribute(&cus, hipDeviceAttributeMultiprocessorCount, dev) != hipSuccess) { grid = -1; return; }
        if (hipFuncSetAttribute((const void*)mega_fwd, hipFuncAttributeMaxDynamicSharedMemorySize, LDS_BYTES) != hipSuccess) { fprintf(stderr, "kernel_launch: hipFuncSetAttribute failed\n"); grid = -1; return; }
        if (hipOccupancyMaxActiveBlocksPerMultiprocessor(&per_cu, (const void*)mega_fwd, NWAVES * 64, LDS_BYTES) != hipSuccess || per_cu < 1) { fprintf(stderr, "kernel_launch: occupancy query reports %d\n", per_cu); }
        (void)hipGetLastError();
        grid = cus;
    }
    if (grid < 0) return;
    if (hipMemsetAsync((char*)d_ws + WS_CTL, 0, CTL_ZERO_BYTES, stream) != hipSuccess) return;
    Args a{};
    for (int i = 0; i < 18; ++i) a.in[i] = (const float*)d_in[i];
    a.out = (float*)d_out; a.ws = (unsigned char*)d_ws;
    for (int li = 0; li < N_LAUNCHES; ++li) {
        a.ph_lo = (N_LAUNCHES == 1) ? 0 : li; a.ph_hi = (N_LAUNCHES == 1) ? NPH : li + 1; a.li = li; a.pad = 0;
        hipLaunchKernelGGL(mega_fwd, dim3(grid), dim3(NWAVES * 64), LDS_BYTES, stream, a);
        const hipError_t le = hipPeekAtLastError();
        if (le != hipSuccess) { fprintf(stderr, "kernel_launch: launch %d failed: %s\n", li, hipGetErrorName(le)); break; }
    }
}
```

```cpp
#include <hip/hip_runtime.h>
#include <cstdio>
#include <cstdint>

#ifndef MK_N_LAUNCHES
#define MK_N_LAUNCHES 1
#endif

namespace pg8 {
#define PG8_LAS __attribute__((address_space(3)))
typedef unsigned short bf16_t;
typedef short bf16x8 __attribute__((ext_vector_type(8)));
typedef float f32x4 __attribute__((ext_vector_type(4)));
typedef unsigned u32x4 __attribute__((ext_vector_type(4)));
constexpr int BM = 256, BK = 64, HALF = 128, HTB = HALF * BK * 2, STAGE_BYTES = 8 * HTB, NXCD = 8, WGM = 8;

__host__ __device__ __forceinline__ int lds_byte(int r, int c) { const int st = (r >> 4) * 2 + (c >> 5), rr = r & 15, cc = c & 31, ob = rr * 64 + cc * 2; return st * 1024 + (ob ^ (((ob >> 9) & 1) << 5)); }
__host__ __device__ __forceinline__ void stage_rc(int b, int& R, int& C) { const int st = b / 1024, sb = b % 1024, swz = sb ^ (((sb >> 9) & 1) << 5); R = (st >> 1) * 16 + swz / 64; C = (st & 1) * 32 + (swz % 64) / 2; }
__host__ __device__ __forceinline__ int perm32(int rho) { const int n = rho >> 4, i = rho & 15; return 8 * (i >> 2) + 4 * n + (i & 3); }

struct Unit { int pm, pn; size_t boff; int e, s0, cnt; };
struct Gemm { const bf16_t* A; const bf16_t* Bt; int M, N, K; };

struct StaticOrder {
    static constexpr bool GATHER = false;
    int nM, nN, nwg, G, c;
    __host__ __device__ void init(int M, int N, int G_, int c_) { nM = M / BM; nN = N / BM; nwg = nM * nN; G = G_; c = c_; }
    __host__ __device__ bool next(int i, Unit& u) const {
        const long L = (long)i * G + c; if (L >= nwg) return false;
        int wgid = (int)L; { const int q = nwg / NXCD, r = nwg % NXCD, xcd = wgid % NXCD, off = wgid / NXCD; wgid = (xcd < r ? xcd * (q + 1) : r * (q + 1) + (xcd - r) * q) + off; }
        const int nig = WGM * nN, gid = wgid / nig, fm = gid * WGM, gsz = (nM - fm) < WGM ? (nM - fm) : WGM;
        u.pm = fm + ((wgid % nig) % gsz); u.pn = (wgid % nig) / gsz; u.boff = 0; u.e = 0; u.s0 = 0; u.cnt = 0; return true;
    }
    __device__ __forceinline__ int arow(const Unit& u, int r) const { return u.pm * BM + r; }
    __device__ __forceinline__ void a_ready(const Unit&) const {}
    __device__ __forceinline__ void done(const Unit&) const {}
};
template <bool GATHER_>
struct MoeOrder {
    static constexpr bool GATHER = GATHER_;
    int nrt, NT, nwg, G, c; size_t estride; const volatile PG8_LAS int* misc; const int* list;
    int mode, r_lo, r_hi;
    __device__ __forceinline__ bool next(int i, Unit& u) const {
        int rt, pn;
        if (mode == 0) {
            const long L = (long)i * G + c; if (L >= nwg) return false;
            int wgid = (int)L; { const int q = nwg / NXCD, r = nwg % NXCD, xcd = wgid % NXCD, off = wgid / NXCD; wgid = (xcd < r ? xcd * (q + 1) : r * (q + 1) + (xcd - r) * q) + off; }
            rt = wgid / NT; pn = wgid % NT;
        } else {
            const int x = c & 7, j = c >> 3;
            if (mode == 1) { const int round = r_lo + i; if (round >= r_hi) return false; rt = 64 * round + 8 * x + (j >> 2); pn = j & 3; if (rt >= nrt) return false; }
            else {
                const int lt = nrt > 128 ? nrt - 128 : 0;
                int lightBefore = 0, nLight = 0, hcx = 0;
                for (int xx = 0; xx < 8; ++xx) { int hc = 4 * (lt - 8 * xx); hc = hc < 0 ? 0 : (hc > 32 ? 32 : hc); if (xx < x) lightBefore += 32 - hc; if (xx == x) hcx = hc; nLight += 32 - hc; }
                int u2;
                if (mode == 2) { if (j < hcx || i >= 4) return false; u2 = i * nLight + lightBefore + (j - hcx); if (u2 >= 1024) return false; }
                else u2 = (4 * nLight < 1024 ? 4 * nLight : 1024) + i * 256 + x * 32 + j;
                if (u2 >= nwg) return false;
                rt = u2 >> 3; pn = u2 & 7;
            }
        }
        u.pm = rt; u.pn = pn;
        u.e = __builtin_amdgcn_readfirstlane(misc[64 + u.pm]); u.s0 = __builtin_amdgcn_readfirstlane(misc[320 + u.pm]); u.cnt = __builtin_amdgcn_readfirstlane(misc[480 + u.e]);
        u.boff = (size_t)u.e * estride; return true;
    }
    __device__ __forceinline__ int arow(const Unit& u, int r) const { if (!GATHER_) return u.pm * BM + r; int slot = u.s0 + r; slot = slot < u.cnt ? slot : u.cnt - 1; return list[u.e * 16384 + slot] >> 1; }
    __device__ __forceinline__ void a_ready(const Unit&) const {}
    __device__ __forceinline__ void done(const Unit&) const {}
};

__device__ __forceinline__ unsigned cvt_pk_bf16(float lo, float hi) { unsigned r; asm volatile("v_cvt_pk_bf16_f32 %0, %1, %2" : "=v"(r) : "v"(lo), "v"(hi)); return r; }
__device__ __forceinline__ u32x4 pack8(const f32x4& v0, const f32x4& v1) { u32x4 w; w.x = cvt_pk_bf16(v0[0], v0[1]); w.y = cvt_pk_bf16(v0[2], v0[3]); w.z = cvt_pk_bf16(v1[0], v1[1]); w.w = cvt_pk_bf16(v1[2], v1[3]); return w; }
__device__ __forceinline__ float fexp(float x) { return __builtin_amdgcn_exp2f(x * 1.44269504089f); }
__device__ __forceinline__ float silu_f(float x) { return x * __builtin_amdgcn_rcpf(1.0f + fexp(-x)); }

struct NoPre {};
template <bool BASE_BF16>
struct EpiRes {
    static constexpr bool PERM = true, AFTER_DRAIN = false, KSCALE = false;
    const void* base; bf16_t* out; int ldc;
    typedef NoPre Pre; __device__ __forceinline__ Pre pre(const Unit&, int, int) const { return Pre{}; }
    __device__ __forceinline__ void operator()(const f32x4 (&acc)[2][2][4][2], const Unit& u, int wr, int wc, int fr, int fq, const Pre&) const {
        const int row0 = u.pm * BM + wr * 64 + fr, col0 = u.pn * BM + wc * 32 + 8 * fq;
        static_assert(BASE_BF16, "only the bf16 residual base is in use");
        u32x4 bw[4][2], pk[4][2];
#define EPIRES_LOAD(ai) do { _Pragma("unroll") for (int m = 0; m < 4; ++m) { const size_t off = (size_t)(row0 + (ai) * HALF + m * 16) * ldc + col0; \
            _Pragma("unroll") for (int bj = 0; bj < 2; ++bj) bw[m][bj] = *(const u32x4*)((const bf16_t*)base + off + bj * HALF); } asm volatile("" ::: "memory"); } while (0)
#define EPIRES_CALC(ai, m, bj) ({ const u32x4 w = bw[m][bj]; \
            const f32x4 b0 = (f32x4){__uint_as_float(w.x << 16), __uint_as_float(w.x & 0xffff0000u), __uint_as_float(w.y << 16), __uint_as_float(w.y & 0xffff0000u)}; \
            const f32x4 b1 = (f32x4){__uint_as_float(w.z << 16), __uint_as_float(w.z & 0xffff0000u), __uint_as_float(w.w << 16), __uint_as_float(w.w & 0xffff0000u)}; \
            pack8(b0 + acc[ai][bj][m][0], b1 + acc[ai][bj][m][1]); })
        EPIRES_LOAD(0);
#pragma unroll
        for (int m = 0; m < 4; ++m)
#pragma unroll
            for (int bj = 0; bj < 2; ++bj) pk[m][bj] = EPIRES_CALC(0, m, bj);
        asm volatile("" ::: "memory");
        EPIRES_LOAD(1);
#pragma unroll
        for (int m = 0; m < 4; ++m) { const size_t off = (size_t)(row0 + m * 16) * ldc + col0;
#pragma unroll
            for (int bj = 0; bj < 2; ++bj) *(u32x4*)(out + off + bj * HALF) = pk[m][bj]; }
        asm volatile("" ::: "memory");
#pragma unroll
        for (int m = 0; m < 4; ++m) { const size_t off = (size_t)(row0 + HALF + m * 16) * ldc + col0;
#pragma unroll
            for (int bj = 0; bj < 2; ++bj) *(u32x4*)(out + off + bj * HALF) = EPIRES_CALC(1, m, bj); }
        asm volatile("" ::: "memory");
#undef EPIRES_LOAD
#undef EPIRES_CALC
    }
};
struct EpiResHead {
    static constexpr bool PERM = true, AFTER_DRAIN = false, KSCALE = true;
    const bf16_t* base; bf16_t* out; int ldc; const float* SS;
    struct Pre { const PG8_LAS float* tab; };
    __device__ __forceinline__ Pre pre2(const Unit& u, PG8_LAS unsigned char* lds, int ui, int tid) const {
        PG8_LAS float* tab = (PG8_LAS float*)(lds + 131072 + (ui & 1) * 4096);
        if (tid < 256) { const size_t row = (size_t)u.pm * BM + tid; float r[4];
#pragma unroll
            for (int h = 0; h < 4; ++h) { const f32x4 p = *(const f32x4*)(SS + row * 16 + h * 4); r[h] = 1.0f / sqrtf(((p.x + p.y) + (p.z + p.w)) * (1.0f / 512.0f) + 1e-6f); }
            *(PG8_LAS f32x4*)(tab + tid * 4) = (f32x4){r[0] / r[1], r[1] / r[2], r[2] / r[3], r[3]}; }
        return Pre{tab};
    }
    __device__ __forceinline__ void kscale(f32x4 (&acc)[2][2][4][2], const Pre& pf, int b, int wr, int fr) const {
#pragma unroll
        for (int ai = 0; ai < 2; ++ai)
#pragma unroll
            for (int m = 0; m < 4; ++m) { const float f = pf.tab[(ai * HALF + wr * 64 + m * 16 + fr) * 4 + b];
#pragma unroll
                for (int bj = 0; bj < 2; ++bj)
#pragma unroll
                    for (int n = 0; n < 2; ++n) acc[ai][bj][m][n] = acc[ai][bj][m][n] * f; }
    }
    __device__ __forceinline__ void operator()(const f32x4 (&acc)[2][2][4][2], const Unit& u, int wr, int wc, int fr, int fq, const Pre& pf) const {
        const int row0 = u.pm * BM + wr * 64 + fr, col0 = u.pn * BM + wc * 32 + 8 * fq;
        u32x4 bw[4][2], pk[4][2]; float ff[4];
#define EPIRH_LOAD(ai) do { _Pragma("unroll") for (int m = 0; m < 4; ++m) { const size_t off = (size_t)(row0 + (ai) * HALF + m * 16) * ldc + col0; ff[m] = pf.tab[((ai) * HALF + wr * 64 + m * 16 + fr) * 4 + 3]; \
            _Pragma("unroll") for (int bj = 0; bj < 2; ++bj) bw[m][bj] = *(const u32x4*)(base + off + bj * HALF); } asm volatile("" ::: "memory"); } while (0)
#define EPIRH_CALC(ai, m, bj) ({ const u32x4 w = bw[m][bj]; const float f = ff[m]; \
            const f32x4 b0 = (f32x4){__uint_as_float(w.x << 16), __uint_as_float(w.x & 0xffff0000u), __uint_as_float(w.y << 16), __uint_as_float(w.y & 0xffff0000u)}; \
            const f32x4 b1 = (f32x4){__uint_as_float(w.z << 16), __uint_as_float(w.z & 0xffff0000u), __uint_as_float(w.w << 16), __uint_as_float(w.w & 0xffff0000u)}; \
            pack8(b0 + acc[ai][bj][m][0] * f, b1 + acc[ai][bj][m][1] * f); })
        EPIRH_LOAD(0);
#pragma unroll
        for (int m = 0; m < 4; ++m)
#pragma unroll
            for (int bj = 0; bj < 2; ++bj) pk[m][bj] = EPIRH_CALC(0, m, bj);
        asm volatile("" ::: "memory");
        EPIRH_LOAD(1);
#pragma unroll
        for (int m = 0; m < 4; ++m) { const size_t off = (size_t)(row0 + m * 16) * ldc + col0;
#pragma unroll
            for (int bj = 0; bj < 2; ++bj) *(u32x4*)(out + off + bj * HALF) = pk[m][bj]; }
        asm volatile("" ::: "memory");
#pragma unroll
        for (int m = 0; m < 4; ++m) { const size_t off = (size_t)(row0 + HALF + m * 16) * ldc + col0;
#pragma unroll
            for (int bj = 0; bj < 2; ++bj) *(u32x4*)(out + off + bj * HALF) = EPIRH_CALC(1, m, bj); }
        asm volatile("" ::: "memory");
#undef EPIRH_LOAD
#undef EPIRH_CALC
    }
};
struct EpiGlaIn {
    static constexpr bool PERM = true, AFTER_DRAIN = false, KSCALE = false;
    bf16_t *Qp, *Kp, *Vb, *Gb; const float* Bc; const float* rstd;
    struct Pre { float rs[2][4]; };
    __device__ __forceinline__ Pre pre(const Unit& u, int wr, int fr) const { Pre p; const int row0 = u.pm * BM + wr * 64 + fr;
#pragma unroll
        for (int ai = 0; ai < 2; ++ai)
#pragma unroll
            for (int m = 0; m < 4; ++m) p.rs[ai][m] = rstd[row0 + ai * HALF + m * 16];
        return p; }
    __device__ __forceinline__ void operator()(const f32x4 (&acc)[2][2][4][2], const Unit& u, int wr, int wc, int fr, int fq, const Pre& pf) const {
        const int row0 = u.pm * BM + wr * 64 + fr, cl = wc * 32 + 8 * fq, ct = u.pn;
        float rs[2][4];
#pragma unroll
        for (int ai = 0; ai < 2; ++ai)
#pragma unroll
            for (int m = 0; m < 4; ++m) rs[ai][m] = pf.rs[ai][m];
        if (ct < 8) {
            const bool isq = ct < 4; const int cb = (ct & 3) * 256 + cl; bf16_t* dst = isq ? Qp : Kp; const float sgn = isq ? 1.4426950408889634f : -1.4426950408889634f, mul = isq ? 0.0625f : 1.0f;
            f32x4 bb[4][2][2]; u32x4 pk[4][2];
#define EPIGI_LOAD(ai) do { _Pragma("unroll") for (int m = 0; m < 4; ++m) { const size_t ro = (size_t)(row0 + (ai) * HALF + m * 16) * 1024; \
                _Pragma("unroll") for (int bj = 0; bj < 2; ++bj) { bb[m][bj][0] = __builtin_nontemporal_load((const f32x4*)(Bc + ro + cb + bj * HALF)); bb[m][bj][1] = __builtin_nontemporal_load((const f32x4*)(Bc + ro + cb + bj * HALF + 4)); } } asm volatile("" ::: "memory"); } while (0)
#define EPIGI_CALC(ai, m, bj) ({ const float rm = rs[ai][m] * mul; f32x4 v0 = acc[ai][bj][m][0], v1 = acc[ai][bj][m][1]; \
                _Pragma("unroll") for (int j = 0; j < 4; ++j) { v0[j] *= __builtin_amdgcn_exp2f(sgn * bb[m][bj][0][j]) * rm; v1[j] *= __builtin_amdgcn_exp2f(sgn * bb[m][bj][1][j]) * rm; } pack8(v0, v1); })
            EPIGI_LOAD(0);
#pragma unroll
            for (int m = 0; m < 4; ++m)
#pragma unroll
                for (int bj = 0; bj < 2; ++bj) pk[m][bj] = EPIGI_CALC(0, m, bj);
            asm volatile("" ::: "memory");
            EPIGI_LOAD(1);
#pragma unroll
            for (int m = 0; m < 4; ++m) { const size_t ro = (size_t)(row0 + m * 16) * 1024;
#pragma unroll
                for (int bj = 0; bj < 2; ++bj) *(u32x4*)(dst + ro + cb + bj * HALF) = pk[m][bj]; }
            asm volatile("" ::: "memory");
#pragma unroll
            for (int m = 0; m < 4; ++m) { const size_t ro = (size_t)(row0 + HALF + m * 16) * 1024;
#pragma unroll
                for (int bj = 0; bj < 2; ++bj) *(u32x4*)(dst + ro + cb + bj * HALF) = EPIGI_CALC(1, m, bj); }
            asm volatile("" ::: "memory");
#undef EPIGI_LOAD
#undef EPIGI_CALC
        } else if (ct < 16) {
            const int cb = (ct - 8) * 256 + cl;
#pragma unroll
            for (int ai = 0; ai < 2; ++ai)
#pragma unroll
                for (int m = 0; m < 4; ++m) { const size_t ro = (size_t)(row0 + ai * HALF + m * 16) * 2048;
#pragma unroll
                    for (int bj = 0; bj < 2; ++bj) *(u32x4*)(Vb + ro + cb + bj * HALF) = pack8(acc[ai][bj][m][0] * rs[ai][m], acc[ai][bj][m][1] * rs[ai][m]); }
        } else {
            const int cb = (ct - 16) * 256 + cl;
#pragma unroll
            for (int ai = 0; ai < 2; ++ai)
#pragma unroll
                for (int m = 0; m < 4; ++m) { const size_t ro = (size_t)(row0 + ai * HALF + m * 16) * 2048;
#pragma unroll
                    for (int bj = 0; bj < 2; ++bj) { f32x4 v0 = acc[ai][bj][m][0] * rs[ai][m], v1 = acc[ai][bj][m][1] * rs[ai][m];
#pragma unroll
                        for (int j = 0; j < 4; ++j) { v0[j] = silu_f(v0[j]); v1[j] = silu_f(v1[j]); }
                        *(u32x4*)(Gb + ro + cb + bj * HALF) = pack8(v0, v1); } }
        }
    }
};
struct EpiConvIn {
    static constexpr bool PERM = true, AFTER_DRAIN = false, KSCALE = false;
    bf16_t *BG, *U; const float* rstd;
    struct Pre { float rs[2][4]; };
    __device__ __forceinline__ Pre pre(const Unit& u, int wr, int fr) const { Pre p; const int row0 = u.pm * BM + wr * 64 + fr;
#pragma unroll
        for (int ai = 0; ai < 2; ++ai)
#pragma unroll
            for (int m = 0; m < 4; ++m) p.rs[ai][m] = rstd[row0 + ai * HALF + m * 16];
        return p; }
    __device__ __forceinline__ void operator()(const f32x4 (&acc)[2][2][4][2], const Unit& u, int wr, int wc, int fr, int fq, const Pre& pf) const {
        const int row0 = u.pm * BM + wr * 64 + fr, cl = wc * 32 + 8 * fq, ct = u.pn;
        float rs[2][4];
#pragma unroll
        for (int ai = 0; ai < 2; ++ai)
#pragma unroll
            for (int m = 0; m < 4; ++m) rs[ai][m] = pf.rs[ai][m];
        if (ct < 8) {
            const int cb = ct * 256 + cl;
#pragma unroll
            for (int ai = 0; ai < 2; ++ai)
#pragma unroll
                for (int m = 0; m < 4; ++m) { const size_t ro = (size_t)(row0 + ai * HALF + m * 16) * 2048;
#pragma unroll
                    for (int bj = 0; bj < 2; ++bj) *(u32x4*)(BG + ro + cb + bj * HALF) = pack8(acc[ai][bj][m][0] * rs[ai][m], acc[ai][bj][m][1] * rs[ai][m]); }
        } else {
            const int cb = (ct - 8) * 128 + cl;
#pragma unroll
            for (int ai = 0; ai < 2; ++ai)
#pragma unroll
                for (int m = 0; m < 4; ++m) { const size_t ro = (size_t)(row0 + ai * HALF + m * 16) * 2048; const float r2 = rs[ai][m] * rs[ai][m];
                    *(u32x4*)(U + ro + cb) = pack8(acc[ai][0][m][0] * acc[ai][1][m][0] * r2, acc[ai][0][m][1] * acc[ai][1][m][1] * r2); }
        }
    }
};
struct EpiGateUp {
    static constexpr bool PERM = true, AFTER_DRAIN = false, KSCALE = false;
    bf16_t* ACT; const float* lrs;
    struct Pre { float rs[2][4]; };
    __device__ __forceinline__ Pre pre(const Unit& u, int wr, int fr) const { Pre p; const int rl0 = wr * 64 + fr;
#pragma unroll
        for (int ai = 0; ai < 2; ++ai)
#pragma unroll
            for (int m = 0; m < 4; ++m) { int slot = u.s0 + rl0 + ai * HALF + m * 16; slot = slot < u.cnt ? slot : u.cnt - 1; p.rs[ai][m] = lrs[u.e * 16384 + slot]; }
        return p; }
    __device__ __forceinline__ void operator()(const f32x4 (&acc)[2][2][4][2], const Unit& u, int wr, int wc, int fr, int fq, const Pre& pf) const {
        const int rl0 = wr * 64 + fr, row0 = u.pm * BM + rl0, cb = u.pn * 128 + wc * 32 + 8 * fq;
        float rs[2][4];
#pragma unroll
        for (int ai = 0; ai < 2; ++ai)
#pragma unroll
            for (int m = 0; m < 4; ++m) rs[ai][m] = pf.rs[ai][m];
#pragma unroll
        for (int ai = 0; ai < 2; ++ai)
#pragma unroll
            for (int m = 0; m < 4; ++m) { const size_t ro = (size_t)(row0 + ai * HALF + m * 16) * 512; const float r = rs[ai][m];
                f32x4 v0 = acc[ai][0][m][0] * r, v1 = acc[ai][0][m][1] * r;
#pragma unroll
                for (int j = 0; j < 4; ++j) { v0[j] = silu_f(v0[j]) * (acc[ai][1][m][0][j] * r); v1[j] = silu_f(v1[j]) * (acc[ai][1][m][1][j] * r); }
                *(u32x4*)(ACT + ro + cb) = pack8(v0, v1); }
    }
};
struct EpiDown {
    static constexpr bool PERM = true, AFTER_DRAIN = false, KSCALE = false;
    bf16_t* Y;
    typedef NoPre Pre; __device__ __forceinline__ Pre pre(const Unit&, int, int) const { return Pre{}; }
    __device__ __forceinline__ void operator()(const f32x4 (&acc)[2][2][4][2], const Unit& u, int wr, int wc, int fr, int fq, const Pre&) const {
        const int rl0 = wr * 64 + fr, row0 = u.pm * BM + rl0, cb = u.pn * 256 + wc * 32 + 8 * fq, nvalid = u.cnt - u.s0;
#pragma unroll
        for (int ai = 0; ai < 2; ++ai)
#pragma unroll
            for (int m = 0; m < 4; ++m) { if (rl0 + ai * HALF + m * 16 >= nvalid) continue; const size_t ro = (size_t)(row0 + ai * HALF + m * 16) * 2048;
#pragma unroll
                for (int bj = 0; bj < 2; ++bj) *(u32x4*)(Y + ro + cb + bj * HALF) = pack8(acc[ai][bj][m][0], acc[ai][bj][m][1]); }
    }
};

template <class Epi, class Sched, bool ALIGN_EPI = false>
__device__ __forceinline__ void gemm_phase(PG8_LAS unsigned char* lds, const Gemm g, const Sched& S, const Epi& E) {
    const int tid = threadIdx.x, wid = __builtin_amdgcn_readfirstlane(tid >> 6), lane = tid & 63, wr = wid >> 2, wc = wid & 3, fr = lane & 15, fq = lane >> 4;
    const int K = g.K, nt = K / BK;
    unsigned voffA[2], voffB[2]; int RA[2], CA[2];
#pragma unroll
    for (int i = 0; i < 2; ++i) { int R, C; stage_rc(tid * 16 + i * 8192, R, C); const int Rb = Epi::PERM ? ((R & ~31) + perm32(R & 31)) : R; RA[i] = R; CA[i] = C;
        voffA[i] = (unsigned)(R * K + C) * 2u; voffB[i] = (unsigned)(Rb * K + C) * 2u; }
    const size_t kstep = (size_t)(BK * 2);
    const size_t hstep = (size_t)HALF * K * 2;
    const size_t tstep = 2 * hstep;
    const size_t hstepA = Sched::GATHER ? 0 : hstep;
    const unsigned ldsw = (unsigned)wid * 1024u;
    const int aoff = lds_byte(wr * 64 + fr, fq * 8), boff = lds_byte(wc * 32 + fr, fq * 8);
#define PG8_SA(b, h) (((b) * 2 + (h)) * HTB)
#define PG8_SB(b, h) ((4 + (b) * 2 + (h)) * HTB)
#define PG8_STAGE(bufoff, gbase, voff) do { _Pragma("unroll") for (int _i = 0; _i < 2; ++_i) \
        __builtin_amdgcn_global_load_lds((const unsigned*)((const char*)(gbase) + (voff)[_i]), (PG8_LAS unsigned*)(lds + (bufoff) + ldsw + _i * 8192), 16, 0, 0); } while (0)
#define PG8_LDA(dst, b, h) do { _Pragma("unroll") for (int m = 0; m < 4; ++m) _Pragma("unroll") for (int k = 0; k < 2; ++k) dst[m][k] = *(const PG8_LAS bf16x8*)(lds + PG8_SA(b, h) + aoff + m * 2048 + k * 1024); } while (0)
#define PG8_LDB(dst, b, h) do { _Pragma("unroll") for (int n = 0; n < 2; ++n) _Pragma("unroll") for (int k = 0; k < 2; ++k) dst[n][k] = *(const PG8_LAS bf16x8*)(lds + PG8_SB(b, h) + boff + n * 2048 + k * 1024); } while (0)
#define PG8_MMA(ai, bj, At, Bt) do { __builtin_amdgcn_s_setprio(1); _Pragma("unroll") for (int m = 0; m < 4; ++m) _Pragma("unroll") for (int n = 0; n < 2; ++n) _Pragma("unroll") for (int k = 0; k < 2; ++k) \
        acc[ai][bj][m][n] = __builtin_amdgcn_mfma_f32_16x16x32_bf16(Bt[n][k], At[m][k], acc[ai][bj][m][n], 0, 0, 0); __builtin_amdgcn_s_setprio(0); } while (0)
#define PG8_WAIT_V(n) asm volatile("s_waitcnt vmcnt(" #n ")" ::: "memory")
#define PG8_WAIT_L(n) asm volatile("s_waitcnt lgkmcnt(" #n ")" ::: "memory")
#define PG8_BAR __builtin_amdgcn_s_barrier()
#define PG8_SCHED __builtin_amdgcn_sched_barrier(0)
    Unit cur, nxt; int ui = 0;
    if (!S.next(0, cur)) return;
    f32x4 acc[2][2][4][2];
#pragma unroll
    for (int a = 0; a < 2; ++a)
#pragma unroll
        for (int b = 0; b < 2; ++b)
#pragma unroll
            for (int m = 0; m < 4; ++m)
#pragma unroll
                for (int n = 0; n < 2; ++n) acc[a][b][m][n] = (f32x4){0.f, 0.f, 0.f, 0.f};
    bf16x8 At[4][2], B0[2][2], B1[2][2];
    unsigned vc0[2], vc1[2], vn0[2], vn1[2];
    if constexpr (Sched::GATHER) {
#pragma unroll
        for (int i = 0; i < 2; ++i) { vc0[i] = (unsigned)(S.arow(cur, RA[i]) * K + CA[i]) * 2u; vc1[i] = (unsigned)(S.arow(cur, RA[i] + HALF) * K + CA[i]) * 2u; vn0[i] = vc0[i]; vn1[i] = vc1[i]; }
    } else {
#pragma unroll
        for (int i = 0; i < 2; ++i) { vc0[i] = voffA[i]; vc1[i] = voffA[i]; vn0[i] = voffA[i]; vn1[i] = voffA[i]; }
    }
    const char* cA = Sched::GATHER ? (const char*)g.A : (const char*)g.A + (size_t)cur.pm * tstep; const char* cB = (const char*)g.Bt + cur.boff + (size_t)cur.pn * tstep;
    S.a_ready(cur);
    PG8_STAGE(PG8_SB(0, 0), cB, voffB); PG8_STAGE(PG8_SB(0, 1), cB + hstep, voffB); PG8_STAGE(PG8_SA(0, 0), cA, vc0); PG8_STAGE(PG8_SA(0, 1), cA + hstepA, vc1);
    if (wr == 1) PG8_BAR;
    PG8_WAIT_V(2); PG8_BAR;
    PG8_STAGE(PG8_SB(1, 0), cB + kstep, voffB); PG8_STAGE(PG8_SA(1, 0), cA + kstep, vc0); PG8_STAGE(PG8_SB(1, 1), cB + hstep + kstep, voffB);
    PG8_WAIT_V(6); PG8_BAR;
    for (;;) {
        typename Epi::Pre pf;
        if constexpr (Epi::KSCALE) pf = E.pre2(cur, lds, ui, tid); else pf = E.pre(cur, wr, fr);
        const bool has_next = S.next(ui + 1, nxt);
        if constexpr (Sched::GATHER) { if (has_next) {
#pragma unroll
            for (int i = 0; i < 2; ++i) { vn0[i] = (unsigned)(S.arow(nxt, RA[i]) * K + CA[i]) * 2u; vn1[i] = (unsigned)(S.arow(nxt, RA[i] + HALF) * K + CA[i]) * 2u; } } }
        const char* nA = Sched::GATHER ? (const char*)g.A : (has_next ? (const char*)g.A + (size_t)nxt.pm * tstep : cA); const char* nB = has_next ? (const char*)g.Bt + nxt.boff + (size_t)nxt.pn * tstep : cB;
        for (int t = 0; t < nt; t += 2) {
            const bool last = (t == nt - 2);
            const char* a1 = cA + (size_t)(t + 1) * kstep;
            const char* a2 = last ? nA : cA + (size_t)(t + 2) * kstep; const char* b2 = last ? nB : cB + (size_t)(t + 2) * kstep;
            const char* a3 = a2 + kstep; const char* b3 = b2 + kstep;
            unsigned w0[2], w1[2];
#pragma unroll
            for (int i = 0; i < 2; ++i) { w0[i] = (Sched::GATHER && last) ? vn0[i] : vc0[i]; w1[i] = (Sched::GATHER && last) ? vn1[i] : vc1[i]; }
            if (last && has_next) S.a_ready(nxt);
            PG8_LDB(B0, 0, 0); PG8_LDB(B1, 0, 1); PG8_SCHED; PG8_LDA(At, 0, 0); PG8_STAGE(PG8_SA(1, 1), a1 + hstepA, vc1);
            PG8_WAIT_V(8); PG8_WAIT_L(0); PG8_BAR; PG8_MMA(0, 0, At, B0); PG8_MMA(0, 1, At, B1); PG8_BAR; PG8_SCHED;
            PG8_LDA(At, 0, 1); PG8_STAGE(PG8_SB(0, 0), b2, voffB); PG8_STAGE(PG8_SB(0, 1), b2 + hstep, voffB); PG8_STAGE(PG8_SA(0, 0), a2, w0);
            PG8_WAIT_V(8); PG8_WAIT_L(0); PG8_BAR; PG8_MMA(1, 0, At, B0); PG8_MMA(1, 1, At, B1); PG8_BAR; PG8_SCHED;
            PG8_LDB(B0, 1, 0); PG8_LDB(B1, 1, 1); PG8_SCHED; PG8_LDA(At, 1, 0); PG8_STAGE(PG8_SA(0, 1), a2 + hstepA, w1);
            PG8_WAIT_V(8); PG8_WAIT_L(0); PG8_BAR; PG8_MMA(0, 0, At, B0); PG8_MMA(0, 1, At, B1); PG8_BAR; PG8_SCHED;
            PG8_LDA(At, 1, 1); PG8_STAGE(PG8_SB(1, 0), b3, voffB); PG8_STAGE(PG8_SB(1, 1), b3 + hstep, voffB); PG8_STAGE(PG8_SA(1, 0), a3, w0);
            PG8_WAIT_V(8); PG8_WAIT_L(0); PG8_BAR; PG8_MMA(1, 0, At, B0); PG8_MMA(1, 1, At, B1); PG8_BAR; PG8_SCHED;
            if constexpr (Epi::KSCALE) { if (((t + 2) & 7) == 0 && t + 2 < nt) { E.kscale(acc, pf, ((t + 2) >> 3) - 1, wr, fr); PG8_SCHED; } }
        }
        if constexpr (ALIGN_EPI) { if (wr == 0) PG8_BAR; }
        if constexpr (!Epi::AFTER_DRAIN) { E(acc, cur, wr, wc, fr, fq, pf); S.done(cur); }
        if (!has_next) break;
#pragma unroll
        for (int a = 0; a < 2; ++a)
#pragma unroll
            for (int b = 0; b < 2; ++b)
#pragma unroll
                for (int m = 0; m < 4; ++m)
#pragma unroll
                    for (int n = 0; n < 2; ++n) acc[a][b][m][n] = (f32x4){0.f, 0.f, 0.f, 0.f};
        cur = nxt; cA = nA; cB = nB; ++ui;
        if constexpr (Sched::GATHER) {
#pragma unroll
            for (int i = 0; i < 2; ++i) { vc0[i] = vn0[i]; vc1[i] = vn1[i]; } }
        if constexpr (ALIGN_EPI) { if (wr == 1) PG8_BAR; }
    }
    PG8_WAIT_V(0);
    if constexpr (!ALIGN_EPI) { if (wr == 0) PG8_BAR; }
    PG8_BAR;
#undef PG8_SA
#undef PG8_SB
#undef PG8_STAGE
#undef PG8_LDA
#undef PG8_LDB
#undef PG8_MMA
#undef PG8_WAIT_V
#undef PG8_WAIT_L
#undef PG8_BAR
#undef PG8_SCHED
}
}

constexpr int NWAVES = 8;
enum { PH_CONV = 0, PH_NORM0, PH_GIN, PH_GLA1, PH_GLA2, PH_HNORM, PH_GOUT, PH_MOE0  , PH_CIN = PH_MOE0 + 5, PH_CONVE, PH_COUT, PH_MOE1, NPH = PH_MOE1 + 5 };
constexpr int N_LAUNCHES = (MK_N_LAUNCHES == 1) ? 1 : NPH;

constexpr int T = 16384, D = 2048;
constexpr int KD = 1024, VD = 2048, GIN = 6160, GINM = 6144, DKH = 256, DVH = 512, NHEAD = 4, CHK = 64, NCHUNK = T / CHK, RANK = 16;
constexpr int NE = 32, FF = 512, NGRP = 4, EPG = 8, NLOG = 48;
constexpr int MAX_RT = 160;
constexpr float EPS = 1e-6f;

constexpr size_t MiB = 1u << 20;
constexpr size_t WS_CTL = 0, CTL_ZERO_BYTES = 65536;
constexpr size_t WS_SS = 1 * MiB;
constexpr size_t WS_TKE = 2 * MiB;
constexpr size_t WS_TKS = WS_TKE + 131072;
constexpr size_t WS_TKG = WS_TKS + 131072;
constexpr size_t WS_RSTD = WS_TKG + 131072;
constexpr size_t WS_LIST = 3 * MiB;
constexpr size_t WS_WRT = 5 * MiB;
constexpr size_t WS_WRH = 6 * MiB;
constexpr size_t WS_WRL = WS_WRH + 393216;
constexpr size_t WS_WGH = 7 * MiB;
constexpr size_t WS_WGL = WS_WGH + 65536;
constexpr size_t WS_WGI = 8 * MiB;
constexpr size_t WS_WGO = 32 * MiB;
constexpr size_t WS_WCI = 40 * MiB;
constexpr size_t WS_WCO = 64 * MiB;
constexpr size_t WS_WGU = 72 * MiB;
constexpr size_t WS_WDN = 328 * MiB;
constexpr size_t WS_HN = 456 * MiB;
constexpr size_t WS_BC = 520 * MiB;
constexpr size_t WS_QP = 584 * MiB;
constexpr size_t WS_KP = 616 * MiB;
constexpr size_t WS_VB = 648 * MiB;
constexpr size_t WS_GB = 712 * MiB;
constexpr size_t WS_O = 776 * MiB;
constexpr size_t WS_LRS = 776 * MiB;
constexpr size_t WS_OG = 904 * MiB;
constexpr size_t WS_H1 = 968 * MiB;
constexpr size_t WS_H2 = 1096 * MiB;
constexpr size_t WS_XS = 1224 * MiB;
constexpr size_t WS_ACT = 1384 * MiB;
constexpr size_t WS_Y = 1424 * MiB;
constexpr size_t WS_SEND = 1584 * MiB;
constexpr size_t WS_GTOT = 1616 * MiB;
constexpr size_t WS_END = 1617 * MiB;
constexpr int CW_TMO = 0, CW_CODE = 1;
constexpr int CW_BAR = 4096;
constexpr int CW_CNT = 8192;

constexpr int RING_OFF = 0, RING_BYTES = 131072;
constexpr int SCR_OFF = 131072, SCR_BYTES = 8192;
constexpr int MISC_OFF = SCR_OFF + SCR_BYTES;
constexpr int MISC_BYTES = 2048;
constexpr int LDS_BYTES = 147456;
static_assert(MISC_OFF + MISC_BYTES <= LDS_BYTES, "LDS map");
constexpr int MI_PSTART = 16, MI_NRT = 49, MI_TEXP = 64, MI_CNTL = 256, MI_BASEL = 288, MI_TSLOT = 320, MI_ECNT = 480;
static_assert(MI_TEXP == 64 && MI_TSLOT == 320 && MI_ECNT == 480, "pg8::MoeOrder reads these words by number");

#define GAS __attribute__((address_space(1)))
#define LAS __attribute__((address_space(3)))
typedef unsigned short bf16;
typedef unsigned v4u __attribute__((ext_vector_type(4)));
typedef unsigned v2u __attribute__((ext_vector_type(2)));
typedef float f32x4 __attribute__((ext_vector_type(4)));
typedef GAS unsigned gu32;
#define RLX_AGENT __ATOMIC_RELAXED, __HIP_MEMORY_SCOPE_AGENT
#define LDS_WAIT() asm volatile("s_waitcnt lgkmcnt(0)" ::: "memory")
#define VM_WAIT() asm volatile("s_waitcnt vmcnt(0)" ::: "memory")
__device__ __forceinline__ unsigned f2bf(float f) { unsigned u = __builtin_bit_cast(unsigned, f); return (u + 0x7fffu + ((u >> 16) & 1u)) >> 16; }
__device__ __forceinline__ unsigned pk2(float lo, float hi) { return f2bf(lo) | (f2bf(hi) << 16); }
__device__ __forceinline__ float bflo(unsigned w) { return __uint_as_float(w << 16); }
__device__ __forceinline__ float bfhi(unsigned w) { return __uint_as_float(w & 0xffff0000u); }
__device__ __forceinline__ f32x4 bf4lo(const v4u& w) { return (f32x4){bflo(w.x), bfhi(w.x), bflo(w.y), bfhi(w.y)}; }
__device__ __forceinline__ f32x4 bf4hi(const v4u& w) { return (f32x4){bflo(w.z), bfhi(w.z), bflo(w.w), bfhi(w.w)}; }

#define XB_TMO      128
#define XB_XCNT(j)  (256  + 64 * (j))
#define XB_XSUB(j)  (1280 + 64 * (j))
#define XB_XGEN(j)  (2304 + 64 * (j))
#define XB_TOP      3328
#define XB_TOPGEN   3392
#define XCD_BAR_WORDS 3456
#define XB_SPIN_CAP (1u << 22)
__device__ __forceinline__ unsigned xb_ld(unsigned* p)              { return __hip_atomic_load(p, __ATOMIC_RELAXED, __HIP_MEMORY_SCOPE_AGENT); }
__device__ __forceinline__ unsigned xb_add(unsigned* p, unsigned v) { return __hip_atomic_fetch_add(p, v, __ATOMIC_RELAXED, __HIP_MEMORY_SCOPE_AGENT); }
__device__ __forceinline__ unsigned xb_xcc_id() { return (unsigned)__builtin_amdgcn_s_getreg((3 << 11) | 20) & 0xFu; }
#define XB_SPIN(cond, bar) do { unsigned _sp = 0; while (cond) { __builtin_amdgcn_s_sleep(12); \
    if ((++_sp & 255u) == 0u) { if (xb_ld(&(bar)[XB_TMO])) break; if (_sp > XB_SPIN_CAP) { atomicAdd(&(bar)[XB_TMO], 1u); break; } } } } while (0)
struct XcdBarrier { unsigned* bar; unsigned x; volatile LAS unsigned* st; unsigned G; };
__device__ __forceinline__ XcdBarrier xcd_barrier_post(unsigned* bar, volatile LAS unsigned* st) {
    XcdBarrier b; b.bar = bar; b.x = xb_xcc_id(); b.st = st; b.G = gridDim.x;
    if (threadIdx.x == 0) (void)xb_add(&bar[XB_XCNT(b.x)], 1u);
    return b;
}
__device__ __forceinline__ void xcd_barrier_complete(unsigned* bar, unsigned x, unsigned G, unsigned& nloc, unsigned& nx) {
    unsigned sum, cnt, mine, sp = 0u;
    for (;;) {
        sum = 0u; cnt = 0u; mine = 0u;
#pragma unroll
        for (unsigned j = 0; j < 16; ++j) { const unsigned c = xb_ld(&bar[XB_XCNT(j)]); sum += c; cnt += (c > 0u) ? 1u : 0u; mine = (j == x) ? c : mine; }
        if (sum == G) break;
        __builtin_amdgcn_s_sleep(1);
        if ((++sp & 255u) == 0u) { if (xb_ld(&bar[XB_TMO])) break; if (sp > XB_SPIN_CAP) { atomicAdd(&bar[XB_TMO], 1u); break; } }
    }
    nloc = mine > 0u ? mine : 1u; nx = cnt > 0u ? cnt : 1u;
}
__device__ __forceinline__ void xcd_barrier(const XcdBarrier& b) {
    asm volatile("s_waitcnt vmcnt(0)" ::: "memory");
    __syncthreads();
    if (threadIdx.x == 0) {
        unsigned* bar = b.bar;
        __builtin_amdgcn_s_waitcnt(0);
        unsigned nloc = b.st[0], nx = b.st[1];
        if (nloc == 0u) { xcd_barrier_complete(bar, b.x, b.G, nloc, nx); b.st[0] = nloc; b.st[1] = nx; }
        const unsigned old = xb_add(&bar[XB_XSUB(b.x)], 1u);
        const unsigned gen = old / nloc;
        if (old + 1u == (gen + 1u) * nloc) {
            __builtin_amdgcn_fence(__ATOMIC_RELEASE, "agent");
            asm volatile("s_waitcnt vmcnt(0)" ::: "memory");
            const unsigned og = xb_add(&bar[XB_TOP], 1u);
            const unsigned tg = og / nx;
            if (og + 1u == (tg + 1u) * nx) xb_add(&bar[XB_TOPGEN], 1u);
            else XB_SPIN(xb_ld(&bar[XB_TOPGEN]) == tg, bar);
            __builtin_amdgcn_fence(__ATOMIC_ACQUIRE, "agent");
            xb_add(&bar[XB_XGEN(b.x)], 1u);
            asm volatile("s_waitcnt vmcnt(0)" ::: "memory");
        } else {
            XB_SPIN(xb_ld(&bar[XB_XGEN(b.x)]) == gen, bar);
            __builtin_amdgcn_fence(__ATOMIC_ACQUIRE, "agent");
            asm volatile("s_waitcnt vmcnt(0)" ::: "memory");
        }
    }
    __syncthreads();
}

struct Frame {
    LAS unsigned char* lds;
    volatile LAS int* MISC;
    unsigned* ctl;
    int tid, lane, wave, G;
    unsigned long long tp_t0, tp_acc;
    __attribute__((address_space(4))) const unsigned char* ka;
};
#define KIN(i) (*(const float* const __attribute__((address_space(4)))*)(F.ka + 8 * (i)))
#define KOUT   (*(float* const __attribute__((address_space(4)))*)(F.ka + 8 * 18))
#define KWS    (*(unsigned char* const __attribute__((address_space(4)))*)(F.ka + 8 * 19))
#define TPROBE_MASK 0u
#define TPROBE_MULT 4
#define TP_BEGIN(k) do { if ((TPROBE_MASK >> (k)) & 1u) { if (F.tid == 0) F.MISC[50] = (int)__builtin_amdgcn_s_memrealtime(); } } while (0)
#define TP_END(k) do { if ((TPROBE_MASK >> (k)) & 1u) { if (F.tid == 0) F.MISC[51] = F.MISC[51] + ((int)__builtin_amdgcn_s_memrealtime() - F.MISC[50]); } } while (0)
__device__ __forceinline__ float wave_sum(float v) {
#pragma unroll
    for (int o = 1; o < 64; o <<= 1) v += __shfl_xor(v, o);
    return v;
}

struct XTile { const float* W; bf16* WT; const float* ks; int K, ldw, kb, nb, kind; };
constexpr int XT_LD = 257;
__device__ __forceinline__ void xtile_load(const XTile& t, f32x4 (&v)[16], int w, int lane) {
    const float* p = t.W + (size_t)(128 * t.kb + 16 * w) * t.ldw + 256 * t.nb + 4 * lane;
#pragma unroll
    for (int i = 0; i < 16; ++i) v[i] = __builtin_nontemporal_load((const f32x4*)(p + (size_t)i * t.ldw));
}
__device__ __forceinline__ void xtile_to_lds(const XTile& t, const f32x4 (&v)[16], LAS unsigned* buf, int w, int lane) {
    float sc[16];
#pragma unroll
    for (int i = 0; i < 16; ++i) sc[i] = t.ks ? t.ks[128 * t.kb + 16 * w + i] : 1.0f;
#pragma unroll
    for (int i = 0; i < 8; ++i) { LAS unsigned* d = buf + (8 * w + i) * XT_LD + 4 * lane; const f32x4 a = v[2 * i] * sc[2 * i], b = v[2 * i + 1] * sc[2 * i + 1];
        d[0] = pk2(a.x, b.x); d[1] = pk2(a.y, b.y); d[2] = pk2(a.z, b.z); d[3] = pk2(a.w, b.w); }
}
__device__ __forceinline__ int conv_in_row(int n) { if (n < 2048) return n; const int s = (n - 2048) >> 11, f = (n - 2048) & 2047; return 2048 + 256 * (f >> 7) + 128 * s + (f & 127); }
__device__ __forceinline__ int gate_up_row(int n) { const int s = n >> 9, f = n & 511; return 256 * (f >> 7) + 128 * s + (f & 127); }

__device__ __forceinline__ XTile xtile_decode(Frame& F, int r) {
    constexpr int T_GI = 16 * 24, T_GO = 16 * 8, T_CI = 16 * 24, T_CO = 16 * 8, T_GU1 = 16 * 4, T_DN1 = 4 * 8, T_GU = T_GU1 * 64;
    bf16* WGI = (bf16*)(KWS + WS_WGI); bf16* WGO = (bf16*)(KWS + WS_WGO); bf16* WCI = (bf16*)(KWS + WS_WCI); bf16* WCO = (bf16*)(KWS + WS_WCO);
    bf16* WGU = (bf16*)(KWS + WS_WGU); bf16* WDN = (bf16*)(KWS + WS_WDN);
    XTile t; t.kind = 0; t.ks = nullptr;
    if (r < T_GI) { t.kb = r / 24; t.nb = r % 24; t.W = KIN(2); t.K = 2048; t.ldw = GIN; t.WT = WGI; t.ks = KIN(1); return t; } r -= T_GI;
    if (r < T_GO) { t.kb = r / 8; t.nb = r % 8; t.W = KIN(6); t.K = 2048; t.ldw = 2048; t.WT = WGO; return t; } r -= T_GO;
    if (r < T_CI) { t.kb = r / 24; t.nb = r % 24; t.W = KIN(7); t.K = 2048; t.ldw = 6144; t.WT = WCI; t.kind = 1; t.ks = KIN(1) + D; return t; } r -= T_CI;
    if (r < T_CO) { t.kb = r / 8; t.nb = r % 8; t.W = KIN(9); t.K = 2048; t.ldw = 2048; t.WT = WCO; return t; } r -= T_CO;
    if (r < T_GU) { const int le = r / T_GU1, q = r % T_GU1; t.kb = q / 4; t.nb = q % 4; t.W = KIN(15) + (size_t)le * 2048 * 1024; t.K = 2048; t.ldw = 1024; t.WT = WGU + (size_t)le * 1024 * 2048; t.kind = 2; t.ks = KIN(10) + (le >> 5) * D; return t; } r -= T_GU;
    { const int le = r / T_DN1, q = r % T_DN1; t.kb = q / 8; t.nb = q % 8; t.W = KIN(16) + (size_t)le * 512 * 2048; t.K = 512; t.ldw = 2048; t.WT = WDN + (size_t)le * 2048 * 512; return t; }
}
__device__ __forceinline__ void xtile_store(const XTile& t, const LAS unsigned* buf, int w, int lane) {
    const int n0 = 256 * t.nb + 32 * w, dr0 = t.kind == 1 ? conv_in_row(n0) : t.kind == 2 ? gate_up_row(n0) : n0;
    const int c = lane & 15, k0 = 128 * t.kb;
#pragma unroll
    for (int j = 0; j < 8; ++j) { const int n = (lane >> 4) + 4 * j; const LAS unsigned* s = buf + (4 * c) * XT_LD + 32 * w + n;
        v4u o; o.x = s[0]; o.y = s[XT_LD]; o.z = s[2 * XT_LD]; o.w = s[3 * XT_LD];
        __builtin_nontemporal_store(o, (v4u*)(t.WT + (size_t)(dr0 + n) * t.K + k0 + 8 * c)); }
}
__device__ __forceinline__ void p0_convert(Frame& F) {
    constexpr int NTILES = 16 * 24 + 16 * 8 + 16 * 24 + 16 * 8 + 16 * 4 * 64 + 4 * 8 * 64;
    static_assert(2 * 64 * XT_LD * 4 <= MISC_OFF, "convert LDS");
    {
        f32x4 v[16]; XTile cur, nxt; int i = 0;
        int t = blockIdx.x;
        if (t < NTILES) { cur = xtile_decode(F, t); xtile_load(cur, v, F.wave, F.lane); }
        for (; t < NTILES; t += F.G, ++i) {
            LAS unsigned* buf = (LAS unsigned*)(F.lds) + (i & 1) * 64 * XT_LD;
            xtile_to_lds(cur, v, buf, F.wave, F.lane);
            asm volatile("s_waitcnt lgkmcnt(0)" ::: "memory"); __builtin_amdgcn_s_barrier(); asm volatile("" ::: "memory");
            const bool hn = t + F.G < NTILES;
            if (hn) { nxt = xtile_decode(F, t + F.G); xtile_load(nxt, v, F.wave, F.lane); }
            asm volatile("" ::: "memory");
            xtile_store(cur, buf, F.wave, F.lane);
            if (hn) cur = nxt;
        }
        __syncthreads();
    }
    bf16* WRH = (bf16*)(KWS + WS_WRH); bf16* WRL = (bf16*)(KWS + WS_WRL);
    for (int i = blockIdx.x * 512 + F.tid; i < 2 * NLOG * 2048; i += F.G * 512) {
        const int l = i / (NLOG * 2048), c = (i / 2048) % NLOG, k = i % 2048;
        float w = 0.f;
        if (c < 4) w = KIN(11)[((size_t)l * 2048 + k) * 4 + c]; else if (c < 36) w = KIN(13)[((size_t)l * 2048 + k) * 32 + (c - 4)];
        w *= KIN(10)[l * 2048 + k];
        const unsigned h = f2bf(w); WRH[i] = (bf16)h; WRL[i] = (bf16)f2bf(w - __uint_as_float(h << 16));
    }
    bf16* WGH = (bf16*)(KWS + WS_WGH); bf16* WGL = (bf16*)(KWS + WS_WGL);
    for (int i = blockIdx.x * 512 + F.tid; i < 16 * 2048; i += F.G * 512) {
        const int k = i >> 4, r = i & 15; const float w = KIN(2)[(size_t)k * GIN + GINM + r] * KIN(1)[k];
        const unsigned h = f2bf(w); WGH[r * 2048 + k] = (bf16)h; WGL[r * 2048 + k] = (bf16)f2bf(w - __uint_as_float(h << 16));
    }
}

typedef short rb_bf16x8 __attribute__((ext_vector_type(8)));
typedef float rb_f32x2 __attribute__((ext_vector_type(2))); typedef __bf16 rb_bf16x2 __attribute__((ext_vector_type(2)));
__device__ __forceinline__ unsigned rb_cvtpk(float lo, float hi) { rb_f32x2 v = {lo, hi}; rb_bf16x2 b = __builtin_convertvector(v, rb_bf16x2); return __builtin_bit_cast(unsigned, b); }
constexpr int RB_LD = 1040;
template <int NC>
__device__ __forceinline__ void rowblock_mfma(Frame& F, const float* X, const bf16* WH, const bf16* WL, LAS float* part, LAS float* sqp, bf16* HNrows) {
    const int w = F.wave, lane = F.lane, r = lane & 15, q = lane >> 4;
    LAS unsigned char* img = F.lds;
    f32x4 acc[4][NC]; float ss[4];
#pragma unroll
    for (int rt = 0; rt < 4; ++rt) { ss[rt] = 0.f;
#pragma unroll
        for (int c = 0; c < NC; ++c) acc[rt][c] = (f32x4){0.f, 0.f, 0.f, 0.f}; }
    const GAS char* xb = (const GAS char*)X; const GAS char* whb = (const GAS char*)WH; const GAS char* wlb = (const GAS char*)WL; GAS char* hb = (GAS char*)HNrows;
    const unsigned xo = (unsigned)((8 * w) * D + 4 * lane) * 4u;
    const unsigned wo = (unsigned)(r * 2048 + w * 32 + 8 * q) * 2u;
    f32x4 xr[8]; rb_bf16x8 bh[NC], bl[NC], bhn[NC], bln[NC];
#pragma unroll
    for (int i = 0; i < 8; ++i) xr[i] = __builtin_nontemporal_load((const GAS f32x4*)(xb + i * D * 4 + xo));
#pragma unroll
    for (int c = 0; c < NC; ++c) { bhn[c] = *(const GAS rb_bf16x8*)(whb + c * 16 * 2048 * 2 + wo); bln[c] = *(const GAS rb_bf16x8*)(wlb + c * 16 * 2048 * 2 + wo); }
    __syncthreads();
#pragma unroll 1
    for (int ch = 0; ch < 8; ++ch) {
#pragma unroll
        for (int i = 0; i < 8; ++i) { *(LAS f32x4*)(img + (8 * w + i) * RB_LD + 16 * lane) = xr[i];
            const f32x4 y = xr[i]; v2u o; o.x = rb_cvtpk(y.x, y.y); o.y = rb_cvtpk(y.z, y.w); *(GAS v2u*)(hb + (8 * w + i) * D * 2 + (unsigned)(ch * 256 + 4 * lane) * 2u) = o; }
#pragma unroll
        for (int c = 0; c < NC; ++c) { bh[c] = bhn[c]; bl[c] = bln[c]; }
        asm volatile("s_waitcnt lgkmcnt(0)" ::: "memory"); __builtin_amdgcn_s_barrier(); asm volatile("" ::: "memory");
        if (ch + 1 < 8) {
#pragma unroll
            for (int i = 0; i < 8; ++i) xr[i] = __builtin_nontemporal_load((const GAS f32x4*)(xb + i * D * 4 + (xo + (ch + 1) * 1024)));
#pragma unroll
            for (int c = 0; c < NC; ++c) { bhn[c] = *(const GAS rb_bf16x8*)(whb + c * 16 * 2048 * 2 + (wo + (ch + 1) * 512)); bln[c] = *(const GAS rb_bf16x8*)(wlb + c * 16 * 2048 * 2 + (wo + (ch + 1) * 512)); }
        }
        asm volatile("" ::: "memory");
#pragma unroll
        for (int rt = 0; rt < 4; ++rt) {
            const LAS unsigned char* fp = img + (16 * rt + r) * RB_LD + w * 128 + q * 32;
            const f32x4 a = *(const LAS f32x4*)fp, b = *(const LAS f32x4*)(fp + 16);
            ss[rt] += (a.x * a.x + a.y * a.y) + (a.z * a.z + a.w * a.w) + (b.x * b.x + b.y * b.y) + (b.z * b.z + b.w * b.w);
            v4u h; h.x = rb_cvtpk(a.x, a.y); h.y = rb_cvtpk(a.z, a.w); h.z = rb_cvtpk(b.x, b.y); h.w = rb_cvtpk(b.z, b.w);
            v4u l; l.x = rb_cvtpk(a.x - bflo(h.x), a.y - bfhi(h.x)); l.y = rb_cvtpk(a.z - bflo(h.y), a.w - bfhi(h.y)); l.z = rb_cvtpk(b.x - bflo(h.z), b.y - bfhi(h.z)); l.w = rb_cvtpk(b.z - bflo(h.w), b.w - bfhi(h.w));
            const rb_bf16x8 ah = __builtin_bit_cast(rb_bf16x8, h), al = __builtin_bit_cast(rb_bf16x8, l);
#pragma unroll
            for (int c = 0; c < NC; ++c) { acc[rt][c] = __builtin_amdgcn_mfma_f32_16x16x32_bf16(ah, bh[c], acc[rt][c], 0, 0, 0); acc[rt][c] = __builtin_amdgcn_mfma_f32_16x16x32_bf16(ah, bl[c], acc[rt][c], 0, 0, 0);
                acc[rt][c] = __builtin_amdgcn_mfma_f32_16x16x32_bf16(al, bh[c], acc[rt][c], 0, 0, 0); }
        }
        asm volatile("s_waitcnt lgkmcnt(0)" ::: "memory"); __builtin_amdgcn_s_barrier(); asm volatile("" ::: "memory");
    }
#pragma unroll
    for (int rt = 0; rt < 4; ++rt) {
#pragma unroll
        for (int c = 0; c < NC; ++c)
#pragma unroll
            for (int j = 0; j < 4; ++j) part[(w * 64 + rt * 16 + 4 * q + j) * (NC * 16) + c * 16 + r] = acc[rt][c][j];
        float t = ss[rt]; t += __shfl_xor(t, 16); t += __shfl_xor(t, 32);
        if (q == 0) sqp[w * 64 + rt * 16 + r] = t;
    }
}

constexpr int RBB_LD = 528;
template <int NC>
__device__ __forceinline__ void rowblock_bf16(Frame& F, const bf16* X, const bf16* WH, const bf16* WL, LAS float* part, LAS float* sqp) {
    const int w = F.wave, lane = F.lane, r = lane & 15, q = lane >> 4;
    LAS unsigned char* img = F.lds;
    f32x4 acc[4][NC]; float ss[4];
#pragma unroll
    for (int rt = 0; rt < 4; ++rt) { ss[rt] = 0.f;
#pragma unroll
        for (int c = 0; c < NC; ++c) acc[rt][c] = (f32x4){0.f, 0.f, 0.f, 0.f}; }
    const GAS char* xb = (const GAS char*)X; const GAS char* whb = (const GAS char*)WH; const GAS char* wlb = (const GAS char*)WL;
    const int lr = lane >> 5, lc = lane & 31;
    const unsigned xo = (unsigned)((8 * w + lr) * D + 8 * lc) * 2u;
    const unsigned wo = (unsigned)(r * 2048 + w * 32 + 8 * q) * 2u;
    v4u xa[4], xb2[4]; rb_bf16x8 bh[NC], bl[NC], ha[NC], la[NC], hb[NC], lb[NC];
#define RBB_LD_X(dst, chunk) do { _Pragma("unroll") for (int i = 0; i < 4; ++i) dst[i] = *(const GAS v4u*)(xb + i * 2 * D * 2 + (xo + (chunk) * 512)); } while (0)
#define RBB_LD_W(dh, dl, chunk) do { _Pragma("unroll") for (int c = 0; c < NC; ++c) { dh[c] = *(const GAS rb_bf16x8*)(whb + c * 16 * 2048 * 2 + (wo + (chunk) * 512)); dl[c] = *(const GAS rb_bf16x8*)(wlb + c * 16 * 2048 * 2 + (wo + (chunk) * 512)); } } while (0)
#define RBB_STEP(xs, hs, ls, chunk, more) do { \
        _Pragma("unroll") for (int i = 0; i < 4; ++i) *(LAS v4u*)(img + (8 * w + 2 * i + lr) * RBB_LD + 16 * lc) = xs[i]; \
        _Pragma("unroll") for (int c = 0; c < NC; ++c) { bh[c] = hs[c]; bl[c] = ls[c]; } \
        asm volatile("s_waitcnt lgkmcnt(0)" ::: "memory"); __builtin_amdgcn_s_barrier(); asm volatile("" ::: "memory"); \
        if (more) { RBB_LD_X(xs, (chunk) + 2); RBB_LD_W(hs, ls, (chunk) + 2); } \
        asm volatile("" ::: "memory"); \
        _Pragma("unroll") for (int rt = 0; rt < 4; ++rt) { \
            const v4u a = *(const LAS v4u*)(img + (16 * rt + r) * RBB_LD + w * 64 + q * 16); \
            { const float e0 = bflo(a.x), e1 = bfhi(a.x), e2 = bflo(a.y), e3 = bfhi(a.y), e4 = bflo(a.z), e5 = bfhi(a.z), e6 = bflo(a.w), e7 = bfhi(a.w); \
              ss[rt] += (e0 * e0 + e1 * e1) + (e2 * e2 + e3 * e3) + (e4 * e4 + e5 * e5) + (e6 * e6 + e7 * e7); } \
            const rb_bf16x8 ah = __builtin_bit_cast(rb_bf16x8, a); \
            _Pragma("unroll") for (int c = 0; c < NC; ++c) { acc[rt][c] = __builtin_amdgcn_mfma_f32_16x16x32_bf16(ah, bh[c], acc[rt][c], 0, 0, 0); acc[rt][c] = __builtin_amdgcn_mfma_f32_16x16x32_bf16(ah, bl[c], acc[rt][c], 0, 0, 0); } } \
        asm volatile("s_waitcnt lgkmcnt(0)" ::: "memory"); __builtin_amdgcn_s_barrier(); asm volatile("" ::: "memory"); } while (0)
    RBB_LD_X(xa, 0); RBB_LD_W(ha, la, 0); RBB_LD_X(xb2, 1); RBB_LD_W(hb, lb, 1);
    __syncthreads();
#pragma unroll 1
    for (int ch = 0; ch < 8; ch += 2) {
        RBB_STEP(xa, ha, la, ch, ch + 2 < 8);
        RBB_STEP(xb2, hb, lb, ch + 1, ch + 3 < 8);
    }
#undef RBB_LD_X
#undef RBB_LD_W
#undef RBB_STEP
#pragma unroll
    for (int rt = 0; rt < 4; ++rt) {
#pragma unroll
        for (int c = 0; c < NC; ++c)
#pragma unroll
            for (int j = 0; j < 4; ++j) part[(w * 64 + rt * 16 + 4 * q + j) * (NC * 16) + c * 16 + r] = acc[rt][c][j];
        float t = ss[rt]; t += __shfl_xor(t, 16); t += __shfl_xor(t, 32);
        if (q == 0) sqp[w * 64 + rt * 16 + r] = t;
    }
}

__device__ __forceinline__ void p0_norm_gl(Frame& F) {
    LAS float* part = (LAS float*)(F.lds);
    LAS float* sqp = (LAS float*)(F.lds + 32768);
    LAS float* glc = (LAS float*)(F.lds + 32768 + 2048);
    LAS float* rs = (LAS float*)(F.lds + 32768 + 2048 + 4096);
    const float* x = KIN(0); const float* wn = KIN(1); bf16* HN = (bf16*)(KWS + WS_HN); float* BC = (float*)(KWS + WS_BC); float* RSTD = (float*)(KWS + WS_RSTD);
    const float* w2 = KIN(3); const float* bgk = KIN(4);
    for (int ch = blockIdx.x; ch < NCHUNK; ch += F.G) {
        TP_BEGIN(22); rowblock_mfma<1>(F, x + (size_t)ch * CHK * D, (const bf16*)(KWS + WS_WGH), (const bf16*)(KWS + WS_WGL), part, sqp, HN + (size_t)ch * CHK * D);
        __syncthreads(); TP_END(22); TP_BEGIN(23);
        if (F.tid < 64) { float t = 0.f;
#pragma unroll
            for (int w = 0; w < 8; ++w) t += sqp[w * 64 + F.tid];
            const float rstd = 1.0f / sqrtf(t * (1.0f / D) + EPS); rs[F.tid] = rstd; RSTD[ch * CHK + F.tid] = rstd; }
        __syncthreads();
#pragma unroll
        for (int i = 0; i < 2; ++i) { const int idx = F.tid + 512 * i; float t = 0.f;
#pragma unroll
            for (int w = 0; w < 8; ++w) t += part[w * 1024 + idx];
            glc[idx] = t * rs[idx >> 4]; }
        __syncthreads();
        {
            typedef float v2f __attribute__((ext_vector_type(2)));
            const int c0 = F.tid, c1 = F.tid + 512; v2f wv[16];
#pragma unroll
            for (int r = 0; r < 16; ++r) wv[r] = (v2f){w2[r * KD + c0], w2[r * KD + c1]};
            const v2f bv = (v2f){bgk[c0], bgk[c1]}; float cuma = 0.f, cumb = 0.f;
#pragma unroll 2
            for (int t = 0; t < CHK; ++t) {
                v2f z = bv;
#pragma unroll
                for (int r = 0; r < 16; ++r) { const float g = glc[t * 16 + r]; z = __builtin_elementwise_fma(wv[r], (v2f){g, g}, z); }
                const float za = z.x, zb = z.y;
                const float la = fminf(za, 0.f) - __logf(1.0f + __expf(-fabsf(za))), lb = fminf(zb, 0.f) - __logf(1.0f + __expf(-fabsf(zb)));
                cuma += la * (1.0f / 16.0f); cumb += lb * (1.0f / 16.0f);
                BC[(size_t)(ch * CHK + t) * KD + c0] = cuma; BC[(size_t)(ch * CHK + t) * KD + c1] = cumb;
            }
        }
        __syncthreads(); TP_END(23);
    }
}

__device__ __forceinline__ void ph_gla_naive(Frame& F) {
    const bf16* QP = (const bf16*)(KWS + WS_QP); const bf16* KP = (const bf16*)(KWS + WS_KP); const bf16* VB = (const bf16*)(KWS + WS_VB);
    const float* BC = (const float*)(KWS + WS_BC); float* O = (float*)(KWS + WS_O);
    for (int u = blockIdx.x; u < 128; u += F.G) {
        const int h = u >> 5, col0 = (u & 31) * 16, ds = F.tid & 31, col = F.tid >> 5;
        float R[8];
#pragma unroll
        for (int i = 0; i < 8; ++i) R[i] = 0.f;
        const bf16* qp = QP + h * DKH + ds * 8; const bf16* kp = KP + h * DKH + ds * 8; const bf16* vp = VB + h * DVH + col0 + col;
        const float* bp = BC + h * DKH + ds * 8; float* op = O + h * DVH + col0 + col;
        for (int t0 = 0; t0 < T; t0 += 8) {
            v4u kk[8], qq[8]; unsigned short vv[8];
#pragma unroll
            for (int j = 0; j < 8; ++j) { kk[j] = *(const v4u*)(kp + (size_t)(t0 + j) * KD); qq[j] = *(const v4u*)(qp + (size_t)(t0 + j) * KD); vv[j] = vp[(size_t)(t0 + j) * VD]; }
#pragma unroll
            for (int j = 0; j < 8; ++j) {
                const float v = __uint_as_float(((unsigned)vv[j]) << 16);
                float po = 0.f;
#pragma unroll
                for (int i = 0; i < 4; ++i) { const unsigned kw = kk[j][i], qw = qq[j][i];
                    R[2 * i] += bflo(kw) * v; R[2 * i + 1] += bfhi(kw) * v; po += bflo(qw) * R[2 * i] + bfhi(qw) * R[2 * i + 1]; }
                po += __shfl_xor(po, 1); po += __shfl_xor(po, 2); po += __shfl_xor(po, 4); po += __shfl_xor(po, 8); po += __shfl_xor(po, 16);
                if (ds == 0) op[(size_t)(t0 + j) * VD] = po;
            }
            if (((t0 + 8) & 63) == 0) { const f32x4 b0 = *(const f32x4*)(bp + (size_t)(t0 + 7) * KD), b1 = *(const f32x4*)(bp + (size_t)(t0 + 7) * KD + 4);
#pragma unroll
                for (int i = 0; i < 4; ++i) { R[i] *= expf(b0[i]); R[4 + i] *= expf(b1[i]); } }
        }
    }
}

namespace gla {
typedef short bf16x8 __attribute__((ext_vector_type(8)));
typedef short s16x4 __attribute__((ext_vector_type(4)));
typedef short v4i16_t __attribute__((ext_vector_type(4)));
typedef float f32x2_t __attribute__((ext_vector_type(2))); typedef __bf16 bf16x2_t __attribute__((ext_vector_type(2)));
__device__ __forceinline__ unsigned cvtpk(float lo, float hi) { f32x2_t v = {lo, hi}; bf16x2_t b = __builtin_convertvector(v, bf16x2_t); return __builtin_bit_cast(unsigned, b); }
__device__ __forceinline__ s16x4 trread(const LAS unsigned char* p) { return __builtin_bit_cast(s16x4, __builtin_amdgcn_ds_read_tr16_b64_v4i16((LAS v4i16_t*)p)); }
__device__ __forceinline__ bf16x8 cat4(s16x4 a, s16x4 b) { bf16x8 r; r[0] = a[0]; r[1] = a[1]; r[2] = a[2]; r[3] = a[3]; r[4] = b[0]; r[5] = b[1]; r[6] = b[2]; r[7] = b[3]; return r; }
constexpr int QS = 528, KS = 544, VS = 288, OS = 272, PS = 144;
constexpr int OFF_Q = 0, OFF_K = 64 * QS, OFF_V = OFF_K + 64 * KS, OFF_P = OFF_V + 64 * VS, OFF_G = OFF_P + 64 * PS, OFF_O = OFF_G + 1024, LDS_END = OFF_O + 64 * OS;
static_assert(LDS_END <= RING_BYTES, "gla LDS");
constexpr int NPART = 16, CPP = NCHUNK / NPART;
struct Stage { v4u q[4], k[4], v[2]; float g; };
template <bool NEEDQ>
__device__ __forceinline__ void issue_loads(Stage& st, const bf16* QP, const bf16* KP, const bf16* VB, const float* BC, int tok0, int h, int s, int tid, unsigned qkoff, unsigned voff) {
    const GAS char* qb = (const GAS char*)QP + (size_t)tok0 * KD * 2; const GAS char* kb = (const GAS char*)KP + (size_t)tok0 * KD * 2; const GAS char* vb = (const GAS char*)VB + (size_t)tok0 * VD * 2;
#pragma unroll
    for (int i = 0; i < 4; ++i) { if (NEEDQ) { st.q[i] = __builtin_nontemporal_load((const GAS v4u*)(qb + i * 16 * KD * 2 + qkoff)); st.k[i] = __builtin_nontemporal_load((const GAS v4u*)(kb + i * 16 * KD * 2 + qkoff)); } else st.k[i] = *(const GAS v4u*)(kb + i * 16 * KD * 2 + qkoff); }
#pragma unroll
    for (int i = 0; i < 2; ++i) st.v[i] = NEEDQ ? __builtin_nontemporal_load((const GAS v4u*)(vb + i * 32 * VD * 2 + voff)) : *(const GAS v4u*)(vb + i * 32 * VD * 2 + voff);
    st.g = *(const GAS float*)((const GAS char*)BC + (size_t)(tok0 + 63) * KD * 4 + (unsigned)(h * DKH + (tid & 255)) * 4u);
    (void)s;
}
template <bool NEEDQ>
__device__ __forceinline__ void write_stage(LAS unsigned char* lds, const Stage& st, int tid) {
#pragma unroll
    for (int i = 0; i < 4; ++i) { const int id = tid + 512 * i, row = id >> 5, cc = id & 31;
        if (NEEDQ) *(LAS v4u*)(lds + OFF_Q + row * QS + cc * 16) = st.q[i]; *(LAS v4u*)(lds + OFF_K + row * KS + ((cc * 16) ^ (((row >> 3) & 1) << 7))) = st.k[i]; }
#pragma unroll
    for (int i = 0; i < 2; ++i) { const int id = tid + 512 * i, row = id >> 4, cc = id & 15; *(LAS v4u*)(lds + OFF_V + row * VS + ((cc * 16) ^ (((row >> 3) & 1) << 7))) = st.v[i]; }
    if (tid < 256) *(LAS float*)(lds + OFF_G + 4 * tid) = expf(st.g);
}
template <int PASS>
__device__ __forceinline__ void unit(LAS unsigned char* lds, int tid, int lane, int w, int p, int h, int s, const bf16* QP, const bf16* KP, const bf16* VB, const float* BC, bf16* OG, f32x4* SEND, float* GTOT, const bf16* GB, const float* hnw, float* SS, unsigned long long& tp_t0, unsigned long long& tp_acc) {
#define GTP_BEGIN(k) do { if ((TPROBE_MASK >> (k)) & 1u) { if (tid == 0) ((volatile LAS int*)(lds + MISC_OFF))[50] = (int)__builtin_amdgcn_s_memrealtime(); } } while (0)
#define GTP_END(k) do { if ((TPROBE_MASK >> (k)) & 1u) { if (tid == 0) { volatile LAS int* m_ = (volatile LAS int*)(lds + MISC_OFF); m_[51] = m_[51] + ((int)__builtin_amdgcn_s_memrealtime() - m_[50]); } } } while (0)
    constexpr bool NQ = (PASS == 2);
    const int r = lane & 15, q = lane >> 4, qq = r >> 2, pp = r & 3;
    f32x4 S[16];
#pragma unroll
    for (int dt = 0; dt < 16; ++dt) S[dt] = (f32x4){0.f, 0.f, 0.f, 0.f};
    const int tokbase = p * CPP * CHK;
    const unsigned qkoff = (unsigned)((tid >> 5) * KD + h * DKH + (tid & 31) * 8) * 2u, voff = (unsigned)((tid >> 4) * VD + h * DVH + s * 128 + (tid & 15) * 8) * 2u;
    Stage st0, st1;
    issue_loads<NQ>(st0, QP, KP, VB, BC, tokbase, h, s, tid, qkoff, voff);
    __syncthreads();
    if (PASS == 2 && p > 0) {
        LAS int* cw = (LAS int*)(lds + OFF_P);
        if (tid == 0) *cw = 1 << 30;
        __syncthreads();
        if (tid < 256) { float prod = 1.f; int j0 = 0; for (int j = p - 1; j >= 1; --j) { prod *= GTOT[((size_t)j * 4 + h) * DKH + tid]; if (prod < 1e-30f) { j0 = j; break; } }
            __hip_atomic_fetch_min(cw, j0, __ATOMIC_RELAXED, __HIP_MEMORY_SCOPE_WORKGROUP); }
        __syncthreads();
        const int p0 = *cw;
        for (int pj = p0; pj < p; ++pj) {
            const f32x4* se = SEND + ((((size_t)pj * 4 + h) * 4 + s) * 8 + w) * 16 * 64 + lane; const float* gt = GTOT + ((size_t)pj * 4 + h) * DKH;
#pragma unroll
            for (int hf = 0; hf < 2; ++hf) {
                f32x4 gg[8], ee[8];
#pragma unroll
                for (int d8 = 0; d8 < 8; ++d8) { const int dt = 8 * hf + d8; gg[d8] = *(const f32x4*)(gt + 16 * dt + 4 * q); ee[d8] = se[dt * 64]; }
                asm volatile("" ::: "memory");
#pragma unroll
                for (int d8 = 0; d8 < 8; ++d8) { const int dt = 8 * hf + d8; S[dt] = S[dt] * gg[d8] + ee[d8]; }
                asm volatile("" ::: "memory");
            }
        }
        __syncthreads();
    }
    write_stage<NQ>(lds, st0, tid);
    if (CPP > 1) issue_loads<NQ>(st0, QP, KP, VB, BC, tokbase + CHK, h, s, tid, qkoff, voff);
    if (PASS == 1 && CPP > 2) issue_loads<NQ>(st1, QP, KP, VB, BC, tokbase + 2 * CHK, h, s, tid, qkoff, voff);
    __syncthreads();
    const LAS unsigned char* qnat = lds + OFF_Q + r * QS + q * 16;
    const int kd = ((r >> 3) & 1) << 7;
    const LAS unsigned char* knatP = lds + OFF_K + r * KS + q * 16 + kd; const LAS unsigned char* knatM = lds + OFF_K + r * KS + q * 16 - kd;
    const LAS unsigned char* qperm = lds + OFF_Q + r * QS + q * 8;
    const LAS unsigned char* qperm2 = qperm + 32; asm volatile("" : "+v"(qperm2));
    const int td = (q & 1) << 7;
    const LAS unsigned char* ktrP = lds + OFF_K + (8 * q + qq) * KS + pp * 8 + td; const LAS unsigned char* ktrM = lds + OFF_K + (8 * q + qq) * KS + pp * 8 - td;
    const LAS unsigned char* vtr = lds + OFF_V + (8 * q + qq) * VS + ((w * 32 + pp * 8) ^ td);
    const LAS unsigned char* pnat = lds + OFF_P + r * PS + q * 16;
    const LAS unsigned char* gbase = lds + OFF_G + 16 * q;
#define GLA_FENCE() asm volatile("" ::: "memory")
#define GLA_BAR() do { asm volatile("s_waitcnt lgkmcnt(0)" ::: "memory"); __builtin_amdgcn_s_barrier(); asm volatile("" ::: "memory"); } while (0)
    if (PASS == 2 && tid < 32) *(LAS f32x4*)(lds + MISC_OFF + 256 + tid * 16) = *(const f32x4*)(hnw + s * 128 + tid * 4);
#pragma unroll 1
    for (int c = 0; c < CPP; ++c) {
        const int tok0 = tokbase + c * CHK;
        bf16x8 vb[2]; v4u gpre[2];
        if (PASS == 2) GTP_BEGIN(24);
#pragma unroll
        for (int kt = 0; kt < 2; ++kt) vb[kt] = cat4(trread(vtr + kt * 32 * VS), trread(vtr + kt * 32 * VS + 4 * VS));
        if (PASS == 2) {
            const int it = w >> 1, jt0 = 2 * (w & 1);
            f32x4 pa0 = (f32x4){0.f, 0.f, 0.f, 0.f}, pa1 = pa0;
            bf16x8 fb[4], fa0[4], fa1[4];
#define P_LOAD(sl, ks) do { fb[sl] = *(const LAS bf16x8*)(qnat + it * 16 * QS + (ks) * 64); fa0[sl] = *(const LAS bf16x8*)((((ks) & 2) ? knatM : knatP) + jt0 * 16 * KS + (ks) * 64); fa1[sl] = *(const LAS bf16x8*)((((ks) & 2) ? knatM : knatP) + (jt0 + 1) * 16 * KS + (ks) * 64); } while (0)
            P_LOAD(0, 0); P_LOAD(1, 1); P_LOAD(2, 2);
#pragma unroll
            for (int ks = 0; ks < 8; ++ks) { if (ks + 3 < 8) P_LOAD((ks + 3) & 3, ks + 3); GLA_FENCE();
                pa0 = __builtin_amdgcn_mfma_f32_16x16x32_bf16(fa0[ks & 3], fb[ks & 3], pa0, 0, 0, 0); pa1 = __builtin_amdgcn_mfma_f32_16x16x32_bf16(fa1[ks & 3], fb[ks & 3], pa1, 0, 0, 0); }
#undef P_LOAD
            { const int i = 16 * it + r, j0 = 16 * jt0 + 4 * q; v2u o;
              o.x = cvtpk(j0 + 0 <= i ? pa0[0] : 0.f, j0 + 1 <= i ? pa0[1] : 0.f); o.y = cvtpk(j0 + 2 <= i ? pa0[2] : 0.f, j0 + 3 <= i ? pa0[3] : 0.f);
              *(LAS v2u*)(lds + OFF_P + i * PS + j0 * 2) = o;
              o.x = cvtpk(j0 + 16 <= i ? pa1[0] : 0.f, j0 + 17 <= i ? pa1[1] : 0.f); o.y = cvtpk(j0 + 18 <= i ? pa1[2] : 0.f, j0 + 19 <= i ? pa1[3] : 0.f);
              *(LAS v2u*)(lds + OFF_P + i * PS + (j0 + 16) * 2) = o; }
            f32x4 Oa[4];
#pragma unroll
            for (int i4 = 0; i4 < 4; ++i4) Oa[i4] = (f32x4){0.f, 0.f, 0.f, 0.f};
            bf16x8 qa[2][4];
#define Q_LOAD(sl, ks) do { _Pragma("unroll") for (int i4 = 0; i4 < 4; ++i4) qa[sl][i4] = cat4(*(const LAS s16x4*)(qperm + i4 * 16 * QS + (ks) * 64), *(const LAS s16x4*)(qperm2 + i4 * 16 * QS + (ks) * 64)); } while (0)
            Q_LOAD(0, 0); GLA_FENCE();
#pragma unroll
            for (int ks = 0; ks < 8; ++ks) {
                if (ks + 1 < 8) Q_LOAD((ks + 1) & 1, ks + 1);
                GLA_FENCE();
                v4u bw; bw.x = cvtpk(S[2 * ks][0], S[2 * ks][1]); bw.y = cvtpk(S[2 * ks][2], S[2 * ks][3]); bw.z = cvtpk(S[2 * ks + 1][0], S[2 * ks + 1][1]); bw.w = cvtpk(S[2 * ks + 1][2], S[2 * ks + 1][3]);
                const bf16x8 bfrag = __builtin_bit_cast(bf16x8, bw);
#pragma unroll
                for (int i4 = 0; i4 < 4; ++i4) Oa[i4] = __builtin_amdgcn_mfma_f32_16x16x32_bf16(bfrag, qa[ks & 1][i4], Oa[i4], 0, 0, 0);
            }
#undef Q_LOAD
            GLA_BAR();
            GTP_END(24); GTP_BEGIN(25);
#pragma unroll
            for (int i = 0; i < 2; ++i) gpre[i] = *(const GAS v4u*)((const GAS char*)GB + (size_t)tok0 * VD * 2 + i * 32 * VD * 2 + voff);
            { bf16x8 pf[6];
              pf[0] = *(const LAS bf16x8*)(pnat); pf[1] = *(const LAS bf16x8*)(pnat + 16 * PS); pf[2] = *(const LAS bf16x8*)(pnat + 32 * PS); pf[3] = *(const LAS bf16x8*)(pnat + 32 * PS + 64);
              pf[4] = *(const LAS bf16x8*)(pnat + 48 * PS); pf[5] = *(const LAS bf16x8*)(pnat + 48 * PS + 64);
              Oa[0] = __builtin_amdgcn_mfma_f32_16x16x32_bf16(vb[0], pf[0], Oa[0], 0, 0, 0); Oa[1] = __builtin_amdgcn_mfma_f32_16x16x32_bf16(vb[0], pf[1], Oa[1], 0, 0, 0);
              Oa[2] = __builtin_amdgcn_mfma_f32_16x16x32_bf16(vb[0], pf[2], Oa[2], 0, 0, 0); Oa[2] = __builtin_amdgcn_mfma_f32_16x16x32_bf16(vb[1], pf[3], Oa[2], 0, 0, 0);
              Oa[3] = __builtin_amdgcn_mfma_f32_16x16x32_bf16(vb[0], pf[4], Oa[3], 0, 0, 0); Oa[3] = __builtin_amdgcn_mfma_f32_16x16x32_bf16(vb[1], pf[5], Oa[3], 0, 0, 0); }
#pragma unroll
            for (int i4 = 0; i4 < 4; ++i4) { v2u o; o.x = cvtpk(Oa[i4][0], Oa[i4][1]); o.y = cvtpk(Oa[i4][2], Oa[i4][3]); *(LAS v2u*)(lds + OFF_O + (16 * i4 + r) * OS + (16 * w + 4 * q) * 2) = o; }
        }
        if (PASS == 2) { GTP_END(25); GTP_BEGIN(26); }
        { constexpr int RD = (PASS == 1) ? 4 : 2;
          bf16x8 ka0[RD], ka1[RD]; f32x4 gg[RD];
#define KV_LOAD(sl, dt) do { const LAS unsigned char* kb_ = (((dt) & 4) ? ktrM : ktrP) + (dt) * 32; ka0[sl] = cat4(trread(kb_), trread(kb_ + 4 * KS)); ka1[sl] = cat4(trread(kb_ + 32 * KS), trread(kb_ + 32 * KS + 4 * KS)); gg[sl] = *(const LAS f32x4*)(gbase + (dt) * 64); } while (0)
#pragma unroll
          for (int d0 = 0; d0 < RD - 1; ++d0) KV_LOAD(d0, d0);
#pragma unroll
          for (int dt = 0; dt < 16; ++dt) { if (dt + RD - 1 < 16) KV_LOAD((dt + RD - 1) % RD, dt + RD - 1); GLA_FENCE();
              S[dt] = __builtin_amdgcn_mfma_f32_16x16x32_bf16(ka0[dt % RD], vb[0], S[dt], 0, 0, 0); S[dt] = __builtin_amdgcn_mfma_f32_16x16x32_bf16(ka1[dt % RD], vb[1], S[dt], 0, 0, 0);
              S[dt] = S[dt] * gg[dt % RD]; }
#undef KV_LOAD
        }
        if (PASS == 2) { GTP_END(26); GTP_BEGIN(27); }
        GLA_BAR();
        if (PASS == 2) {
            const f32x4 hw0 = *(const LAS f32x4*)(lds + MISC_OFF + 256 + (tid & 15) * 32), hw1 = *(const LAS f32x4*)(lds + MISC_OFF + 256 + (tid & 15) * 32 + 16);
#pragma unroll
            for (int i = 0; i < 2; ++i) { const int id = tid + 512 * i, row = id >> 4, cc = id & 15;
                const v4u ov = *(const LAS v4u*)(lds + OFF_O + row * OS + cc * 16);
                const f32x4 a = bf4lo(ov), b = bf4hi(ov), ga = bf4lo(gpre[i]), gb = bf4hi(gpre[i]);
                float ss = (a.x * a.x + a.y * a.y) + (a.z * a.z + a.w * a.w) + (b.x * b.x + b.y * b.y) + (b.z * b.z + b.w * b.w);
                ss += __shfl_xor(ss, 1); ss += __shfl_xor(ss, 2); ss += __shfl_xor(ss, 4); ss += __shfl_xor(ss, 8);
                if (cc == 0) SS[(size_t)(tok0 + row) * 16 + h * 4 + s] = ss;
                const f32x4 ya = a * ga * hw0, yb = b * gb * hw1;
                v4u o; o.x = cvtpk(ya.x, ya.y); o.y = cvtpk(ya.z, ya.w); o.z = cvtpk(yb.x, yb.y); o.w = cvtpk(yb.z, yb.w);
                *(GAS v4u*)((GAS char*)OG + (size_t)tok0 * VD * 2 + i * 32 * VD * 2 + voff) = o; }
        }
        if (c + 1 < CPP) {
            if (PASS == 1) {
                if ((c & 1) == 0) { write_stage<NQ>(lds, st0, tid); if (c + 3 < CPP) issue_loads<NQ>(st0, QP, KP, VB, BC, tok0 + 3 * CHK, h, s, tid, qkoff, voff); }
                else { write_stage<NQ>(lds, st1, tid); if (c + 3 < CPP) issue_loads<NQ>(st1, QP, KP, VB, BC, tok0 + 3 * CHK, h, s, tid, qkoff, voff); }
            } else { write_stage<NQ>(lds, st0, tid); if (c + 2 < CPP) issue_loads<NQ>(st0, QP, KP, VB, BC, tok0 + 2 * CHK, h, s, tid, qkoff, voff); }
            GLA_BAR();
        }
        if (PASS == 2) GTP_END(27);
    }
#undef GLA_FENCE
#undef GLA_BAR
    if (PASS == 1) {
        f32x4* se = SEND + ((((size_t)p * 4 + h) * 4 + s) * 8 + w) * 16 * 64 + lane;
#pragma unroll
        for (int dt = 0; dt < 16; ++dt) se[dt * 64] = S[dt];
        if (s == 0 && tid < 256) { float a = 0.f; for (int c = 0; c < CPP; ++c) a += BC[(size_t)(tokbase + c * CHK + 63) * KD + h * DKH + tid]; GTOT[((size_t)p * 4 + h) * DKH + tid] = expf(a); }
    }
}
}
template <int PASS>
__device__ __forceinline__ void ph_gla(Frame& F) {
    const bf16* QP = (const bf16*)(KWS + WS_QP); const bf16* KP = (const bf16*)(KWS + WS_KP); const bf16* VB = (const bf16*)(KWS + WS_VB);
    const float* BC = (const float*)(KWS + WS_BC); bf16* OG = (bf16*)(KWS + WS_OG); f32x4* SEND = (f32x4*)(KWS + WS_SEND); float* GTOT = (float*)(KWS + WS_GTOT);
    for (int u = blockIdx.x; u < 256; u += F.G) {
        const int idx = u >> 3, s = idx & 3, ph = (u & 7) * 8 + (idx >> 2), p = ph >> 2, h = ph & 3;
        if (PASS == 1 && p == gla::NPART - 1) continue;
        gla::unit<PASS>(F.lds, F.tid, F.lane, F.wave, p, h, s, QP, KP, VB, BC, OG, SEND, GTOT, (const bf16*)(KWS + WS_GB), KIN(5), (float*)(KWS + WS_SS), F.tp_t0, F.tp_acc);
    }
}

__device__ __forceinline__ void ph_headnorm(Frame& F) {
    const bf16* O = (const bf16*)(KWS + WS_O); const bf16* GB = (const bf16*)(KWS + WS_GB); bf16* OG = (bf16*)(KWS + WS_OG); const float* hnw = KIN(5);
    const int gw = blockIdx.x * NWAVES + F.wave, NGW = F.G * NWAVES;
    const f32x4 w0 = ((const f32x4*)hnw)[2 * F.lane], w1 = ((const f32x4*)hnw)[2 * F.lane + 1];
    for (int it = gw; it < T * NHEAD; it += 4 * NGW) {
        v4u ov[4], gv[4]; size_t off[4];
#pragma unroll
        for (int k = 0; k < 4; ++k) { const int i2 = it + k * NGW; const int ic = i2 < T * NHEAD ? i2 : it; off[k] = (size_t)(ic >> 2) * VD + (ic & 3) * DVH + 8 * F.lane; ov[k] = *(const v4u*)(O + off[k]); gv[k] = *(const v4u*)(GB + off[k]); }
#pragma unroll
        for (int k = 0; k < 4; ++k) {
            const f32x4 a = bf4lo(ov[k]), b = bf4hi(ov[k]), ga = bf4lo(gv[k]), gb = bf4hi(gv[k]);
            const float ss = wave_sum((a.x * a.x + a.y * a.y) + (a.z * a.z + a.w * a.w) + (b.x * b.x + b.y * b.y) + (b.z * b.z + b.w * b.w));
            const float rstd = 1.0f / sqrtf(ss * (1.0f / DVH) + EPS);
            const f32x4 ya = a * rstd * w0 * ga, yb = b * rstd * w1 * gb;
            v4u o; o.x = pk2(ya.x, ya.y); o.y = pk2(ya.z, ya.w); o.z = pk2(yb.x, yb.y); o.w = pk2(yb.z, yb.w);
            if (it + k * NGW < T * NHEAD) *(v4u*)(OG + off[k]) = o;
        }
    }
}

__device__ __forceinline__ void ph_router(Frame& F, int layer, const bf16* H) {
    const bf16* WH = (const bf16*)(KWS + WS_WRH) + (size_t)layer * NLOG * 2048; const bf16* WL = (const bf16*)(KWS + WS_WRL) + (size_t)layer * NLOG * 2048;
    const float* wn = KIN(10) + layer * D; const float* bg = KIN(12) + layer * NGRP; const float* br = KIN(14) + layer * NE;
    bf16* HN = (bf16*)(KWS + WS_HN);
    int* TKE = (int*)(KWS + WS_TKE); int* TKS = (int*)(KWS + WS_TKS); float* TKG = (float*)(KWS + WS_TKG); int* LIST = (int*)(KWS + WS_LIST);
    unsigned* gcnt = F.ctl + CW_CNT + 2048 * layer;
    LAS float* part = (LAS float*)(F.lds);
    LAS float* sqp = (LAS float*)(F.lds + 98304);
    LAS float* lg = (LAS float*)(F.lds + 98304 + 2048);
    LAS float* rs = (LAS float*)(F.lds + 98304 + 2048 + 12288);
    LAS int* sel = (LAS int*)(F.lds + 98304 + 2048 + 12288 + 256);
    LAS float* selg = (LAS float*)(F.lds + 98304 + 2048 + 12288 + 256 + 1024);
    static_assert(98304 + 2048 + 12288 + 256 + 1024 + 512 <= RING_BYTES, "router LDS");
    volatile LAS int* cntl = F.MISC + MI_CNTL; volatile LAS int* basel = F.MISC + MI_BASEL;
    for (int blk = blockIdx.x; blk < T / 64; blk += F.G) {
        if (F.tid < 32) cntl[F.tid] = 0;
        TP_BEGIN(20); rowblock_bf16<3>(F, H + (size_t)blk * 64 * D, WH, WL, part, sqp);
        __syncthreads(); TP_END(20); TP_BEGIN(21);
        if (F.tid < 64) { float t = 0.f;
#pragma unroll
            for (int w = 0; w < 8; ++w) t += sqp[w * 64 + F.tid];
            const float rstd = 1.0f / sqrtf(t * (1.0f / D) + EPS); rs[F.tid] = rstd; ((float*)(KWS + WS_RSTD))[blk * 64 + F.tid] = rstd; }
#pragma unroll
        for (int i = 0; i < 6; ++i) { const int idx = F.tid + 512 * i; float t = 0.f;
#pragma unroll
            for (int w = 0; w < 8; ++w) t += part[w * 3072 + idx];
            lg[idx] = t; }
        __syncthreads();
        if (F.tid < 64) {
            const int rl = F.tid; const float rstd = rs[rl]; const LAS float* L = lg + rl * 48;
            float gl0 = L[0] * rstd + bg[0]; int g = 0; float gv[4]; gv[0] = gl0;
#pragma unroll
            for (int j = 1; j < 4; ++j) { gv[j] = L[j] * rstd + bg[j]; if (gv[j] > gl0) { gl0 = gv[j]; g = j; } }
            float den = 0.f;
#pragma unroll
            for (int j = 0; j < 4; ++j) den += expf(gv[j] - gl0);
            const float gp = 1.0f / den;
            float l1 = -3.0e38f, l2 = -3.0e38f; int e1 = 0, e2 = 0;
            const f32x4 bq0 = *(const f32x4*)(br + 8 * g), bq1 = *(const f32x4*)(br + 8 * g + 4);
            const float bv[8] = {bq0.x, bq0.y, bq0.z, bq0.w, bq1.x, bq1.y, bq1.z, bq1.w};
#pragma unroll
            for (int j = 0; j < 8; ++j) { const float v = L[4 + 8 * g + j] * rstd + bv[j];
                if (v > l1) { l2 = l1; e2 = e1; l1 = v; e1 = j; } else if (v > l2) { l2 = v; e2 = j; } }
            const float ex = expf(l2 - l1), p1 = 1.0f / (1.0f + ex), p2 = ex * p1;
            const int E0 = 8 * g + e1, E1 = 8 * g + e2;
            sel[rl * 4 + 0] = E0; sel[rl * 4 + 1] = E1;
            sel[rl * 4 + 2] = __hip_atomic_fetch_add((LAS int*)&cntl[E0], 1, __ATOMIC_RELAXED, __HIP_MEMORY_SCOPE_WORKGROUP); sel[rl * 4 + 3] = __hip_atomic_fetch_add((LAS int*)&cntl[E1], 1, __ATOMIC_RELAXED, __HIP_MEMORY_SCOPE_WORKGROUP);
            selg[rl * 2 + 0] = gp * p1; selg[rl * 2 + 1] = gp * p2;
        }
        __syncthreads();
        if (F.tid < 32) basel[F.tid] = (int)__hip_atomic_fetch_add(gcnt + 64 * F.tid, (unsigned)cntl[F.tid], RLX_AGENT);
        __syncthreads();
        if (F.tid < 128) {
            const int rl = F.tid >> 1, k = F.tid & 1, tk = (blk * 64 + rl) * 2 + k, e = sel[rl * 4 + k], slot = basel[e] + sel[rl * 4 + 2 + k];
            TKE[tk] = e; TKS[tk] = slot; TKG[tk] = selg[rl * 2 + k]; LIST[e * T + slot] = tk; ((float*)(KWS + WS_LRS))[e * T + slot] = rs[rl];
        }
        __syncthreads(); TP_END(21);
    }
}

__device__ __forceinline__ void moe_meta(Frame& F, int layer) {
    __syncthreads();
    if (F.tid < 64) {
        const unsigned* gcnt = F.ctl + CW_CNT + 2048 * layer;
        const int e = F.tid, c = e < NE ? (int)__hip_atomic_load(gcnt + 64 * (e & 31), RLX_AGENT) : 0, tl = e < NE ? (c + 255) >> 8 : 0;
        int sc = tl;
#pragma unroll
        for (int o = 1; o < 32; o <<= 1) { const int v = __shfl_up(sc, o); if (F.lane >= o) sc += v; }
        const int t0 = sc - tl;
        if (e < NE) { F.MISC[MI_PSTART + e] = t0 * 256; F.MISC[MI_ECNT + e] = c;
            for (int j = 0; j < tl; ++j) { F.MISC[MI_TEXP + t0 + j] = e; F.MISC[MI_TSLOT + t0 + j] = 256 * j; } }
        if (e == NE - 1) { F.MISC[MI_PSTART + NE] = sc * 256; F.MISC[MI_NRT] = sc; }
    }
    __syncthreads();
}

template <bool FINAL>
__device__ __forceinline__ void ph_combine(Frame& F, const bf16* H, bf16* Hout, const float* wn) {
    int tid_ = threadIdx.x; asm volatile("" : "+v"(tid_)); const int lane_ = tid_ & 63;
    const bf16* Y = (const bf16*)(KWS + WS_Y); const int* TKE = (const int*)(KWS + WS_TKE); const int* TKS = (const int*)(KWS + WS_TKS); const float* TKG = (const float*)(KWS + WS_TKG); float* RSTD = (float*)(KWS + WS_RSTD);
    const int gw = blockIdx.x * NWAVES + F.wave, NGW = F.G * NWAVES;
    f32x4 wv[8];
    if (FINAL) {
#pragma unroll
        for (int j = 0; j < 8; ++j) wv[j] = ((const f32x4*)wn)[lane_ + 64 * j];
    }
    for (int t = gw; t < T; t += NGW) {
        const int r0 = F.MISC[MI_PSTART + TKE[2 * t]] + TKS[2 * t], r1 = F.MISC[MI_PSTART + TKE[2 * t + 1]] + TKS[2 * t + 1]; const float g0 = TKG[2 * t], g1 = TKG[2 * t + 1];
        const v2u* hr = (const v2u*)(H + (size_t)t * D) + lane_;
        const v2u* y0 = (const v2u*)(Y + (size_t)r0 * D) + lane_; const v2u* y1 = (const v2u*)(Y + (size_t)r1 * D) + lane_;
        f32x4 v[8]; float s = 0.f;
#pragma unroll
        for (int j = 0; j < 8; ++j) { const v2u a = __builtin_nontemporal_load(y0 + 64 * j), b = __builtin_nontemporal_load(y1 + 64 * j), hh = __builtin_nontemporal_load(hr + 64 * j); f32x4 h = {bflo(hh.x), bfhi(hh.x), bflo(hh.y), bfhi(hh.y)};
            h.x += g0 * bflo(a.x) + g1 * bflo(b.x); h.y += g0 * bfhi(a.x) + g1 * bfhi(b.x); h.z += g0 * bflo(a.y) + g1 * bflo(b.y); h.w += g0 * bfhi(a.y) + g1 * bfhi(b.y);
            v[j] = h; s += (h.x * h.x + h.y * h.y) + (h.z * h.z + h.w * h.w); }
        const float rstd = 1.0f / sqrtf(wave_sum(s) * (1.0f / D) + EPS);
        if (FINAL) {
            f32x4* o = (f32x4*)(KOUT + (size_t)t * D) + lane_;
#pragma unroll
            for (int j = 0; j < 8; ++j) __builtin_nontemporal_store(v[j] * rstd * wv[j], o + 64 * j);
        } else {
            v2u* ho = (v2u*)(Hout + (size_t)t * D) + lane_;
#pragma unroll
            for (int j = 0; j < 8; ++j) { v2u o; o.x = pk2(v[j].x, v[j].y); o.y = pk2(v[j].z, v[j].w); ho[64 * j] = o; }
            if (lane_ == 0) RSTD[t] = rstd;
        }
    }
}

__device__ __forceinline__ void ph_conv(Frame& F) {
    const bf16* BG = (const bf16*)(KWS + WS_VB); const bf16* U = (const bf16*)(KWS + WS_GB); bf16* OG = (bf16*)(KWS + WS_OG); const float* cw = KIN(8);
    const int c = (F.tid & 255) * 8, rh = F.tid >> 8;
    const f32x4 wa0 = *(const f32x4*)(cw + c), wa1 = *(const f32x4*)(cw + c + 4), wb0 = *(const f32x4*)(cw + D + c), wb1 = *(const f32x4*)(cw + D + c + 4), wc0 = *(const f32x4*)(cw + 2 * D + c), wc1 = *(const f32x4*)(cw + 2 * D + c + 4);
    for (int blk = blockIdx.x; blk < T / 64; blk += F.G) {
        const int t0 = blk * 64 + rh * 32;
        const v4u zero = {0u, 0u, 0u, 0u};
        v4u p2 = t0 >= 2 ? *(const v4u*)(U + (size_t)(t0 - 2) * D + c) : zero, p1 = t0 >= 1 ? *(const v4u*)(U + (size_t)(t0 - 1) * D + c) : zero;
        f32x4 u2l = bf4lo(p2), u2h = bf4hi(p2), u1l = bf4lo(p1), u1h = bf4hi(p1);
#pragma unroll 1
        for (int tb = 0; tb < 32; tb += 8) {
            v4u uu[8], bb[8];
#pragma unroll
            for (int j = 0; j < 8; ++j) { const size_t off = (size_t)(t0 + tb + j) * D + c; uu[j] = __builtin_nontemporal_load((const v4u*)(U + off)); bb[j] = __builtin_nontemporal_load((const v4u*)(BG + off)); }
#pragma unroll
            for (int j = 0; j < 8; ++j) {
                const f32x4 u0l = bf4lo(uu[j]), u0h = bf4hi(uu[j]), bl = bf4lo(bb[j]), bh = bf4hi(bb[j]);
                const f32x4 yl = bl * (wa0 * u2l + wb0 * u1l + wc0 * u0l), yh = bh * (wa1 * u2h + wb1 * u1h + wc1 * u0h);
                v4u o; o.x = pk2(yl.x, yl.y); o.y = pk2(yl.z, yl.w); o.z = pk2(yh.x, yh.y); o.w = pk2(yh.z, yh.w);
                *(v4u*)(OG + (size_t)(t0 + tb + j) * D + c) = o;
                u2l = u1l; u2h = u1h; u1l = u0l; u1h = u0h;
            }
        }
    }
}

#ifndef PH_MASK
#define PH_MASK 0xFFFFFFFFu
#endif
#define IN(k) (((PH_MASK >> (k)) & 1u) && lo <= (k) && (k) < hi)
#define BOTH(k) (IN(k) && IN((k) + 1))
#ifndef DUP_MASK
#define DUP_MASK 0u
#endif
#define NREP(k) ((((unsigned)DUP_MASK >> (k)) & 1u) ? 2 : 1)
#define GRID_BAR() do { if (N_LAUNCHES == 1) xcd_barrier(bar); } while (0)
template <int LAYER>
__device__ __forceinline__ void moe_block(Frame& F, const int lo, const int hi, const XcdBarrier& bar) {
    constexpr int pb = LAYER ? PH_MOE1 : PH_MOE0;
    bf16* H1 = (bf16*)(KWS + WS_H1); bf16* H2 = (bf16*)(KWS + WS_H2);
    TP_BEGIN(pb + 0);
    if (IN(pb + 0)) { ph_router(F, LAYER, H1); if (BOTH(pb + 0)) GRID_BAR(); }
    TP_END(pb + 0);
    const bool split = (F.G == 256);
    TP_BEGIN(pb + 1);
    if (IN(pb + 1)) {
        moe_meta(F, LAYER);
        const int nrt = F.MISC[MI_NRT];
        pg8::Gemm g{(const bf16*)H1, (const bf16*)(KWS + WS_WGU) + (size_t)LAYER * NE * 1024 * 2048, nrt * 256, 1024, D};
        pg8::MoeOrder<true> S{nrt, 4, nrt * 4, F.G, (int)blockIdx.x, (size_t)1024 * 2048 * 2, (const volatile LAS int*)F.MISC, (const int*)(KWS + WS_LIST), split ? 1 : 0, 0, 2};
        pg8::EpiGateUp E{(bf16*)(KWS + WS_ACT), (const float*)(KWS + WS_LRS)};
        for (int rep = 0; rep < NREP(pb + 1); ++rep) { pg8::gemm_phase<pg8::EpiGateUp, pg8::MoeOrder<true>, true>(F.lds + RING_OFF, g, S, E); if (rep + 1 < NREP(pb + 1)) GRID_BAR(); }
        if (BOTH(pb + 1)) GRID_BAR();
    }
    TP_END(pb + 1);
    TP_BEGIN(pb + 2);
    if (IN(pb + 2)) {
        if (split) {
            if (N_LAUNCHES != 1) moe_meta(F, LAYER);
            const int nrt = F.MISC[MI_NRT];
            { pg8::Gemm g{(const bf16*)H1, (const bf16*)(KWS + WS_WGU) + (size_t)LAYER * NE * 1024 * 2048, nrt * 256, 1024, D};
              pg8::MoeOrder<true> S{nrt, 4, nrt * 4, F.G, (int)blockIdx.x, (size_t)1024 * 2048 * 2, (const volatile LAS int*)F.MISC, (const int*)(KWS + WS_LIST), 1, 2, 3};
              pg8::EpiGateUp E{(bf16*)(KWS + WS_ACT), (const float*)(KWS + WS_LRS)};
              pg8::gemm_phase<pg8::EpiGateUp, pg8::MoeOrder<true>, true>(F.lds + RING_OFF, g, S, E); }
            { pg8::Gemm g{(const bf16*)(KWS + WS_ACT), (const bf16*)(KWS + WS_WDN) + (size_t)LAYER * NE * 2048 * 512, nrt * 256, 2048, FF};
              pg8::MoeOrder<false> S{nrt, 8, nrt * 8, F.G, (int)blockIdx.x, (size_t)2048 * 512 * 2, (const volatile LAS int*)F.MISC, (const int*)(KWS + WS_LIST), 2, 0, 0};
              pg8::EpiDown E{(bf16*)(KWS + WS_Y)};
              pg8::gemm_phase<pg8::EpiDown, pg8::MoeOrder<false>, true>(F.lds + RING_OFF, g, S, E); }
        }
        if (BOTH(pb + 2)) GRID_BAR();
    }
    TP_END(pb + 2);
    TP_BEGIN(pb + 3);
    if (IN(pb + 3)) {
        if (N_LAUNCHES != 1) moe_meta(F, LAYER);
        const int nrt = F.MISC[MI_NRT];
        pg8::Gemm g{(const bf16*)(KWS + WS_ACT), (const bf16*)(KWS + WS_WDN) + (size_t)LAYER * NE * 2048 * 512, nrt * 256, 2048, FF};
        pg8::MoeOrder<false> S{nrt, 8, nrt * 8, F.G, (int)blockIdx.x, (size_t)2048 * 512 * 2, (const volatile LAS int*)F.MISC, (const int*)(KWS + WS_LIST), split ? 3 : 0, 0, 0};
        pg8::EpiDown E{(bf16*)(KWS + WS_Y)};
        for (int rep = 0; rep < NREP(pb + 3); ++rep) { pg8::gemm_phase<pg8::EpiDown, pg8::MoeOrder<false>, true>(F.lds + RING_OFF, g, S, E); if (rep + 1 < NREP(pb + 3)) GRID_BAR(); }
        if (BOTH(pb + 3)) GRID_BAR();
    }
    TP_END(pb + 3);
    TP_BEGIN(pb + 4);
    if (IN(pb + 4)) {
        if (N_LAUNCHES != 1) moe_meta(F, LAYER);
        if (LAYER == 0) { for (int rep = 0; rep < NREP(pb + 4); ++rep) { ph_combine<false>(F, H1, H2, nullptr); if (rep + 1 < NREP(pb + 4)) GRID_BAR(); } if (BOTH(pb + 4)) GRID_BAR(); }
        else for (int rep = 0; rep < NREP(pb + 4); ++rep) { ph_combine<true>(F, H1, nullptr, KIN(17)); if (rep + 1 < NREP(pb + 4)) GRID_BAR(); }
    }
    TP_END(pb + 4);
}

struct Args { const float* in[18]; float* out; unsigned char* ws; int ph_lo, ph_hi, li, pad; };
__global__ void __launch_bounds__(NWAVES * 64, 2) mega_fwd(Args args) {
    extern __shared__ __attribute__((aligned(16))) unsigned char lds[];
    Frame F;
    F.lds = (LAS unsigned char*)lds;
    F.MISC = (volatile LAS int*)(F.lds + MISC_OFF);
    F.tid = threadIdx.x; F.lane = F.tid & 63; F.wave = __builtin_amdgcn_readfirstlane(F.tid >> 6);
    F.G = gridDim.x; F.tp_t0 = 0; F.tp_acc = 0;
    F.ka = (__attribute__((address_space(4))) const unsigned char*)__builtin_amdgcn_kernarg_segment_ptr();
    F.ctl = (unsigned*)(args.ws + WS_CTL);
    for (int u = F.tid; u < MISC_BYTES / 4; u += NWAVES * 64) F.MISC[u] = 0;
    __syncthreads();
    XcdBarrier bar; bar.bar = F.ctl + CW_BAR; bar.x = 0; bar.st = nullptr; bar.G = F.G;
    if (N_LAUNCHES == 1) bar = xcd_barrier_post(F.ctl + CW_BAR, (volatile LAS unsigned*)(F.MISC + 8));
    const int lo = args.ph_lo, hi = args.ph_hi;
    bf16* HN = (bf16*)(KWS + WS_HN); bf16* H1 = (bf16*)(KWS + WS_H1); bf16* H2 = (bf16*)(KWS + WS_H2);

    TP_BEGIN(PH_CONV);
    if (IN(PH_CONV)) { for (int rep = 0; rep < NREP(PH_CONV); ++rep) { p0_convert(F); if (rep + 1 < NREP(PH_CONV)) GRID_BAR(); } if (BOTH(PH_CONV)) GRID_BAR(); }
    TP_END(PH_CONV);
    TP_BEGIN(PH_NORM0);
    if (IN(PH_NORM0)) { for (int rep = 0; rep < NREP(PH_NORM0); ++rep) { p0_norm_gl(F); if (rep + 1 < NREP(PH_NORM0)) GRID_BAR(); } if (BOTH(PH_NORM0)) GRID_BAR(); }
    TP_END(PH_NORM0);
    TP_BEGIN(PH_GIN);
    if (IN(PH_GIN)) {
        pg8::Gemm g{HN, (const bf16*)(KWS + WS_WGI), T, GINM, D}; pg8::StaticOrder S; S.init(T, GINM, F.G, (int)blockIdx.x);
        pg8::EpiGlaIn E{(bf16*)(KWS + WS_QP), (bf16*)(KWS + WS_KP), (bf16*)(KWS + WS_VB), (bf16*)(KWS + WS_GB), (const float*)(KWS + WS_BC), (const float*)(KWS + WS_RSTD)};
        for (int rep = 0; rep < NREP(PH_GIN); ++rep) { pg8::gemm_phase<pg8::EpiGlaIn, pg8::StaticOrder, true>(F.lds + RING_OFF, g, S, E); if (rep + 1 < NREP(PH_GIN)) GRID_BAR(); }
        if (BOTH(PH_GIN)) GRID_BAR();
    }
    TP_END(PH_GIN);
    TP_BEGIN(PH_GLA1);
    if (IN(PH_GLA1)) { for (int rep = 0; rep < NREP(PH_GLA1); ++rep) { ph_gla<1>(F); if (rep + 1 < NREP(PH_GLA1)) GRID_BAR(); } if (BOTH(PH_GLA1)) GRID_BAR(); }
    TP_END(PH_GLA1);
    TP_BEGIN(PH_GLA2);
    if (IN(PH_GLA2)) { for (int rep = 0; rep < NREP(PH_GLA2); ++rep) { ph_gla<2>(F); if (rep + 1 < NREP(PH_GLA2)) GRID_BAR(); } if (BOTH(PH_GLA2)) GRID_BAR(); }
    TP_END(PH_GLA2);
    TP_BEGIN(PH_HNORM);
    if (IN(PH_HNORM)) { }
    TP_END(PH_HNORM);
    TP_BEGIN(PH_GOUT);
    if (IN(PH_GOUT)) {
        pg8::Gemm g{(const bf16*)(KWS + WS_OG), (const bf16*)(KWS + WS_WGO), T, D, D}; pg8::StaticOrder S; S.init(T, D, F.G, (int)blockIdx.x);
        pg8::EpiResHead E{HN, H1, D, (const float*)(KWS + WS_SS)};
        for (int rep = 0; rep < NREP(PH_GOUT); ++rep) { pg8::gemm_phase<pg8::EpiResHead, pg8::StaticOrder, true>(F.lds + RING_OFF, g, S, E); if (rep + 1 < NREP(PH_GOUT)) GRID_BAR(); }
        if (BOTH(PH_GOUT)) GRID_BAR();
    }
    TP_END(PH_GOUT);
    moe_block<0>(F, lo, hi, bar);
    TP_BEGIN(PH_CIN);
    if (IN(PH_CIN)) {
        pg8::Gemm g{H2, (const bf16*)(KWS + WS_WCI), T, 6144, D}; pg8::StaticOrder S; S.init(T, 6144, F.G, (int)blockIdx.x);
        pg8::EpiConvIn E{(bf16*)(KWS + WS_VB), (bf16*)(KWS + WS_GB), (const float*)(KWS + WS_RSTD)};
        for (int rep = 0; rep < NREP(PH_CIN); ++rep) { pg8::gemm_phase<pg8::EpiConvIn, pg8::StaticOrder, true>(F.lds + RING_OFF, g, S, E); if (rep + 1 < NREP(PH_CIN)) GRID_BAR(); }
        if (BOTH(PH_CIN)) GRID_BAR();
    }
    TP_END(PH_CIN);
    TP_BEGIN(PH_CONVE);
    if (IN(PH_CONVE)) { for (int rep = 0; rep < NREP(PH_CONVE); ++rep) { ph_conv(F); if (rep + 1 < NREP(PH_CONVE)) GRID_BAR(); } if (BOTH(PH_CONVE)) GRID_BAR(); }
    TP_END(PH_CONVE);
    TP_BEGIN(PH_COUT);
    if (IN(PH_COUT)) {
        pg8::Gemm g{(const bf16*)(KWS + WS_OG), (const bf16*)(KWS + WS_WCO), T, D, D}; pg8::StaticOrder S; S.init(T, D, F.G, (int)blockIdx.x);
        pg8::EpiRes<true> E{H2, H1, D};
        for (int rep = 0; rep < NREP(PH_COUT); ++rep) { pg8::gemm_phase<pg8::EpiRes<true>, pg8::StaticOrder, true>(F.lds + RING_OFF, g, S, E); if (rep + 1 < NREP(PH_COUT)) GRID_BAR(); }
        if (BOTH(PH_COUT)) GRID_BAR();
    }
    TP_END(PH_COUT);
    moe_block<1>(F, lo, hi, bar);
    if (TPROBE_MASK != 0u && blockIdx.x == 0 && F.tid == 0) { const unsigned long long t0 = __builtin_amdgcn_s_memrealtime(), w = (unsigned long long)(unsigned)F.MISC[51] * TPROBE_MULT; while (__builtin_amdgcn_s_memrealtime() - t0 < w) __builtin_amdgcn_s_sleep(8); }
#undef IN
#undef BOTH
#undef GRID_BAR
}

extern "C" void kernel_launch(void* const* d_in, const int* in_sizes, int n_in, void* d_out, int out_size, void* d_ws, size_t ws_size, hipStream_t stream) {
    static int grid = 0;
    if (grid == 0) {
        if (n_in != 18 || in_sizes[0] != T * D || out_size != T * D || ws_size < WS_END) { fprintf(stderr, "kernel_launch: unexpected shapes (n_in %d, in0 %d, out %d, ws %zu)\n", n_in, n_in > 0 ? in_sizes[0] : -1, out_size, ws_size); grid = -1; return; }
        int dev = 0, cus = 0, per_cu = 0;
        if (hipGetDevice(&dev) != hipSuccess || hipDeviceGetAttribute(&cus, hipDeviceAttributeMultiprocessorCount, dev) != hipSuccess) { grid = -1; return; }
        if (hipFuncSetAttribute((const void*)mega_fwd, hipFuncAttributeMaxDynamicSharedMemorySize, LDS_BYTES) != hipSuccess) { fprintf(stderr, "kernel_launch: hipFuncSetAttribute failed\n"); grid = -1; return; }
        if (hipOccupancyMaxActiveBlocksPerMultiprocessor(&per_cu, (const void*)mega_fwd, NWAVES * 64, LDS_BYTES) != hipSuccess || per_cu < 1) { fprintf(stderr, "kernel_launch: occupancy query reports %d\n", per_cu); }
        (void)hipGetLastError();
        grid = cus;
    }
    if (grid < 0) return;
    if (hipMemsetAsync((char*)d_ws + WS_CTL, 0, CTL_ZERO_BYTES, stream) != hipSuccess) return;
    Args a{};
    for (int i = 0; i < 18; ++i) a.in[i] = (const float*)d_in[i];
    a.out = (float*)d_out; a.ws = (unsigned char*)d_ws;
    for (int li = 0; li < N_LAUNCHES; ++li) {
        a.ph_lo = (N_LAUNCHES == 1) ? 0 : li; a.ph_hi = (N_LAUNCHES == 1) ? NPH : li + 1; a.li = li; a.pad = 0;
        hipLaunchKernelGGL(mega_fwd, dim3(grid), dim3(NWAVES * 64), LDS_BYTES, stream, a);
        const hipError_t le = hipPeekAtLastError();
        if (le != hipSuccess) { fprintf(stderr, "kernel_launch: launch %d failed: %s\n", li, hipGetErrorName(le)); break; }
    }
}
```
